# Optimizing an MI355X kernel written in HIP

```python
import math
import numpy as np
import jax
import jax.numpy as jnp
from jax import lax

D_MODEL = 1024
BATCH = 2
SEQ = 8192
DEPTH = 1

GRID_W = 64
CTX_LEN = 256

RWKV_HEADS = 8
RWKV_HEAD_DIM = 64
RWKV_WIDTH = RWKV_HEADS * RWKV_HEAD_DIM
DECAY_LORA = 64
ICLR_LORA = 64
GATE_LORA = 128
GN_EPS = 64e-5
RWKV_SPLIT = [RWKV_WIDTH, RWKV_WIDTH, RWKV_WIDTH, DECAY_LORA, ICLR_LORA, GATE_LORA]
RWKV_COLS = sum(RWKV_SPLIT)

MLA_HEADS = 4
QK_NOPE_DIM = 128
QK_ROPE_DIM = 64
QK_HEAD_DIM = QK_NOPE_DIM + QK_ROPE_DIM
V_HEAD_DIM = 128
Q_LORA_RANK = 256
KV_LORA_RANK = 128
MLA_WIDTH = MLA_HEADS * V_HEAD_DIM
MLA_SPLIT = [Q_LORA_RANK, KV_LORA_RANK, QK_ROPE_DIM]
MLA_COLS = sum(MLA_SPLIT)
ROPE_THETA = 10000.0
ROPE_FREQS = QK_ROPE_DIM // 4
Q_BLOCK = 128

IN_COLS = RWKV_COLS + MLA_COLS
MIX_WIDTH = RWKV_WIDTH + MLA_WIDTH

N_EXPERTS = 32
TOP_K = 4
D_EXPERT = D_MODEL
SWIGLU_ALPHA = 1.702
SWIGLU_LIMIT = 7.0
EXPERT_BLOCK = 128

RMS_EPS = 1e-6
N_MOD = 6

kernel_name = "hybrid_rwkv7_mla_moe_dit_block"


def rmsnorm(x, g):
    xf = x.astype(jnp.float32)
    y = xf * lax.rsqrt(jnp.mean(xf * xf, axis=-1, keepdims=True) + RMS_EPS)
    return (y * g.astype(jnp.float32)).astype(x.dtype)


def adaln(cvec, w_mod, b_mod, n):
    m = jax.nn.silu(cvec) @ w_mod[:, : n * D_MODEL] + b_mod[: n * D_MODEL]
    return jnp.split(m, n, axis=-1)


def modulate(h, shift, scale):
    return h * (1.0 + scale) + shift


def split_cols(p, sizes):
    return jnp.split(p, np.cumsum(sizes)[:-1].tolist(), axis=-1)


def centred_shift(p, mu):
    pad = jnp.pad(p, ((0, 0), (1, 1), (0, 0)))
    return p + mu * (0.5 * (pad[:, :-2] + pad[:, 2:]) - p)


def to_heads(t):
    return t.reshape(t.shape[:-1] + (RWKV_HEADS, RWKV_HEAD_DIM))


def rwkv_prepare(p, mu, w0, w2, a0, a2, k_k, k_a):
    r, k, v, xw, xa, xg = split_cols(centred_shift(p, mu), RWKV_SPLIT)
    wl = (w0[:, None, None, :] + jnp.einsum("btl,dlc->dbtc", jnp.tanh(xw), w2)).astype(jnp.float32)
    decay = jnp.exp(-jnp.exp(-jax.nn.softplus(-wl) - 0.5))
    a = jax.nn.sigmoid((a0[:, None, None, :] + jnp.einsum("btl,dlc->dbtc", xa, a2)).astype(jnp.float32))
    kk = to_heads((k * k_k).astype(jnp.float32))
    kk = kk * lax.rsqrt(jnp.maximum(jnp.sum(kk * kk, axis=-1, keepdims=True), 1e-24))
    k_dir = k.astype(jnp.float32)[None] * (1.0 + (a - 1.0) * k_a.astype(jnp.float32))
    return {"r": to_heads(r.astype(jnp.float32)), "k": to_heads(k_dir), "v": to_heads(v.astype(jnp.float32)),
            "kk": kk, "a": to_heads(a), "decay": to_heads(decay), "xg": xg}


def both_dirs(t):
    return jnp.broadcast_to(t[None], (2,) + t.shape)


def time_major(t):
    t = jnp.stack([t[0], jnp.flip(t[1], axis=1)])
    return jnp.moveaxis(t, 2, 0)


def from_time_major(o):
    o = jnp.moveaxis(o, 0, 2)
    return o[0] + jnp.flip(o[1], axis=1)


def scan_operands(prep):
    return (time_major(prep["decay"]), time_major(prep["k"]), time_major(both_dirs(prep["v"])),
            time_major(both_dirs(prep["kk"])), time_major(prep["a"]))


def wkv_update(S, w_t, k_t, v_t, kk_t, a_t):
    sa = jnp.einsum("dbhvk,dbhk->dbhv", S, kk_t)
    return S * w_t[..., None, :] - sa[..., :, None] * (kk_t * a_t)[..., None, :] + v_t[..., :, None] * k_t[..., None, :]


def wkv_final_state(S0, ops):
    def step(S, inp):
        return wkv_update(S, *inp), None
    S, _ = lax.scan(step, S0, ops)
    return S


def wkv_outputs(S0, r, ops):
    def step(S, inp):
        r_t, rest = inp
        S = wkv_update(S, *rest)
        return S, jnp.einsum("dbhvk,dbhk->dbhv", S, r_t)
    S, out = lax.scan(step, S0, (r, ops))
    return S, from_time_major(out)


def rwkv_readout(o, prep, r_k, g2, ln_w, ln_b):
    B, T = o.shape[:2]
    mean = jnp.mean(o, axis=-1, keepdims=True)
    var = jnp.mean(jnp.square(o - mean), axis=-1, keepdims=True)
    y = ((o - mean) * lax.rsqrt(var + GN_EPS)).reshape(B, T, RWKV_WIDTH) * ln_w + ln_b
    bonus = jnp.sum(prep["r"][None] * prep["k"] * r_k, axis=(0, -1))[..., None] * prep["v"]
    g = jax.nn.sigmoid(prep["xg"]) @ g2
    return (y + bonus.reshape(B, T, RWKV_WIDTH)) * g


def rwkv_mixer(p_lat, p_ctx, mu, w0, w2, a0, a2, k_k, k_a, r_k, g2, ln_w, ln_b, ctx_out):
    lat = rwkv_prepare(p_lat, mu, w0, w2, a0, a2, k_k, k_a)
    ctx = rwkv_prepare(p_ctx, mu, w0, w2, a0, a2, k_k, k_a)
    s0 = jnp.zeros((2, p_lat.shape[0], RWKV_HEADS, RWKV_HEAD_DIM, RWKV_HEAD_DIM), jnp.float32)
    y_ctx = None
    if ctx_out:
        s_ctx, o_ctx = wkv_outputs(s0, time_major(both_dirs(ctx["r"])), scan_operands(ctx))
        y_ctx = rwkv_readout(o_ctx, ctx, r_k, g2, ln_w, ln_b).astype(p_ctx.dtype)
    else:
        s_ctx = wkv_final_state(s0, scan_operands(ctx))
    _, o_lat = wkv_outputs(s_ctx, time_major(both_dirs(lat["r"])), scan_operands(lat))
    y_lat = rwkv_readout(o_lat, lat, r_k, g2, ln_w, ln_b).astype(p_lat.dtype)
    return y_lat, y_ctx


def rope_angles(n_tok):
    n_rows = n_tok // GRID_W
    row = jnp.repeat(jnp.arange(n_rows, dtype=jnp.float32), GRID_W)
    col = jnp.tile(jnp.arange(GRID_W, dtype=jnp.float32), n_rows)
    freqs = ROPE_THETA ** (-jnp.arange(ROPE_FREQS, dtype=jnp.float32) / ROPE_FREQS)
    return jnp.stack([row[:, None] * freqs, col[:, None] * freqs], axis=1)


def axial_rope(x, ang):
    if ang is None:
        return x
    shape = x.shape
    xa = x.astype(jnp.float32).reshape(shape[:-1] + (2, 2, ROPE_FREQS))
    x1, x2 = xa[..., 0, :], xa[..., 1, :]
    bshape = (shape[1],) + (1,) * (x.ndim - 3) + (2, ROPE_FREQS)
    cos, sin = jnp.cos(ang).reshape(bshape), jnp.sin(ang).reshape(bshape)
    out = jnp.stack([x1 * cos - x2 * sin, x2 * cos + x1 * sin], axis=-2)
    return out.reshape(shape).astype(x.dtype)


def mla_keys_values(p, kv_norm, w_ukv, ang):
    B, T, _ = p.shape
    _, c_kv, k_rope = split_cols(p, MLA_SPLIT)
    kv = (rmsnorm(c_kv, kv_norm) @ w_ukv).reshape(B, T, MLA_HEADS, QK_NOPE_DIM + V_HEAD_DIM)
    k_rope = jnp.broadcast_to(axial_rope(k_rope, ang)[:, :, None, :], (B, T, MLA_HEADS, QK_ROPE_DIM))
    return jnp.concatenate([kv[..., :QK_NOPE_DIM], k_rope], axis=-1), kv[..., QK_NOPE_DIM:]


def mla_queries(p, q_norm, w_uq, ang):
    B, T, _ = p.shape
    q = (rmsnorm(p[..., :Q_LORA_RANK], q_norm) @ w_uq).reshape(B, T, MLA_HEADS, QK_HEAD_DIM)
    return jnp.concatenate([q[..., :QK_NOPE_DIM], axial_rope(q[..., QK_NOPE_DIM:], ang)], axis=-1)


def attend(q, k, v):
    s = jnp.einsum("bqhd,bkhd->bhqk", q, k, preferred_element_type=jnp.float32) / math.sqrt(QK_HEAD_DIM)
    p = jax.nn.softmax(s, axis=-1).astype(v.dtype)
    return jnp.einsum("bhqk,bkhd->bqhd", p, v)


def attend_blocked(q, k, v):
    B, T = q.shape[:2]
    qb = jnp.moveaxis(q.reshape((B, T // Q_BLOCK, Q_BLOCK) + q.shape[2:]), 1, 0)
    o = lax.map(lambda blk: attend(blk, k, v), qb)
    return jnp.moveaxis(o, 0, 1).reshape(B, T, MLA_WIDTH)


def mla_mixer(p_lat, p_ctx, q_norm, w_uq, kv_norm, w_ukv, ang, ctx_out):
    k_ctx, v_ctx = mla_keys_values(p_ctx, kv_norm, w_ukv, None)
    k_lat, v_lat = mla_keys_values(p_lat, kv_norm, w_ukv, ang)
    q_lat = mla_queries(p_lat, q_norm, w_uq, ang)
    y_lat = attend_blocked(q_lat, jnp.concatenate([k_ctx, k_lat], axis=1), jnp.concatenate([v_ctx, v_lat], axis=1))
    y_ctx = None
    if ctx_out:
        B, L, _ = p_ctx.shape
        y_ctx = attend(mla_queries(p_ctx, q_norm, w_uq, None), k_ctx, v_ctx).reshape(B, L, MLA_WIDTH)
    return y_lat, y_ctx


def moe_ffn(h, router_w, router_b, w1, b1, w2, b2):
    n_tok, d = h.shape
    n_slot = n_tok * TOP_K
    logits = (h @ router_w + router_b).astype(jnp.float32)
    top_logits, top_e = lax.top_k(logits, TOP_K)
    gates = jax.nn.softmax(top_logits, axis=-1).astype(h.dtype)
    flat_e = top_e.reshape(-1)
    order = jnp.argsort(flat_e)
    sorted_e = flat_e[order]
    counts = jnp.bincount(flat_e, length=N_EXPERTS)
    padded = (counts + EXPERT_BLOCK - 1) // EXPERT_BLOCK * EXPERT_BLOCK
    pend = jnp.cumsum(padded)
    rank = jnp.arange(n_slot) - (jnp.cumsum(counts) - counts)[sorted_e]
    dest_sorted = ((pend - padded)[sorted_e] + rank).astype(jnp.int32)
    slot_dest = jnp.zeros((n_slot,), jnp.int32).at[order].set(dest_sorted)
    n_blocks = -(-n_slot // EXPERT_BLOCK) + N_EXPERTS
    slot_tok = jnp.full((n_blocks * EXPERT_BLOCK,), n_tok, jnp.int32).at[slot_dest].set(
        jnp.arange(n_slot, dtype=jnp.int32) // TOP_K)
    block_e = jnp.minimum(jnp.searchsorted(pend, jnp.arange(n_blocks) * EXPERT_BLOCK, side="right"), N_EXPERTS - 1)
    h_pad = jnp.concatenate([h, jnp.zeros((1, d), h.dtype)], axis=0)
    xb = h_pad[slot_tok].reshape(n_blocks, EXPERT_BLOCK, d)

    def expert_block(args):
        xblk, e = args
        u = xblk @ w1[e] + b1[e]
        glu = jnp.minimum(u[:, 0::2], SWIGLU_LIMIT)
        lin = jnp.clip(u[:, 1::2], -SWIGLU_LIMIT, SWIGLU_LIMIT)
        return (glu * jax.nn.sigmoid(SWIGLU_ALPHA * glu) * (lin + 1.0)) @ w2[e] + b2[e]

    yb = lax.map(expert_block, (xb, block_e)).reshape(n_blocks * EXPERT_BLOCK, d)
    y = yb[slot_dest].reshape(n_tok, TOP_K, d)
    return jnp.einsum("nk,nkd->nd", gates, y)


def setup_inputs(seed: int = 0) -> dict:
    key = jax.random.key(seed)
    ks = iter(list(jax.random.split(key, 40)))

    def nrm(shape, s):
        return s * jax.random.normal(next(ks), shape, jnp.float32)

    D, C, L = D_MODEL, RWKV_WIDTH, DEPTH
    return {
        "x": nrm((BATCH, SEQ, D), 1.0),
        "c": nrm((BATCH, D), 1.0),
        "ctx": nrm((BATCH, CTX_LEN, D), 1.0),
        "c_ctx": nrm((D,), 1.0),
        "mod_w": nrm((L, D, N_MOD * D), 0.5 * D ** -0.5),
        "mod_b": nrm((L, N_MOD * D), 0.02),
        "norm1_g": 1.0 + nrm((L, D), 0.02),
        "w_in": nrm((L, D, IN_COLS), D ** -0.5),
        "rwkv_mu": jax.random.uniform(next(ks), (L, RWKV_COLS), jnp.float32),
        "rwkv_w0": jax.random.uniform(next(ks), (L, 2, C), jnp.float32, -6.5, -1.5),
        "rwkv_w2": nrm((L, 2, DECAY_LORA, C), 0.1),
        "rwkv_a0": nrm((L, 2, C), 0.1),
        "rwkv_a2": nrm((L, 2, ICLR_LORA, C), 0.1),
        "rwkv_k_k": 0.85 + nrm((L, C), 0.02),
        "rwkv_k_a": 1.0 + nrm((L, C), 0.02),
        "rwkv_r_k": nrm((L, RWKV_HEADS, RWKV_HEAD_DIM), 0.1),
        "rwkv_g2": nrm((L, GATE_LORA, C), GATE_LORA ** -0.5),
        "rwkv_ln_w": 1.0 + nrm((L, C), 0.02),
        "rwkv_ln_b": nrm((L, C), 0.02),
        "mla_q_norm": 1.0 + nrm((L, Q_LORA_RANK), 0.02),
        "mla_w_uq": nrm((L, Q_LORA_RANK, MLA_HEADS * QK_HEAD_DIM), Q_LORA_RANK ** -0.5),
        "mla_kv_norm": 1.0 + nrm((L, KV_LORA_RANK), 0.02),
        "mla_w_ukv": nrm((L, KV_LORA_RANK, MLA_HEADS * (QK_NOPE_DIM + V_HEAD_DIM)), KV_LORA_RANK ** -0.5),
        "w_out": nrm((L, MIX_WIDTH, D), MIX_WIDTH ** -0.5),
        "norm2_g": 1.0 + nrm((L, D), 0.02),
        "router_w": nrm((L, D, N_EXPERTS), D ** -0.5),
        "router_b": nrm((L, N_EXPERTS), 0.01),
        "exp_w1": nrm((L, N_EXPERTS, D, 2 * D_EXPERT), D ** -0.5),
        "exp_b1": nrm((L, N_EXPERTS, 2 * D_EXPERT), 0.02),
        "exp_w2": nrm((L, N_EXPERTS, D_EXPERT, D), D_EXPERT ** -0.5),
        "exp_b2": nrm((L, N_EXPERTS, D), 0.02),
        "final_norm_g": 1.0 + nrm((D,), 0.02),
    }


def reference(x, c, ctx, c_ctx, mod_w, mod_b, norm1_g, w_in, rwkv_mu, rwkv_w0, rwkv_w2, rwkv_a0, rwkv_a2,
              rwkv_k_k, rwkv_k_a, rwkv_r_k, rwkv_g2, rwkv_ln_w, rwkv_ln_b, mla_q_norm, mla_w_uq, mla_kv_norm,
              mla_w_ukv, w_out, norm2_g, router_w, router_b, exp_w1, exp_b1, exp_w2, exp_b2, final_norm_g):
    B, T, D = x.shape
    ang = rope_angles(T)
    for l in range(DEPTH):
        ctx_out = l < DEPTH - 1
        sh1, sc1, gt1, sh2, sc2, gt2 = [m[:, None, :] for m in adaln(c, mod_w[l], mod_b[l], N_MOD)]
        mc = adaln(c_ctx, mod_w[l], mod_b[l], N_MOD if ctx_out else 2)
        p_lat = modulate(rmsnorm(x, norm1_g[l]), sh1, sc1) @ w_in[l]
        p_ctx = modulate(rmsnorm(ctx, norm1_g[l]), mc[0], mc[1]) @ w_in[l]
        y_rwkv, yc_rwkv = rwkv_mixer(p_lat[..., :RWKV_COLS], p_ctx[..., :RWKV_COLS], rwkv_mu[l], rwkv_w0[l],
                                     rwkv_w2[l], rwkv_a0[l], rwkv_a2[l], rwkv_k_k[l], rwkv_k_a[l], rwkv_r_k[l],
                                     rwkv_g2[l], rwkv_ln_w[l], rwkv_ln_b[l], ctx_out)
        y_mla, yc_mla = mla_mixer(p_lat[..., RWKV_COLS:], p_ctx[..., RWKV_COLS:], mla_q_norm[l], mla_w_uq[l],
                                  mla_kv_norm[l], mla_w_ukv[l], ang, ctx_out)
        x = x + gt1 * (jnp.concatenate([y_rwkv, y_mla], axis=-1) @ w_out[l])
        h2 = modulate(rmsnorm(x, norm2_g[l]), sh2, sc2).reshape(B * T, D)
        if ctx_out:
            ctx = ctx + mc[2] * (jnp.concatenate([yc_rwkv, yc_mla], axis=-1) @ w_out[l])
            hc2 = modulate(rmsnorm(ctx, norm2_g[l]), mc[3], mc[4]).reshape(-1, D)
            f = moe_ffn(jnp.concatenate([h2, hc2], axis=0), router_w[l], router_b[l],
                        exp_w1[l], exp_b1[l], exp_w2[l], exp_b2[l])
            ctx = ctx + mc[5] * f[B * T:].reshape(ctx.shape)
            f = f[: B * T]
        else:
            f = moe_ffn(h2, router_w[l], router_b[l], exp_w1[l], exp_b1[l], exp_w2[l], exp_b2[l])
        x = x + gt2 * f.reshape(B, T, D)
    return rmsnorm(x, final_norm_g)
```

```cpp
#include <hip/hip_runtime.h>
#include <cstdio>
#include <cstring>
#include <cstdint>
#define HD __host__ __device__
#ifndef HD
#define HD
#endif
struct Dm {
  int D, B, T, GW, C, RH, LW, LA, LG, MH, DN, DR, DV, QL, KL, NE, DE;
  int RW, RC, QK, MC, IN, MIX, NF, BT, BC, NR, PADR, NPOSMAX, pad_;
};
HD inline void dm_finish(Dm& d) {
  d.RW = d.RH * 64; d.RC = 3 * d.RW + d.LW + d.LA + d.LG; d.QK = d.DN + d.DR; d.MC = d.QL + d.KL + d.DR; d.IN = d.RC + d.MC;
  d.MIX = d.RW + d.MH * d.DV; d.NF = d.DR / 4; d.BT = d.B * d.T; d.BC = d.B * d.C; d.NR = d.BT + d.BC;
  d.NPOSMAX = d.BT * 4 + d.NE * d.PADR;
}
typedef unsigned short bf16_t;
HD inline bf16_t f2bf(float f) { unsigned u = __builtin_bit_cast(unsigned, f); return (bf16_t)((u + 0x7fffu + ((u >> 16) & 1u)) >> 16); }
HD inline float bf2f(bf16_t h) { return __builtin_bit_cast(float, (unsigned)h << 16); }
struct Pm {
  Dm d;
  const float *x, *c, *ctx, *c_ctx, *mod_w, *mod_b, *norm1_g, *w_in, *mu, *w0, *w2, *a0, *a2, *k_k, *k_a, *r_k, *g2, *ln_w, *ln_b, *q_norm, *w_uq, *kv_norm,
      *w_ukv, *w_out, *norm2_g, *router_w, *router_b, *exp_w1, *exp_b1, *exp_w2, *exp_b2, *final_g;
  float* out;
  float *modv, *P, *Rr, *Vv, *KK, *Kd, *Wd, *Bb, *Gt, *O2, *Zt, *Fend, *Sst, *QF, *KVF, *x1, *gate;
  bf16_t *A1, *QN, *CN, *MIXb, *WinT, *WuqT, *WukvT, *WoutT, *W1T, *W2T, *H2b, *Xg, *ACTb, *Yb, *Q, *K, *V;
  int *top_e, *cnt, *slot_pos, *pos_tok, *tile_e, *npos;
};
HD inline float sigmoidf_(float x) { return 1.f / (1.f + expf(-x)); }

template <int TM, class Epi>
HD inline void gemm_naive(const float* A, int lda, const float* Bm, int ldb, int M, int N, int K, long tid, long nth, Epi epi) {
  const long ngm = (M + TM - 1) / TM, items = ngm * N;
  for (long it = tid; it < items; it += nth) {
    const int n = (int)(it % N); const long m0 = (it / N) * TM;
    float acc[TM];
#pragma unroll
    for (int i = 0; i < TM; ++i) acc[i] = 0.f;
    const float* a[TM];
#pragma unroll
    for (int i = 0; i < TM; ++i) a[i] = A + (size_t)((m0 + i < M) ? (m0 + i) : (M - 1)) * lda;
    for (int k = 0; k < K; k += 4) {
      const float b0 = Bm[(size_t)k * ldb + n], b1 = Bm[(size_t)(k + 1) * ldb + n], b2 = Bm[(size_t)(k + 2) * ldb + n], b3 = Bm[(size_t)(k + 3) * ldb + n];
#pragma unroll
      for (int i = 0; i < TM; ++i) { acc[i] += a[i][k] * b0; acc[i] += a[i][k + 1] * b1; acc[i] += a[i][k + 2] * b2; acc[i] += a[i][k + 3] * b3; }
    }
#pragma unroll
    for (int i = 0; i < TM; ++i) if (m0 + i < M) epi(m0 + i, n, acc[i]);
  }
}

HD inline void ph_mod(const Pm& p, long tid, long nth) {
  const Dm& d = p.d; const int N6 = 6 * d.D; const long items = (long)(d.B + 1) * N6;
  for (long it = tid; it < items; it += nth) {
    const int v = (int)(it / N6), n = (int)(it % N6); const float* cv = v < d.B ? p.c + (size_t)v * d.D : p.c_ctx;
    float acc = 0.f;
    for (int k = 0; k < d.D; ++k) { const float c = cv[k]; acc += c * sigmoidf_(c) * p.mod_w[(size_t)k * N6 + n]; }
    p.modv[it] = acc + p.mod_b[n];
  }
}
HD inline void ph_norm1(const Pm& p, long tid, long nth) {
  const Dm& d = p.d;
  for (long row = tid; row < d.NR; row += nth) {
    const float* src = row < d.BT ? p.x + (size_t)row * d.D : p.ctx + (size_t)(row - d.BT) * d.D; const int v = row < d.BT ? (int)(row / d.T) : d.B;
    float ss = 0.f; for (int k = 0; k < d.D; ++k) ss += src[k] * src[k];
    const float rs = 1.f / sqrtf(ss / d.D + 1e-6f); const float* sh = p.modv + (size_t)v * 6 * d.D; const float* sc = sh + d.D;
    for (int k = 0; k < d.D; ++k) p.A1[(size_t)row * d.D + k] = f2bf(src[k] * rs * p.norm1_g[k] * (1.f + sc[k]) + sh[k]);
  }
}
HD inline void row_pos(const Dm& d, long row, int& t, int& len, int& b, int& isctx) {
  if (row < d.BT) { b = (int)(row / d.T); t = (int)(row % d.T); len = d.T; isctx = 0; } else { const long r = row - d.BT; b = (int)(r / d.C); t = (int)(r % d.C); len = d.C; isctx = 1; }
}
HD inline float ps_at(const Pm& p, long row, int col, int t, int len) {
  const Dm& d = p.d; const float cur = p.P[(size_t)row * d.IN + col], prev = t > 0 ? p.P[(size_t)(row - 1) * d.IN + col] : 0.f, next = t < len - 1 ? p.P[(size_t)(row + 1) * d.IN + col] : 0.f;
  return cur + p.mu[col] * (0.5f * (prev + next) - cur);
}
HD inline void ph_rwkv_prep(const Pm& p, long tid, long nth) {
  const Dm& d = p.d; const int RW = d.RW; const long items = (long)d.NR * RW; const size_t NRW = (size_t)d.NR * RW;
  for (long it = tid; it < items; it += nth) {
    const long row = it / RW; const int c = (int)(it % RW), h0 = (c / 64) * 64; int t, len, b_, ic; row_pos(d, row, t, len, b_, ic);
#define PSV(col) ps_at(p, row, (col), t, len)
    const float r = PSV(c), k = PSV(RW + c), v = PSV(2 * RW + c);
    float ss = 0.f; for (int j = 0; j < 64; ++j) { const float q = PSV(RW + h0 + j) * p.k_k[h0 + j]; ss += q * q; }
    const float kk = k * p.k_k[c] / sqrtf(fmaxf(ss, 1e-24f));
    p.Rr[it] = r; p.Vv[it] = v; p.KK[it] = kk;
    for (int dd = 0; dd < 2; ++dd) {
      float wl = p.w0[dd * RW + c]; for (int l = 0; l < d.LW; ++l) wl += tanhf(PSV(3 * RW + l)) * p.w2[((size_t)dd * d.LW + l) * RW + c];
      float al = p.a0[dd * RW + c]; for (int l = 0; l < d.LA; ++l) al += PSV(3 * RW + d.LW + l) * p.a2[((size_t)dd * d.LA + l) * RW + c];
      const float decay = expf(-0.60653065971263342f * sigmoidf_(wl)), a = sigmoidf_(al);
      p.Wd[dd * NRW + it] = decay; p.Bb[dd * NRW + it] = kk * a; p.Kd[dd * NRW + it] = k * (1.f + (a - 1.f) * p.k_a[c]);
    }
    if (row < d.BT) { float g = 0.f; for (int l = 0; l < d.LG; ++l) g += sigmoidf_(PSV(3 * RW + d.LW + d.LA + l)) * p.g2[(size_t)l * RW + c]; p.Gt[it] = g; }
#undef PSV
  }
}
HD inline void ph_scan(const Pm& p, long tid, long nth) {
  const Dm& d = p.d; const int RW = d.RW; const long items = (long)2 * d.B * d.RH * 64; const size_t NRW = (size_t)d.NR * RW;
  for (long it = tid; it < items; it += nth) {
    const int vr = (int)(it % 64); const int ch = (int)(it / 64); const int h = ch % d.RH, b = (ch / d.RH) % d.B, dd = ch / (d.RH * d.B);
    float S[64];
#pragma unroll
    for (int j = 0; j < 64; ++j) S[j] = 0.f;
    for (int seg = 0; seg < 2; ++seg) {
      const int len = seg == 0 ? d.C : d.T;
      for (int s = 0; s < len; ++s) {
        const int t = dd == 0 ? s : len - 1 - s; const size_t row = seg == 0 ? (size_t)d.BT + (size_t)b * d.C + t : (size_t)b * d.T + t; const size_t o = row * RW + h * 64;
        const float* w = p.Wd + dd * NRW + o; const float* bb = p.Bb + dd * NRW + o; const float* kd = p.Kd + dd * NRW + o; const float* kk = p.KK + o; const float* rr = p.Rr + o;
        const float vv = p.Vv[o + vr];
        float sa = 0.f;
#pragma unroll
        for (int j = 0; j < 64; ++j) sa += S[j] * kk[j];
        float oo = 0.f;
#pragma unroll
        for (int j = 0; j < 64; ++j) { S[j] = S[j] * w[j] - sa * bb[j] + vv * kd[j]; oo += S[j] * rr[j]; }
        if (seg == 1) p.O2[dd * (size_t)d.BT * RW + o + vr] = oo;
      }
    }
  }
}
HD inline void chain_step(const Dm& d, int dd, int b, int sg, size_t& row, bool& lat) {
  if (sg < d.C) { const int t = dd == 0 ? sg : d.C - 1 - sg; row = (size_t)d.BT + (size_t)b * d.C + t; lat = false; }
  else { const int s = sg - d.C; const int t = dd == 0 ? s : d.T - 1 - s; row = (size_t)b * d.T + t; lat = true; }
}
HD inline void ph_scan_a1(const Pm& p, long tid, long nth, int NSEG) {
  const Dm& d = p.d; const int RW = d.RW; const int SL = (d.C + d.T) / NSEG; const long items = (long)2 * d.B * d.RH * NSEG * 128; const size_t NRW = (size_t)d.NR * RW, BTW = (size_t)d.BT * RW;
  for (long it = tid; it < items; it += nth) {
    const int rho = (int)(it % 128); const int g = (int)((it / 128) % NSEG); const int ch = (int)(it / (128 * (long)NSEG)); const int h = ch % d.RH, b = (ch / d.RH) % d.B, dd = ch / (d.RH * d.B);
    float S[64];
#pragma unroll
    for (int j = 0; j < 64; ++j) S[j] = (rho >= 64 && j == rho - 64) ? 1.f : 0.f;
    for (int sg = g * SL; sg < (g + 1) * SL; ++sg) {
      size_t row; bool lat; chain_step(d, dd, b, sg, row, lat); const size_t o = row * RW + h * 64;
      const float* w = p.Wd + dd * NRW + o; const float* bb = p.Bb + dd * NRW + o; const float* kd = p.Kd + dd * NRW + o; const float* kk = p.KK + o; const float* rr = p.Rr + o;
      const float vv = rho < 64 ? p.Vv[o + rho] : 0.f;
      float sa = 0.f;
#pragma unroll
      for (int j = 0; j < 64; ++j) sa += S[j] * kk[j];
      float oo = 0.f;
#pragma unroll
      for (int j = 0; j < 64; ++j) { S[j] = S[j] * w[j] - sa * bb[j] + vv * kd[j]; oo += S[j] * rr[j]; }
      if (lat) { if (rho < 64) p.O2[dd * BTW + o + rho] = oo; else p.Zt[dd * BTW + o + rho - 64] = oo; }
    }
    float* fe = p.Fend + (((size_t)ch * NSEG + g) * 128 + rho) * 64;
#pragma unroll
    for (int j = 0; j < 64; ++j) fe[j] = S[j];
  }
}
__device__ inline void ph_scan_a2(const Pm& p, int gw, int ngw, int lane, int NSEG) {
  const Dm& d = p.d; const int items = 2 * d.B * d.RH * 64;
  for (int it = gw; it < items; it += ngw) { const int v = it % 64, ch = it / 64; float S = 0.f;
    for (int g = 0; g < NSEG; ++g) { p.Sst[(((size_t)ch * NSEG + g) * 64 + v) * 64 + lane] = S;
      const float* fe = p.Fend + ((size_t)ch * NSEG + g) * 128 * 64; float acc = fe[(size_t)v * 64 + lane];
#pragma unroll
      for (int i = 0; i < 64; ++i) { const float si = __builtin_bit_cast(float, __builtin_amdgcn_readlane(__builtin_bit_cast(int, S), i)); acc += si * fe[(size_t)(64 + i) * 64 + lane]; }
      S = acc; } }
}
HD inline void ph_scan_a3(const Pm& p, long tid, long nth, int NSEG) {
  const Dm& d = p.d; const int RW = d.RW; const int SL = (d.C + d.T) / NSEG; const size_t BTW = (size_t)d.BT * RW; const long items = (long)2 * BTW;
  for (long it = tid; it < items; it += nth) {
    const int dd = (int)(it / BTW); const long rem = it % BTW; const long row = rem / RW; const int c = (int)(rem % RW), h = c / 64, v = c % 64; const int b = (int)(row / d.T), t = (int)(row % d.T);
    const int sg = d.C + (dd == 0 ? t : d.T - 1 - t), g = sg / SL; const int ch = (dd * d.B + b) * d.RH + h;
    const float* st = p.Sst + (((size_t)ch * NSEG + g) * 64 + v) * 64; const float* z = p.Zt + dd * BTW + (size_t)row * RW + h * 64;
    float a = p.O2[it];
    for (int i = 0; i < 64; ++i) a += st[i] * z[i];
    p.O2[it] = a;
  }
}
HD inline void ph_readout(const Pm& p, long tid, long nth) {
  const Dm& d = p.d; const int RW = d.RW; const long items = (long)d.BT * d.RH; const size_t NRW = (size_t)d.NR * RW, BTW = (size_t)d.BT * RW;
  for (long it = tid; it < items; it += nth) {
    const long row = it / d.RH; const int h = (int)(it % d.RH); const size_t o = (size_t)row * RW + h * 64;
    float mean = 0.f, bon = 0.f;
    for (int n = 0; n < 64; ++n) { mean += p.O2[o + n] + p.O2[BTW + o + n]; bon += p.Rr[o + n] * (p.Kd[o + n] + p.Kd[NRW + o + n]) * p.r_k[h * 64 + n]; }
    mean *= (1.f / 64.f); float var = 0.f;
    for (int n = 0; n < 64; ++n) { const float q = p.O2[o + n] + p.O2[BTW + o + n] - mean; var += q * q; }
    const float rs = 1.f / sqrtf(var * (1.f / 64.f) + 64e-5f);
    for (int n = 0; n < 64; ++n) { const int c = h * 64 + n; const float y = (p.O2[o + n] + p.O2[BTW + o + n] - mean) * rs * p.ln_w[c] + p.ln_b[c];
      p.MIXb[(size_t)row * d.MIX + c] = f2bf((y + bon * p.Vv[o + n]) * p.Gt[o + n]); }
  }
}
HD inline void ph_mla_a(const Pm& p, long tid, long nth) {
  const Dm& d = p.d;
  for (long row = tid; row < d.NR; row += nth) {
    const float* pm = p.P + (size_t)row * d.IN + d.RC;
    if (row < d.BT) { float ss = 0.f; for (int k = 0; k < d.QL; ++k) ss += pm[k] * pm[k]; const float rs = 1.f / sqrtf(ss / d.QL + 1e-6f);
      for (int k = 0; k < d.QL; ++k) p.QN[(size_t)row * d.QL + k] = f2bf(pm[k] * rs * p.q_norm[k]); }
    float ss = 0.f; for (int k = 0; k < d.KL; ++k) ss += pm[d.QL + k] * pm[d.QL + k]; const float rs = 1.f / sqrtf(ss / d.KL + 1e-6f);
    for (int k = 0; k < d.KL; ++k) p.CN[(size_t)row * d.KL + k] = f2bf(pm[d.QL + k] * rs * p.kv_norm[k]);
  }
}
HD inline void ph_mla_b(const Pm& p, long tid, long nth) {
  const Dm& d = p.d; const long items = (long)d.NR * d.MH; const int NK = d.C + d.T;
  for (long it = tid; it < items; it += nth) {
    const long row = it / d.MH; const int h = (int)(it % d.MH); int t, len, b, ic; row_pos(d, row, t, len, b, ic);
    const int key = ic ? t : d.C + t; bf16_t* Ko = p.K + ((size_t)(b * d.MH + h) * NK + key) * d.QK; bf16_t* Vo = p.V + ((size_t)(b * d.MH + h) * NK + key) * d.DV;
    const float* kv = p.KVF + (size_t)row * d.MH * (d.DN + d.DV) + (size_t)h * (d.DN + d.DV);
    for (int i = 0; i < d.DN; ++i) Ko[i] = f2bf(kv[i]);
    for (int i = 0; i < d.DV; ++i) Vo[i] = f2bf(kv[d.DN + i]);
    const float* kr = p.P + (size_t)row * d.IN + d.RC + d.QL + d.KL;
    bf16_t* Qo = ic ? nullptr : p.Q + ((size_t)(b * d.MH + h) * d.T + t) * d.QK; const float* qf = p.QF + (size_t)row * d.MH * d.QK + (size_t)h * d.QK;
    if (!ic) for (int i = 0; i < d.DN; ++i) Qo[i] = f2bf(qf[i]);
    for (int a = 0; a < 2; ++a) for (int f = 0; f < d.NF; ++f) {
      const float freq = expf(-(float)f / (float)d.NF * 9.210340371976184f); const float pos = a == 0 ? (float)(t / d.GW) : (float)(t % d.GW); const float ang = pos * freq;
      const float cs = ic ? 1.f : cosf(ang), sn = ic ? 0.f : sinf(ang); const int i1 = a * 2 * d.NF + f, i2 = i1 + d.NF;
      Ko[d.DN + i1] = f2bf(kr[i1] * cs - kr[i2] * sn); Ko[d.DN + i2] = f2bf(kr[i2] * cs + kr[i1] * sn);
      if (!ic) { Qo[d.DN + i1] = f2bf(qf[d.DN + i1] * cs - qf[d.DN + i2] * sn); Qo[d.DN + i2] = f2bf(qf[d.DN + i2] * cs + qf[d.DN + i1] * sn); }
    }
  }
}
template <int NE>
HD inline void ph_route(const Pm& p, long tid, long nth) {
  const Dm& d = p.d;
  for (long tok = tid; tok < d.BT; tok += nth) {
    const int b = (int)(tok / d.T); const float* xr = p.x1 + (size_t)tok * d.D; const float* sh = p.modv + (size_t)b * 6 * d.D + 3 * d.D; const float* sc = sh + d.D;
    float ss = 0.f; for (int k = 0; k < d.D; ++k) ss += xr[k] * xr[k]; const float rs = 1.f / sqrtf(ss / d.D + 1e-6f);
    float lg[NE];
#pragma unroll
    for (int e = 0; e < NE; ++e) lg[e] = p.router_b[e];
    for (int k = 0; k < d.D; ++k) { const float hv = xr[k] * rs * p.norm2_g[k] * (1.f + sc[k]) + sh[k]; p.H2b[(size_t)tok * d.D + k] = f2bf(hv); const float* rw = p.router_w + (size_t)k * NE;
#pragma unroll
      for (int e = 0; e < NE; ++e) lg[e] += hv * rw[e]; }
    float tv[4]; int ti[4];
#pragma unroll
    for (int kk = 0; kk < 4; ++kk) { float bv = -3e38f; int bi = 0;
#pragma unroll
      for (int e = 0; e < NE; ++e) if (lg[e] > bv) { bv = lg[e]; bi = e; }
#pragma unroll
      for (int e = 0; e < NE; ++e) if (e == bi) lg[e] = -3e38f;
      tv[kk] = bv; ti[kk] = bi; }
    const float e0 = 1.f, e1 = expf(tv[1] - tv[0]), e2 = expf(tv[2] - tv[0]), e3 = expf(tv[3] - tv[0]), inv = 1.f / (e0 + e1 + e2 + e3);
    p.gate[tok * 4 + 0] = e0 * inv; p.gate[tok * 4 + 1] = e1 * inv; p.gate[tok * 4 + 2] = e2 * inv; p.gate[tok * 4 + 3] = e3 * inv;
    p.top_e[tok * 4 + 0] = ti[0]; p.top_e[tok * 4 + 1] = ti[1]; p.top_e[tok * 4 + 2] = ti[2]; p.top_e[tok * 4 + 3] = ti[3];
  }
}
HD inline void ph_sort_a(const Pm& p, long tid, long nth) {
  const Dm& d = p.d; const long ns = (long)d.BT * 4;
  for (long e = tid; e < d.NE; e += nth) { int c = 0; for (long s = 0; s < ns; ++s) c += (p.top_e[s] == (int)e); p.cnt[e] = c; }
}
HD inline void ph_sort_b(const Pm& p, long tid, long nth) {
  const Dm& d = p.d; const long ns = (long)d.BT * 4;
  for (long e = tid; e < d.NE; e += nth) {
    int off = 0; for (int q = 0; q < (int)e; ++q) off += (p.cnt[q] + d.PADR - 1) / d.PADR * d.PADR;
    const int mine = p.cnt[e], padded = (mine + d.PADR - 1) / d.PADR * d.PADR;
    int r = 0; for (long s = 0; s < ns; ++s) if (p.top_e[s] == (int)e) { p.slot_pos[s] = off + r; p.pos_tok[off + r] = (int)(s / 4); ++r; }
    for (int q = mine; q < padded; ++q) p.pos_tok[off + q] = -1;
    for (int q = 0; q < padded / d.PADR; ++q) p.tile_e[off / d.PADR + q] = (int)e;
    if (e == d.NE - 1) p.npos[0] = off + padded;
  }
}
HD inline void ph_final(const Pm& p, long tid, long nth) {
  const Dm& d = p.d;
  for (long tok = tid; tok < d.BT; tok += nth) {
    const int b = (int)(tok / d.T); const float* gt2 = p.modv + (size_t)b * 6 * d.D + 5 * d.D; const float* xr = p.x1 + (size_t)tok * d.D;
    const float g0 = p.gate[tok * 4], g1 = p.gate[tok * 4 + 1], g2 = p.gate[tok * 4 + 2], g3 = p.gate[tok * 4 + 3];
    const bf16_t* y0 = p.Yb + (size_t)p.slot_pos[tok * 4] * d.D; const bf16_t* y1 = p.Yb + (size_t)p.slot_pos[tok * 4 + 1] * d.D;
    const bf16_t* y2 = p.Yb + (size_t)p.slot_pos[tok * 4 + 2] * d.D; const bf16_t* y3 = p.Yb + (size_t)p.slot_pos[tok * 4 + 3] * d.D;
    float ss = 0.f;
    for (int k = 0; k < d.D; ++k) { const float v = xr[k] + gt2[k] * (g0 * bf2f(y0[k]) + g1 * bf2f(y1[k]) + g2 * bf2f(y2[k]) + g3 * bf2f(y3[k])); ss += v * v; }
    const float rs = 1.f / sqrtf(ss / d.D + 1e-6f);
    for (int k = 0; k < d.D; ++k) { const float v = xr[k] + gt2[k] * (g0 * bf2f(y0[k]) + g1 * bf2f(y1[k]) + g2 * bf2f(y2[k]) + g3 * bf2f(y3[k])); p.out[(size_t)tok * d.D + k] = v * rs * p.final_g[k]; }
  }
}


namespace pg8 {
#define PG8_LAS __attribute__((address_space(3)))
typedef unsigned short bf16_t;
typedef short bf16x8 __attribute__((ext_vector_type(8)));
typedef float f32x4 __attribute__((ext_vector_type(4)));
typedef unsigned u32x4 __attribute__((ext_vector_type(4)));
constexpr int BM = 256, BK = 64, HALF = 128, HTB = HALF * BK * 2  , STAGE_BYTES = 8 * HTB, NXCD = 8, WGM = 8;

__host__ __device__ __forceinline__ int lds_byte(int r, int c) { const int st = (r >> 4) * 2 + (c >> 5), rr = r & 15, cc = c & 31, ob = rr * 64 + cc * 2; return st * 1024 + (ob ^ (((ob >> 9) & 1) << 5)); }
__host__ __device__ __forceinline__ void stage_rc(int b, int& R, int& C) { const int st = b / 1024, sb = b % 1024, swz = sb ^ (((sb >> 9) & 1) << 5); R = (st >> 1) * 16 + swz / 64; C = (st & 1) * 32 + (swz % 64) / 2; }
__host__ __device__ __forceinline__ int perm32(int rho) { const int n = rho >> 4, i = rho & 15; return 8 * (i >> 2) + 4 * n + (i & 3); }

struct Unit { int pm, pn, eb; };
struct Gemm { const bf16_t* A; const bf16_t* Bt; int M, N, K; size_t bexp; };

struct StaticOrder {
    int nM, nN, nwg, G, c; const int* tile_e;
    __host__ __device__ void init(int M, int N, int G_, int c_, const int* te = nullptr) { nM = M / BM; nN = N / BM; nwg = nM * nN; G = G_; c = c_; tile_e = te; }
    __device__ bool next(int i, Unit& u) const {
        const long L = (long)i * G + c; if (L >= nwg) return false;
        int wgid = (int)L; { const int q = nwg / NXCD, r = nwg % NXCD, xcd = wgid % NXCD, off = wgid / NXCD; wgid = (xcd < r ? xcd * (q + 1) : r * (q + 1) + (xcd - r) * q) + off; }
        const int nig = WGM * nN, gid = wgid / nig, fm = gid * WGM, gsz = (nM - fm) < WGM ? (nM - fm) : WGM;
        u.pm = fm + ((wgid % nig) % gsz); u.pn = (wgid % nig) / gsz; u.eb = tile_e ? __builtin_amdgcn_readfirstlane(__hip_atomic_load(tile_e + u.pm, __ATOMIC_RELAXED, __HIP_MEMORY_SCOPE_AGENT)) : 0; return true;
    }
    __device__ __forceinline__ void a_ready(const Unit&) const {}
    __device__ __forceinline__ void done(const Unit&) const {}
};
__device__ __forceinline__ unsigned cvt_pk_bf16(float lo, float hi) { unsigned r; asm volatile("v_cvt_pk_bf16_f32 %0, %1, %2" : "=v"(r) : "v"(lo), "v"(hi)); return r; }
typedef float f32x2 __attribute__((ext_vector_type(2)));
template <class Epi, class Sched, bool ALIGN_EPI = false, bool SP2 = false>
__device__ __forceinline__ void gemm_phase(PG8_LAS unsigned char* lds, const Gemm g, const Sched& S, const Epi& E) {
    int tid_ = threadIdx.x; asm volatile("" : "+v"(tid_));
    const int tid = tid_, wid = __builtin_amdgcn_readfirstlane(tid >> 6), lane = tid & 63, wr = wid >> 2, wc = wid & 3, fr = lane & 15, fq = lane >> 4;
    const int K = g.K, nt = K / BK;
    unsigned voffA[2], voffB[2];
#pragma unroll
    for (int i = 0; i < 2; ++i) { int R, C; stage_rc(tid * 16 + i * 8192, R, C); const int Rb = Epi::PERM ? ((R & ~31) + perm32(R & 31)) : R;
        voffA[i] = (unsigned)(R * K + C) * 2u; voffB[i] = (unsigned)(Rb * K + C) * 2u; }
    const size_t kstep = (size_t)(BK * 2);
    const size_t hstep = (size_t)HALF * K * 2;
    const size_t tstep = 2 * hstep;
    const unsigned ldsw = (unsigned)wid * 1024u;
    const int aoff = lds_byte(wr * 64 + fr, fq * 8), boff = lds_byte(wc * 32 + fr, fq * 8);
#define PG8_SA(b, h) (((b) * 2 + (h)) * HTB)
#define PG8_SB(b, h) ((4 + (b) * 2 + (h)) * HTB)
#define PG8_STAGE(bufoff, gbase, voff) do { _Pragma("unroll") for (int _i = 0; _i < 2; ++_i) \
        __builtin_amdgcn_global_load_lds((const unsigned*)((const char*)(gbase) + (voff)[_i]), (PG8_LAS unsigned*)(lds + (bufoff) + ldsw + _i * 8192), 16, 0, 0); } while (0)
#define PG8_LDA(dst, b, h) do { _Pragma("unroll") for (int m = 0; m < 4; ++m) _Pragma("unroll") for (int k = 0; k < 2; ++k) dst[m][k] = *(const PG8_LAS bf16x8*)(lds + PG8_SA(b, h) + aoff + m * 2048 + k * 1024); } while (0)
#define PG8_LDB(dst, b, h) do { _Pragma("unroll") for (int n = 0; n < 2; ++n) _Pragma("unroll") for (int k = 0; k < 2; ++k) dst[n][k] = *(const PG8_LAS bf16x8*)(lds + PG8_SB(b, h) + boff + n * 2048 + k * 1024); } while (0)
#define PG8_MMA(ai, bj, At, Bt) do { __builtin_amdgcn_s_setprio(1); _Pragma("unroll") for (int m = 0; m < 4; ++m) _Pragma("unroll") for (int n = 0; n < 2; ++n) _Pragma("unroll") for (int k = 0; k < 2; ++k) \
        acc[ai][bj][m][n] = __builtin_amdgcn_mfma_f32_16x16x32_bf16(Bt[n][k], At[m][k], acc[ai][bj][m][n], 0, 0, 0); __builtin_amdgcn_s_setprio(0); } while (0)
#define PG8_WAIT_V(n) asm volatile("s_waitcnt vmcnt(" #n ")" ::: "memory")
#define PG8_WAIT_L(n) asm volatile("s_waitcnt lgkmcnt(" #n ")" ::: "memory")
#define PG8_BAR __builtin_amdgcn_s_barrier()
#define PG8_SCHED __builtin_amdgcn_sched_barrier(0)
    Unit cur, nxt; int ui = 0;
    if (!S.next(0, cur)) return;
    f32x4 acc[2][2][4][2];
#pragma unroll
    for (int a = 0; a < 2; ++a)
#pragma unroll
        for (int b = 0; b < 2; ++b)
#pragma unroll
            for (int m = 0; m < 4; ++m)
#pragma unroll
                for (int n = 0; n < 2; ++n) acc[a][b][m][n] = (f32x4){0.f, 0.f, 0.f, 0.f};
    bf16x8 At[4][2], B0[2][2], B1[2][2];
    const char* cA = (const char*)g.A + (size_t)cur.pm * tstep; const char* cB = (const char*)g.Bt + (size_t)cur.eb * g.bexp + (size_t)cur.pn * tstep;
    S.a_ready(cur);
    if constexpr (SP2) {
        PG8_STAGE(PG8_SB(0, 0), cB, voffB); PG8_STAGE(PG8_SB(0, 1), cB + hstep, voffB); PG8_STAGE(PG8_SA(0, 0), cA, voffA); PG8_STAGE(PG8_SA(0, 1), cA + hstep, voffA);
        if (wr == 1) PG8_BAR;
        PG8_WAIT_V(2); PG8_BAR;
        PG8_STAGE(PG8_SB(1, 0), cB + kstep, voffB); PG8_STAGE(PG8_SA(1, 0), cA + kstep, voffA); PG8_STAGE(PG8_SB(1, 1), cB + hstep + kstep, voffB);
        PG8_WAIT_V(6); PG8_BAR;
    } else {
        PG8_STAGE(PG8_SB(0, 0), cB, voffB); PG8_STAGE(PG8_SA(0, 0), cA, voffA); PG8_STAGE(PG8_SB(0, 1), cB + hstep, voffB); PG8_STAGE(PG8_SA(0, 1), cA + hstep, voffA);
        if (wr == 1) PG8_BAR;
        PG8_WAIT_V(4); PG8_BAR;
        PG8_STAGE(PG8_SB(1, 0), cB + kstep, voffB); PG8_STAGE(PG8_SA(1, 0), cA + kstep, voffA); PG8_STAGE(PG8_SB(1, 1), cB + hstep + kstep, voffB);
        PG8_WAIT_V(6); PG8_BAR;
    }
    for (;;) {
        const bool has_next = S.next(ui + 1, nxt);
        const char* nA = has_next ? (const char*)g.A + (size_t)nxt.pm * tstep : cA; const char* nB = has_next ? (const char*)g.Bt + (size_t)nxt.eb * g.bexp + (size_t)nxt.pn * tstep : cB;
        for (int t = 0; t < nt; t += 2) {
            const bool last = (t == nt - 2);
            const char* a1 = cA + (size_t)(t + 1) * kstep;
            const char* a2 = last ? nA : cA + (size_t)(t + 2) * kstep; const char* b2 = last ? nB : cB + (size_t)(t + 2) * kstep;
            const char* a3 = a2 + kstep; const char* b3 = b2 + kstep;
            if (last && has_next) S.a_ready(nxt);
            if constexpr (SP2) {
            PG8_LDB(B0, 0, 0); PG8_LDB(B1, 0, 1); PG8_SCHED; PG8_LDA(At, 0, 0); PG8_STAGE(PG8_SA(1, 1), a1 + hstep, voffA);
            PG8_WAIT_V(8); PG8_WAIT_L(0); PG8_BAR; PG8_MMA(0, 0, At, B0); PG8_MMA(0, 1, At, B1); PG8_BAR; PG8_SCHED;
            PG8_LDA(At, 0, 1); PG8_STAGE(PG8_SB(0, 0), b2, voffB); PG8_STAGE(PG8_SB(0, 1), b2 + hstep, voffB); PG8_STAGE(PG8_SA(0, 0), a2, voffA);
            PG8_WAIT_V(8); PG8_WAIT_L(0); PG8_BAR; PG8_MMA(1, 0, At, B0); PG8_MMA(1, 1, At, B1); PG8_BAR; PG8_SCHED;
            PG8_LDB(B0, 1, 0); PG8_LDB(B1, 1, 1); PG8_SCHED; PG8_LDA(At, 1, 0); PG8_STAGE(PG8_SA(0, 1), a2 + hstep, voffA);
            PG8_WAIT_V(8); PG8_WAIT_L(0); PG8_BAR; PG8_MMA(0, 0, At, B0); PG8_MMA(0, 1, At, B1); PG8_BAR; PG8_SCHED;
            PG8_LDA(At, 1, 1); PG8_STAGE(PG8_SB(1, 0), b3, voffB); PG8_STAGE(PG8_SB(1, 1), b3 + hstep, voffB); PG8_STAGE(PG8_SA(1, 0), a3, voffA);
            PG8_WAIT_V(8); PG8_WAIT_L(0); PG8_BAR; PG8_MMA(1, 0, At, B0); PG8_MMA(1, 1, At, B1); PG8_BAR; PG8_SCHED;
            } else {
            PG8_LDB(B0, 0, 0); PG8_SCHED; PG8_LDA(At, 0, 0); PG8_STAGE(PG8_SA(1, 1), a1 + hstep, voffA);
            PG8_WAIT_L(8); PG8_BAR; PG8_WAIT_L(0); PG8_MMA(0, 0, At, B0); PG8_BAR; PG8_SCHED;
            PG8_LDB(B1, 0, 1); PG8_STAGE(PG8_SB(0, 0), b2, voffB);
            PG8_BAR; PG8_WAIT_L(0); PG8_MMA(0, 1, At, B1); PG8_BAR;
            PG8_LDA(At, 0, 1); PG8_STAGE(PG8_SA(0, 0), a2, voffA);
            PG8_BAR; PG8_WAIT_L(0); PG8_MMA(1, 0, At, B0); PG8_BAR; PG8_SCHED;
            PG8_STAGE(PG8_SB(0, 1), b2 + hstep, voffB);
            PG8_WAIT_V(6); PG8_BAR; PG8_MMA(1, 1, At, B1); PG8_BAR;
            PG8_LDB(B0, 1, 0); PG8_SCHED; PG8_LDA(At, 1, 0); PG8_STAGE(PG8_SA(0, 1), a2 + hstep, voffA);
            PG8_WAIT_L(8); PG8_BAR; PG8_WAIT_L(0); PG8_MMA(0, 0, At, B0); PG8_BAR; PG8_SCHED;
            PG8_LDB(B1, 1, 1); PG8_STAGE(PG8_SB(1, 0), b3, voffB);
            PG8_BAR; PG8_WAIT_L(0); PG8_MMA(0, 1, At, B1); PG8_BAR;
            PG8_LDA(At, 1, 1); PG8_STAGE(PG8_SA(1, 0), a3, voffA);
            PG8_BAR; PG8_WAIT_L(0); PG8_MMA(1, 0, At, B0); PG8_BAR; PG8_SCHED;
            PG8_STAGE(PG8_SB(1, 1), b3 + hstep, voffB);
            PG8_WAIT_V(6); PG8_BAR; PG8_MMA(1, 1, At, B1); PG8_BAR;
            }
        }
        if constexpr (ALIGN_EPI) { if (wr == 0) PG8_BAR; }
        if constexpr (!Epi::AFTER_DRAIN) { E(acc, cur, wr, wc, fr, fq); S.done(cur); }
        if (!has_next) break;
#pragma unroll
        for (int a = 0; a < 2; ++a)
#pragma unroll
            for (int b = 0; b < 2; ++b)
#pragma unroll
                for (int m = 0; m < 4; ++m)
#pragma unroll
                    for (int n = 0; n < 2; ++n) acc[a][b][m][n] = (f32x4){0.f, 0.f, 0.f, 0.f};
        cur = nxt; cA = nA; cB = nB; ++ui;
        if constexpr (ALIGN_EPI) { if (wr == 1) PG8_BAR; }
    }
    PG8_WAIT_V(0);
    if constexpr (!ALIGN_EPI) { if (wr == 0) PG8_BAR; }
    PG8_BAR;
    if constexpr (Epi::AFTER_DRAIN) { E.fused(acc, cur, wr, wc, fr, fq, lds, wid, lane); S.done(cur); }
#undef PG8_SA
#undef PG8_SB
#undef PG8_STAGE
#undef PG8_LDA
#undef PG8_LDB
#undef PG8_MMA
#undef PG8_WAIT_V
#undef PG8_WAIT_L
#undef PG8_BAR
#undef PG8_SCHED
}
}

#define XB_TMO      128
#define XB_XCNT(j)  (256  + 64 * (j))
#define XB_XSUB(j)  (1280 + 64 * (j))
#define XB_XGEN(j)  (2304 + 64 * (j))
#define XB_TOP      3328
#define XB_TOPGEN   3392
#define XCD_BAR_WORDS 3456
#define XB_SPIN_CAP (1u << 22)
#define LAS __attribute__((address_space(3)))

__device__ __forceinline__ unsigned xb_ld(unsigned* p)              { return __hip_atomic_load(p, __ATOMIC_RELAXED, __HIP_MEMORY_SCOPE_AGENT); }
__device__ __forceinline__ unsigned xb_add(unsigned* p, unsigned v) { return __hip_atomic_fetch_add(p, v, __ATOMIC_RELAXED, __HIP_MEMORY_SCOPE_AGENT); }
__device__ __forceinline__ unsigned xb_xcc_id() { return (unsigned)__builtin_amdgcn_s_getreg((3 << 11) | 20) & 0xFu; }
#define XB_SPIN(cond, bar) do { unsigned _sp = 0; while (cond) { __builtin_amdgcn_s_sleep(1); \
    if ((++_sp & 255u) == 0u) { if (xb_ld(&(bar)[XB_TMO])) break; if (_sp > XB_SPIN_CAP) { atomicAdd(&(bar)[XB_TMO], 1u); break; } } } } while (0)

struct XcdBarrier {
    unsigned* bar; unsigned x;
    volatile LAS unsigned* st;
};

__device__ __forceinline__ XcdBarrier xcd_barrier_post(unsigned* bar, volatile LAS unsigned* st) {
    XcdBarrier b; b.bar = bar; b.x = xb_xcc_id(); b.st = st;
    if (threadIdx.x == 0) (void)xb_add(&bar[XB_XCNT(b.x)], 1u);
    return b;
}
__device__ __forceinline__ void xcd_barrier_complete(unsigned* bar, unsigned x, unsigned& nloc, unsigned& nx) {
    const unsigned G = gridDim.x * gridDim.y * gridDim.z;
    unsigned sum, cnt, mine, sp = 0u;
    for (;;) {
        sum = 0u; cnt = 0u; mine = 0u;
#pragma unroll
        for (unsigned j = 0; j < 16; ++j) { const unsigned c = xb_ld(&bar[XB_XCNT(j)]); sum += c; cnt += (c > 0u) ? 1u : 0u; mine = (j == x) ? c : mine; }
        if (sum == G) break;
        __builtin_amdgcn_s_sleep(1);
        if ((++sp & 255u) == 0u) { if (xb_ld(&bar[XB_TMO])) break; if (sp > XB_SPIN_CAP) { atomicAdd(&bar[XB_TMO], 1u); break; } }
    }
    nloc = mine > 0u ? mine : 1u; nx = cnt > 0u ? cnt : 1u;
}

__device__ __forceinline__ void xcd_barrier(const XcdBarrier& b) {
    asm volatile("s_waitcnt vmcnt(0)" ::: "memory");
    __syncthreads();
    if (threadIdx.x == 0) {
        unsigned* bar = b.bar;
        __builtin_amdgcn_s_waitcnt(0);
        unsigned nloc = b.st[0], nx = b.st[1];
        if (nloc == 0u) { xcd_barrier_complete(bar, b.x, nloc, nx); b.st[0] = nloc; b.st[1] = nx; }
        const unsigned old = xb_add(&bar[XB_XSUB(b.x)], 1u);
        const unsigned gen = old / nloc;
        if (old + 1u == (gen + 1u) * nloc) {
            __builtin_amdgcn_fence(__ATOMIC_RELEASE, "agent");
            asm volatile("s_waitcnt vmcnt(0)" ::: "memory");
            const unsigned og = xb_add(&bar[XB_TOP], 1u);
            const unsigned tg = og / nx;
            if (og + 1u == (tg + 1u) * nx) xb_add(&bar[XB_TOPGEN], 1u);
            else XB_SPIN(xb_ld(&bar[XB_TOPGEN]) == tg, bar);
            __builtin_amdgcn_fence(__ATOMIC_ACQUIRE, "agent");
            xb_add(&bar[XB_XGEN(b.x)], 1u);
            asm volatile("s_waitcnt vmcnt(0)" ::: "memory");
        } else {
            XB_SPIN(xb_ld(&bar[XB_XGEN(b.x)]) == gen, bar);
            __builtin_amdgcn_fence(__ATOMIC_ACQUIRE, "agent");
            asm volatile("s_waitcnt vmcnt(0)" ::: "memory");
        }
    }
    __syncthreads();
}


namespace attn {
using bf16 = unsigned short;
constexpr int DQK = 192, DV = 128, NW = 8, QBLK = 32, KVBLK = 64;
constexpr float SCALE = 0.07216878364870322f;
constexpr float THR = 8.f;
constexpr int SDEPTH = 1;
constexpr int LDQ = DQK, LDK = DQK, LDV = DV, LDO = 1024;
constexpr size_t SHM_V = KVBLK * DV * 2, SHM_K = KVBLK * DQK * 2, SHM_ATTN = 2 * SHM_V + 2 * SHM_K + NW * 64 * 4;
using bf16x8 = __attribute__((ext_vector_type(8))) short;
using s16x4  = __attribute__((ext_vector_type(4))) short;
using f32x16 = __attribute__((ext_vector_type(16))) float;
using f32x8  = __attribute__((ext_vector_type(8))) float;
using u32x4  = __attribute__((ext_vector_type(4))) unsigned;
#define KSWZ(row, colB) ((row) * 384 + ((colB) ^ (((row) & 7) << 4)))
#define SBAR() __builtin_amdgcn_sched_barrier(0)
__device__ __forceinline__ int crow(int r, int hi) { return (r & 3) + 8 * (r >> 2) + 4 * hi; }
__device__ __forceinline__ unsigned cvtpk(float lo, float hi) {
  unsigned r; asm volatile("v_cvt_pk_bf16_f32 %0, %1, %2" : "=v"(r) : "v"(lo), "v"(hi)); return r;
}
struct St { using T = bf16x8;
  __device__ static __forceinline__ T ld8(const bf16* p) { return *reinterpret_cast<const bf16x8*>(p); }
  __device__ static __forceinline__ bf16x8 tobf(T x) { return x; } };
__device__ __forceinline__ void partialSM(f32x16& p0, f32x16& p1, float& m_reg, float& mn, float& alpha) {
  constexpr float C = SCALE * 1.4426950408889634f;
  float pmax = p0[0]; for (int r = 1; r < 16; ++r) pmax = fmaxf(pmax, p0[r]); for (int r = 0; r < 16; ++r) pmax = fmaxf(pmax, p1[r]);
  { auto rr = __builtin_amdgcn_permlane32_swap(__float_as_uint(pmax), __float_as_uint(pmax), false, false);
    pmax = fmaxf(__uint_as_float(rr[0]), __uint_as_float(rr[1])); }
  if (__builtin_expect(__all(pmax - m_reg <= THR / SCALE), 1)) { mn = m_reg; alpha = 1.f; }
  else { mn = fmaxf(m_reg, pmax); alpha = __builtin_amdgcn_exp2f((m_reg - mn) * C); m_reg = mn; }
  float mnC = -mn * C;
  for (int r = 0; r < 16; ++r) p0[r] = fmaf(p0[r], C, mnC); for (int r = 0; r < 16; ++r) p1[r] = fmaf(p1[r], C, mnC);
  for (int r = 0; r < 16; ++r) p0[r] = __builtin_amdgcn_exp2f(p0[r]);
}
__device__ __forceinline__ void finishSM(f32x16& p0, f32x16& p1, float alpha, float& l_reg, bf16x8& pa0, bf16x8& pa1, bf16x8& pa2, bf16x8& pa3) {
  for (int r = 0; r < 16; ++r) p1[r] = __builtin_amdgcn_exp2f(p1[r]);
  float ps = 0; for (int r = 0; r < 16; ++r) ps += p0[r]; for (int r = 0; r < 16; ++r) ps += p1[r];
  { auto rr = __builtin_amdgcn_permlane32_swap(__float_as_uint(ps), __float_as_uint(ps), false, false);
    ps = __uint_as_float(rr[0]) + __uint_as_float(rr[1]); }
  l_reg = l_reg * alpha + ps;
#define PK4(P, BASE, OUT) do { unsigned a0 = cvtpk(P[BASE + 0], P[BASE + 1]), a1 = cvtpk(P[BASE + 2], P[BASE + 3]);   \
    unsigned b0 = cvtpk(P[BASE + 4], P[BASE + 5]), b1 = cvtpk(P[BASE + 6], P[BASE + 7]);                              \
    auto r0 = __builtin_amdgcn_permlane32_swap(a0, b0, false, false); auto r1 = __builtin_amdgcn_permlane32_swap(a1, b1, false, false); \
    u32x4 w = {r0[0], r1[0], r0[1], r1[1]}; OUT = *reinterpret_cast<bf16x8*>(&w); } while (0)
  PK4(p0, 0, pa0); PK4(p0, 8, pa1); PK4(p1, 0, pa2); PK4(p1, 8, pa3);
#undef PK4
}
__device__ __forceinline__ void qkt(f32x16& p0, f32x16& p1, const bf16* Ks, const bf16x8* qr, int r32, int hi) {
  p0 = f32x16{}; p1 = f32x16{};
  for (int d0 = 0; d0 < 12; ++d0) { int cb = (d0 * 16 + hi * 8) * 2;
    bf16x8 b0 = *reinterpret_cast<const bf16x8*>((const char*)Ks + KSWZ(r32, cb));
    bf16x8 b1 = *reinterpret_cast<const bf16x8*>((const char*)Ks + KSWZ(32 + r32, cb));
    p0 = __builtin_amdgcn_mfma_f32_32x32x16_bf16(b0, qr[d0], p0, 0, 0, 0);
    p1 = __builtin_amdgcn_mfma_f32_32x32x16_bf16(b1, qr[d0], p1, 0, 0, 0); }
}
__device__ __forceinline__ int v_st(int k, int c) { const int kk = (k & ~0xC) | ((k & 4) << 1) | ((k & 8) >> 1); return ((kk >> 3) * 4 + (c >> 5)) * 512 + ((kk & 7) * 32 + (c & 31)) * 2; }
__device__ __forceinline__ int v_rd_base(int lane) { return ((lane & 3) << 3) | (((lane >> 2) & 3) << 6) | (((lane >> 4) & 1) << 5) | (((lane >> 5) & 1) << 8); }
constexpr int v_rd_off(int d0, int ks, int half) { return d0 * 512 + ks * 4096 + half * 2048; }
template <int OFF> __device__ __forceinline__ s16x4 tr_read(int vb) {
  s16x4 r; asm volatile("ds_read_b64_tr_b16 %0, %1 offset:%2" : "=&v"(r) : "v"(vb), "i"(OFF) : "memory"); return r;
}
template <int D0> __device__ __forceinline__ void pv_one(f32x16& od, int vb, bf16x8 pa0, bf16x8 pa1, bf16x8 pa2, bf16x8 pa3) {
  const s16x4 l0 = tr_read<v_rd_off(D0, 0, 0)>(vb), h0 = tr_read<v_rd_off(D0, 0, 1)>(vb), l1 = tr_read<v_rd_off(D0, 1, 0)>(vb), h1 = tr_read<v_rd_off(D0, 1, 1)>(vb);
  const s16x4 l2 = tr_read<v_rd_off(D0, 2, 0)>(vb), h2 = tr_read<v_rd_off(D0, 2, 1)>(vb), l3 = tr_read<v_rd_off(D0, 3, 0)>(vb), h3 = tr_read<v_rd_off(D0, 3, 1)>(vb);
  asm volatile("s_waitcnt lgkmcnt(0)" ::: "memory"); SBAR();
#define PK(L, H) (bf16x8){L[0], L[1], L[2], L[3], H[0], H[1], H[2], H[3]}
  od = __builtin_amdgcn_mfma_f32_32x32x16_bf16(pa0, PK(l0, h0), od, 0, 0, 0);
  od = __builtin_amdgcn_mfma_f32_32x32x16_bf16(pa1, PK(l1, h1), od, 0, 0, 0);
  od = __builtin_amdgcn_mfma_f32_32x32x16_bf16(pa2, PK(l2, h2), od, 0, 0, 0);
  od = __builtin_amdgcn_mfma_f32_32x32x16_bf16(pa3, PK(l3, h3), od, 0, 0, 0);
#undef PK
}
__device__ __forceinline__ void pv_d0(f32x16* o, int vb, bf16x8 pa0, bf16x8 pa1, bf16x8 pa2, bf16x8 pa3) {
  pv_one<0>(o[0], vb, pa0, pa1, pa2, pa3); pv_one<1>(o[1], vb, pa0, pa1, pa2, pa3); pv_one<2>(o[2], vb, pa0, pa1, pa2, pa3); pv_one<3>(o[3], vb, pa0, pa1, pa2, pa3);
}

__device__ __forceinline__ void attn_dense_body(const bf16* __restrict__ Qb, const bf16* __restrict__ Kh, const bf16* __restrict__ Vh,
                                                bf16* __restrict__ Ob, int seq, char* lds) {
  int tid_ = threadIdx.x; asm volatile("" : "+v"(tid_));
  const int tid = tid_, wid = tid >> 6, lane = tid & 63, r32 = lane & 31, hi = lane >> 5;
  bf16* V_lds = (bf16*)lds; bf16* K_lds = (bf16*)(lds + 2 * SHM_V);
  float* ws = (float*)(lds + 2 * SHM_V + 2 * SHM_K) + wid * 64; float* li_l = ws; float* al_l = ws + 32;
  float m_reg = -1e30f, l_reg = 0; f32x16 o[4] = {}; bf16x8 qr[12];
  const bf16* Qw = Qb + (long)(wid * QBLK + r32) * LDQ + hi * 8;
#pragma unroll
  for (int d0 = 0; d0 < 12; ++d0) qr[d0] = St::ld8(Qw + d0 * 16);
  const int sr = tid >> 4, sc = (tid & 15) * 8, vst0 = v_st(sr, sc), vst1 = v_st(32 + sr, sc);
  const int kr0 = tid / 24, kc0 = (tid % 24) * 8, kr1 = (tid + 512) / 24, kc1 = ((tid + 512) % 24) * 8, kr2 = (tid + 1024) / 24, kc2 = ((tid + 1024) % 24) * 8;
  const int vb0 = (int)(uintptr_t)V_lds + v_rd_base(lane);
  struct { St::T vs0, vs1, ks0, ks1, ks2; } sr_[SDEPTH];
#define SLOAD(i, k0) do { sr_[i].vs0 = St::ld8(&Vh[(long)((k0) + sr) * LDV + sc]); sr_[i].vs1 = St::ld8(&Vh[(long)((k0) + 32 + sr) * LDV + sc]); \
    sr_[i].ks0 = St::ld8(&Kh[(long)((k0) + kr0) * LDK + kc0]); sr_[i].ks1 = St::ld8(&Kh[(long)((k0) + kr1) * LDK + kc1]); sr_[i].ks2 = St::ld8(&Kh[(long)((k0) + kr2) * LDK + kc2]); } while (0)
#define SWRITE(b, i) do { *(bf16x8*)((char*)V_lds + (b) * SHM_V + vst0) = St::tobf(sr_[i].vs0);          \
    *(bf16x8*)((char*)V_lds + (b) * SHM_V + vst1) = St::tobf(sr_[i].vs1);                                \
    *(bf16x8*)((char*)K_lds + (b) * SHM_K + KSWZ(kr0, kc0 * 2)) = St::tobf(sr_[i].ks0);                  \
    *(bf16x8*)((char*)K_lds + (b) * SHM_K + KSWZ(kr1, kc1 * 2)) = St::tobf(sr_[i].ks1);                  \
    *(bf16x8*)((char*)K_lds + (b) * SHM_K + KSWZ(kr2, kc2 * 2)) = St::tobf(sr_[i].ks2); } while (0)
#define SWAIT() do { if constexpr (SDEPTH == 2) asm volatile("s_waitcnt vmcnt(5)" ::: "memory"); else asm volatile("s_waitcnt vmcnt(0)" ::: "memory"); } while (0)
#define RESC(a) do { if (__any((a) < 1.f)) { if (hi == 0) al_l[r32] = (a); asm volatile("s_waitcnt lgkmcnt(0)" ::: "memory"); \
    for (int d = 0; d < 4; ++d) for (int r = 0; r < 16; ++r) o[d][r] *= al_l[crow(r, hi)]; } } while (0)
  f32x16 p0, p1; float mn, al; bf16x8 pa0, pa1, pa2, pa3; const int NT = seq / KVBLK;
  SLOAD(0, 0); asm volatile("s_waitcnt vmcnt(0)" ::: "memory"); SWRITE(0, 0); __syncthreads();
  for (int j = 0; j < NT; ++j) {
    const int cur = j & 1; const bool more = j + 1 < NT;
    if (more) SLOAD(0, (j + 1) * KVBLK);
    SBAR(); qkt(p0, p1, (bf16*)((char*)K_lds + cur * SHM_K), qr, r32, hi);
    partialSM(p0, p1, m_reg, mn, al); RESC(al);
    finishSM(p0, p1, al, l_reg, pa0, pa1, pa2, pa3); SBAR();
    pv_d0(o, vb0 + cur * (int)SHM_V, pa0, pa1, pa2, pa3);
    if (more) { SWAIT(); SWRITE(cur ^ 1, 0); }
    __syncthreads();
  }
  if (hi == 0) li_l[r32] = l_reg; asm volatile("s_waitcnt lgkmcnt(0)" ::: "memory");
  float rli[16];
#pragma unroll
  for (int r = 0; r < 16; ++r) rli[r] = __builtin_amdgcn_rcpf(li_l[crow(r, hi)]);
  bf16* Ow = Ob + (long)(wid * QBLK) * LDO;
#pragma unroll
  for (int r = 0; r < 16; ++r) { int orow = crow(r, hi);
    for (int d0 = 0; d0 < 4; ++d0) Ow[(long)orow * LDO + d0 * 32 + r32] = f2bf(o[d0][r] * rli[r]); }
#undef SLOAD
#undef SWRITE
#undef SWAIT
#undef RESC
}

}


constexpr int NWAVES = 8, NTHREADS = 512;
constexpr int RING_BYTES = 131072, MISC_OFF = RING_BYTES + 320, LDS_BYTES = 147456;
#define GAS __attribute__((address_space(1)))
typedef unsigned v4u __attribute__((ext_vector_type(4)));
typedef float f32x4 __attribute__((ext_vector_type(4)));
#define LDS_WAIT() asm volatile("s_waitcnt lgkmcnt(0)" ::: "memory")

template <class F> struct EpiFn {
  static constexpr bool PERM = true, AFTER_DRAIN = false; F f;
  __device__ __forceinline__ void operator()(const pg8::f32x4 (&acc)[2][2][4][2], const pg8::Unit& u, int wr, int wc, int fr, int fq) const {
#pragma unroll
    for (int ai = 0; ai < 2; ++ai)
#pragma unroll
      for (int m = 0; m < 4; ++m) { const int row = u.pm * 256 + ai * 128 + wr * 64 + m * 16 + fr;
#pragma unroll
        for (int bj = 0; bj < 2; ++bj) { const int col = u.pn * 256 + bj * 128 + wc * 32 + 8 * fq; f(u, row, col, acc[ai][bj][m][0], acc[ai][bj][m][1]); } }
  }
};
template <class F> __device__ __forceinline__ void run_gemm(LAS unsigned char* lds, const bf16_t* A, const bf16_t* Bt, int M, int N, int K, F f, const int* tile_e = nullptr, size_t bexp = 0) {
  pg8::Gemm g{A, Bt, M, N, K, bexp}; pg8::StaticOrder S; S.init(M, N, (int)gridDim.x, (int)blockIdx.x, tile_e);
  EpiFn<F> E{f};
  pg8::gemm_phase<EpiFn<F>, pg8::StaticOrder, true, true>((PG8_LAS unsigned char*)lds, g, S, E);
}

__device__ __forceinline__ unsigned pk2(float lo, float hi) { return (unsigned)f2bf(lo) | ((unsigned)f2bf(hi) << 16); }
__device__ __forceinline__ void transpose_item(const float* W, int K, int N, bf16_t* WT, LAS float* scr, int item, int lane) {
  const int nblk = N / 32, kb = item / nblk, nb = item % nblk, k0 = 64 * kb, n0 = 32 * nb;
#pragma unroll 8
  for (int i = 0; i < 32; ++i) { const int kk = 2 * i + (lane >> 5); scr[kk * 33 + (lane & 31)] = W[(size_t)(k0 + kk) * N + n0 + (lane & 31)]; }
  LDS_WAIT(); asm volatile("" ::: "memory");
  const int c = lane & 7;
#pragma unroll
  for (int j = 0; j < 4; ++j) { const int n = (lane >> 3) + 8 * j; const LAS float* s = scr + (8 * c) * 33 + n;
    v4u o; o.x = pk2(s[0 * 33], s[1 * 33]); o.y = pk2(s[2 * 33], s[3 * 33]); o.z = pk2(s[4 * 33], s[5 * 33]); o.w = pk2(s[6 * 33], s[7 * 33]);
    *(v4u*)(WT + (size_t)(n0 + n) * K + k0 + 8 * c) = o; }
  LDS_WAIT(); asm volatile("" ::: "memory");
}
__device__ __forceinline__ void transpose_all(const float* W, int K, int N, bf16_t* WT, LAS unsigned char* lds, int gw, int ngw, int wave, int lane) {
  LAS float* scr = (LAS float*)(lds + wave * 16384); const int items = (K / 64) * (N / 32);
  for (int it = gw; it < items; it += ngw) transpose_item(W, K, N, WT, scr, it, lane);
}

constexpr int INP = 2304;

__global__ void __launch_bounds__(NTHREADS, 2) fwd(Pm p, unsigned* bar) {
  extern __shared__ __attribute__((aligned(16))) unsigned char lds_raw[];
  LAS unsigned char* lds = (LAS unsigned char*)lds_raw;
  const int tidb = threadIdx.x, lane = tidb & 63, wave = __builtin_amdgcn_readfirstlane(tidb >> 6);
  for (int u = tidb; u < (LDS_BYTES - RING_BYTES) / 4; u += NTHREADS) ((LAS unsigned*)(lds + RING_BYTES))[u] = 0u;
  __syncthreads();
  XcdBarrier xb = xcd_barrier_post(bar, (volatile LAS unsigned*)(lds + MISC_OFF + 32));
  const long tid = (long)blockIdx.x * NTHREADS + tidb, nth = (long)gridDim.x * NTHREADS;
  const int gw = blockIdx.x * NWAVES + wave, ngw = gridDim.x * NWAVES;
  const Dm& d = p.d;
#define GSYNC() xcd_barrier(xb)
  ph_mod(p, tid, nth);
  transpose_all(p.w_in, d.D, d.IN, p.WinT, lds, gw, ngw, wave, lane);
  for (long i = tid; i < (long)(INP - d.IN) * d.D; i += nth) p.WinT[(size_t)d.IN * d.D + i] = 0;
  transpose_all(p.w_uq, d.QL, d.MH * d.QK, p.WuqT, lds, gw, ngw, wave, lane);
  transpose_all(p.w_ukv, d.KL, d.MH * (d.DN + d.DV), p.WukvT, lds, gw, ngw, wave, lane);
  transpose_all(p.w_out, d.MIX, d.D, p.WoutT, lds, gw, ngw, wave, lane);
  for (int e = 0; e < d.NE; ++e) {
    transpose_all(p.exp_w1 + (size_t)e * d.D * 2 * d.DE, d.D, 2 * d.DE, p.W1T + (size_t)e * 2 * d.DE * d.D, lds, gw, ngw, wave, lane);
    transpose_all(p.exp_w2 + (size_t)e * d.DE * d.D, d.DE, d.D, p.W2T + (size_t)e * d.D * d.DE, lds, gw, ngw, wave, lane);
  }
  GSYNC();
  ph_norm1(p, tid, nth); GSYNC();
  { float* P = p.P; const int IN = d.IN;
    run_gemm(lds, p.A1, p.WinT, d.NR, INP, d.D, [=](const pg8::Unit& u, int row, int col, pg8::f32x4 v0, pg8::f32x4 v1) {
      if (col < IN) { float* o = P + (size_t)row * IN + col; *(pg8::f32x4*)o = v0; *(pg8::f32x4*)(o + 4) = v1; } }); }
  GSYNC();
  ph_mla_a(p, tid, nth); ph_rwkv_prep(p, tid, nth); GSYNC();
  { float* QF = p.QF; const int N = d.MH * d.QK;
    run_gemm(lds, p.QN, p.WuqT, d.BT, N, d.QL, [=](const pg8::Unit& u, int row, int col, pg8::f32x4 v0, pg8::f32x4 v1) { float* o = QF + (size_t)row * N + col; *(pg8::f32x4*)o = v0; *(pg8::f32x4*)(o + 4) = v1; }); }
  { float* KVF = p.KVF; const int N = d.MH * (d.DN + d.DV);
    run_gemm(lds, p.CN, p.WukvT, d.NR, N, d.KL, [=](const pg8::Unit& u, int row, int col, pg8::f32x4 v0, pg8::f32x4 v1) { float* o = KVF + (size_t)row * N + col; *(pg8::f32x4*)o = v0; *(pg8::f32x4*)(o + 4) = v1; }); }
  GSYNC();
  ph_mla_b(p, tid, nth); GSYNC();
  constexpr int NSEG = 32;
  ph_scan_a1(p, tid, nth, NSEG); GSYNC();
  ph_scan_a2(p, gw, ngw, lane, NSEG); GSYNC();
  ph_scan_a3(p, tid, nth, NSEG);
  for (int u = blockIdx.x; u < d.B * d.MH * (d.T / 256); u += gridDim.x) { const int bh = u % (d.B * d.MH), qb = u / (d.B * d.MH), b = bh / d.MH, h = bh % d.MH; const int NK = d.C + d.T;
    attn::attn_dense_body(p.Q + ((size_t)bh * d.T + (size_t)qb * 256) * attn::DQK, p.K + (size_t)bh * NK * attn::DQK, p.V + (size_t)bh * NK * attn::DV,
                          p.MIXb + ((size_t)b * d.T + (size_t)qb * 256) * d.MIX + d.RW + h * attn::DV, NK, (char*)lds_raw); }
  GSYNC();
  ph_readout(p, tid, nth); GSYNC();
  { float* x1 = p.x1; const float* x = p.x; const float* modv = p.modv; const int D = d.D, T = d.T;
    run_gemm(lds, p.MIXb, p.WoutT, d.BT, D, d.MIX, [=](const pg8::Unit& u, int row, int col, pg8::f32x4 v0, pg8::f32x4 v1) {
      const float* g = modv + (size_t)(row / T) * 6 * D + 2 * D + col; const float* xr = x + (size_t)row * D + col; float* o = x1 + (size_t)row * D + col;
      const pg8::f32x4 g0 = *(const pg8::f32x4*)g, g1 = *(const pg8::f32x4*)(g + 4), x0 = *(const pg8::f32x4*)xr, x1v = *(const pg8::f32x4*)(xr + 4);
      *(pg8::f32x4*)o = x0 + g0 * v0; *(pg8::f32x4*)(o + 4) = x1v + g1 * v1; }); }
  GSYNC();
  ph_route<32>(p, tid, nth); GSYNC();
  ph_sort_a(p, tid, nth); GSYNC();
  ph_sort_b(p, tid, nth); GSYNC();
  const int npos = __builtin_amdgcn_readfirstlane(__hip_atomic_load(p.npos, __ATOMIC_RELAXED, __HIP_MEMORY_SCOPE_AGENT));
  for (int pos = gw; pos < npos; pos += ngw) { const int tok = p.pos_tok[pos]; v4u a = {0u, 0u, 0u, 0u}, b = a;
    if (tok >= 0) { const v4u* src = (const v4u*)(p.H2b + (size_t)tok * d.D) + lane * 2; a = src[0]; b = src[1]; }
    v4u* dst = (v4u*)(p.Xg + (size_t)pos * d.D) + lane * 2; dst[0] = a; dst[1] = b; }
  GSYNC();
  { bf16_t* ACT = p.ACTb; const float* b1 = p.exp_b1; const int DE = d.DE;
    run_gemm(lds, p.Xg, p.W1T, npos, 2 * d.DE, d.D, [=](const pg8::Unit& u, int row, int col, pg8::f32x4 v0, pg8::f32x4 v1) {
      const float* bb = b1 + (size_t)u.eb * 2 * DE + col; const pg8::f32x4 c0 = *(const pg8::f32x4*)bb, c1 = *(const pg8::f32x4*)(bb + 4);
      v0 = v0 + c0; v1 = v1 + c1; float o[4];
#pragma unroll
      for (int q = 0; q < 4; ++q) { const float gl = fminf(q < 2 ? v0[2 * q] : v1[2 * q - 4], 7.f), li = fminf(fmaxf(q < 2 ? v0[2 * q + 1] : v1[2 * q - 3], -7.f), 7.f);
        o[q] = gl * (li + 1.f) / (1.f + __expf(-1.702f * gl)); }
      uint2 w; w.x = pk2(o[0], o[1]); w.y = pk2(o[2], o[3]); *(uint2*)(ACT + (size_t)row * DE + (col >> 1)) = w; }, p.tile_e, (size_t)2 * d.DE * d.D * 2); }
  GSYNC();
  { bf16_t* Y = p.Yb; const float* b2 = p.exp_b2; const int D = d.D;
    run_gemm(lds, p.ACTb, p.W2T, npos, d.D, d.DE, [=](const pg8::Unit& u, int row, int col, pg8::f32x4 v0, pg8::f32x4 v1) {
      const float* bb = b2 + (size_t)u.eb * D + col; const pg8::f32x4 c0 = *(const pg8::f32x4*)bb, c1 = *(const pg8::f32x4*)(bb + 4);
      v0 = v0 + c0; v1 = v1 + c1; v4u w; w.x = pk2(v0[0], v0[1]); w.y = pk2(v0[2], v0[3]); w.z = pk2(v1[0], v1[1]); w.w = pk2(v1[2], v1[3]);
      *(v4u*)(Y + (size_t)row * D + col) = w; }, p.tile_e, (size_t)d.D * d.DE * 2); }
  GSYNC();
  ph_final(p, tid, nth);
}

static size_t carve(Pm& p, char* base) {
  const Dm& d = p.d; size_t off = 0;
#define CARVE(ptr, type, count) do { p.ptr = (type*)(base + off); off += (((size_t)(count) * sizeof(type)) + 255) / 256 * 256; } while (0)
  const size_t NRW = (size_t)d.NR * d.RW; const int NK = d.C + d.T;
  CARVE(modv, float, (size_t)(d.B + 1) * 6 * d.D);
  CARVE(top_e, int, (size_t)d.BT * 4); CARVE(cnt, int, d.NE); CARVE(slot_pos, int, (size_t)d.BT * 4); CARVE(pos_tok, int, d.NPOSMAX); CARVE(tile_e, int, d.NPOSMAX / d.PADR + 1); CARVE(npos, int, 4);
  CARVE(gate, float, (size_t)d.BT * 4);
  CARVE(WinT, bf16_t, (size_t)INP * d.D); CARVE(WuqT, bf16_t, (size_t)d.MH * d.QK * d.QL); CARVE(WukvT, bf16_t, (size_t)d.MH * (d.DN + d.DV) * d.KL); CARVE(WoutT, bf16_t, (size_t)d.D * d.MIX);
  CARVE(W1T, bf16_t, (size_t)d.NE * 2 * d.DE * d.D); CARVE(W2T, bf16_t, (size_t)d.NE * d.D * d.DE);
  const size_t early0 = off;
  CARVE(P, float, (size_t)d.NR * d.IN); CARVE(A1, bf16_t, (size_t)d.NR * d.D);
  const size_t after_p = off;
  CARVE(Rr, float, NRW); CARVE(Vv, float, NRW); CARVE(KK, float, NRW); CARVE(Kd, float, 2 * NRW); CARVE(Wd, float, 2 * NRW); CARVE(Bb, float, 2 * NRW);
  CARVE(Gt, float, (size_t)d.BT * d.RW); CARVE(QN, bf16_t, (size_t)d.BT * d.QL); CARVE(CN, bf16_t, (size_t)d.NR * d.KL);
  p.O2 = (float*)(base + off); CARVE(QF, float, (size_t)d.BT * d.MH * d.QK); CARVE(KVF, float, (size_t)d.NR * d.MH * (d.DN + d.DV));
  CARVE(Q, bf16_t, (size_t)d.B * d.MH * d.T * d.QK); CARVE(K, bf16_t, (size_t)d.B * d.MH * NK * d.QK); CARVE(V, bf16_t, (size_t)d.B * d.MH * NK * d.DV);
  CARVE(MIXb, bf16_t, (size_t)d.BT * d.MIX);
  size_t end1 = off;
  off = early0; CARVE(Zt, float, (size_t)2 * d.BT * d.RW); CARVE(Fend, float, (size_t)2 * d.B * d.RH * 32 * 128 * 64); CARVE(Sst, float, (size_t)2 * d.B * d.RH * 32 * 64 * 64);
  if (off > after_p) return (size_t)-1;
  off = early0; CARVE(x1, float, (size_t)d.BT * d.D); CARVE(H2b, bf16_t, (size_t)d.BT * d.D);
  if (off > after_p) return (size_t)-1;
  off = after_p; CARVE(Xg, bf16_t, (size_t)d.NPOSMAX * d.D); CARVE(ACTb, bf16_t, (size_t)d.NPOSMAX * d.DE); CARVE(Yb, bf16_t, (size_t)d.NPOSMAX * d.D);
  if (off > end1) end1 = off;
#undef CARVE
  return end1;
}

extern "C" void kernel_launch(void* const* d_in, const int* in_sizes, int n_in, void* d_out, int out_size, void* d_ws, size_t ws_size, hipStream_t stream) {
  static int grid = 0;
  if (!grid) {
    int dev = 0, cus = 0;
    hipGetDevice(&dev); hipDeviceGetAttribute(&cus, hipDeviceAttributeMultiprocessorCount, dev);
    if (hipFuncSetAttribute((const void*)fwd, hipFuncAttributeMaxDynamicSharedMemorySize, LDS_BYTES) != hipSuccess) { fprintf(stderr, "kernel_launch: hipFuncSetAttribute failed\n"); grid = -1; return; }
    grid = cus;
  }
  if (grid < 0) return;
  Pm p; memset(&p, 0, sizeof(p));
  Dm& d = p.d; d.D = 1024; d.B = 2; d.T = 8192; d.GW = 64; d.C = 256; d.RH = 8; d.LW = 64; d.LA = 64; d.LG = 128; d.MH = 4; d.DN = 128; d.DR = 64; d.DV = 128; d.QL = 256; d.KL = 128;
  d.NE = 32; d.DE = 1024; d.PADR = 256; dm_finish(d);
  const float** ip = &p.x; for (int i = 0; i < 32; ++i) ip[i] = (const float*)d_in[i];
  p.out = (float*)d_out;
  unsigned* bar = (unsigned*)d_ws;
  const size_t used = carve(p, (char*)d_ws + 16384);
  if (used == (size_t)-1 || used + 16384 > ws_size) { fprintf(stderr, "kernel_launch: workspace too small (%zu needed, %zu given)\n", used + 16384, ws_size); return; }
  static bool once = false; if (!once) { once = true; fprintf(stderr, "ws used %zu of %zu\n", used + 16384, ws_size); }
  hipMemsetAsync(bar, 0, 16384, stream);
  hipLaunchKernelGGL(fwd, dim3(grid), dim3(NTHREADS), LDS_BYTES, stream, p, bar);
}
```

```cpp
#include <hip/hip_runtime.h>
#include <cstdio>
#include <cstring>
#include <cstdint>
#define HD __host__ __device__
#ifndef HD
#define HD
#endif
struct Dm {
  int D, B, T, GW, C, RH, LW, LA, LG, MH, DN, DR, DV, QL, KL, NE, DE;
  int RW, RC, QK, MC, IN, MIX, NF, BT, BC, NR, PADR, NPOSMAX, pad_;
};
HD constexpr void dm_finish(Dm& d) {
  d.RW = d.RH * 64; d.RC = 3 * d.RW + d.LW + d.LA + d.LG; d.QK = d.DN + d.DR; d.MC = d.QL + d.KL + d.DR; d.IN = d.RC + d.MC;
  d.MIX = d.RW + d.MH * d.DV; d.NF = d.DR / 4; d.BT = d.B * d.T; d.BC = d.B * d.C; d.NR = d.BT + d.BC;
  d.NPOSMAX = d.BT * 4 + d.NE * d.PADR;
}
typedef unsigned short bf16_t;
HD inline bf16_t f2bf(float f) { unsigned u = __builtin_bit_cast(unsigned, f); return (bf16_t)((u + 0x7fffu + ((u >> 16) & 1u)) >> 16); }
HD inline float bf2f(bf16_t h) { return __builtin_bit_cast(float, (unsigned)h << 16); }
HD constexpr Dm make_dmc() { Dm d{}; d.D = 1024; d.B = 2; d.T = 8192; d.GW = 64; d.C = 256; d.RH = 8; d.LW = 64; d.LA = 64; d.LG = 128; d.MH = 4; d.DN = 128; d.DR = 64; d.DV = 128; d.QL = 256; d.KL = 128;
  d.NE = 32; d.DE = 1024; d.PADR = 256; dm_finish(d); return d; }
constexpr Dm DMC = make_dmc();
struct Pm {
  Dm d;
  const float *x, *c, *ctx, *c_ctx, *mod_w, *mod_b, *norm1_g, *w_in, *mu, *w0, *w2, *a0, *a2, *k_k, *k_a, *r_k, *g2, *ln_w, *ln_b, *q_norm, *w_uq, *kv_norm,
      *w_ukv, *w_out, *norm2_g, *router_w, *router_b, *exp_w1, *exp_b1, *exp_w2, *exp_b2, *final_g;
  float* out;
  float *modv, *modp, *ropet, *Kraw, *P, *Rr, *Vv, *KK, *Kd, *Wd, *Bb, *Gt, *O2, *Zt, *Fend, *Sst, *x1, *gate;
  bf16_t *A1, *QN, *CN, *MIXb, *WinT, *WuqT, *WukvT, *WoutT, *W1T, *W2T, *H2b, *Xg, *ACTb, *Yb, *Q, *K, *V, *AL1, *AL2, *WlT, *G2T;
  int *top_e, *cnt, *slot_pos, *pos_tok, *tile_e, *npos, *lrank, *blkcnt;
};
HD inline float sigmoidf_(float x) { return 1.f / (1.f + expf(-x)); }

template <int TM, class Epi>
HD inline void gemm_naive(const float* A, int lda, const float* Bm, int ldb, int M, int N, int K, long tid, long nth, Epi epi) {
  const long ngm = (M + TM - 1) / TM, items = ngm * N;
  for (long it = tid; it < items; it += nth) {
    const int n = (int)(it % N); const long m0 = (it / N) * TM;
    float acc[TM];
#pragma unroll
    for (int i = 0; i < TM; ++i) acc[i] = 0.f;
    const float* a[TM];
#pragma unroll
    for (int i = 0; i < TM; ++i) a[i] = A + (size_t)((m0 + i < M) ? (m0 + i) : (M - 1)) * lda;
    for (int k = 0; k < K; k += 4) {
      const float b0 = Bm[(size_t)k * ldb + n], b1 = Bm[(size_t)(k + 1) * ldb + n], b2 = Bm[(size_t)(k + 2) * ldb + n], b3 = Bm[(size_t)(k + 3) * ldb + n];
#pragma unroll
      for (int i = 0; i < TM; ++i) { acc[i] += a[i][k] * b0; acc[i] += a[i][k + 1] * b1; acc[i] += a[i][k + 2] * b2; acc[i] += a[i][k + 3] * b3; }
    }
#pragma unroll
    for (int i = 0; i < TM; ++i) if (m0 + i < M) epi(m0 + i, n, acc[i]);
  }
}

HD inline void row_pos(const Dm& d, long row, int& t, int& len, int& b, int& isctx) {
  if (row < d.BT) { b = (int)(row / d.T); t = (int)(row % d.T); len = d.T; isctx = 0; } else { const long r = row - d.BT; b = (int)(r / d.C); t = (int)(r % d.C); len = d.C; isctx = 1; }
}

HD inline void chain_step(const Dm& d, int dd, int b, int sg, size_t& row, bool& lat) {
  if (sg < d.C) { const int t = dd == 0 ? sg : d.C - 1 - sg; row = (size_t)d.BT + (size_t)b * d.C + t; lat = false; }
  else { const int s = sg - d.C; const int t = dd == 0 ? s : d.T - 1 - s; row = (size_t)b * d.T + t; lat = true; }
}
HD inline void ph_scan_a1(const Pm& p, long tid, long nth, int NSEG) {
  constexpr Dm d = DMC; const int RW = d.RW; const int SL = (d.C + d.T) / NSEG; const long items = (long)2 * d.B * d.RH * NSEG * 128; const size_t NRW = (size_t)d.NR * RW, BTW = (size_t)d.BT * RW;
  for (long it = tid; it < items; it += nth) {
    const int rho = (int)(it % 128); const int g = (int)((it / 128) % NSEG); const int ch = (int)(it / (128 * (long)NSEG)); const int h = ch % d.RH, b = (ch / d.RH) % d.B, dd = ch / (d.RH * d.B);
    float S[64];
#pragma unroll
    for (int j = 0; j < 64; ++j) S[j] = (rho >= 64 && j == rho - 64) ? 1.f : 0.f;
    for (int sg = g * SL; sg < (g + 1) * SL; ++sg) {
      size_t row; bool lat; chain_step(d, dd, b, sg, row, lat); const size_t o = row * RW + h * 64;
      const float* w = p.Wd + dd * NRW + o; const float* bb = p.Bb + dd * NRW + o; const float* kd = p.Kd + dd * NRW + o; const float* kk = p.KK + o; const float* rr = p.Rr + o;
      const float vv = rho < 64 ? p.Vv[o + rho] : 0.f;
      float sa = 0.f;
#pragma unroll
      for (int j = 0; j < 64; ++j) sa += S[j] * kk[j];
      float oo = 0.f;
#pragma unroll
      for (int j = 0; j < 64; ++j) { S[j] = S[j] * w[j] - sa * bb[j] + vv * kd[j]; oo += S[j] * rr[j]; }
      if (lat) { if (rho < 64) p.O2[dd * BTW + o + rho] = oo; else p.Zt[dd * BTW + o + rho - 64] = oo; }
    }
    float* fe = p.Fend + (((size_t)ch * NSEG + g) * 128 + rho) * 64;
#pragma unroll
    for (int j = 0; j < 64; ++j) fe[j] = S[j];
  }
}
__device__ inline void ph_scan_a2(const Pm& p, int gw, int ngw, int lane, int NSEG) {
  constexpr Dm d = DMC; const int items = 2 * d.B * d.RH * 64;
  for (int it = gw; it < items; it += ngw) { const int v = it % 64, ch = it / 64; float S = 0.f;
    for (int g = 0; g < NSEG; ++g) { p.Sst[(((size_t)ch * NSEG + g) * 64 + v) * 64 + lane] = S;
      const float* fe = p.Fend + ((size_t)ch * NSEG + g) * 128 * 64; float acc = fe[(size_t)v * 64 + lane];
#pragma unroll
      for (int i = 0; i < 64; ++i) { const float si = __builtin_bit_cast(float, __builtin_amdgcn_readlane(__builtin_bit_cast(int, S), i)); acc += si * fe[(size_t)(64 + i) * 64 + lane]; }
      S = acc; } }
}
HD inline void ph_scan_a3(const Pm& p, long tid, long nth, int NSEG) {
  constexpr Dm d = DMC; const int RW = d.RW; const int SL = (d.C + d.T) / NSEG; const size_t BTW = (size_t)d.BT * RW; const long items = (long)2 * BTW;
  for (long it = tid; it < items; it += nth) {
    const int dd = (int)(it / BTW); const long rem = it % BTW; const long row = rem / RW; const int c = (int)(rem % RW), h = c / 64, v = c % 64; const int b = (int)(row / d.T), t = (int)(row % d.T);
    const int sg = d.C + (dd == 0 ? t : d.T - 1 - t), g = sg / SL; const int ch = (dd * d.B + b) * d.RH + h;
    const float* st = p.Sst + (((size_t)ch * NSEG + g) * 64 + v) * 64; const float* z = p.Zt + dd * BTW + (size_t)row * RW + h * 64;
    float a = p.O2[it];
    for (int i = 0; i < 64; ++i) a += st[i] * z[i];
    p.O2[it] = a;
  }
}

namespace pg8 {
#define PG8_LAS __attribute__((address_space(3)))
typedef unsigned short bf16_t;
typedef short bf16x8 __attribute__((ext_vector_type(8)));
typedef float f32x4 __attribute__((ext_vector_type(4)));
typedef unsigned u32x4 __attribute__((ext_vector_type(4)));
constexpr int BM = 256, BK = 64, HALF = 128, HTB = HALF * BK * 2  , STAGE_BYTES = 8 * HTB, NXCD = 8, WGM = 8;

__host__ __device__ __forceinline__ int lds_byte(int r, int c) { const int st = (r >> 4) * 2 + (c >> 5), rr = r & 15, cc = c & 31, ob = rr * 64 + cc * 2; return st * 1024 + (ob ^ (((ob >> 9) & 1) << 5)); }
__host__ __device__ __forceinline__ void stage_rc(int b, int& R, int& C) { const int st = b / 1024, sb = b % 1024, swz = sb ^ (((sb >> 9) & 1) << 5); R = (st >> 1) * 16 + swz / 64; C = (st & 1) * 32 + (swz % 64) / 2; }
__host__ __device__ __forceinline__ int perm32(int rho) { const int n = rho >> 4, i = rho & 15; return 8 * (i >> 2) + 4 * n + (i & 3); }

struct Unit { int pm, pn, eb; };
struct Gemm { const bf16_t* A; const bf16_t* Bt; int M, N, K; size_t bexp; };

struct StaticOrder {
    int nM, nN, nwg, G, c; const int* tile_e;
    __host__ __device__ void init(int M, int N, int G_, int c_, const int* te = nullptr) { nM = M / BM; nN = N / BM; nwg = nM * nN; G = G_; c = c_; tile_e = te; }
    __device__ bool next(int i, Unit& u) const {
        const long L = (long)i * G + c; if (L >= nwg) return false;
        int wgid = (int)L; { const int q = nwg / NXCD, r = nwg % NXCD, xcd = wgid % NXCD, off = wgid / NXCD; wgid = (xcd < r ? xcd * (q + 1) : r * (q + 1) + (xcd - r) * q) + off; }
        const int nig = WGM * nN, gid = wgid / nig, fm = gid * WGM, gsz = (nM - fm) < WGM ? (nM - fm) : WGM;
        u.pm = fm + ((wgid % nig) % gsz); u.pn = (wgid % nig) / gsz; u.eb = tile_e ? __builtin_amdgcn_readfirstlane(__hip_atomic_load(tile_e + u.pm, __ATOMIC_RELAXED, __HIP_MEMORY_SCOPE_AGENT)) : 0; return true;
    }
    __device__ __forceinline__ void a_ready(const Unit&) const {}
    __device__ __forceinline__ void done(const Unit&) const {}
};
__device__ __forceinline__ unsigned cvt_pk_bf16(float lo, float hi) { unsigned r; asm volatile("v_cvt_pk_bf16_f32 %0, %1, %2" : "=v"(r) : "v"(lo), "v"(hi)); return r; }
typedef float f32x2 __attribute__((ext_vector_type(2)));
template <class Epi, class Sched, bool ALIGN_EPI = false, bool SP2 = false>
__device__ __forceinline__ void gemm_phase(PG8_LAS unsigned char* lds, const Gemm g, const Sched& S, const Epi& E, const int tid_in) {
    int tid_ = tid_in; asm volatile("" : "+v"(tid_));
    const int tid = tid_, wid = __builtin_amdgcn_readfirstlane(tid >> 6), lane = tid & 63, wr = wid >> 2, wc = wid & 3, fr = lane & 15, fq = lane >> 4;
    const int K = g.K, nt = K / BK;
    unsigned voffA[2], voffB[2];
#pragma unroll
    for (int i = 0; i < 2; ++i) { int R, C; stage_rc(tid * 16 + i * 8192, R, C); const int Rb = Epi::PERM ? ((R & ~31) + perm32(R & 31)) : R;
        voffA[i] = (unsigned)(R * K + C) * 2u; voffB[i] = (unsigned)(Rb * K + C) * 2u; }
    const size_t kstep = (size_t)(BK * 2);
    const size_t hstep = (size_t)HALF * K * 2;
    const size_t tstep = 2 * hstep;
    const unsigned ldsw = (unsigned)wid * 1024u;
    const int aoff = lds_byte(wr * 64 + fr, fq * 8), boff = lds_byte(wc * 32 + fr, fq * 8);
#define PG8_SA(b, h) (((b) * 2 + (h)) * HTB)
#define PG8_SB(b, h) ((4 + (b) * 2 + (h)) * HTB)
#define PG8_STAGE(bufoff, gbase, voff) do { _Pragma("unroll") for (int _i = 0; _i < 2; ++_i) \
        __builtin_amdgcn_global_load_lds((const unsigned*)((const char*)(gbase) + (voff)[_i]), (PG8_LAS unsigned*)(lds + (bufoff) + ldsw + _i * 8192), 16, 0, 0); } while (0)
#define PG8_LDA(dst, b, h) do { _Pragma("unroll") for (int m = 0; m < 4; ++m) _Pragma("unroll") for (int k = 0; k < 2; ++k) dst[m][k] = *(const PG8_LAS bf16x8*)(lds + PG8_SA(b, h) + aoff + m * 2048 + k * 1024); } while (0)
#define PG8_LDB(dst, b, h) do { _Pragma("unroll") for (int n = 0; n < 2; ++n) _Pragma("unroll") for (int k = 0; k < 2; ++k) dst[n][k] = *(const PG8_LAS bf16x8*)(lds + PG8_SB(b, h) + boff + n * 2048 + k * 1024); } while (0)
#define PG8_MMA(ai, bj, At, Bt) do { __builtin_amdgcn_s_setprio(1); _Pragma("unroll") for (int m = 0; m < 4; ++m) _Pragma("unroll") for (int n = 0; n < 2; ++n) _Pragma("unroll") for (int k = 0; k < 2; ++k) \
        acc[ai][bj][m][n] = __builtin_amdgcn_mfma_f32_16x16x32_bf16(Bt[n][k], At[m][k], acc[ai][bj][m][n], 0, 0, 0); __builtin_amdgcn_s_setprio(0); } while (0)
#define PG8_WAIT_V(n) asm volatile("s_waitcnt vmcnt(" #n ")" ::: "memory")
#define PG8_WAIT_L(n) asm volatile("s_waitcnt lgkmcnt(" #n ")" ::: "memory")
#define PG8_BAR __builtin_amdgcn_s_barrier()
#define PG8_SCHED __builtin_amdgcn_sched_barrier(0)
    Unit cur, nxt; int ui = 0;
    if (!S.next(0, cur)) return;
    f32x4 acc[2][2][4][2];
#pragma unroll
    for (int a = 0; a < 2; ++a)
#pragma unroll
        for (int b = 0; b < 2; ++b)
#pragma unroll
            for (int m = 0; m < 4; ++m)
#pragma unroll
                for (int n = 0; n < 2; ++n) acc[a][b][m][n] = (f32x4){0.f, 0.f, 0.f, 0.f};
    bf16x8 At[4][2], B0[2][2], B1[2][2];
    const char* cA = (const char*)g.A + (size_t)cur.pm * tstep; const char* cB = (const char*)g.Bt + (size_t)cur.eb * g.bexp + (size_t)cur.pn * tstep;
    S.a_ready(cur);
    if constexpr (SP2) {
        PG8_STAGE(PG8_SB(0, 0), cB, voffB); PG8_STAGE(PG8_SB(0, 1), cB + hstep, voffB); PG8_STAGE(PG8_SA(0, 0), cA, voffA); PG8_STAGE(PG8_SA(0, 1), cA + hstep, voffA);
        if (wr == 1) PG8_BAR;
        PG8_WAIT_V(2); PG8_BAR;
        PG8_STAGE(PG8_SB(1, 0), cB + kstep, voffB); PG8_STAGE(PG8_SA(1, 0), cA + kstep, voffA); PG8_STAGE(PG8_SB(1, 1), cB + hstep + kstep, voffB);
        PG8_WAIT_V(6); PG8_BAR;
    } else {
        PG8_STAGE(PG8_SB(0, 0), cB, voffB); PG8_STAGE(PG8_SA(0, 0), cA, voffA); PG8_STAGE(PG8_SB(0, 1), cB + hstep, voffB); PG8_STAGE(PG8_SA(0, 1), cA + hstep, voffA);
        if (wr == 1) PG8_BAR;
        PG8_WAIT_V(4); PG8_BAR;
        PG8_STAGE(PG8_SB(1, 0), cB + kstep, voffB); PG8_STAGE(PG8_SA(1, 0), cA + kstep, voffA); PG8_STAGE(PG8_SB(1, 1), cB + hstep + kstep, voffB);
        PG8_WAIT_V(6); PG8_BAR;
    }
    for (;;) {
        const bool has_next = S.next(ui + 1, nxt);
        const char* nA = has_next ? (const char*)g.A + (size_t)nxt.pm * tstep : cA; const char* nB = has_next ? (const char*)g.Bt + (size_t)nxt.eb * g.bexp + (size_t)nxt.pn * tstep : cB;
        for (int t = 0; t < nt; t += 2) {
            const bool last = (t == nt - 2);
            const char* a1 = cA + (size_t)(t + 1) * kstep;
            const char* a2 = last ? nA : cA + (size_t)(t + 2) * kstep; const char* b2 = last ? nB : cB + (size_t)(t + 2) * kstep;
            const char* a3 = a2 + kstep; const char* b3 = b2 + kstep;
            if (last && has_next) S.a_ready(nxt);
            if constexpr (SP2) {
            PG8_LDB(B0, 0, 0); PG8_LDB(B1, 0, 1); PG8_SCHED; PG8_LDA(At, 0, 0); PG8_STAGE(PG8_SA(1, 1), a1 + hstep, voffA);
            PG8_WAIT_V(8); PG8_WAIT_L(0); PG8_BAR; PG8_MMA(0, 0, At, B0); PG8_MMA(0, 1, At, B1); PG8_BAR; PG8_SCHED;
            PG8_LDA(At, 0, 1); PG8_STAGE(PG8_SB(0, 0), b2, voffB); PG8_STAGE(PG8_SB(0, 1), b2 + hstep, voffB); PG8_STAGE(PG8_SA(0, 0), a2, voffA);
            PG8_WAIT_V(8); PG8_WAIT_L(0); PG8_BAR; PG8_MMA(1, 0, At, B0); PG8_MMA(1, 1, At, B1); PG8_BAR; PG8_SCHED;
            PG8_LDB(B0, 1, 0); PG8_LDB(B1, 1, 1); PG8_SCHED; PG8_LDA(At, 1, 0); PG8_STAGE(PG8_SA(0, 1), a2 + hstep, voffA);
            PG8_WAIT_V(8); PG8_WAIT_L(0); PG8_BAR; PG8_MMA(0, 0, At, B0); PG8_MMA(0, 1, At, B1); PG8_BAR; PG8_SCHED;
            PG8_LDA(At, 1, 1); PG8_STAGE(PG8_SB(1, 0), b3, voffB); PG8_STAGE(PG8_SB(1, 1), b3 + hstep, voffB); PG8_STAGE(PG8_SA(1, 0), a3, voffA);
            PG8_WAIT_V(8); PG8_WAIT_L(0); PG8_BAR; PG8_MMA(1, 0, At, B0); PG8_MMA(1, 1, At, B1); PG8_BAR; PG8_SCHED;
            } else {
            PG8_LDB(B0, 0, 0); PG8_SCHED; PG8_LDA(At, 0, 0); PG8_STAGE(PG8_SA(1, 1), a1 + hstep, voffA);
            PG8_WAIT_L(8); PG8_BAR; PG8_WAIT_L(0); PG8_MMA(0, 0, At, B0); PG8_BAR; PG8_SCHED;
            PG8_LDB(B1, 0, 1); PG8_STAGE(PG8_SB(0, 0), b2, voffB);
            PG8_BAR; PG8_WAIT_L(0); PG8_MMA(0, 1, At, B1); PG8_BAR;
            PG8_LDA(At, 0, 1); PG8_STAGE(PG8_SA(0, 0), a2, voffA);
            PG8_BAR; PG8_WAIT_L(0); PG8_MMA(1, 0, At, B0); PG8_BAR; PG8_SCHED;
            PG8_STAGE(PG8_SB(0, 1), b2 + hstep, voffB);
            PG8_WAIT_V(6); PG8_BAR; PG8_MMA(1, 1, At, B1); PG8_BAR;
            PG8_LDB(B0, 1, 0); PG8_SCHED; PG8_LDA(At, 1, 0); PG8_STAGE(PG8_SA(0, 1), a2 + hstep, voffA);
            PG8_WAIT_L(8); PG8_BAR; PG8_WAIT_L(0); PG8_MMA(0, 0, At, B0); PG8_BAR; PG8_SCHED;
            PG8_LDB(B1, 1, 1); PG8_STAGE(PG8_SB(1, 0), b3, voffB);
            PG8_BAR; PG8_WAIT_L(0); PG8_MMA(0, 1, At, B1); PG8_BAR;
            PG8_LDA(At, 1, 1); PG8_STAGE(PG8_SA(1, 0), a3, voffA);
            PG8_BAR; PG8_WAIT_L(0); PG8_MMA(1, 0, At, B0); PG8_BAR; PG8_SCHED;
            PG8_STAGE(PG8_SB(1, 1), b3 + hstep, voffB);
            PG8_WAIT_V(6); PG8_BAR; PG8_MMA(1, 1, At, B1); PG8_BAR;
            }
        }
        if constexpr (ALIGN_EPI) { if (wr == 0) PG8_BAR; }
        if constexpr (!Epi::AFTER_DRAIN) { E(acc, cur, wr, wc, fr, fq); S.done(cur); }
        if (!has_next) break;
#pragma unroll
        for (int a = 0; a < 2; ++a)
#pragma unroll
            for (int b = 0; b < 2; ++b)
#pragma unroll
                for (int m = 0; m < 4; ++m)
#pragma unroll
                    for (int n = 0; n < 2; ++n) acc[a][b][m][n] = (f32x4){0.f, 0.f, 0.f, 0.f};
        cur = nxt; cA = nA; cB = nB; ++ui;
        if constexpr (ALIGN_EPI) { if (wr == 1) PG8_BAR; }
    }
    PG8_WAIT_V(0);
    if constexpr (!ALIGN_EPI) { if (wr == 0) PG8_BAR; }
    PG8_BAR;
    if constexpr (Epi::AFTER_DRAIN) { E.fused(acc, cur, wr, wc, fr, fq, lds, wid, lane); S.done(cur); }
#undef PG8_SA
#undef PG8_SB
#undef PG8_STAGE
#undef PG8_LDA
#undef PG8_LDB
#undef PG8_MMA
#undef PG8_WAIT_V
#undef PG8_WAIT_L
#undef PG8_BAR
#undef PG8_SCHED
}
}

#define XB_TMO      128
#define XB_XCNT(j)  (256  + 64 * (j))
#define XB_XSUB(j)  (1280 + 64 * (j))
#define XB_XGEN(j)  (2304 + 64 * (j))
#define XB_TOP      3328
#define XB_TOPGEN   3392
#define XCD_BAR_WORDS 3456
#define XB_SPIN_CAP (1u << 22)
#define LAS __attribute__((address_space(3)))

__device__ __forceinline__ unsigned xb_ld(unsigned* p)              { return __hip_atomic_load(p, __ATOMIC_RELAXED, __HIP_MEMORY_SCOPE_AGENT); }
__device__ __forceinline__ unsigned xb_add(unsigned* p, unsigned v) { return __hip_atomic_fetch_add(p, v, __ATOMIC_RELAXED, __HIP_MEMORY_SCOPE_AGENT); }
__device__ __forceinline__ unsigned xb_xcc_id() { return (unsigned)__builtin_amdgcn_s_getreg((3 << 11) | 20) & 0xFu; }
#define XB_SPIN(cond, bar) do { unsigned _sp = 0; while (cond) { __builtin_amdgcn_s_sleep(1); \
    if ((++_sp & 255u) == 0u) { if (xb_ld(&(bar)[XB_TMO])) break; if (_sp > XB_SPIN_CAP) { atomicAdd(&(bar)[XB_TMO], 1u); break; } } } } while (0)

struct XcdBarrier {
    unsigned* bar; unsigned x; int wv;
    volatile LAS unsigned* st;
};

__device__ __forceinline__ XcdBarrier xcd_barrier_post(unsigned* bar, volatile LAS unsigned* st) {
    XcdBarrier b; b.bar = bar; b.x = xb_xcc_id(); b.st = st; b.wv = __builtin_amdgcn_readfirstlane((int)threadIdx.x >> 6);
    if (threadIdx.x == 0) (void)xb_add(&bar[XB_XCNT(b.x)], 1u);
    return b;
}
__device__ __forceinline__ void xcd_barrier_complete(unsigned* bar, unsigned x, unsigned& nloc, unsigned& nx) {
    const unsigned G = gridDim.x * gridDim.y * gridDim.z;
    unsigned sum, cnt, mine, sp = 0u;
    for (;;) {
        sum = 0u; cnt = 0u; mine = 0u;
#pragma unroll
        for (unsigned j = 0; j < 16; ++j) { const unsigned c = xb_ld(&bar[XB_XCNT(j)]); sum += c; cnt += (c > 0u) ? 1u : 0u; mine = (j == x) ? c : mine; }
        if (sum == G) break;
        __builtin_amdgcn_s_sleep(1);
        if ((++sp & 255u) == 0u) { if (xb_ld(&bar[XB_TMO])) break; if (sp > XB_SPIN_CAP) { atomicAdd(&bar[XB_TMO], 1u); break; } }
    }
    nloc = mine > 0u ? mine : 1u; nx = cnt > 0u ? cnt : 1u;
}

__device__ __forceinline__ void xcd_barrier(const XcdBarrier& b) {
    asm volatile("s_waitcnt vmcnt(0)" ::: "memory");
    __syncthreads();
    int ln_; asm volatile("v_mbcnt_lo_u32_b32 %0, -1, 0\n\tv_mbcnt_hi_u32_b32 %0, -1, %0" : "=v"(ln_));
    if (b.wv == 0 && ln_ == 0) {
        unsigned* bar = b.bar;
        __builtin_amdgcn_s_waitcnt(0);
        unsigned nloc = b.st[0], nx = b.st[1];
        if (nloc == 0u) { xcd_barrier_complete(bar, b.x, nloc, nx); b.st[0] = nloc; b.st[1] = nx; }
        const unsigned old = xb_add(&bar[XB_XSUB(b.x)], 1u);
        const unsigned gen = old / nloc;
        if (old + 1u == (gen + 1u) * nloc) {
            __builtin_amdgcn_fence(__ATOMIC_RELEASE, "agent");
            asm volatile("s_waitcnt vmcnt(0)" ::: "memory");
            const unsigned og = xb_add(&bar[XB_TOP], 1u);
            const unsigned tg = og / nx;
            if (og + 1u == (tg + 1u) * nx) xb_add(&bar[XB_TOPGEN], 1u);
            else XB_SPIN(xb_ld(&bar[XB_TOPGEN]) == tg, bar);
            __builtin_amdgcn_fence(__ATOMIC_ACQUIRE, "agent");
            xb_add(&bar[XB_XGEN(b.x)], 1u);
            asm volatile("s_waitcnt vmcnt(0)" ::: "memory");
        } else {
            XB_SPIN(xb_ld(&bar[XB_XGEN(b.x)]) == gen, bar);
            __builtin_amdgcn_fence(__ATOMIC_ACQUIRE, "agent");
            asm volatile("s_waitcnt vmcnt(0)" ::: "memory");
        }
    }
    __syncthreads();
}


namespace attn {
using bf16 = unsigned short;
constexpr int DQK = 192, DV = 128, NW = 8, QBLK = 32, KVBLK = 64;
constexpr float SCALE = 0.07216878364870322f;
constexpr float THR = 8.f;
constexpr int SDEPTH = 1;
constexpr int LDQ = DQK, LDK = DQK, LDV = DV, LDO = 1024;
constexpr size_t SHM_V = KVBLK * DV * 2, SHM_K = KVBLK * DQK * 2, SHM_ATTN = 2 * SHM_V + 2 * SHM_K + NW * 64 * 4;
using bf16x8 = __attribute__((ext_vector_type(8))) short;
using s16x4  = __attribute__((ext_vector_type(4))) short;
using f32x16 = __attribute__((ext_vector_type(16))) float;
using f32x8  = __attribute__((ext_vector_type(8))) float;
using u32x4  = __attribute__((ext_vector_type(4))) unsigned;
#define KSWZ(row, colB) ((row) * 384 + ((colB) ^ (((row) & 7) << 4)))
#define SBAR() __builtin_amdgcn_sched_barrier(0)
__device__ __forceinline__ int crow(int r, int hi) { return (r & 3) + 8 * (r >> 2) + 4 * hi; }
__device__ __forceinline__ unsigned cvtpk(float lo, float hi) {
  unsigned r; asm volatile("v_cvt_pk_bf16_f32 %0, %1, %2" : "=v"(r) : "v"(lo), "v"(hi)); return r;
}
struct St { using T = bf16x8;
  __device__ static __forceinline__ T ld8(const bf16* p) { return *reinterpret_cast<const bf16x8*>(p); }
  __device__ static __forceinline__ bf16x8 tobf(T x) { return x; } };
__device__ __forceinline__ void partialSM(f32x16& p0, f32x16& p1, float& m_reg, float& mn, float& alpha) {
  constexpr float C = SCALE * 1.4426950408889634f;
  float pmax = p0[0]; for (int r = 1; r < 16; ++r) pmax = fmaxf(pmax, p0[r]); for (int r = 0; r < 16; ++r) pmax = fmaxf(pmax, p1[r]);
  { auto rr = __builtin_amdgcn_permlane32_swap(__float_as_uint(pmax), __float_as_uint(pmax), false, false);
    pmax = fmaxf(__uint_as_float(rr[0]), __uint_as_float(rr[1])); }
  if (__builtin_expect(__all(pmax - m_reg <= THR / SCALE), 1)) { mn = m_reg; alpha = 1.f; }
  else { mn = fmaxf(m_reg, pmax); alpha = __builtin_amdgcn_exp2f((m_reg - mn) * C); m_reg = mn; }
  float mnC = -mn * C;
  for (int r = 0; r < 16; ++r) p0[r] = fmaf(p0[r], C, mnC); for (int r = 0; r < 16; ++r) p1[r] = fmaf(p1[r], C, mnC);
  for (int r = 0; r < 16; ++r) p0[r] = __builtin_amdgcn_exp2f(p0[r]);
}
__device__ __forceinline__ void finishSM(f32x16& p0, f32x16& p1, float alpha, float& l_reg, bf16x8& pa0, bf16x8& pa1, bf16x8& pa2, bf16x8& pa3) {
  for (int r = 0; r < 16; ++r) p1[r] = __builtin_amdgcn_exp2f(p1[r]);
  float ps = 0; for (int r = 0; r < 16; ++r) ps += p0[r]; for (int r = 0; r < 16; ++r) ps += p1[r];
  { auto rr = __builtin_amdgcn_permlane32_swap(__float_as_uint(ps), __float_as_uint(ps), false, false);
    ps = __uint_as_float(rr[0]) + __uint_as_float(rr[1]); }
  l_reg = l_reg * alpha + ps;
#define PK4(P, BASE, OUT) do { unsigned a0 = cvtpk(P[BASE + 0], P[BASE + 1]), a1 = cvtpk(P[BASE + 2], P[BASE + 3]);   \
    unsigned b0 = cvtpk(P[BASE + 4], P[BASE + 5]), b1 = cvtpk(P[BASE + 6], P[BASE + 7]);                              \
    auto r0 = __builtin_amdgcn_permlane32_swap(a0, b0, false, false); auto r1 = __builtin_amdgcn_permlane32_swap(a1, b1, false, false); \
    u32x4 w = {r0[0], r1[0], r0[1], r1[1]}; OUT = *reinterpret_cast<bf16x8*>(&w); } while (0)
  PK4(p0, 0, pa0); PK4(p0, 8, pa1); PK4(p1, 0, pa2); PK4(p1, 8, pa3);
#undef PK4
}
__device__ __forceinline__ void qkt(f32x16& p0, f32x16& p1, const bf16* Ks, const bf16x8* qr, int r32, int hi) {
  p0 = f32x16{}; p1 = f32x16{};
  for (int d0 = 0; d0 < 12; ++d0) { int cb = (d0 * 16 + hi * 8) * 2;
    bf16x8 b0 = *reinterpret_cast<const bf16x8*>((const char*)Ks + KSWZ(r32, cb));
    bf16x8 b1 = *reinterpret_cast<const bf16x8*>((const char*)Ks + KSWZ(32 + r32, cb));
    p0 = __builtin_amdgcn_mfma_f32_32x32x16_bf16(b0, qr[d0], p0, 0, 0, 0);
    p1 = __builtin_amdgcn_mfma_f32_32x32x16_bf16(b1, qr[d0], p1, 0, 0, 0); }
}
__device__ __forceinline__ int v_st(int k, int c) { const int kk = (k & ~0xC) | ((k & 4) << 1) | ((k & 8) >> 1); return ((kk >> 3) * 4 + (c >> 5)) * 512 + ((kk & 7) * 32 + (c & 31)) * 2; }
__device__ __forceinline__ int v_rd_base(int lane) { return ((lane & 3) << 3) | (((lane >> 2) & 3) << 6) | (((lane >> 4) & 1) << 5) | (((lane >> 5) & 1) << 8); }
constexpr int v_rd_off(int d0, int ks, int half) { return d0 * 512 + ks * 4096 + half * 2048; }
template <int OFF> __device__ __forceinline__ s16x4 tr_read(int vb) {
  s16x4 r; asm volatile("ds_read_b64_tr_b16 %0, %1 offset:%2" : "=&v"(r) : "v"(vb), "i"(OFF) : "memory"); return r;
}
template <int D0> __device__ __forceinline__ void pv_one(f32x16& od, int vb, bf16x8 pa0, bf16x8 pa1, bf16x8 pa2, bf16x8 pa3) {
  const s16x4 l0 = tr_read<v_rd_off(D0, 0, 0)>(vb), h0 = tr_read<v_rd_off(D0, 0, 1)>(vb), l1 = tr_read<v_rd_off(D0, 1, 0)>(vb), h1 = tr_read<v_rd_off(D0, 1, 1)>(vb);
  const s16x4 l2 = tr_read<v_rd_off(D0, 2, 0)>(vb), h2 = tr_read<v_rd_off(D0, 2, 1)>(vb), l3 = tr_read<v_rd_off(D0, 3, 0)>(vb), h3 = tr_read<v_rd_off(D0, 3, 1)>(vb);
  asm volatile("s_waitcnt lgkmcnt(0)" ::: "memory"); SBAR();
#define PK(L, H) (bf16x8){L[0], L[1], L[2], L[3], H[0], H[1], H[2], H[3]}
  od = __builtin_amdgcn_mfma_f32_32x32x16_bf16(pa0, PK(l0, h0), od, 0, 0, 0);
  od = __builtin_amdgcn_mfma_f32_32x32x16_bf16(pa1, PK(l1, h1), od, 0, 0, 0);
  od = __builtin_amdgcn_mfma_f32_32x32x16_bf16(pa2, PK(l2, h2), od, 0, 0, 0);
  od = __builtin_amdgcn_mfma_f32_32x32x16_bf16(pa3, PK(l3, h3), od, 0, 0, 0);
#undef PK
}
__device__ __forceinline__ void pv_d0(f32x16* o, int vb, bf16x8 pa0, bf16x8 pa1, bf16x8 pa2, bf16x8 pa3) {
  pv_one<0>(o[0], vb, pa0, pa1, pa2, pa3); pv_one<1>(o[1], vb, pa0, pa1, pa2, pa3); pv_one<2>(o[2], vb, pa0, pa1, pa2, pa3); pv_one<3>(o[3], vb, pa0, pa1, pa2, pa3);
}

__device__ __forceinline__ void attn_dense_body(const bf16* __restrict__ Qb, const bf16* __restrict__ Kh, const bf16* __restrict__ Vh,
                                                bf16* __restrict__ Ob, int seq, char* lds, const int tid_in) {
  int tid_ = tid_in; asm volatile("" : "+v"(tid_));
  const int tid = tid_, wid = tid >> 6, lane = tid & 63, r32 = lane & 31, hi = lane >> 5;
  bf16* V_lds = (bf16*)lds; bf16* K_lds = (bf16*)(lds + 2 * SHM_V);
  float* ws = (float*)(lds + 2 * SHM_V + 2 * SHM_K) + wid * 64; float* li_l = ws; float* al_l = ws + 32;
  float m_reg = -1e30f, l_reg = 0; f32x16 o[4] = {}; bf16x8 qr[12];
  const bf16* Qw = Qb + (long)(wid * QBLK + r32) * LDQ + hi * 8;
#pragma unroll
  for (int d0 = 0; d0 < 12; ++d0) qr[d0] = St::ld8(Qw + d0 * 16);
  const int sr = tid >> 4, sc = (tid & 15) * 8, vst0 = v_st(sr, sc), vst1 = v_st(32 + sr, sc);
  const int kr0 = tid / 24, kc0 = (tid % 24) * 8, kr1 = (tid + 512) / 24, kc1 = ((tid + 512) % 24) * 8, kr2 = (tid + 1024) / 24, kc2 = ((tid + 1024) % 24) * 8;
  const int vb0 = (int)(uintptr_t)V_lds + v_rd_base(lane);
  struct { St::T vs0, vs1, ks0, ks1, ks2; } sr_[SDEPTH];
#define SLOAD(i, k0) do { sr_[i].vs0 = St::ld8(&Vh[(long)((k0) + sr) * LDV + sc]); sr_[i].vs1 = St::ld8(&Vh[(long)((k0) + 32 + sr) * LDV + sc]); \
    sr_[i].ks0 = St::ld8(&Kh[(long)((k0) + kr0) * LDK + kc0]); sr_[i].ks1 = St::ld8(&Kh[(long)((k0) + kr1) * LDK + kc1]); sr_[i].ks2 = St::ld8(&Kh[(long)((k0) + kr2) * LDK + kc2]); } while (0)
#define SWRITE(b, i) do { *(bf16x8*)((char*)V_lds + (b) * SHM_V + vst0) = St::tobf(sr_[i].vs0);          \
    *(bf16x8*)((char*)V_lds + (b) * SHM_V + vst1) = St::tobf(sr_[i].vs1);                                \
    *(bf16x8*)((char*)K_lds + (b) * SHM_K + KSWZ(kr0, kc0 * 2)) = St::tobf(sr_[i].ks0);                  \
    *(bf16x8*)((char*)K_lds + (b) * SHM_K + KSWZ(kr1, kc1 * 2)) = St::tobf(sr_[i].ks1);                  \
    *(bf16x8*)((char*)K_lds + (b) * SHM_K + KSWZ(kr2, kc2 * 2)) = St::tobf(sr_[i].ks2); } while (0)
#define SWAIT() do { if constexpr (SDEPTH == 2) asm volatile("s_waitcnt vmcnt(5)" ::: "memory"); else asm volatile("s_waitcnt vmcnt(0)" ::: "memory"); } while (0)
#define RESC(a) do { if (__any((a) < 1.f)) { if (hi == 0) al_l[r32] = (a); asm volatile("s_waitcnt lgkmcnt(0)" ::: "memory"); \
    for (int d = 0; d < 4; ++d) for (int r = 0; r < 16; ++r) o[d][r] *= al_l[crow(r, hi)]; } } while (0)
  f32x16 p0, p1; float mn, al; bf16x8 pa0, pa1, pa2, pa3; const int NT = seq / KVBLK;
  SLOAD(0, 0); asm volatile("s_waitcnt vmcnt(0)" ::: "memory"); SWRITE(0, 0); __syncthreads();
  for (int j = 0; j < NT; ++j) {
    const int cur = j & 1; const bool more = j + 1 < NT;
    if (more) SLOAD(0, (j + 1) * KVBLK);
    SBAR(); qkt(p0, p1, (bf16*)((char*)K_lds + cur * SHM_K), qr, r32, hi);
    partialSM(p0, p1, m_reg, mn, al); RESC(al);
    finishSM(p0, p1, al, l_reg, pa0, pa1, pa2, pa3); SBAR();
    pv_d0(o, vb0 + cur * (int)SHM_V, pa0, pa1, pa2, pa3);
    if (more) { SWAIT(); SWRITE(cur ^ 1, 0); }
    __syncthreads();
  }
  if (hi == 0) li_l[r32] = l_reg; asm volatile("s_waitcnt lgkmcnt(0)" ::: "memory");
  float rli[16];
#pragma unroll
  for (int r = 0; r < 16; ++r) rli[r] = __builtin_amdgcn_rcpf(li_l[crow(r, hi)]);
  bf16* Ow = Ob + (long)(wid * QBLK) * LDO;
#pragma unroll
  for (int r = 0; r < 16; ++r) { int orow = crow(r, hi);
    for (int d0 = 0; d0 < 4; ++d0) Ow[(long)orow * LDO + d0 * 32 + r32] = f2bf(o[d0][r] * rli[r]); }
#undef SLOAD
#undef SWRITE
#undef SWAIT
#undef RESC
}

}


constexpr int NWAVES = 8, NTHREADS = 512;
constexpr int RING_BYTES = 131072, MISC_OFF = RING_BYTES + 320, LDS_BYTES = 147456;
#define GAS __attribute__((address_space(1)))
typedef unsigned v4u __attribute__((ext_vector_type(4)));
typedef float f32x4 __attribute__((ext_vector_type(4)));
#define LDS_WAIT() asm volatile("s_waitcnt lgkmcnt(0)" ::: "memory")
typedef float f4 __attribute__((ext_vector_type(4)));
typedef unsigned u2 __attribute__((ext_vector_type(2)));
typedef unsigned u4 __attribute__((ext_vector_type(4)));
__device__ __forceinline__ float wave_sum(float v) {
#pragma unroll
  for (int o = 1; o < 64; o <<= 1) v += __shfl_xor(v, o);
  return v;
}
__device__ __forceinline__ unsigned pkbf(float lo, float hi) { return (unsigned)f2bf(lo) | ((unsigned)f2bf(hi) << 16); }

constexpr int MOD_KS = 16, MOD_CG = 16, MOD_COLS = 384;
__device__ __forceinline__ void f_mod_partial(const Pm& p, int tidb) {
  const int N6 = 6 * 1024;
  for (int u = blockIdx.x; u < MOD_KS * MOD_CG; u += gridDim.x) { const int ks = u / MOD_CG, cg = u % MOD_CG;
    if (tidb < MOD_COLS) { const int n = cg * MOD_COLS + tidb; float a0 = 0.f, a1 = 0.f, a2 = 0.f;
      for (int k = ks * 64; k < ks * 64 + 64; ++k) { const float w = p.mod_w[(size_t)k * N6 + n]; const float c0 = p.c[k], c1 = p.c[1024 + k], c2 = p.c_ctx[k];
        a0 += c0 * sigmoidf_(c0) * w; a1 += c1 * sigmoidf_(c1) * w; a2 += c2 * sigmoidf_(c2) * w; }
      float* o = p.modp + (size_t)ks * 3 * N6 + n; o[0] = a0; o[N6] = a1; o[2 * N6] = a2; } }
}
__device__ __forceinline__ void f_mod_reduce(const Pm& p, LAS float* modL, int tidb) {
  const int N6 = 6 * 1024;
  for (int i = tidb; i < 3 * 2048; i += NTHREADS) { const int v = i / 2048, n = i % 2048; float a = p.mod_b[n];
#pragma unroll
    for (int ks = 0; ks < MOD_KS; ++ks) a += p.modp[((size_t)ks * 3 + v) * N6 + n];
    modL[i] = a; }
  const int per = (3 * N6 + gridDim.x - 1) / gridDim.x;
  for (int i = blockIdx.x * per + tidb; i < (int)(blockIdx.x + 1) * per && i < 3 * N6; i += NTHREADS) { const int v = i / N6, n = i % N6; float a = p.mod_b[n];
#pragma unroll
    for (int ks = 0; ks < MOD_KS; ++ks) a += p.modp[((size_t)ks * 3 + v) * N6 + n];
    p.modv[i] = a; }
  __syncthreads();
}
__device__ __forceinline__ void f_norm1(const Pm& p, const LAS float* modL, int gw, int ngw, int lane) {
  constexpr Dm d = DMC;
  for (int row = gw; row < d.NR; row += ngw) {
    const float* src = row < d.BT ? p.x + (size_t)row * 1024 : p.ctx + (size_t)(row - d.BT) * 1024; const int v = row < d.BT ? row / d.T : 2;
    f4 xv[4]; float ss = 0.f;
#pragma unroll
    for (int j = 0; j < 4; ++j) { xv[j] = *(const f4*)(src + 4 * lane + 256 * j); ss += xv[j].x * xv[j].x + xv[j].y * xv[j].y + xv[j].z * xv[j].z + xv[j].w * xv[j].w; }
    const float rs = 1.f / sqrtf(wave_sum(ss) * (1.f / 1024.f) + 1e-6f);
#pragma unroll
    for (int j = 0; j < 4; ++j) { const int k = 4 * lane + 256 * j; const f4 g = *(const f4*)(p.norm1_g + k); const LAS float* sh = modL + v * 2048 + k; const LAS float* sc = sh + 1024;
      const float o0 = xv[j].x * rs * g.x * (1.f + sc[0]) + sh[0], o1 = xv[j].y * rs * g.y * (1.f + sc[1]) + sh[1], o2 = xv[j].z * rs * g.z * (1.f + sc[2]) + sh[2], o3 = xv[j].w * rs * g.w * (1.f + sc[3]) + sh[3];
      u2 w; w.x = pkbf(o0, o1); w.y = pkbf(o2, o3); *(u2*)(p.A1 + (size_t)row * 1024 + k) = w; }
  }
}
__device__ __forceinline__ void f_rope_table(const Pm& p, long tid, long nth) {
  for (long i = tid; i < (long)8192 * 32; i += nth) { const int t = (int)(i >> 5), q = (int)(i & 31), a = q >> 4, f = q & 15;
    const float freq = expf(-(float)f * (1.f / 16.f) * 9.210340371976184f), pos = a == 0 ? (float)(t >> 6) : (float)(t & 63), ang = pos * freq;
    p.ropet[2 * i] = cosf(ang); p.ropet[2 * i + 1] = sinf(ang); }
}
__device__ __forceinline__ void f_mla_a(const Pm& p, int gw, int ngw, int lane) {
  constexpr Dm d = DMC; const int NK = d.C + d.T;
  for (int row = gw; row < d.NR; row += ngw) {
    const float* pm = p.P + (size_t)row * d.IN + d.RC; int t, len, b, ic; row_pos(d, row, t, len, b, ic);
    const f4 q = *(const f4*)(pm + 4 * lane); const float c0 = pm[256 + 2 * lane], c1 = pm[256 + 2 * lane + 1]; const float kr = pm[384 + lane];
    const float qs = wave_sum(q.x * q.x + q.y * q.y + q.z * q.z + q.w * q.w), cs2 = wave_sum(c0 * c0 + c1 * c1);
    if (!ic) { const float rs = 1.f / sqrtf(qs * (1.f / 256.f) + 1e-6f); const f4 g = *(const f4*)(p.q_norm + 4 * lane);
      u2 w; w.x = pkbf(q.x * rs * g.x, q.y * rs * g.y); w.y = pkbf(q.z * rs * g.z, q.w * rs * g.w); *(u2*)(p.QN + (size_t)row * 256 + 4 * lane) = w; }
    { const float rs = 1.f / sqrtf(cs2 * (1.f / 128.f) + 1e-6f); *(unsigned*)(p.CN + (size_t)row * 128 + 2 * lane) = pkbf(c0 * rs * p.kv_norm[2 * lane], c1 * rs * p.kv_norm[2 * lane + 1]); }
    const float partner = __shfl_xor(kr, 16); float cs = 1.f, sn = 0.f;
    if (!ic) { const float* ct = p.ropet + ((size_t)t * 32 + (lane >> 5) * 16 + (lane & 15)) * 2; cs = ct[0]; sn = ct[1]; }
    const float o = (lane & 16) ? kr * cs + partner * sn : kr * cs - partner * sn; const bf16_t ob = f2bf(o); const int key = ic ? t : d.C + t;
#pragma unroll
    for (int h = 0; h < 4; ++h) p.K[((size_t)(b * 4 + h) * NK + key) * 192 + 128 + lane] = ob;
  }
}
__device__ __forceinline__ void f_readout(const Pm& p, int gw, int ngw, int lane) {
  constexpr Dm d = DMC; const size_t NRW = (size_t)d.NR * 512, BTW = (size_t)d.BT * 512;
  for (int row = gw; row < d.BT; row += ngw) { const size_t o = (size_t)row * 512 + 8 * lane;
    float ov[8], rv[8], kv[8], vv[8], gv[8];
#pragma unroll
    for (int q = 0; q < 2; ++q) { const f4 a = *(const f4*)(p.O2 + o + 4 * q), b2 = *(const f4*)(p.O2 + BTW + o + 4 * q), r = *(const f4*)(p.Rr + o + 4 * q), k0 = *(const f4*)(p.Kd + o + 4 * q), k1 = *(const f4*)(p.Kd + NRW + o + 4 * q),
        v = *(const f4*)(p.Vv + o + 4 * q), g = *(const f4*)(p.Gt + o + 4 * q);
#pragma unroll
      for (int e = 0; e < 4; ++e) { ov[4 * q + e] = a[e] + b2[e]; rv[4 * q + e] = r[e]; kv[4 * q + e] = k0[e] + k1[e]; vv[4 * q + e] = v[e]; gv[4 * q + e] = g[e]; } }
    float s = 0.f, bon = 0.f;
#pragma unroll
    for (int e = 0; e < 8; ++e) { s += ov[e]; bon += rv[e] * kv[e] * p.r_k[8 * lane + e]; }
#pragma unroll
    for (int m = 1; m < 8; m <<= 1) { s += __shfl_xor(s, m); bon += __shfl_xor(bon, m); }
    const float mean = s * (1.f / 64.f); float var = 0.f;
#pragma unroll
    for (int e = 0; e < 8; ++e) { const float q = ov[e] - mean; var += q * q; }
#pragma unroll
    for (int m = 1; m < 8; m <<= 1) var += __shfl_xor(var, m);
    const float rs = 1.f / sqrtf(var * (1.f / 64.f) + 64e-5f); float y[8];
#pragma unroll
    for (int e = 0; e < 8; ++e) y[e] = ((ov[e] - mean) * rs * p.ln_w[8 * lane + e] + p.ln_b[8 * lane + e] + bon * vv[e]) * gv[e];
    u4 w; w.x = pkbf(y[0], y[1]); w.y = pkbf(y[2], y[3]); w.z = pkbf(y[4], y[5]); w.w = pkbf(y[6], y[7]);
    *(u4*)(p.MIXb + (size_t)row * 1024 + 8 * lane) = w; }
}
__device__ __forceinline__ void f_final(const Pm& p, int gw, int ngw, int lane) {
  constexpr Dm d = DMC;
  for (int tok = gw; tok < d.BT; tok += ngw) { const int b = tok / d.T; const float* gt2 = p.modv + (size_t)b * 6144 + 5 * 1024; const float* xr = p.x1 + (size_t)tok * 1024;
    const f4 gq = *(const f4*)(p.gate + (size_t)tok * 4); const int4 sp = *(const int4*)(p.slot_pos + (size_t)tok * 4);
    const bf16_t* y0 = p.Yb + (size_t)sp.x * 1024; const bf16_t* y1 = p.Yb + (size_t)sp.y * 1024; const bf16_t* y2 = p.Yb + (size_t)sp.z * 1024; const bf16_t* y3 = p.Yb + (size_t)sp.w * 1024;
    f4 xv[4]; float ss = 0.f;
#pragma unroll
    for (int j = 0; j < 4; ++j) { const int k = 4 * lane + 256 * j; const f4 x = *(const f4*)(xr + k), g = *(const f4*)(gt2 + k);
      const u2 a = *(const u2*)(y0 + k), b2 = *(const u2*)(y1 + k), c = *(const u2*)(y2 + k), e = *(const u2*)(y3 + k);
#define BFLO(u) __builtin_bit_cast(float, (u) << 16)
#define BFHI(u) __builtin_bit_cast(float, (u) & 0xffff0000u)
      f4 f; f.x = gq.x * BFLO(a.x) + gq.y * BFLO(b2.x) + gq.z * BFLO(c.x) + gq.w * BFLO(e.x); f.y = gq.x * BFHI(a.x) + gq.y * BFHI(b2.x) + gq.z * BFHI(c.x) + gq.w * BFHI(e.x);
      f.z = gq.x * BFLO(a.y) + gq.y * BFLO(b2.y) + gq.z * BFLO(c.y) + gq.w * BFLO(e.y); f.w = gq.x * BFHI(a.y) + gq.y * BFHI(b2.y) + gq.z * BFHI(c.y) + gq.w * BFHI(e.y);
      xv[j] = x + g * f; ss += xv[j].x * xv[j].x + xv[j].y * xv[j].y + xv[j].z * xv[j].z + xv[j].w * xv[j].w; }
    const float rs = 1.f / sqrtf(wave_sum(ss) * (1.f / 1024.f) + 1e-6f);
#pragma unroll
    for (int j = 0; j < 4; ++j) { const int k = 4 * lane + 256 * j; const f4 fg = *(const f4*)(p.final_g + k); *(f4*)(p.out + (size_t)tok * 1024 + k) = xv[j] * rs * fg; }
  }
}

__device__ __forceinline__ void f_route(const Pm& p, LAS unsigned char* lds, int wave, int lane, int tidb) {
  constexpr Dm d = DMC; const int G = gridDim.x, TPB = (d.BT + G - 1) / G;
  LAS int* cnt_l = (LAS int*)(lds); LAS float* hrow = (LAS float*)(lds + 1024 + wave * 4096);
  if (tidb < 32) cnt_l[tidb] = 0;
  __syncthreads();
  const int t0 = blockIdx.x * TPB, t1 = (t0 + TPB < d.BT) ? t0 + TPB : d.BT;
  for (int tok = t0 + wave; tok < t1; tok += NWAVES) {
    const int b = tok / d.T; const float* xr = p.x1 + (size_t)tok * 1024; const float* sh = p.modv + (size_t)b * 6144 + 3 * 1024; const float* sc = sh + 1024;
    f4 xv[4]; float ss = 0.f;
#pragma unroll
    for (int j = 0; j < 4; ++j) { xv[j] = *(const f4*)(xr + 4 * lane + 256 * j); ss += xv[j].x * xv[j].x + xv[j].y * xv[j].y + xv[j].z * xv[j].z + xv[j].w * xv[j].w; }
    const float rs = 1.f / sqrtf(wave_sum(ss) * (1.f / 1024.f) + 1e-6f);
#pragma unroll
    for (int j = 0; j < 4; ++j) { const int k = 4 * lane + 256 * j; const f4 g = *(const f4*)(p.norm2_g + k), s4 = *(const f4*)(sh + k), c4 = *(const f4*)(sc + k);
      f4 hv; hv.x = xv[j].x * rs * g.x * (1.f + c4.x) + s4.x; hv.y = xv[j].y * rs * g.y * (1.f + c4.y) + s4.y; hv.z = xv[j].z * rs * g.z * (1.f + c4.z) + s4.z; hv.w = xv[j].w * rs * g.w * (1.f + c4.w) + s4.w;
      u2 w; w.x = pkbf(hv.x, hv.y); w.y = pkbf(hv.z, hv.w); *(u2*)(p.H2b + (size_t)tok * 1024 + k) = w; *(LAS f4*)(hrow + k) = hv; }
    asm volatile("s_waitcnt lgkmcnt(0)" ::: "memory");
    const int e = lane & 31, half = lane >> 5; const float* rw = p.router_w + (size_t)(half * 512) * 32 + e; const LAS float* hh = hrow + half * 512; float acc = 0.f;
#pragma unroll 8
    for (int k = 0; k < 512; ++k) acc += hh[k] * rw[(size_t)k * 32];
    acc += __shfl_xor(acc, 32);
    float lg = acc + p.router_b[e]; float tv[4]; int te[4];
#pragma unroll
    for (int kk = 0; kk < 4; ++kk) { float m = lg;
#pragma unroll
      for (int o = 1; o < 32; o <<= 1) m = fmaxf(m, __shfl_xor(m, o));
      const unsigned long long bal = __ballot(lg == m); const int bi = __builtin_ctzll(bal) & 31;
      tv[kk] = m; te[kk] = bi; if (e == bi) lg = -3e38f; }
    const float e1 = __expf(tv[1] - tv[0]), e2 = __expf(tv[2] - tv[0]), e3 = __expf(tv[3] - tv[0]), inv = 1.f / (1.f + e1 + e2 + e3);
    if (lane < 4) { const int me = lane == 0 ? te[0] : lane == 1 ? te[1] : lane == 2 ? te[2] : te[3]; const float mg = (lane == 0 ? 1.f : lane == 1 ? e1 : lane == 2 ? e2 : e3) * inv;
      const int rk = atomicAdd((int*)&cnt_l[me], 1);
      p.top_e[(size_t)tok * 4 + lane] = me; p.gate[(size_t)tok * 4 + lane] = mg; p.lrank[(size_t)tok * 4 + lane] = rk; }
  }
  __syncthreads();
  if (tidb < 32) p.blkcnt[(size_t)blockIdx.x * 32 + tidb] = cnt_l[tidb];
}
__device__ __forceinline__ void f_place(const Pm& p, LAS unsigned char* lds, int wave, int lane, int tidb) {
  constexpr Dm d = DMC; const int G = gridDim.x, TPB = (d.BT + G - 1) / G;
  LAS int* ps = (LAS int*)lds;
  LAS int* pb = ps + 512;
  LAS int* off = pb + 512;
  LAS int* base = off + 64;
  { const int e = tidb & 31, part = tidb >> 5; int sa = 0, sb = 0;
    for (int bb = part; bb < G; bb += 16) { const int c = __hip_atomic_load(p.blkcnt + (size_t)bb * 32 + e, __ATOMIC_RELAXED, __HIP_MEMORY_SCOPE_AGENT); sa += c; if (bb < (int)blockIdx.x) sb += c; }
    ps[part * 32 + e] = sa; pb[part * 32 + e] = sb; }
  __syncthreads();
  if (tidb < 32) { int sa = 0, sb = 0;
#pragma unroll
    for (int q = 0; q < 16; ++q) { sa += ps[q * 32 + tidb]; sb += pb[q * 32 + tidb]; }
    base[tidb] = sb; ps[tidb] = (sa + 255) / 256 * 256; }
  __syncthreads();
  if (tidb == 0) { int o = 0; for (int e = 0; e < 32; ++e) { off[e] = o; o += ps[e]; } off[32] = o; }
  __syncthreads();
  if (blockIdx.x == 0) { const int npos = off[32];
    for (int t = tidb; t < npos / 256; t += NTHREADS) { int e = 0; for (int q = 1; q < 32; ++q) if (t * 256 >= off[q]) e = q; p.tile_e[t] = e; }
    if (tidb == 0) p.npos[0] = npos; }
  const int t0 = blockIdx.x * TPB, t1 = (t0 + TPB < d.BT) ? t0 + TPB : d.BT;
  for (int tok = t0 + wave; tok < t1; tok += NWAVES) {
    const u4* src = (const u4*)(p.H2b + (size_t)tok * 1024) + lane * 2; const u4 a = src[0], b = src[1];
#pragma unroll
    for (int kk = 0; kk < 4; ++kk) { const int e = p.top_e[(size_t)tok * 4 + kk], rk = p.lrank[(size_t)tok * 4 + kk]; const int pos = off[e] + base[e] + rk;
      if (lane == 0) p.slot_pos[(size_t)tok * 4 + kk] = pos;
      u4* dst = (u4*)(p.Xg + (size_t)pos * 1024) + lane * 2; dst[0] = a; dst[1] = b; }
  }
}
__device__ __forceinline__ void f_rwkv_s1(const Pm& p, int gw, int ngw, int lane) {
  constexpr Dm d = DMC;
  for (int row = gw; row < d.NR; row += ngw) { int t, len, b, ic; row_pos(d, row, t, len, b, ic);
    const float* cur = p.P + (size_t)row * d.IN; const bool hp = t > 0, hn = t < len - 1; f4 ps[7];
#pragma unroll
    for (int j = 0; j < 7; ++j) { const int c = 4 * lane + 256 * j; const f4 x = *(const f4*)(cur + c), mu = *(const f4*)(p.mu + c); f4 pr = {0.f, 0.f, 0.f, 0.f}, nx = pr;
      if (hp) pr = *(const f4*)(cur - d.IN + c); if (hn) nx = *(const f4*)(cur + d.IN + c);
      ps[j] = x + mu * (0.5f * (pr + nx) - x); }
    const size_t o = (size_t)row * 512 + 4 * lane;
    *(f4*)(p.Rr + o) = ps[0]; *(f4*)(p.Rr + o + 256) = ps[1]; *(f4*)(p.Vv + o) = ps[4]; *(f4*)(p.Vv + o + 256) = ps[5];
#pragma unroll
    for (int j = 0; j < 2; ++j) { const f4 k = ps[2 + j]; const f4 kq = k * *(const f4*)(p.k_k + 4 * lane + 256 * j); float ss = kq.x * kq.x + kq.y * kq.y + kq.z * kq.z + kq.w * kq.w;
#pragma unroll
      for (int m = 1; m < 16; m <<= 1) ss += __shfl_xor(ss, m);
      const float inv = 1.f / sqrtf(fmaxf(ss, 1e-24f)); *(f4*)(p.Kraw + o + 256 * j) = k; *(f4*)(p.KK + o + 256 * j) = kq * inv; }
    const f4 x6 = ps[6];
    if (lane < 16) { u2 w; w.x = pkbf(tanhf(x6.x), tanhf(x6.y)); w.y = pkbf(tanhf(x6.z), tanhf(x6.w)); *(u2*)(p.AL1 + (size_t)row * 128 + 4 * lane) = w; }
    else if (lane < 32) { u2 w; w.x = pkbf(x6.x, x6.y); w.y = pkbf(x6.z, x6.w); *(u2*)(p.AL1 + (size_t)row * 128 + 4 * lane) = w; }
    else if (!ic) { u2 w; w.x = pkbf(sigmoidf_(x6.x), sigmoidf_(x6.y)); w.y = pkbf(sigmoidf_(x6.z), sigmoidf_(x6.w)); *(u2*)(p.AL2 + (size_t)row * 128 + 4 * (lane - 32)) = w; }
  }
}
__device__ __forceinline__ void f_lora_weights(const Pm& p, long tid, long nth) {
  for (long i = tid; i < (long)2048 * 128; i += nth) { const int n = (int)(i >> 7), k = (int)(i & 127); float v = 0.f;
    if (n < 1024) { if (k < 64) v = p.w2[((size_t)(n >> 9) * 64 + k) * 512 + (n & 511)]; } else { const int q = n - 1024; if (k >= 64) v = p.a2[((size_t)(q >> 9) * 64 + (k - 64)) * 512 + (q & 511)]; }
    p.WlT[i] = f2bf(v); }
  for (long i = tid; i < (long)512 * 128; i += nth) { const int n = (int)(i >> 7), k = (int)(i & 127); p.G2T[i] = f2bf(p.g2[(size_t)k * 512 + n]); }
}


template <class F> struct EpiFn {
  static constexpr bool PERM = true, AFTER_DRAIN = false; F f;
  __device__ __forceinline__ void operator()(const pg8::f32x4 (&acc)[2][2][4][2], const pg8::Unit& u, int wr, int wc, int fr, int fq) const {
#pragma unroll
    for (int ai = 0; ai < 2; ++ai)
#pragma unroll
      for (int m = 0; m < 4; ++m) { const int row = u.pm * 256 + ai * 128 + wr * 64 + m * 16 + fr;
#pragma unroll
        for (int bj = 0; bj < 2; ++bj) { const int col = u.pn * 256 + bj * 128 + wc * 32 + 8 * fq; f(u, row, col, acc[ai][bj][m][0], acc[ai][bj][m][1]); asm volatile("" ::: "memory"); } }
  }
};
template <class F> __device__ __forceinline__ void run_gemm(LAS unsigned char* lds, const bf16_t* A, const bf16_t* Bt, int M, int N, int K, F f, const int tid_in, const int* tile_e = nullptr, size_t bexp = 0) {
  asm volatile("" : "+s"(M), "+s"(N), "+s"(K));
  pg8::Gemm g{A, Bt, M, N, K, bexp}; pg8::StaticOrder S; S.init(M, N, (int)gridDim.x, (int)blockIdx.x, tile_e);
  EpiFn<F> E{f};
  pg8::gemm_phase<EpiFn<F>, pg8::StaticOrder, true, true>((PG8_LAS unsigned char*)lds, g, S, E, tid_in);
}

__device__ __forceinline__ unsigned pk2(float lo, float hi) { return (unsigned)f2bf(lo) | ((unsigned)f2bf(hi) << 16); }
__device__ __forceinline__ void transpose_item(const float* W, int K, int N, bf16_t* WT, LAS float* scr, int item, int lane) {
  const int nblk = N / 32, kb = item / nblk, nb = item % nblk, k0 = 64 * kb, n0 = 32 * nb;
#pragma unroll 8
  for (int i = 0; i < 32; ++i) { const int kk = 2 * i + (lane >> 5); scr[kk * 33 + (lane & 31)] = W[(size_t)(k0 + kk) * N + n0 + (lane & 31)]; }
  LDS_WAIT(); asm volatile("" ::: "memory");
  const int c = lane & 7;
#pragma unroll
  for (int j = 0; j < 4; ++j) { const int n = (lane >> 3) + 8 * j; const LAS float* s = scr + (8 * c) * 33 + n;
    v4u o; o.x = pk2(s[0 * 33], s[1 * 33]); o.y = pk2(s[2 * 33], s[3 * 33]); o.z = pk2(s[4 * 33], s[5 * 33]); o.w = pk2(s[6 * 33], s[7 * 33]);
    *(v4u*)(WT + (size_t)(n0 + n) * K + k0 + 8 * c) = o; }
  LDS_WAIT(); asm volatile("" ::: "memory");
}
__device__ __forceinline__ void transpose_all(const float* W, int K, int N, bf16_t* WT, LAS unsigned char* lds, int gw, int ngw, int wave, int lane) {
  LAS float* scr = (LAS float*)(lds + wave * 16384); const int items = (K / 64) * (N / 32);
  for (int it = gw; it < items; it += ngw) transpose_item(W, K, N, WT, scr, it, lane);
}

constexpr int INP = 2304;

__global__ void __launch_bounds__(NTHREADS, 2) fwd(Pm p, unsigned* bar) {
  extern __shared__ __attribute__((aligned(16))) unsigned char lds_raw[];
  LAS unsigned char* lds = (LAS unsigned char*)lds_raw;
#define IDS() int tidb; asm volatile("v_mbcnt_lo_u32_b32 %0, -1, 0\n\tv_mbcnt_hi_u32_b32 %0, -1, %0" : "=v"(tidb)); tidb += wave_s * 64; const int lane = tidb & 63, wave = __builtin_amdgcn_readfirstlane(tidb >> 6); \
    const long tid = (long)blockIdx.x * NTHREADS + tidb, nth = (long)gridDim.x * NTHREADS; const int gw = blockIdx.x * NWAVES + wave, ngw = gridDim.x * NWAVES; \
    (void)lane; (void)wave; (void)tid; (void)nth; (void)gw; (void)ngw
  for (int u = threadIdx.x; u < (LDS_BYTES - RING_BYTES) / 4; u += NTHREADS) ((LAS unsigned*)(lds + RING_BYTES))[u] = 0u;
  __syncthreads();
  const int wave_s = __builtin_amdgcn_readfirstlane((int)threadIdx.x >> 6);
  XcdBarrier xb = xcd_barrier_post(bar, (volatile LAS unsigned*)(lds + MISC_OFF + 32));
  constexpr Dm d = DMC;
#define GSYNC() xcd_barrier(xb)
  constexpr int NSEG = 32;
#define NPOS() __builtin_amdgcn_readfirstlane(__hip_atomic_load(p.npos, __ATOMIC_RELAXED, __HIP_MEMORY_SCOPE_AGENT))
  {
  IDS();
  f_mod_partial(p, tidb); f_rope_table(p, tid, nth); f_lora_weights(p, tid, nth);
  transpose_all(p.w_in, d.D, d.IN, p.WinT, lds, gw, ngw, wave, lane);
  for (long i = tid; i < (long)(INP - d.IN) * d.D; i += nth) p.WinT[(size_t)d.IN * d.D + i] = 0;
  transpose_all(p.w_uq, d.QL, d.MH * d.QK, p.WuqT, lds, gw, ngw, wave, lane);
  transpose_all(p.w_ukv, d.KL, d.MH * (d.DN + d.DV), p.WukvT, lds, gw, ngw, wave, lane);
  transpose_all(p.w_out, d.MIX, d.D, p.WoutT, lds, gw, ngw, wave, lane);
  for (int e = 0; e < d.NE; ++e) {
    transpose_all(p.exp_w1 + (size_t)e * d.D * 2 * d.DE, d.D, 2 * d.DE, p.W1T + (size_t)e * 2 * d.DE * d.D, lds, gw, ngw, wave, lane);
    transpose_all(p.exp_w2 + (size_t)e * d.DE * d.D, d.DE, d.D, p.W2T + (size_t)e * d.D * d.DE, lds, gw, ngw, wave, lane);
  }
    }
  GSYNC();
  {
  IDS();

  f_mod_reduce(p, (LAS float*)lds, tidb); f_norm1(p, (const LAS float*)lds, gw, ngw, lane);   }
  GSYNC();
  {
  IDS();

  { float* P = p.P; const int IN = d.IN;
    run_gemm(lds, p.A1, p.WinT, d.NR, INP, d.D, [=](const pg8::Unit& u, int row, int col, pg8::f32x4 v0, pg8::f32x4 v1) {
      if (col < IN) { float* o = P + (size_t)row * IN + col; *(pg8::f32x4*)o = v0; *(pg8::f32x4*)(o + 4) = v1; } }, tidb); }
    }
  GSYNC();
  {
  IDS();

  f_mla_a(p, gw, ngw, lane); f_rwkv_s1(p, gw, ngw, lane);   }
  GSYNC();
  {
  IDS();

  { bf16_t* Q = p.Q; const float* ropet = p.ropet;
    run_gemm(lds, p.QN, p.WuqT, d.BT, 768, 256, [=](const pg8::Unit& u, int row, int col, pg8::f32x4 v0, pg8::f32x4 v1) {
      const int h = col / 192, i0 = col - h * 192, b = row >> 13, t = row & 8191;
      float x[8] = {v0[0], v0[1], v0[2], v0[3], v1[0], v1[1], v1[2], v1[3]}, pr[8];
#pragma unroll
      for (int e = 0; e < 8; ++e) pr[e] = __shfl_xor(x[e], 32);
      if (i0 >= 128) { const int i = i0 - 128, a = i >> 5, half = (i >> 4) & 1, f0 = i & 15; const float* ct = ropet + ((size_t)t * 32 + a * 16 + f0) * 2;
#pragma unroll
        for (int e = 0; e < 8; ++e) { const float c = ct[2 * e], s = ct[2 * e + 1]; x[e] = half ? x[e] * c + pr[e] * s : x[e] * c - pr[e] * s; } }
      v4u w; w.x = pk2(x[0], x[1]); w.y = pk2(x[2], x[3]); w.z = pk2(x[4], x[5]); w.w = pk2(x[6], x[7]);
      *(v4u*)(Q + ((size_t)(b * 4 + h) * 8192 + t) * 192 + i0) = w; }, tidb); }
  { bf16_t* K = p.K; bf16_t* V = p.V; const int BT = d.BT;
    run_gemm(lds, p.CN, p.WukvT, d.NR, 1024, 128, [=](const pg8::Unit& u, int row, int col, pg8::f32x4 v0, pg8::f32x4 v1) {
      const int h = col >> 8, i0 = col & 255; int b, key; if (row < BT) { b = row >> 13; key = 256 + (row & 8191); } else { b = (row - BT) >> 8; key = (row - BT) & 255; }
      v4u w; w.x = pk2(v0[0], v0[1]); w.y = pk2(v0[2], v0[3]); w.z = pk2(v1[0], v1[1]); w.w = pk2(v1[2], v1[3]);
      const size_t kr = (size_t)(b * 4 + h) * 8448 + key;
      if (i0 < 128) *(v4u*)(K + kr * 192 + i0) = w; else *(v4u*)(V + kr * 128 + (i0 - 128)) = w; }, tidb); }
  { float* Wd = p.Wd; float* Bb = p.Bb; float* Kd = p.Kd; const float* KK = p.KK; const float* Kraw = p.Kraw; const float* w0 = p.w0; const float* a0 = p.a0; const float* k_a = p.k_a; const size_t NRW = (size_t)d.NR * 512;
    run_gemm(lds, p.AL1, p.WlT, d.NR, 2048, 128, [=](const pg8::Unit& u, int row, int col, pg8::f32x4 v0, pg8::f32x4 v1) {
      float x[8] = {v0[0], v0[1], v0[2], v0[3], v1[0], v1[1], v1[2], v1[3]};
      if (col < 1024) { const int dd = col >> 9, c = col & 511; const float* wb = w0 + dd * 512 + c; float o[8];
#pragma unroll
        for (int e = 0; e < 8; ++e) o[e] = __expf(-0.60653065971263342f / (1.f + __expf(-(x[e] + wb[e]))));
        float* dst = Wd + (size_t)dd * NRW + (size_t)row * 512 + c; *(pg8::f32x4*)dst = (pg8::f32x4){o[0], o[1], o[2], o[3]}; *(pg8::f32x4*)(dst + 4) = (pg8::f32x4){o[4], o[5], o[6], o[7]}; }
      else { const int q = col - 1024, dd = q >> 9, c = q & 511; const float* ab = a0 + dd * 512 + c; const float* kkp = KK + (size_t)row * 512 + c; const float* kp = Kraw + (size_t)row * 512 + c; float ob[8], ok[8];
#pragma unroll
        for (int e = 0; e < 8; ++e) { const float a = 1.f / (1.f + __expf(-(x[e] + ab[e]))); ob[e] = kkp[e] * a; ok[e] = kp[e] * (1.f + (a - 1.f) * k_a[c + e]); }
        float* d1 = Bb + (size_t)dd * NRW + (size_t)row * 512 + c; float* d2 = Kd + (size_t)dd * NRW + (size_t)row * 512 + c;
        *(pg8::f32x4*)d1 = (pg8::f32x4){ob[0], ob[1], ob[2], ob[3]}; *(pg8::f32x4*)(d1 + 4) = (pg8::f32x4){ob[4], ob[5], ob[6], ob[7]};
        *(pg8::f32x4*)d2 = (pg8::f32x4){ok[0], ok[1], ok[2], ok[3]}; *(pg8::f32x4*)(d2 + 4) = (pg8::f32x4){ok[4], ok[5], ok[6], ok[7]}; } }, tidb); }
  { float* Gt = p.Gt;
    run_gemm(lds, p.AL2, p.G2T, d.BT, 512, 128, [=](const pg8::Unit& u, int row, int col, pg8::f32x4 v0, pg8::f32x4 v1) { float* o = Gt + (size_t)row * 512 + col; *(pg8::f32x4*)o = v0; *(pg8::f32x4*)(o + 4) = v1; }, tidb); }
    }
  GSYNC();
  {
  IDS();

  ph_scan_a1(p, tid, nth, NSEG);   }
  GSYNC();
  {
  IDS();
  ph_scan_a2(p, gw, ngw, lane, NSEG);   }
  GSYNC();
  {
  IDS();

  ph_scan_a3(p, tid, nth, NSEG);
  for (int u = blockIdx.x; u < d.B * d.MH * (d.T / 256); u += gridDim.x) { const int bh = u % (d.B * d.MH), qb = u / (d.B * d.MH), b = bh / d.MH, h = bh % d.MH; const int NK = d.C + d.T;
    attn::attn_dense_body(p.Q + ((size_t)bh * d.T + (size_t)qb * 256) * attn::DQK, p.K + (size_t)bh * NK * attn::DQK, p.V + (size_t)bh * NK * attn::DV,
                          p.MIXb + ((size_t)b * d.T + (size_t)qb * 256) * d.MIX + d.RW + h * attn::DV, NK, (char*)lds_raw, tidb); }
    }
  GSYNC();
  {
  IDS();

  f_readout(p, gw, ngw, lane);   }
  GSYNC();
  {
  IDS();

  { float* x1 = p.x1; const float* x = p.x; const float* modv = p.modv; const int D = d.D, T = d.T;
    run_gemm(lds, p.MIXb, p.WoutT, d.BT, D, d.MIX, [=](const pg8::Unit& u, int row, int col, pg8::f32x4 v0, pg8::f32x4 v1) {
      const float* g = modv + (size_t)(row / T) * 6 * D + 2 * D + col; const float* xr = x + (size_t)row * D + col; float* o = x1 + (size_t)row * D + col;
      const pg8::f32x4 g0 = *(const pg8::f32x4*)g, g1 = *(const pg8::f32x4*)(g + 4), x0 = *(const pg8::f32x4*)xr, x1v = *(const pg8::f32x4*)(xr + 4);
      *(pg8::f32x4*)o = x0 + g0 * v0; *(pg8::f32x4*)(o + 4) = x1v + g1 * v1; }, tidb); }
    }
  GSYNC();
  {
  IDS();

  f_route(p, lds, wave, lane, tidb);
  }
  GSYNC();
  {
  IDS();
  f_place(p, lds, wave, lane, tidb);
  }
  GSYNC();
  {
  IDS();
  const int npos = NPOS();
  { bf16_t* ACT = p.ACTb; const float* b1 = p.exp_b1; const int DE = d.DE;
    run_gemm(lds, p.Xg, p.W1T, npos, 2 * d.DE, d.D, [=](const pg8::Unit& u, int row, int col, pg8::f32x4 v0, pg8::f32x4 v1) {
      const float* bb = b1 + (size_t)u.eb * 2 * DE + col; const pg8::f32x4 c0 = *(const pg8::f32x4*)bb, c1 = *(const pg8::f32x4*)(bb + 4);
      v0 = v0 + c0; v1 = v1 + c1; float o[4];
#pragma unroll
      for (int q = 0; q < 4; ++q) { const float gl = fminf(q < 2 ? v0[2 * q] : v1[2 * q - 4], 7.f), li = fminf(fmaxf(q < 2 ? v0[2 * q + 1] : v1[2 * q - 3], -7.f), 7.f);
        o[q] = gl * (li + 1.f) / (1.f + __expf(-1.702f * gl)); }
      uint2 w; w.x = pk2(o[0], o[1]); w.y = pk2(o[2], o[3]); *(uint2*)(ACT + (size_t)row * DE + (col >> 1)) = w; }, tidb, p.tile_e, (size_t)2 * d.DE * d.D * 2); }
    }
  GSYNC();
  {
  IDS();

  const int npos = NPOS();
  { bf16_t* Y = p.Yb; const float* b2 = p.exp_b2; const int D = d.D;
    run_gemm(lds, p.ACTb, p.W2T, npos, d.D, d.DE, [=](const pg8::Unit& u, int row, int col, pg8::f32x4 v0, pg8::f32x4 v1) {
      const float* bb = b2 + (size_t)u.eb * D + col; const pg8::f32x4 c0 = *(const pg8::f32x4*)bb, c1 = *(const pg8::f32x4*)(bb + 4);
      v0 = v0 + c0; v1 = v1 + c1; v4u w; w.x = pk2(v0[0], v0[1]); w.y = pk2(v0[2], v0[3]); w.z = pk2(v1[0], v1[1]); w.w = pk2(v1[2], v1[3]);
      *(v4u*)(Y + (size_t)row * D + col) = w; }, tidb, p.tile_e, (size_t)d.D * d.DE * 2); }
    }
  GSYNC();
  {
  IDS();

  f_final(p, gw, ngw, lane);
  }
}

static size_t carve(Pm& p, char* base) {
  const Dm& d = p.d; size_t off = 0;
#define CARVE(ptr, type, count) do { p.ptr = (type*)(base + off); off += (((size_t)(count) * sizeof(type)) + 255) / 256 * 256; } while (0)
  const size_t NRW = (size_t)d.NR * d.RW; const int NK = d.C + d.T;
  CARVE(modv, float, (size_t)(d.B + 1) * 6 * d.D); CARVE(modp, float, (size_t)16 * 3 * 6 * d.D); CARVE(ropet, float, (size_t)d.T * 64);
  CARVE(top_e, int, (size_t)d.BT * 4); CARVE(cnt, int, d.NE); CARVE(slot_pos, int, (size_t)d.BT * 4); CARVE(pos_tok, int, d.NPOSMAX); CARVE(tile_e, int, d.NPOSMAX / d.PADR + 1); CARVE(npos, int, 4);
  CARVE(gate, float, (size_t)d.BT * 4); CARVE(lrank, int, (size_t)d.BT * 4); CARVE(blkcnt, int, 1024 * 32);
  CARVE(WlT, bf16_t, (size_t)2048 * 128); CARVE(G2T, bf16_t, (size_t)512 * 128);
  CARVE(WinT, bf16_t, (size_t)INP * d.D); CARVE(WuqT, bf16_t, (size_t)d.MH * d.QK * d.QL); CARVE(WukvT, bf16_t, (size_t)d.MH * (d.DN + d.DV) * d.KL); CARVE(WoutT, bf16_t, (size_t)d.D * d.MIX);
  CARVE(W1T, bf16_t, (size_t)d.NE * 2 * d.DE * d.D); CARVE(W2T, bf16_t, (size_t)d.NE * d.D * d.DE);
  const size_t early0 = off;
  CARVE(P, float, (size_t)d.NR * d.IN); CARVE(A1, bf16_t, (size_t)d.NR * d.D);
  const size_t after_p = off;
  CARVE(Kraw, float, NRW); CARVE(AL1, bf16_t, (size_t)d.NR * 128); CARVE(AL2, bf16_t, (size_t)d.BT * 128); CARVE(Rr, float, NRW); CARVE(Vv, float, NRW); CARVE(KK, float, NRW); CARVE(Kd, float, 2 * NRW); CARVE(Wd, float, 2 * NRW); CARVE(Bb, float, 2 * NRW);
  CARVE(Gt, float, (size_t)d.BT * d.RW); CARVE(QN, bf16_t, (size_t)d.BT * d.QL); CARVE(CN, bf16_t, (size_t)d.NR * d.KL);
  CARVE(O2, float, (size_t)2 * d.BT * d.RW);
  CARVE(Q, bf16_t, (size_t)d.B * d.MH * d.T * d.QK); CARVE(K, bf16_t, (size_t)d.B * d.MH * NK * d.QK); CARVE(V, bf16_t, (size_t)d.B * d.MH * NK * d.DV);
  CARVE(MIXb, bf16_t, (size_t)d.BT * d.MIX);
  size_t end1 = off;
  off = early0; CARVE(Zt, float, (size_t)2 * d.BT * d.RW); CARVE(Fend, float, (size_t)2 * d.B * d.RH * 32 * 128 * 64); CARVE(Sst, float, (size_t)2 * d.B * d.RH * 32 * 64 * 64);
  if (off > after_p) return (size_t)-1;
  off = early0; CARVE(x1, float, (size_t)d.BT * d.D); CARVE(H2b, bf16_t, (size_t)d.BT * d.D);
  if (off > after_p) return (size_t)-1;
  off = after_p; CARVE(Xg, bf16_t, (size_t)d.NPOSMAX * d.D); CARVE(ACTb, bf16_t, (size_t)d.NPOSMAX * d.DE); CARVE(Yb, bf16_t, (size_t)d.NPOSMAX * d.D);
  if (off > end1) end1 = off;
#undef CARVE
  return end1;
}

extern "C" void kernel_launch(void* const* d_in, const int* in_sizes, int n_in, void* d_out, int out_size, void* d_ws, size_t ws_size, hipStream_t stream) {
  static int grid = 0;
  if (!grid) {
    int dev = 0, cus = 0;
    hipGetDevice(&dev); hipDeviceGetAttribute(&cus, hipDeviceAttributeMultiprocessorCount, dev);
    if (hipFuncSetAttribute((const void*)fwd, hipFuncAttributeMaxDynamicSharedMemorySize, LDS_BYTES) != hipSuccess) { fprintf(stderr, "kernel_launch: hipFuncSetAttribute failed\n"); grid = -1; return; }
    grid = cus;
  }
  if (grid < 0) return;
  Pm p; memset(&p, 0, sizeof(p));
  Dm& d = p.d; d.D = 1024; d.B = 2; d.T = 8192; d.GW = 64; d.C = 256; d.RH = 8; d.LW = 64; d.LA = 64; d.LG = 128; d.MH = 4; d.DN = 128; d.DR = 64; d.DV = 128; d.QL = 256; d.KL = 128;
  d.NE = 32; d.DE = 1024; d.PADR = 256; dm_finish(d);
  const float** ip = &p.x; for (int i = 0; i < 32; ++i) ip[i] = (const float*)d_in[i];
  p.out = (float*)d_out;
  unsigned* bar = (unsigned*)d_ws;
  const size_t used = carve(p, (char*)d_ws + 16384);
  if (used == (size_t)-1 || used + 16384 > ws_size) { fprintf(stderr, "kernel_launch: workspace too small (%zu needed, %zu given)\n", used + 16384, ws_size); return; }
  static bool once = false; if (!once) { once = true; fprintf(stderr, "ws used %zu of %zu\n", used + 16384, ws_size); }
  hipMemsetAsync(bar, 0, 16384, stream);
  hipLaunchKernelGGL(fwd, dim3(grid), dim3(NTHREADS), LDS_BYTES, stream, p, bar);
}
```

```cpp
#include <hip/hip_runtime.h>
#include <cstdio>
#include <cstring>
#include <cstdint>
#define HD __host__ __device__
#ifndef HD
#define HD
#endif
struct Dm {
  int D, B, T, GW, C, RH, LW, LA, LG, MH, DN, DR, DV, QL, KL, NE, DE;
  int RW, RC, QK, MC, IN, MIX, NF, BT, BC, NR, PADR, NPOSMAX, pad_;
};
HD constexpr void dm_finish(Dm& d) {
  d.RW = d.RH * 64; d.RC = 3 * d.RW + d.LW + d.LA + d.LG; d.QK = d.DN + d.DR; d.MC = d.QL + d.KL + d.DR; d.IN = d.RC + d.MC;
  d.MIX = d.RW + d.MH * d.DV; d.NF = d.DR / 4; d.BT = d.B * d.T; d.BC = d.B * d.C; d.NR = d.BT + d.BC;
  d.NPOSMAX = d.BT * 4 + d.NE * d.PADR;
}
typedef unsigned short bf16_t;
HD inline bf16_t f2bf(float f) { unsigned u = __builtin_bit_cast(unsigned, f); return (bf16_t)((u + 0x7fffu + ((u >> 16) & 1u)) >> 16); }
HD inline float bf2f(bf16_t h) { return __builtin_bit_cast(float, (unsigned)h << 16); }
HD constexpr Dm make_dmc() { Dm d{}; d.D = 1024; d.B = 2; d.T = 8192; d.GW = 64; d.C = 256; d.RH = 8; d.LW = 64; d.LA = 64; d.LG = 128; d.MH = 4; d.DN = 128; d.DR = 64; d.DV = 128; d.QL = 256; d.KL = 128;
  d.NE = 32; d.DE = 1024; d.PADR = 256; dm_finish(d); return d; }
constexpr Dm DMC = make_dmc();
typedef float f4q __attribute__((ext_vector_type(4)));
struct Pm {
  Dm d;
  const float *x, *c, *ctx, *c_ctx, *mod_w, *mod_b, *norm1_g, *w_in, *mu, *w0, *w2, *a0, *a2, *k_k, *k_a, *r_k, *g2, *ln_w, *ln_b, *q_norm, *w_uq, *kv_norm,
      *w_ukv, *w_out, *norm2_g, *router_w, *router_b, *exp_w1, *exp_b1, *exp_w2, *exp_b2, *final_g;
  float* out;
  float *modv, *modp, *ropet, *Kraw, *P, *Rr, *Vv, *KK, *Kd, *Wd, *Bb, *Gt, *O2, *Zt, *Fend, *Sst, *x1, *gate;
  bf16_t *A1, *QN, *CN, *MIXb, *WinT, *WuqT, *WukvT, *WoutT, *W1T, *W2T, *H2b, *Xg, *ACTb, *Yb, *Q, *K, *V, *AL1, *AL2, *WlT, *G2T;
  int *top_e, *cnt, *slot_pos, *pos_tok, *tile_e, *npos, *lrank, *blkcnt;
};
HD inline float sigmoidf_(float x) { return 1.f / (1.f + expf(-x)); }

template <int TM, class Epi>
HD inline void gemm_naive(const float* A, int lda, const float* Bm, int ldb, int M, int N, int K, long tid, long nth, Epi epi) {
  const long ngm = (M + TM - 1) / TM, items = ngm * N;
  for (long it = tid; it < items; it += nth) {
    const int n = (int)(it % N); const long m0 = (it / N) * TM;
    float acc[TM];
#pragma unroll
    for (int i = 0; i < TM; ++i) acc[i] = 0.f;
    const float* a[TM];
#pragma unroll
    for (int i = 0; i < TM; ++i) a[i] = A + (size_t)((m0 + i < M) ? (m0 + i) : (M - 1)) * lda;
    for (int k = 0; k < K; k += 4) {
      const float b0 = Bm[(size_t)k * ldb + n], b1 = Bm[(size_t)(k + 1) * ldb + n], b2 = Bm[(size_t)(k + 2) * ldb + n], b3 = Bm[(size_t)(k + 3) * ldb + n];
#pragma unroll
      for (int i = 0; i < TM; ++i) { acc[i] += a[i][k] * b0; acc[i] += a[i][k + 1] * b1; acc[i] += a[i][k + 2] * b2; acc[i] += a[i][k + 3] * b3; }
    }
#pragma unroll
    for (int i = 0; i < TM; ++i) if (m0 + i < M) epi(m0 + i, n, acc[i]);
  }
}

HD inline void row_pos(const Dm& d, long row, int& t, int& len, int& b, int& isctx) {
  if (row < d.BT) { b = (int)(row / d.T); t = (int)(row % d.T); len = d.T; isctx = 0; } else { const long r = row - d.BT; b = (int)(r / d.C); t = (int)(r % d.C); len = d.C; isctx = 1; }
}

HD inline void chain_step(const Dm& d, int dd, int b, int sg, size_t& row, bool& lat) {
  if (sg < d.C) { const int t = dd == 0 ? sg : d.C - 1 - sg; row = (size_t)d.BT + (size_t)b * d.C + t; lat = false; }
  else { const int s = sg - d.C; const int t = dd == 0 ? s : d.T - 1 - s; row = (size_t)b * d.T + t; lat = true; }
}
HD inline void ph_scan_a1(const Pm& p, long tid, long nth, int NSEG) {
  constexpr Dm d = DMC; const int RW = d.RW; const int SL = (d.C + d.T) / NSEG; const long items = (long)2 * d.B * d.RH * NSEG * 128; const size_t NRW = (size_t)d.NR * RW, BTW = (size_t)d.BT * RW;
  for (long it = tid; it < items; it += nth) {
    const int rho = (int)(it % 128); const int g = (int)((it / 128) % NSEG); const int ch = (int)(it / (128 * (long)NSEG)); const int h = ch % d.RH, b = (ch / d.RH) % d.B, dd = ch / (d.RH * d.B);
    float S[64];
#pragma unroll
    for (int j = 0; j < 64; ++j) S[j] = (rho >= 64 && j == rho - 64) ? 1.f : 0.f;
    for (int sg = g * SL; sg < (g + 1) * SL; ++sg) {
      size_t row; bool lat; chain_step(d, dd, b, sg, row, lat); const size_t o = row * RW + h * 64;
      const float* w = p.Wd + dd * NRW + o; const float* bb = p.Bb + dd * NRW + o; const float* kd = p.Kd + dd * NRW + o; const float* kk = p.KK + o; const float* rr = p.Rr + o;
      const float vv = rho < 64 ? p.Vv[o + rho] : 0.f;
      float sa = 0.f;
#pragma unroll
      for (int j = 0; j < 64; ++j) sa += S[j] * kk[j];
      float oo = 0.f;
#pragma unroll
      for (int j = 0; j < 64; ++j) { S[j] = S[j] * w[j] - sa * bb[j] + vv * kd[j]; oo += S[j] * rr[j]; }
      if (lat) { if (rho < 64) p.O2[dd * BTW + o + rho] = oo; else p.Zt[dd * BTW + o + rho - 64] = oo; }
    }
    float* fe = p.Fend + (((size_t)ch * NSEG + g) * 128 + rho) * 64;
#pragma unroll
    for (int j = 0; j < 64; ++j) fe[j] = S[j];
  }
}
__device__ inline void ph_scan_a2(const Pm& p, int gw, int ngw, int lane, int NSEG) {
  constexpr Dm d = DMC; const int items = 2 * d.B * d.RH * 64;
  for (int it = gw; it < items; it += ngw) { const int v = it % 64, ch = it / 64; float S = 0.f;
    for (int g = 0; g < NSEG; ++g) { p.Sst[(((size_t)ch * NSEG + g) * 64 + v) * 64 + lane] = S;
      const float* fe = p.Fend + ((size_t)ch * NSEG + g) * 128 * 64; float acc = fe[(size_t)v * 64 + lane];
#pragma unroll
      for (int i = 0; i < 64; ++i) { const float si = __builtin_bit_cast(float, __builtin_amdgcn_readlane(__builtin_bit_cast(int, S), i)); acc += si * fe[(size_t)(64 + i) * 64 + lane]; }
      S = acc; } }
}
__device__ inline void ph_scan_a3(const Pm& p, int gw, int ngw, int lane, int NSEG) {
  constexpr Dm d = DMC; const int RW = d.RW; const int SL = (d.C + d.T) / NSEG; const size_t BTW = (size_t)d.BT * RW; constexpr int PARTS = 1;
  const int items = 2 * d.B * d.RH * NSEG * PARTS;
  for (int it = gw; it < items; it += ngw) { const int part = it % PARTS, g = (it / PARTS) % NSEG, ch = it / (PARTS * NSEG); const int h = ch % d.RH, b = (ch / d.RH) % d.B, dd = ch / (d.RH * d.B);
    const float* st = p.Sst + (((size_t)ch * NSEG + g) * 64 + lane) * 64; float S[64];
#pragma unroll
    for (int i = 0; i < 64; i += 4) { const f4q x = *(const f4q*)(st + i); S[i] = x.x; S[i + 1] = x.y; S[i + 2] = x.z; S[i + 3] = x.w; }
    const int s0 = g * SL + part * (SL / PARTS), s1 = part == PARTS - 1 ? (g + 1) * SL : s0 + SL / PARTS;
    for (int sg = s0; sg < s1; ++sg) { size_t row; bool lat; chain_step(d, dd, b, sg, row, lat); if (!lat) continue;
      const size_t o = row * RW + h * 64; const float* z = p.Zt + dd * BTW + o; float a = p.O2[dd * BTW + o + lane];
#pragma unroll
      for (int i = 0; i < 64; i += 4) { const f4q x = *(const f4q*)(z + i); a += S[i] * x.x + S[i + 1] * x.y + S[i + 2] * x.z + S[i + 3] * x.w; }
      p.O2[dd * BTW + o + lane] = a; } }
}

namespace pg8 {
#define PG8_LAS __attribute__((address_space(3)))
typedef unsigned short bf16_t;
typedef short bf16x8 __attribute__((ext_vector_type(8)));
typedef float f32x4 __attribute__((ext_vector_type(4)));
typedef unsigned u32x4 __attribute__((ext_vector_type(4)));
constexpr int BM = 256, BK = 64, HALF = 128, HTB = HALF * BK * 2  , STAGE_BYTES = 8 * HTB, NXCD = 8, WGM = 8;

__host__ __device__ __forceinline__ int lds_byte(int r, int c) { const int st = (r >> 4) * 2 + (c >> 5), rr = r & 15, cc = c & 31, ob = rr * 64 + cc * 2; return st * 1024 + (ob ^ (((ob >> 9) & 1) << 5)); }
__host__ __device__ __forceinline__ void stage_rc(int b, int& R, int& C) { const int st = b / 1024, sb = b % 1024, swz = sb ^ (((sb >> 9) & 1) << 5); R = (st >> 1) * 16 + swz / 64; C = (st & 1) * 32 + (swz % 64) / 2; }
__host__ __device__ __forceinline__ int perm32(int rho) { const int n = rho >> 4, i = rho & 15; return 8 * (i >> 2) + 4 * n + (i & 3); }

struct Unit { int pm, pn, eb; };
struct Gemm { const bf16_t* A; const bf16_t* Bt; int M, N, K; size_t bexp; };

struct StaticOrder {
    int nM, nN, nwg, G, c; const int* tile_e;
    __host__ __device__ void init(int M, int N, int G_, int c_, const int* te = nullptr) { nM = M / BM; nN = N / BM; nwg = nM * nN; G = G_; c = c_; tile_e = te; }
    __device__ bool next(int i, Unit& u) const {
        const long L = (long)i * G + c; if (L >= nwg) return false;
        int wgid = (int)L; { const int q = nwg / NXCD, r = nwg % NXCD, xcd = wgid % NXCD, off = wgid / NXCD; wgid = (xcd < r ? xcd * (q + 1) : r * (q + 1) + (xcd - r) * q) + off; }
        const int nig = WGM * nN, gid = wgid / nig, fm = gid * WGM, gsz = (nM - fm) < WGM ? (nM - fm) : WGM;
        u.pm = fm + ((wgid % nig) % gsz); u.pn = (wgid % nig) / gsz; u.eb = tile_e ? __builtin_amdgcn_readfirstlane(__hip_atomic_load(tile_e + u.pm, __ATOMIC_RELAXED, __HIP_MEMORY_SCOPE_AGENT)) : 0; return true;
    }
    __device__ __forceinline__ void a_ready(const Unit&) const {}
    __device__ __forceinline__ void done(const Unit&) const {}
};
__device__ __forceinline__ unsigned cvt_pk_bf16(float lo, float hi) { unsigned r; asm volatile("v_cvt_pk_bf16_f32 %0, %1, %2" : "=v"(r) : "v"(lo), "v"(hi)); return r; }
typedef float f32x2 __attribute__((ext_vector_type(2)));
template <class Epi, class Sched, bool ALIGN_EPI = false, bool SP2 = false>
__device__ __forceinline__ void gemm_phase(PG8_LAS unsigned char* lds, const Gemm g, const Sched& S, const Epi& E, const int tid_in) {
    int tid_ = tid_in; asm volatile("" : "+v"(tid_));
    const int tid = tid_, wid = __builtin_amdgcn_readfirstlane(tid >> 6), lane = tid & 63, wr = wid >> 2, wc = wid & 3, fr = lane & 15, fq = lane >> 4;
    const int K = g.K, nt = K / BK;
    unsigned voffA[2], voffB[2];
#pragma unroll
    for (int i = 0; i < 2; ++i) { int R, C; stage_rc(tid * 16 + i * 8192, R, C); const int Rb = Epi::PERM ? ((R & ~31) + perm32(R & 31)) : R;
        voffA[i] = (unsigned)(R * K + C) * 2u; voffB[i] = (unsigned)(Rb * K + C) * 2u; }
    const size_t kstep = (size_t)(BK * 2);
    const size_t hstep = (size_t)HALF * K * 2;
    const size_t tstep = 2 * hstep;
    const unsigned ldsw = (unsigned)wid * 1024u;
    const int aoff = lds_byte(wr * 64 + fr, fq * 8), boff = lds_byte(wc * 32 + fr, fq * 8);
#define PG8_SA(b, h) (((b) * 2 + (h)) * HTB)
#define PG8_SB(b, h) ((4 + (b) * 2 + (h)) * HTB)
#define PG8_STAGE(bufoff, gbase, voff) do { _Pragma("unroll") for (int _i = 0; _i < 2; ++_i) \
        __builtin_amdgcn_global_load_lds((const unsigned*)((const char*)(gbase) + (voff)[_i]), (PG8_LAS unsigned*)(lds + (bufoff) + ldsw + _i * 8192), 16, 0, 0); } while (0)
#define PG8_LDA(dst, b, h) do { _Pragma("unroll") for (int m = 0; m < 4; ++m) _Pragma("unroll") for (int k = 0; k < 2; ++k) dst[m][k] = *(const PG8_LAS bf16x8*)(lds + PG8_SA(b, h) + aoff + m * 2048 + k * 1024); } while (0)
#define PG8_LDB(dst, b, h) do { _Pragma("unroll") for (int n = 0; n < 2; ++n) _Pragma("unroll") for (int k = 0; k < 2; ++k) dst[n][k] = *(const PG8_LAS bf16x8*)(lds + PG8_SB(b, h) + boff + n * 2048 + k * 1024); } while (0)
#define PG8_MMA(ai, bj, At, Bt) do { __builtin_amdgcn_s_setprio(1); _Pragma("unroll") for (int m = 0; m < 4; ++m) _Pragma("unroll") for (int n = 0; n < 2; ++n) _Pragma("unroll") for (int k = 0; k < 2; ++k) \
        acc[ai][bj][m][n] = __builtin_amdgcn_mfma_f32_16x16x32_bf16(Bt[n][k], At[m][k], acc[ai][bj][m][n], 0, 0, 0); __builtin_amdgcn_s_setprio(0); } while (0)
#define PG8_WAIT_V(n) asm volatile("s_waitcnt vmcnt(" #n ")" ::: "memory")
#define PG8_WAIT_L(n) asm volatile("s_waitcnt lgkmcnt(" #n ")" ::: "memory")
#define PG8_BAR __builtin_amdgcn_s_barrier()
#define PG8_SCHED __builtin_amdgcn_sched_barrier(0)
    Unit cur, nxt; int ui = 0;
    if (!S.next(0, cur)) return;
    f32x4 acc[2][2][4][2];
#pragma unroll
    for (int a = 0; a < 2; ++a)
#pragma unroll
        for (int b = 0; b < 2; ++b)
#pragma unroll
            for (int m = 0; m < 4; ++m)
#pragma unroll
                for (int n = 0; n < 2; ++n) acc[a][b][m][n] = (f32x4){0.f, 0.f, 0.f, 0.f};
    bf16x8 At[4][2], B0[2][2], B1[2][2];
    const char* cA = (const char*)g.A + (size_t)cur.pm * tstep; const char* cB = (const char*)g.Bt + (size_t)cur.eb * g.bexp + (size_t)cur.pn * tstep;
    S.a_ready(cur);
    if constexpr (SP2) {
        PG8_STAGE(PG8_SB(0, 0), cB, voffB); PG8_STAGE(PG8_SB(0, 1), cB + hstep, voffB); PG8_STAGE(PG8_SA(0, 0), cA, voffA); PG8_STAGE(PG8_SA(0, 1), cA + hstep, voffA);
        if (wr == 1) PG8_BAR;
        PG8_WAIT_V(2); PG8_BAR;
        PG8_STAGE(PG8_SB(1, 0), cB + kstep, voffB); PG8_STAGE(PG8_SA(1, 0), cA + kstep, voffA); PG8_STAGE(PG8_SB(1, 1), cB + hstep + kstep, voffB);
        PG8_WAIT_V(6); PG8_BAR;
    } else {
        PG8_STAGE(PG8_SB(0, 0), cB, voffB); PG8_STAGE(PG8_SA(0, 0), cA, voffA); PG8_STAGE(PG8_SB(0, 1), cB + hstep, voffB); PG8_STAGE(PG8_SA(0, 1), cA + hstep, voffA);
        if (wr == 1) PG8_BAR;
        PG8_WAIT_V(4); PG8_BAR;
        PG8_STAGE(PG8_SB(1, 0), cB + kstep, voffB); PG8_STAGE(PG8_SA(1, 0), cA + kstep, voffA); PG8_STAGE(PG8_SB(1, 1), cB + hstep + kstep, voffB);
        PG8_WAIT_V(6); PG8_BAR;
    }
    for (;;) {
        const bool has_next = S.next(ui + 1, nxt);
        const char* nA = has_next ? (const char*)g.A + (size_t)nxt.pm * tstep : cA; const char* nB = has_next ? (const char*)g.Bt + (size_t)nxt.eb * g.bexp + (size_t)nxt.pn * tstep : cB;
        for (int t = 0; t < nt; t += 2) {
            const bool last = (t == nt - 2);
            const char* a1 = cA + (size_t)(t + 1) * kstep;
            const char* a2 = last ? nA : cA + (size_t)(t + 2) * kstep; const char* b2 = last ? nB : cB + (size_t)(t + 2) * kstep;
            const char* a3 = a2 + kstep; const char* b3 = b2 + kstep;
            if (last && has_next) S.a_ready(nxt);
            if constexpr (SP2) {
            PG8_LDB(B0, 0, 0); PG8_LDB(B1, 0, 1); PG8_SCHED; PG8_LDA(At, 0, 0); PG8_STAGE(PG8_SA(1, 1), a1 + hstep, voffA);
            PG8_WAIT_V(8); PG8_WAIT_L(0); PG8_BAR; PG8_MMA(0, 0, At, B0); PG8_MMA(0, 1, At, B1); PG8_BAR; PG8_SCHED;
            PG8_LDA(At, 0, 1); PG8_STAGE(PG8_SB(0, 0), b2, voffB); PG8_STAGE(PG8_SB(0, 1), b2 + hstep, voffB); PG8_STAGE(PG8_SA(0, 0), a2, voffA);
            PG8_WAIT_V(8); PG8_WAIT_L(0); PG8_BAR; PG8_MMA(1, 0, At, B0); PG8_MMA(1, 1, At, B1); PG8_BAR; PG8_SCHED;
            PG8_LDB(B0, 1, 0); PG8_LDB(B1, 1, 1); PG8_SCHED; PG8_LDA(At, 1, 0); PG8_STAGE(PG8_SA(0, 1), a2 + hstep, voffA);
            PG8_WAIT_V(8); PG8_WAIT_L(0); PG8_BAR; PG8_MMA(0, 0, At, B0); PG8_MMA(0, 1, At, B1); PG8_BAR; PG8_SCHED;
            PG8_LDA(At, 1, 1); PG8_STAGE(PG8_SB(1, 0), b3, voffB); PG8_STAGE(PG8_SB(1, 1), b3 + hstep, voffB); PG8_STAGE(PG8_SA(1, 0), a3, voffA);
            PG8_WAIT_V(8); PG8_WAIT_L(0); PG8_BAR; PG8_MMA(1, 0, At, B0); PG8_MMA(1, 1, At, B1); PG8_BAR; PG8_SCHED;
            } else {
            PG8_LDB(B0, 0, 0); PG8_SCHED; PG8_LDA(At, 0, 0); PG8_STAGE(PG8_SA(1, 1), a1 + hstep, voffA);
            PG8_WAIT_L(8); PG8_BAR; PG8_WAIT_L(0); PG8_MMA(0, 0, At, B0); PG8_BAR; PG8_SCHED;
            PG8_LDB(B1, 0, 1); PG8_STAGE(PG8_SB(0, 0), b2, voffB);
            PG8_BAR; PG8_WAIT_L(0); PG8_MMA(0, 1, At, B1); PG8_BAR;
            PG8_LDA(At, 0, 1); PG8_STAGE(PG8_SA(0, 0), a2, voffA);
            PG8_BAR; PG8_WAIT_L(0); PG8_MMA(1, 0, At, B0); PG8_BAR; PG8_SCHED;
            PG8_STAGE(PG8_SB(0, 1), b2 + hstep, voffB);
            PG8_WAIT_V(6); PG8_BAR; PG8_MMA(1, 1, At, B1); PG8_BAR;
            PG8_LDB(B0, 1, 0); PG8_SCHED; PG8_LDA(At, 1, 0); PG8_STAGE(PG8_SA(0, 1), a2 + hstep, voffA);
            PG8_WAIT_L(8); PG8_BAR; PG8_WAIT_L(0); PG8_MMA(0, 0, At, B0); PG8_BAR; PG8_SCHED;
            PG8_LDB(B1, 1, 1); PG8_STAGE(PG8_SB(1, 0), b3, voffB);
            PG8_BAR; PG8_WAIT_L(0); PG8_MMA(0, 1, At, B1); PG8_BAR;
            PG8_LDA(At, 1, 1); PG8_STAGE(PG8_SA(1, 0), a3, voffA);
            PG8_BAR; PG8_WAIT_L(0); PG8_MMA(1, 0, At, B0); PG8_BAR; PG8_SCHED;
            PG8_STAGE(PG8_SB(1, 1), b3 + hstep, voffB);
            PG8_WAIT_V(6); PG8_BAR; PG8_MMA(1, 1, At, B1); PG8_BAR;
            }
        }
        if constexpr (ALIGN_EPI) { if (wr == 0) PG8_BAR; }
        if constexpr (!Epi::AFTER_DRAIN) { E(acc, cur, wr, wc, fr, fq); S.done(cur); }
        if (!has_next) break;
#pragma unroll
        for (int a = 0; a < 2; ++a)
#pragma unroll
            for (int b = 0; b < 2; ++b)
#pragma unroll
                for (int m = 0; m < 4; ++m)
#pragma unroll
                    for (int n = 0; n < 2; ++n) acc[a][b][m][n] = (f32x4){0.f, 0.f, 0.f, 0.f};
        cur = nxt; cA = nA; cB = nB; ++ui;
        if constexpr (ALIGN_EPI) { if (wr == 1) PG8_BAR; }
    }
    PG8_WAIT_V(0);
    if constexpr (!ALIGN_EPI) { if (wr == 0) PG8_BAR; }
    PG8_BAR;
    if constexpr (Epi::AFTER_DRAIN) { E.fused(acc, cur, wr, wc, fr, fq, lds, wid, lane); S.done(cur); }
#undef PG8_SA
#undef PG8_SB
#undef PG8_STAGE
#undef PG8_LDA
#undef PG8_LDB
#undef PG8_MMA
#undef PG8_WAIT_V
#undef PG8_WAIT_L
#undef PG8_BAR
#undef PG8_SCHED
}
}

#define XB_TMO      128
#define XB_XCNT(j)  (256  + 64 * (j))
#define XB_XSUB(j)  (1280 + 64 * (j))
#define XB_XGEN(j)  (2304 + 64 * (j))
#define XB_TOP      3328
#define XB_TOPGEN   3392
#define XCD_BAR_WORDS 3456
#define XB_SPIN_CAP (1u << 22)
#define LAS __attribute__((address_space(3)))

__device__ __forceinline__ unsigned xb_ld(unsigned* p)              { return __hip_atomic_load(p, __ATOMIC_RELAXED, __HIP_MEMORY_SCOPE_AGENT); }
__device__ __forceinline__ unsigned xb_add(unsigned* p, unsigned v) { return __hip_atomic_fetch_add(p, v, __ATOMIC_RELAXED, __HIP_MEMORY_SCOPE_AGENT); }
__device__ __forceinline__ unsigned xb_xcc_id() { return (unsigned)__builtin_amdgcn_s_getreg((3 << 11) | 20) & 0xFu; }
#define XB_SPIN(cond, bar) do { unsigned _sp = 0; while (cond) { __builtin_amdgcn_s_sleep(1); \
    if ((++_sp & 255u) == 0u) { if (xb_ld(&(bar)[XB_TMO])) break; if (_sp > XB_SPIN_CAP) { atomicAdd(&(bar)[XB_TMO], 1u); break; } } } } while (0)

struct XcdBarrier {
    unsigned* bar; unsigned x; int wv;
    volatile LAS unsigned* st;
};

__device__ __forceinline__ XcdBarrier xcd_barrier_post(unsigned* bar, volatile LAS unsigned* st) {
    XcdBarrier b; b.bar = bar; b.x = xb_xcc_id(); b.st = st; b.wv = __builtin_amdgcn_readfirstlane((int)threadIdx.x >> 6);
    if (threadIdx.x == 0) (void)xb_add(&bar[XB_XCNT(b.x)], 1u);
    return b;
}
__device__ __forceinline__ void xcd_barrier_complete(unsigned* bar, unsigned x, unsigned& nloc, unsigned& nx) {
    const unsigned G = gridDim.x * gridDim.y * gridDim.z;
    unsigned sum, cnt, mine, sp = 0u;
    for (;;) {
        sum = 0u; cnt = 0u; mine = 0u;
#pragma unroll
        for (unsigned j = 0; j < 16; ++j) { const unsigned c = xb_ld(&bar[XB_XCNT(j)]); sum += c; cnt += (c > 0u) ? 1u : 0u; mine = (j == x) ? c : mine; }
        if (sum == G) break;
        __builtin_amdgcn_s_sleep(1);
        if ((++sp & 255u) == 0u) { if (xb_ld(&bar[XB_TMO])) break; if (sp > XB_SPIN_CAP) { atomicAdd(&bar[XB_TMO], 1u); break; } }
    }
    nloc = mine > 0u ? mine : 1u; nx = cnt > 0u ? cnt : 1u;
}

__device__ __forceinline__ void xcd_barrier(const XcdBarrier& b) {
    asm volatile("s_waitcnt vmcnt(0)" ::: "memory");
    __syncthreads();
    int ln_; asm volatile("v_mbcnt_lo_u32_b32 %0, -1, 0\n\tv_mbcnt_hi_u32_b32 %0, -1, %0" : "=v"(ln_));
    if (b.wv == 0 && ln_ == 0) {
        unsigned* bar = b.bar;
        __builtin_amdgcn_s_waitcnt(0);
        unsigned nloc = b.st[0], nx = b.st[1];
        if (nloc == 0u) { xcd_barrier_complete(bar, b.x, nloc, nx); b.st[0] = nloc; b.st[1] = nx; }
        const unsigned old = xb_add(&bar[XB_XSUB(b.x)], 1u);
        const unsigned gen = old / nloc;
        if (old + 1u == (gen + 1u) * nloc) {
            __builtin_amdgcn_fence(__ATOMIC_RELEASE, "agent");
            asm volatile("s_waitcnt vmcnt(0)" ::: "memory");
            const unsigned og = xb_add(&bar[XB_TOP], 1u);
            const unsigned tg = og / nx;
            if (og + 1u == (tg + 1u) * nx) xb_add(&bar[XB_TOPGEN], 1u);
            else XB_SPIN(xb_ld(&bar[XB_TOPGEN]) == tg, bar);
            __builtin_amdgcn_fence(__ATOMIC_ACQUIRE, "agent");
            xb_add(&bar[XB_XGEN(b.x)], 1u);
            asm volatile("s_waitcnt vmcnt(0)" ::: "memory");
        } else {
            XB_SPIN(xb_ld(&bar[XB_XGEN(b.x)]) == gen, bar);
            __builtin_amdgcn_fence(__ATOMIC_ACQUIRE, "agent");
            asm volatile("s_waitcnt vmcnt(0)" ::: "memory");
        }
    }
    __syncthreads();
}


namespace attn {
using bf16 = unsigned short;
constexpr int DQK = 192, DV = 128, NW = 8, QBLK = 32, KVBLK = 64;
constexpr float SCALE = 0.07216878364870322f;
constexpr float THR = 8.f;
constexpr int SDEPTH = 1;
constexpr int LDQ = DQK, LDK = DQK, LDV = DV, LDO = 1024;
constexpr size_t SHM_V = KVBLK * DV * 2, SHM_K = KVBLK * DQK * 2, SHM_ATTN = 2 * SHM_V + 2 * SHM_K + NW * 64 * 4;
using bf16x8 = __attribute__((ext_vector_type(8))) short;
using s16x4  = __attribute__((ext_vector_type(4))) short;
using f32x16 = __attribute__((ext_vector_type(16))) float;
using f32x8  = __attribute__((ext_vector_type(8))) float;
using u32x4  = __attribute__((ext_vector_type(4))) unsigned;
#define KSWZ(row, colB) ((row) * 384 + ((colB) ^ (((row) & 7) << 4)))
#define SBAR() __builtin_amdgcn_sched_barrier(0)
__device__ __forceinline__ int crow(int r, int hi) { return (r & 3) + 8 * (r >> 2) + 4 * hi; }
__device__ __forceinline__ unsigned cvtpk(float lo, float hi) {
  unsigned r; asm volatile("v_cvt_pk_bf16_f32 %0, %1, %2" : "=v"(r) : "v"(lo), "v"(hi)); return r;
}
struct St { using T = bf16x8;
  __device__ static __forceinline__ T ld8(const bf16* p) { return *reinterpret_cast<const bf16x8*>(p); }
  __device__ static __forceinline__ bf16x8 tobf(T x) { return x; } };
__device__ __forceinline__ void partialSM(f32x16& p0, f32x16& p1, float& m_reg, float& mn, float& alpha) {
  constexpr float C = SCALE * 1.4426950408889634f;
  float pmax = p0[0]; for (int r = 1; r < 16; ++r) pmax = fmaxf(pmax, p0[r]); for (int r = 0; r < 16; ++r) pmax = fmaxf(pmax, p1[r]);
  { auto rr = __builtin_amdgcn_permlane32_swap(__float_as_uint(pmax), __float_as_uint(pmax), false, false);
    pmax = fmaxf(__uint_as_float(rr[0]), __uint_as_float(rr[1])); }
  if (__builtin_expect(__all(pmax - m_reg <= THR / SCALE), 1)) { mn = m_reg; alpha = 1.f; }
  else { mn = fmaxf(m_reg, pmax); alpha = __builtin_amdgcn_exp2f((m_reg - mn) * C); m_reg = mn; }
  float mnC = -mn * C;
  for (int r = 0; r < 16; ++r) p0[r] = fmaf(p0[r], C, mnC); for (int r = 0; r < 16; ++r) p1[r] = fmaf(p1[r], C, mnC);
  for (int r = 0; r < 16; ++r) p0[r] = __builtin_amdgcn_exp2f(p0[r]);
}
__device__ __forceinline__ void finishSM(f32x16& p0, f32x16& p1, float alpha, float& l_reg, bf16x8& pa0, bf16x8& pa1, bf16x8& pa2, bf16x8& pa3) {
  for (int r = 0; r < 16; ++r) p1[r] = __builtin_amdgcn_exp2f(p1[r]);
  float ps = 0; for (int r = 0; r < 16; ++r) ps += p0[r]; for (int r = 0; r < 16; ++r) ps += p1[r];
  { auto rr = __builtin_amdgcn_permlane32_swap(__float_as_uint(ps), __float_as_uint(ps), false, false);
    ps = __uint_as_float(rr[0]) + __uint_as_float(rr[1]); }
  l_reg = l_reg * alpha + ps;
#define PK4(P, BASE, OUT) do { unsigned a0 = cvtpk(P[BASE + 0], P[BASE + 1]), a1 = cvtpk(P[BASE + 2], P[BASE + 3]);   \
    unsigned b0 = cvtpk(P[BASE + 4], P[BASE + 5]), b1 = cvtpk(P[BASE + 6], P[BASE + 7]);                              \
    auto r0 = __builtin_amdgcn_permlane32_swap(a0, b0, false, false); auto r1 = __builtin_amdgcn_permlane32_swap(a1, b1, false, false); \
    u32x4 w = {r0[0], r1[0], r0[1], r1[1]}; OUT = *reinterpret_cast<bf16x8*>(&w); } while (0)
  PK4(p0, 0, pa0); PK4(p0, 8, pa1); PK4(p1, 0, pa2); PK4(p1, 8, pa3);
#undef PK4
}
__device__ __forceinline__ void qkt(f32x16& p0, f32x16& p1, const bf16* Ks, const bf16x8* qr, int r32, int hi) {
  p0 = f32x16{}; p1 = f32x16{};
  for (int d0 = 0; d0 < 12; ++d0) { int cb = (d0 * 16 + hi * 8) * 2;
    bf16x8 b0 = *reinterpret_cast<const bf16x8*>((const char*)Ks + KSWZ(r32, cb));
    bf16x8 b1 = *reinterpret_cast<const bf16x8*>((const char*)Ks + KSWZ(32 + r32, cb));
    p0 = __builtin_amdgcn_mfma_f32_32x32x16_bf16(b0, qr[d0], p0, 0, 0, 0);
    p1 = __builtin_amdgcn_mfma_f32_32x32x16_bf16(b1, qr[d0], p1, 0, 0, 0); }
}
__device__ __forceinline__ int v_st(int k, int c) { const int kk = (k & ~0xC) | ((k & 4) << 1) | ((k & 8) >> 1); return ((kk >> 3) * 4 + (c >> 5)) * 512 + ((kk & 7) * 32 + (c & 31)) * 2; }
__device__ __forceinline__ int v_rd_base(int lane) { return ((lane & 3) << 3) | (((lane >> 2) & 3) << 6) | (((lane >> 4) & 1) << 5) | (((lane >> 5) & 1) << 8); }
constexpr int v_rd_off(int d0, int ks, int half) { return d0 * 512 + ks * 4096 + half * 2048; }
template <int OFF> __device__ __forceinline__ s16x4 tr_read(int vb) {
  s16x4 r; asm volatile("ds_read_b64_tr_b16 %0, %1 offset:%2" : "=&v"(r) : "v"(vb), "i"(OFF) : "memory"); return r;
}
template <int D0> __device__ __forceinline__ void pv_one(f32x16& od, int vb, bf16x8 pa0, bf16x8 pa1, bf16x8 pa2, bf16x8 pa3) {
  const s16x4 l0 = tr_read<v_rd_off(D0, 0, 0)>(vb), h0 = tr_read<v_rd_off(D0, 0, 1)>(vb), l1 = tr_read<v_rd_off(D0, 1, 0)>(vb), h1 = tr_read<v_rd_off(D0, 1, 1)>(vb);
  const s16x4 l2 = tr_read<v_rd_off(D0, 2, 0)>(vb), h2 = tr_read<v_rd_off(D0, 2, 1)>(vb), l3 = tr_read<v_rd_off(D0, 3, 0)>(vb), h3 = tr_read<v_rd_off(D0, 3, 1)>(vb);
  asm volatile("s_waitcnt lgkmcnt(0)" ::: "memory"); SBAR();
#define PK(L, H) (bf16x8){L[0], L[1], L[2], L[3], H[0], H[1], H[2], H[3]}
  od = __builtin_amdgcn_mfma_f32_32x32x16_bf16(pa0, PK(l0, h0), od, 0, 0, 0);
  od = __builtin_amdgcn_mfma_f32_32x32x16_bf16(pa1, PK(l1, h1), od, 0, 0, 0);
  od = __builtin_amdgcn_mfma_f32_32x32x16_bf16(pa2, PK(l2, h2), od, 0, 0, 0);
  od = __builtin_amdgcn_mfma_f32_32x32x16_bf16(pa3, PK(l3, h3), od, 0, 0, 0);
#undef PK
}
__device__ __forceinline__ void pv_d0(f32x16* o, int vb, bf16x8 pa0, bf16x8 pa1, bf16x8 pa2, bf16x8 pa3) {
  pv_one<0>(o[0], vb, pa0, pa1, pa2, pa3); pv_one<1>(o[1], vb, pa0, pa1, pa2, pa3); pv_one<2>(o[2], vb, pa0, pa1, pa2, pa3); pv_one<3>(o[3], vb, pa0, pa1, pa2, pa3);
}

__device__ __forceinline__ void attn_dense_body(const bf16* __restrict__ Qb, const bf16* __restrict__ Kh, const bf16* __restrict__ Vh,
                                                bf16* __restrict__ Ob, int seq, char* lds, const int tid_in) {
  int tid_ = tid_in; asm volatile("" : "+v"(tid_));
  const int tid = tid_, wid = tid >> 6, lane = tid & 63, r32 = lane & 31, hi = lane >> 5;
  bf16* V_lds = (bf16*)lds; bf16* K_lds = (bf16*)(lds + 2 * SHM_V);
  float* ws = (float*)(lds + 2 * SHM_V + 2 * SHM_K) + wid * 64; float* li_l = ws; float* al_l = ws + 32;
  float m_reg = -1e30f, l_reg = 0; f32x16 o[4] = {}; bf16x8 qr[12];
  const bf16* Qw = Qb + (long)(wid * QBLK + r32) * LDQ + hi * 8;
#pragma unroll
  for (int d0 = 0; d0 < 12; ++d0) qr[d0] = St::ld8(Qw + d0 * 16);
  const int sr = tid >> 4, sc = (tid & 15) * 8, vst0 = v_st(sr, sc), vst1 = v_st(32 + sr, sc);
  const int kr0 = tid / 24, kc0 = (tid % 24) * 8, kr1 = (tid + 512) / 24, kc1 = ((tid + 512) % 24) * 8, kr2 = (tid + 1024) / 24, kc2 = ((tid + 1024) % 24) * 8;
  const int vb0 = (int)(uintptr_t)V_lds + v_rd_base(lane);
  struct { St::T vs0, vs1, ks0, ks1, ks2; } sr_[SDEPTH];
#define SLOAD(i, k0) do { sr_[i].vs0 = St::ld8(&Vh[(long)((k0) + sr) * LDV + sc]); sr_[i].vs1 = St::ld8(&Vh[(long)((k0) + 32 + sr) * LDV + sc]); \
    sr_[i].ks0 = St::ld8(&Kh[(long)((k0) + kr0) * LDK + kc0]); sr_[i].ks1 = St::ld8(&Kh[(long)((k0) + kr1) * LDK + kc1]); sr_[i].ks2 = St::ld8(&Kh[(long)((k0) + kr2) * LDK + kc2]); } while (0)
#define SWRITE(b, i) do { *(bf16x8*)((char*)V_lds + (b) * SHM_V + vst0) = St::tobf(sr_[i].vs0);          \
    *(bf16x8*)((char*)V_lds + (b) * SHM_V + vst1) = St::tobf(sr_[i].vs1);                                \
    *(bf16x8*)((char*)K_lds + (b) * SHM_K + KSWZ(kr0, kc0 * 2)) = St::tobf(sr_[i].ks0);                  \
    *(bf16x8*)((char*)K_lds + (b) * SHM_K + KSWZ(kr1, kc1 * 2)) = St::tobf(sr_[i].ks1);                  \
    *(bf16x8*)((char*)K_lds + (b) * SHM_K + KSWZ(kr2, kc2 * 2)) = St::tobf(sr_[i].ks2); } while (0)
#define SWAIT() do { if constexpr (SDEPTH == 2) asm volatile("s_waitcnt vmcnt(5)" ::: "memory"); else asm volatile("s_waitcnt vmcnt(0)" ::: "memory"); } while (0)
#define RESC(a) do { if (__any((a) < 1.f)) { if (hi == 0) al_l[r32] = (a); asm volatile("s_waitcnt lgkmcnt(0)" ::: "memory"); \
    for (int d = 0; d < 4; ++d) for (int r = 0; r < 16; ++r) o[d][r] *= al_l[crow(r, hi)]; } } while (0)
  f32x16 p0, p1; float mn, al; bf16x8 pa0, pa1, pa2, pa3; const int NT = seq / KVBLK;
  SLOAD(0, 0); asm volatile("s_waitcnt vmcnt(0)" ::: "memory"); SWRITE(0, 0); __syncthreads();
  for (int j = 0; j < NT; ++j) {
    const int cur = j & 1; const bool more = j + 1 < NT;
    if (more) SLOAD(0, (j + 1) * KVBLK);
    SBAR(); qkt(p0, p1, (bf16*)((char*)K_lds + cur * SHM_K), qr, r32, hi);
    partialSM(p0, p1, m_reg, mn, al); RESC(al);
    finishSM(p0, p1, al, l_reg, pa0, pa1, pa2, pa3); SBAR();
    pv_d0(o, vb0 + cur * (int)SHM_V, pa0, pa1, pa2, pa3);
    if (more) { SWAIT(); SWRITE(cur ^ 1, 0); }
    __syncthreads();
  }
  if (hi == 0) li_l[r32] = l_reg; asm volatile("s_waitcnt lgkmcnt(0)" ::: "memory");
  float rli[16];
#pragma unroll
  for (int r = 0; r < 16; ++r) rli[r] = __builtin_amdgcn_rcpf(li_l[crow(r, hi)]);
  bf16* Ow = Ob + (long)(wid * QBLK) * LDO;
#pragma unroll
  for (int r = 0; r < 16; ++r) { int orow = crow(r, hi);
    for (int d0 = 0; d0 < 4; ++d0) Ow[(long)orow * LDO + d0 * 32 + r32] = f2bf(o[d0][r] * rli[r]); }
#undef SLOAD
#undef SWRITE
#undef SWAIT
#undef RESC
}

}


constexpr int NWAVES = 8, NTHREADS = 512;
constexpr int RING_BYTES = 131072, MISC_OFF = RING_BYTES + 320, LDS_BYTES = 147456;
#define GAS __attribute__((address_space(1)))
typedef unsigned v4u __attribute__((ext_vector_type(4)));
typedef float f32x4 __attribute__((ext_vector_type(4)));
#define LDS_WAIT() asm volatile("s_waitcnt lgkmcnt(0)" ::: "memory")
typedef float f4 __attribute__((ext_vector_type(4)));
typedef unsigned u2 __attribute__((ext_vector_type(2)));
typedef unsigned u4 __attribute__((ext_vector_type(4)));
__device__ __forceinline__ float wave_sum(float v) {
#pragma unroll
  for (int o = 1; o < 64; o <<= 1) v += __shfl_xor(v, o);
  return v;
}
__device__ __forceinline__ unsigned pkbf(float lo, float hi) { return (unsigned)f2bf(lo) | ((unsigned)f2bf(hi) << 16); }

constexpr int MOD_KS = 16, MOD_CG = 16, MOD_COLS = 384;
__device__ __forceinline__ void f_mod_partial(const Pm& p, int tidb) {
  const int N6 = 6 * 1024;
  for (int u = blockIdx.x; u < MOD_KS * MOD_CG; u += gridDim.x) { const int ks = u / MOD_CG, cg = u % MOD_CG;
    if (tidb < MOD_COLS) { const int n = cg * MOD_COLS + tidb; float a0 = 0.f, a1 = 0.f, a2 = 0.f;
      for (int k = ks * 64; k < ks * 64 + 64; ++k) { const float w = p.mod_w[(size_t)k * N6 + n]; const float c0 = p.c[k], c1 = p.c[1024 + k], c2 = p.c_ctx[k];
        a0 += c0 * sigmoidf_(c0) * w; a1 += c1 * sigmoidf_(c1) * w; a2 += c2 * sigmoidf_(c2) * w; }
      float* o = p.modp + (size_t)ks * 3 * N6 + n; o[0] = a0; o[N6] = a1; o[2 * N6] = a2; } }
}
__device__ __forceinline__ void f_mod_reduce(const Pm& p, LAS float* modL, int tidb) {
  const int N6 = 6 * 1024;
  for (int i = tidb; i < 3 * 2048; i += NTHREADS) { const int v = i / 2048, n = i % 2048; float a = p.mod_b[n];
#pragma unroll
    for (int ks = 0; ks < MOD_KS; ++ks) a += p.modp[((size_t)ks * 3 + v) * N6 + n];
    modL[i] = a; }
  const int per = (3 * N6 + gridDim.x - 1) / gridDim.x;
  for (int i = blockIdx.x * per + tidb; i < (int)(blockIdx.x + 1) * per && i < 3 * N6; i += NTHREADS) { const int v = i / N6, n = i % N6; float a = p.mod_b[n];
#pragma unroll
    for (int ks = 0; ks < MOD_KS; ++ks) a += p.modp[((size_t)ks * 3 + v) * N6 + n];
    p.modv[i] = a; }
  __syncthreads();
}
__device__ __forceinline__ void f_norm1(const Pm& p, const LAS float* modL, int gw, int ngw, int lane) {
  constexpr Dm d = DMC;
  for (int row = gw; row < d.NR; row += ngw) {
    const float* src = row < d.BT ? p.x + (size_t)row * 1024 : p.ctx + (size_t)(row - d.BT) * 1024; const int v = row < d.BT ? row / d.T : 2;
    f4 xv[4]; float ss = 0.f;
#pragma unroll
    for (int j = 0; j < 4; ++j) { xv[j] = *(const f4*)(src + 4 * lane + 256 * j); ss += xv[j].x * xv[j].x + xv[j].y * xv[j].y + xv[j].z * xv[j].z + xv[j].w * xv[j].w; }
    const float rs = 1.f / sqrtf(wave_sum(ss) * (1.f / 1024.f) + 1e-6f);
#pragma unroll
    for (int j = 0; j < 4; ++j) { const int k = 4 * lane + 256 * j; const f4 g = *(const f4*)(p.norm1_g + k); const LAS float* sh = modL + v * 2048 + k; const LAS float* sc = sh + 1024;
      const float o0 = xv[j].x * rs * g.x * (1.f + sc[0]) + sh[0], o1 = xv[j].y * rs * g.y * (1.f + sc[1]) + sh[1], o2 = xv[j].z * rs * g.z * (1.f + sc[2]) + sh[2], o3 = xv[j].w * rs * g.w * (1.f + sc[3]) + sh[3];
      u2 w; w.x = pkbf(o0, o1); w.y = pkbf(o2, o3); *(u2*)(p.A1 + (size_t)row * 1024 + k) = w; }
  }
}
__device__ __forceinline__ void f_rope_table(const Pm& p, long tid, long nth) {
  for (long i = tid; i < (long)8192 * 32; i += nth) { const int t = (int)(i >> 5), q = (int)(i & 31), a = q >> 4, f = q & 15;
    const float freq = expf(-(float)f * (1.f / 16.f) * 9.210340371976184f), pos = a == 0 ? (float)(t >> 6) : (float)(t & 63), ang = pos * freq;
    p.ropet[2 * i] = cosf(ang); p.ropet[2 * i + 1] = sinf(ang); }
}
__device__ __forceinline__ void f_mla_a(const Pm& p, int gw, int ngw, int lane) {
  constexpr Dm d = DMC; const int NK = d.C + d.T;
  for (int row = gw; row < d.NR; row += ngw) {
    const float* pm = p.P + (size_t)row * d.IN + d.RC; int t, len, b, ic; row_pos(d, row, t, len, b, ic);
    const f4 q = *(const f4*)(pm + 4 * lane); const float c0 = pm[256 + 2 * lane], c1 = pm[256 + 2 * lane + 1]; const float kr = pm[384 + lane];
    const float qs = wave_sum(q.x * q.x + q.y * q.y + q.z * q.z + q.w * q.w), cs2 = wave_sum(c0 * c0 + c1 * c1);
    if (!ic) { const float rs = 1.f / sqrtf(qs * (1.f / 256.f) + 1e-6f); const f4 g = *(const f4*)(p.q_norm + 4 * lane);
      u2 w; w.x = pkbf(q.x * rs * g.x, q.y * rs * g.y); w.y = pkbf(q.z * rs * g.z, q.w * rs * g.w); *(u2*)(p.QN + (size_t)row * 256 + 4 * lane) = w; }
    { const float rs = 1.f / sqrtf(cs2 * (1.f / 128.f) + 1e-6f); *(unsigned*)(p.CN + (size_t)row * 128 + 2 * lane) = pkbf(c0 * rs * p.kv_norm[2 * lane], c1 * rs * p.kv_norm[2 * lane + 1]); }
    const float partner = __shfl_xor(kr, 16); float cs = 1.f, sn = 0.f;
    if (!ic) { const float* ct = p.ropet + ((size_t)t * 32 + (lane >> 5) * 16 + (lane & 15)) * 2; cs = ct[0]; sn = ct[1]; }
    const float o = (lane & 16) ? kr * cs + partner * sn : kr * cs - partner * sn; const bf16_t ob = f2bf(o); const int key = ic ? t : d.C + t;
#pragma unroll
    for (int h = 0; h < 4; ++h) p.K[((size_t)(b * 4 + h) * NK + key) * 192 + 128 + lane] = ob;
  }
}
__device__ __forceinline__ void f_readout(const Pm& p, int gw, int ngw, int lane) {
  constexpr Dm d = DMC; const size_t NRW = (size_t)d.NR * 512, BTW = (size_t)d.BT * 512;
  for (int row = gw; row < d.BT; row += ngw) { const size_t o = (size_t)row * 512 + 8 * lane;
    float ov[8], rv[8], kv[8], vv[8], gv[8];
#pragma unroll
    for (int q = 0; q < 2; ++q) { const f4 a = *(const f4*)(p.O2 + o + 4 * q), b2 = *(const f4*)(p.O2 + BTW + o + 4 * q), r = *(const f4*)(p.Rr + o + 4 * q), k0 = *(const f4*)(p.Kd + o + 4 * q), k1 = *(const f4*)(p.Kd + NRW + o + 4 * q),
        v = *(const f4*)(p.Vv + o + 4 * q), g = *(const f4*)(p.Gt + o + 4 * q);
#pragma unroll
      for (int e = 0; e < 4; ++e) { ov[4 * q + e] = a[e] + b2[e]; rv[4 * q + e] = r[e]; kv[4 * q + e] = k0[e] + k1[e]; vv[4 * q + e] = v[e]; gv[4 * q + e] = g[e]; } }
    float s = 0.f, bon = 0.f;
#pragma unroll
    for (int e = 0; e < 8; ++e) { s += ov[e]; bon += rv[e] * kv[e] * p.r_k[8 * lane + e]; }
#pragma unroll
    for (int m = 1; m < 8; m <<= 1) { s += __shfl_xor(s, m); bon += __shfl_xor(bon, m); }
    const float mean = s * (1.f / 64.f); float var = 0.f;
#pragma unroll
    for (int e = 0; e < 8; ++e) { const float q = ov[e] - mean; var += q * q; }
#pragma unroll
    for (int m = 1; m < 8; m <<= 1) var += __shfl_xor(var, m);
    const float rs = 1.f / sqrtf(var * (1.f / 64.f) + 64e-5f); float y[8];
#pragma unroll
    for (int e = 0; e < 8; ++e) y[e] = ((ov[e] - mean) * rs * p.ln_w[8 * lane + e] + p.ln_b[8 * lane + e] + bon * vv[e]) * gv[e];
    u4 w; w.x = pkbf(y[0], y[1]); w.y = pkbf(y[2], y[3]); w.z = pkbf(y[4], y[5]); w.w = pkbf(y[6], y[7]);
    *(u4*)(p.MIXb + (size_t)row * 1024 + 8 * lane) = w; }
}
__device__ __forceinline__ void f_final(const Pm& p, int gw, int ngw, int lane) {
  constexpr Dm d = DMC;
  for (int tok = gw; tok < d.BT; tok += ngw) { const int b = tok / d.T; const float* gt2 = p.modv + (size_t)b * 6144 + 5 * 1024; const float* xr = p.x1 + (size_t)tok * 1024;
    const f4 gq = *(const f4*)(p.gate + (size_t)tok * 4); const int4 sp = *(const int4*)(p.slot_pos + (size_t)tok * 4);
    const bf16_t* y0 = p.Yb + (size_t)sp.x * 1024; const bf16_t* y1 = p.Yb + (size_t)sp.y * 1024; const bf16_t* y2 = p.Yb + (size_t)sp.z * 1024; const bf16_t* y3 = p.Yb + (size_t)sp.w * 1024;
    f4 xv[4]; float ss = 0.f;
#pragma unroll
    for (int j = 0; j < 4; ++j) { const int k = 4 * lane + 256 * j; const f4 x = *(const f4*)(xr + k), g = *(const f4*)(gt2 + k);
      const u2 a = *(const u2*)(y0 + k), b2 = *(const u2*)(y1 + k), c = *(const u2*)(y2 + k), e = *(const u2*)(y3 + k);
#define BFLO(u) __builtin_bit_cast(float, (u) << 16)
#define BFHI(u) __builtin_bit_cast(float, (u) & 0xffff0000u)
      f4 f; f.x = gq.x * BFLO(a.x) + gq.y * BFLO(b2.x) + gq.z * BFLO(c.x) + gq.w * BFLO(e.x); f.y = gq.x * BFHI(a.x) + gq.y * BFHI(b2.x) + gq.z * BFHI(c.x) + gq.w * BFHI(e.x);
      f.z = gq.x * BFLO(a.y) + gq.y * BFLO(b2.y) + gq.z * BFLO(c.y) + gq.w * BFLO(e.y); f.w = gq.x * BFHI(a.y) + gq.y * BFHI(b2.y) + gq.z * BFHI(c.y) + gq.w * BFHI(e.y);
      xv[j] = x + g * f; ss += xv[j].x * xv[j].x + xv[j].y * xv[j].y + xv[j].z * xv[j].z + xv[j].w * xv[j].w; }
    const float rs = 1.f / sqrtf(wave_sum(ss) * (1.f / 1024.f) + 1e-6f);
#pragma unroll
    for (int j = 0; j < 4; ++j) { const int k = 4 * lane + 256 * j; const f4 fg = *(const f4*)(p.final_g + k); *(f4*)(p.out + (size_t)tok * 1024 + k) = xv[j] * rs * fg; }
  }
}

__device__ __forceinline__ void f_route(const Pm& p, LAS unsigned char* lds, int wave, int lane, int tidb) {
  constexpr Dm d = DMC; const int G = gridDim.x, TPB = (d.BT + G - 1) / G;
  LAS int* cnt_l = (LAS int*)(lds); LAS float* hrow = (LAS float*)(lds + 1024 + wave * 4096);
  if (tidb < 32) cnt_l[tidb] = 0;
  __syncthreads();
  const int t0 = blockIdx.x * TPB, t1 = (t0 + TPB < d.BT) ? t0 + TPB : d.BT;
  for (int tok = t0 + wave; tok < t1; tok += NWAVES) {
    const int b = tok / d.T; const float* xr = p.x1 + (size_t)tok * 1024; const float* sh = p.modv + (size_t)b * 6144 + 3 * 1024; const float* sc = sh + 1024;
    f4 xv[4]; float ss = 0.f;
#pragma unroll
    for (int j = 0; j < 4; ++j) { xv[j] = *(const f4*)(xr + 4 * lane + 256 * j); ss += xv[j].x * xv[j].x + xv[j].y * xv[j].y + xv[j].z * xv[j].z + xv[j].w * xv[j].w; }
    const float rs = 1.f / sqrtf(wave_sum(ss) * (1.f / 1024.f) + 1e-6f);
#pragma unroll
    for (int j = 0; j < 4; ++j) { const int k = 4 * lane + 256 * j; const f4 g = *(const f4*)(p.norm2_g + k), s4 = *(const f4*)(sh + k), c4 = *(const f4*)(sc + k);
      f4 hv; hv.x = xv[j].x * rs * g.x * (1.f + c4.x) + s4.x; hv.y = xv[j].y * rs * g.y * (1.f + c4.y) + s4.y; hv.z = xv[j].z * rs * g.z * (1.f + c4.z) + s4.z; hv.w = xv[j].w * rs * g.w * (1.f + c4.w) + s4.w;
      u2 w; w.x = pkbf(hv.x, hv.y); w.y = pkbf(hv.z, hv.w); *(u2*)(p.H2b + (size_t)tok * 1024 + k) = w; *(LAS f4*)(hrow + k) = hv; }
    asm volatile("s_waitcnt lgkmcnt(0)" ::: "memory");
    const int e = lane & 31, half = lane >> 5; const float* rw = p.router_w + (size_t)(half * 512) * 32 + e; const LAS float* hh = hrow + half * 512; float acc = 0.f;
#pragma unroll 8
    for (int k = 0; k < 512; ++k) acc += hh[k] * rw[(size_t)k * 32];
    acc += __shfl_xor(acc, 32);
    float lg = acc + p.router_b[e]; float tv[4]; int te[4];
#pragma unroll
    for (int kk = 0; kk < 4; ++kk) { float m = lg;
#pragma unroll
      for (int o = 1; o < 32; o <<= 1) m = fmaxf(m, __shfl_xor(m, o));
      const unsigned long long bal = __ballot(lg == m); const int bi = __builtin_ctzll(bal) & 31;
      tv[kk] = m; te[kk] = bi; if (e == bi) lg = -3e38f; }
    const float e1 = __expf(tv[1] - tv[0]), e2 = __expf(tv[2] - tv[0]), e3 = __expf(tv[3] - tv[0]), inv = 1.f / (1.f + e1 + e2 + e3);
    if (lane < 4) { const int me = lane == 0 ? te[0] : lane == 1 ? te[1] : lane == 2 ? te[2] : te[3]; const float mg = (lane == 0 ? 1.f : lane == 1 ? e1 : lane == 2 ? e2 : e3) * inv;
      const int rk = atomicAdd((int*)&cnt_l[me], 1);
      p.top_e[(size_t)tok * 4 + lane] = me; p.gate[(size_t)tok * 4 + lane] = mg; p.lrank[(size_t)tok * 4 + lane] = rk; }
  }
  __syncthreads();
  if (tidb < 32) p.blkcnt[(size_t)blockIdx.x * 32 + tidb] = cnt_l[tidb];
}
__device__ __forceinline__ void f_place(const Pm& p, LAS unsigned char* lds, int wave, int lane, int tidb) {
  constexpr Dm d = DMC; const int G = gridDim.x, TPB = (d.BT + G - 1) / G;
  LAS int* ps = (LAS int*)lds;
  LAS int* pb = ps + 512;
  LAS int* off = pb + 512;
  LAS int* base = off + 64;
  { const int e = tidb & 31, part = tidb >> 5; int sa = 0, sb = 0;
    for (int bb = part; bb < G; bb += 16) { const int c = __hip_atomic_load(p.blkcnt + (size_t)bb * 32 + e, __ATOMIC_RELAXED, __HIP_MEMORY_SCOPE_AGENT); sa += c; if (bb < (int)blockIdx.x) sb += c; }
    ps[part * 32 + e] = sa; pb[part * 32 + e] = sb; }
  __syncthreads();
  if (tidb < 32) { int sa = 0, sb = 0;
#pragma unroll
    for (int q = 0; q < 16; ++q) { sa += ps[q * 32 + tidb]; sb += pb[q * 32 + tidb]; }
    base[tidb] = sb; ps[tidb] = (sa + 255) / 256 * 256; }
  __syncthreads();
  if (tidb == 0) { int o = 0; for (int e = 0; e < 32; ++e) { off[e] = o; o += ps[e]; } off[32] = o; }
  __syncthreads();
  if (blockIdx.x == 0) { const int npos = off[32];
    for (int t = tidb; t < npos / 256; t += NTHREADS) { int e = 0; for (int q = 1; q < 32; ++q) if (t * 256 >= off[q]) e = q; p.tile_e[t] = e; }
    if (tidb == 0) p.npos[0] = npos; }
  const int t0 = blockIdx.x * TPB, t1 = (t0 + TPB < d.BT) ? t0 + TPB : d.BT;
  for (int tok = t0 + wave; tok < t1; tok += NWAVES) {
    const u4* src = (const u4*)(p.H2b + (size_t)tok * 1024) + lane * 2; const u4 a = src[0], b = src[1];
#pragma unroll
    for (int kk = 0; kk < 4; ++kk) { const int e = p.top_e[(size_t)tok * 4 + kk], rk = p.lrank[(size_t)tok * 4 + kk]; const int pos = off[e] + base[e] + rk;
      if (lane == 0) p.slot_pos[(size_t)tok * 4 + kk] = pos;
      u4* dst = (u4*)(p.Xg + (size_t)pos * 1024) + lane * 2; dst[0] = a; dst[1] = b; }
  }
}
__device__ __forceinline__ void f_rwkv_s1(const Pm& p, int gw, int ngw, int lane) {
  constexpr Dm d = DMC;
  for (int row = gw; row < d.NR; row += ngw) { int t, len, b, ic; row_pos(d, row, t, len, b, ic);
    const float* cur = p.P + (size_t)row * d.IN; const bool hp = t > 0, hn = t < len - 1; f4 ps[7];
#pragma unroll
    for (int j = 0; j < 7; ++j) { const int c = 4 * lane + 256 * j; const f4 x = *(const f4*)(cur + c), mu = *(const f4*)(p.mu + c); f4 pr = {0.f, 0.f, 0.f, 0.f}, nx = pr;
      if (hp) pr = *(const f4*)(cur - d.IN + c); if (hn) nx = *(const f4*)(cur + d.IN + c);
      ps[j] = x + mu * (0.5f * (pr + nx) - x); }
    const size_t o = (size_t)row * 512 + 4 * lane;
    *(f4*)(p.Rr + o) = ps[0]; *(f4*)(p.Rr + o + 256) = ps[1]; *(f4*)(p.Vv + o) = ps[4]; *(f4*)(p.Vv + o + 256) = ps[5];
#pragma unroll
    for (int j = 0; j < 2; ++j) { const f4 k = ps[2 + j]; const f4 kq = k * *(const f4*)(p.k_k + 4 * lane + 256 * j); float ss = kq.x * kq.x + kq.y * kq.y + kq.z * kq.z + kq.w * kq.w;
#pragma unroll
      for (int m = 1; m < 16; m <<= 1) ss += __shfl_xor(ss, m);
      const float inv = 1.f / sqrtf(fmaxf(ss, 1e-24f)); *(f4*)(p.Kraw + o + 256 * j) = k; *(f4*)(p.KK + o + 256 * j) = kq * inv; }
    const f4 x6 = ps[6];
    if (lane < 16) { u2 w; w.x = pkbf(tanhf(x6.x), tanhf(x6.y)); w.y = pkbf(tanhf(x6.z), tanhf(x6.w)); *(u2*)(p.AL1 + (size_t)row * 128 + 4 * lane) = w; }
    else if (lane < 32) { u2 w; w.x = pkbf(x6.x, x6.y); w.y = pkbf(x6.z, x6.w); *(u2*)(p.AL1 + (size_t)row * 128 + 4 * lane) = w; }
    else if (!ic) { u2 w; w.x = pkbf(sigmoidf_(x6.x), sigmoidf_(x6.y)); w.y = pkbf(sigmoidf_(x6.z), sigmoidf_(x6.w)); *(u2*)(p.AL2 + (size_t)row * 128 + 4 * (lane - 32)) = w; }
  }
}
__device__ __forceinline__ void f_lora_weights(const Pm& p, long tid, long nth) {
  for (long i = tid; i < (long)2048 * 128; i += nth) { const int n = (int)(i >> 7), k = (int)(i & 127); float v = 0.f;
    if (n < 1024) { if (k < 64) v = p.w2[((size_t)(n >> 9) * 64 + k) * 512 + (n & 511)]; } else { const int q = n - 1024; if (k >= 64) v = p.a2[((size_t)(q >> 9) * 64 + (k - 64)) * 512 + (q & 511)]; }
    p.WlT[i] = f2bf(v); }
  for (long i = tid; i < (long)512 * 128; i += nth) { const int n = (int)(i >> 7), k = (int)(i & 127); p.G2T[i] = f2bf(p.g2[(size_t)k * 512 + n]); }
}
__device__ __forceinline__ void f_scan_a1(const Pm& p, LAS unsigned char* lds, int wave, int lane, int gw, int ngw, int NSEG) {
  constexpr Dm d = DMC; constexpr int RW = 512, TS = 4; const int SL = (d.C + d.T) / NSEG; const size_t NRW = (size_t)d.NR * RW, BTW = (size_t)d.BT * RW;
  const int NU = 2 * d.B * d.RH * NSEG;
  LAS float* buf = (LAS float*)lds + wave * (2 * 6 * TS * 64);
  const int st_step = (lane * 4) >> 6, st_j = (lane * 4) & 63;
  for (int unit = gw; unit < NU; unit += ngw) { const int g = unit % NSEG, ch = unit / NSEG; const int h = ch % d.RH, b = (ch / d.RH) % d.B, dd = ch / (d.RH * d.B);
    const float* vecs[6] = {p.Wd + dd * NRW, p.Bb + dd * NRW, p.Kd + dd * NRW, p.KK, p.Rr, p.Vv};
    float S[64], T[64]; int lane_o = lane; asm volatile("" : "+v"(lane_o));
#pragma unroll
    for (int j = 0; j < 64; ++j) { S[j] = 0.f; T[j] = (j == lane_o) ? 1.f : 0.f; }
    const int sbeg = g * SL, send = (g + 1) * SL;
#define A1_STAGE(s_first, bufp) do { size_t row_; bool lat_; chain_step(d, dd, b, (s_first) + st_step, row_, lat_); const size_t o_ = row_ * RW + h * 64 + st_j; \
      _Pragma("unroll") for (int v = 0; v < 6; ++v) __builtin_amdgcn_global_load_lds((const unsigned*)(vecs[v] + o_), (LAS unsigned*)((bufp) + v * TS * 64), 16, 0, 0); } while (0)
    A1_STAGE(sbeg, buf);
    int cb = 0;
    for (int s0 = sbeg; s0 < send; s0 += TS) {
      LAS float* bw = buf + cb * (6 * TS * 64);
      if (s0 + TS < send) { A1_STAGE(s0 + TS, buf + (cb ^ 1) * (6 * TS * 64)); asm volatile("s_waitcnt vmcnt(6)" ::: "memory"); }
      else asm volatile("s_waitcnt vmcnt(0)" ::: "memory");
#pragma unroll 1
      for (int st = 0; st < TS; ++st) { const LAS float* w = bw + (0 * TS + st) * 64; const LAS float* bb = bw + (1 * TS + st) * 64; const LAS float* kd = bw + (2 * TS + st) * 64;
        const LAS float* kk = bw + (3 * TS + st) * 64; const LAS float* rr = bw + (4 * TS + st) * 64; const float vv = bw[(5 * TS + st) * 64 + lane];
        float sa = 0.f, ta = 0.f;
#pragma unroll
        for (int j = 0; j < 64; j += 4) { const f4 k4 = *(const LAS f4*)(kk + j); sa += S[j] * k4.x + S[j + 1] * k4.y + S[j + 2] * k4.z + S[j + 3] * k4.w; ta += T[j] * k4.x + T[j + 1] * k4.y + T[j + 2] * k4.z + T[j + 3] * k4.w; if ((j & 12) == 12) asm volatile("" ::: "memory"); }
        float oo = 0.f, zz = 0.f;
#pragma unroll
        for (int j = 0; j < 64; j += 4) { const f4 w4 = *(const LAS f4*)(w + j), b4 = *(const LAS f4*)(bb + j), d4 = *(const LAS f4*)(kd + j), r4 = *(const LAS f4*)(rr + j);
#pragma unroll
          for (int e = 0; e < 4; ++e) { S[j + e] = S[j + e] * w4[e] - sa * b4[e] + vv * d4[e]; T[j + e] = T[j + e] * w4[e] - ta * b4[e]; oo += S[j + e] * r4[e]; zz += T[j + e] * r4[e]; } if (j & 4) asm volatile("" ::: "memory"); }
        size_t row; bool lat; chain_step(d, dd, b, s0 + st, row, lat);
        if (lat) { const size_t o = dd * BTW + row * RW + h * 64 + lane; p.O2[o] = oo; p.Zt[o] = zz; } }
      cb ^= 1;
    }
#undef A1_STAGE
    float* fe = p.Fend + (((size_t)ch * NSEG + g) * 128 + lane) * 64;
#pragma unroll
    for (int j = 0; j < 64; j += 4) { *(f4*)(fe + j) = (f4){S[j], S[j + 1], S[j + 2], S[j + 3]}; *(f4*)(fe + 64 * 64 + j) = (f4){T[j], T[j + 1], T[j + 2], T[j + 3]}; }
  }
}


template <class F> struct EpiFn {
  static constexpr bool PERM = true, AFTER_DRAIN = false; F f;
  __device__ __forceinline__ void operator()(const pg8::f32x4 (&acc)[2][2][4][2], const pg8::Unit& u, int wr, int wc, int fr, int fq) const {
#pragma unroll
    for (int ai = 0; ai < 2; ++ai)
#pragma unroll
      for (int m = 0; m < 4; ++m) { const int row = u.pm * 256 + ai * 128 + wr * 64 + m * 16 + fr;
#pragma unroll
        for (int bj = 0; bj < 2; ++bj) { const int col = u.pn * 256 + bj * 128 + wc * 32 + 8 * fq; f(u, row, col, acc[ai][bj][m][0], acc[ai][bj][m][1]); asm volatile("" ::: "memory"); } }
  }
};
template <class F> __device__ __forceinline__ void run_gemm(LAS unsigned char* lds, const bf16_t* A, const bf16_t* Bt, int M, int N, int K, F f, const int tid_in, const int* tile_e = nullptr, size_t bexp = 0) {
  asm volatile("" : "+s"(M), "+s"(N), "+s"(K));
  pg8::Gemm g{A, Bt, M, N, K, bexp}; pg8::StaticOrder S; S.init(M, N, (int)gridDim.x, (int)blockIdx.x, tile_e);
  EpiFn<F> E{f};
  pg8::gemm_phase<EpiFn<F>, pg8::StaticOrder, true, true>((PG8_LAS unsigned char*)lds, g, S, E, tid_in);
}

__device__ __forceinline__ unsigned pk2(float lo, float hi) { return (unsigned)f2bf(lo) | ((unsigned)f2bf(hi) << 16); }
__device__ __forceinline__ void transpose_all(const float* W, int K, int N, bf16_t* WT, int gw, int ngw, int lane) {
  const int nblk = N / 64, items = (K / 64) * nblk;
  for (int it = gw; it < items; it += ngw) { const int kb = it / nblk, nb = it % nblk; const float* src = W + (size_t)(kb * 64) * N + nb * 64 + lane; float x[64];
#pragma unroll
    for (int j = 0; j < 64; ++j) x[j] = src[(size_t)j * N];
    bf16_t* dst = WT + (size_t)(nb * 64 + lane) * K + kb * 64;
#pragma unroll
    for (int c = 0; c < 8; ++c) { v4u o; o.x = pk2(x[8 * c], x[8 * c + 1]); o.y = pk2(x[8 * c + 2], x[8 * c + 3]); o.z = pk2(x[8 * c + 4], x[8 * c + 5]); o.w = pk2(x[8 * c + 6], x[8 * c + 7]); *(v4u*)(dst + 8 * c) = o; } }
}

constexpr int INP = 2304;

__global__ void __launch_bounds__(NTHREADS, 2) fwd(Pm p, unsigned* bar) {
  extern __shared__ __attribute__((aligned(16))) unsigned char lds_raw[];
  LAS unsigned char* lds = (LAS unsigned char*)lds_raw;
#define IDS() int tidb; asm volatile("v_mbcnt_lo_u32_b32 %0, -1, 0\n\tv_mbcnt_hi_u32_b32 %0, -1, %0" : "=v"(tidb)); tidb += wave_s * 64; const int lane = tidb & 63, wave = __builtin_amdgcn_readfirstlane(tidb >> 6); \
    const long tid = (long)blockIdx.x * NTHREADS + tidb, nth = (long)gridDim.x * NTHREADS; const int gw = blockIdx.x * NWAVES + wave, ngw = gridDim.x * NWAVES; \
    (void)lane; (void)wave; (void)tid; (void)nth; (void)gw; (void)ngw
  for (int u = threadIdx.x; u < (LDS_BYTES - RING_BYTES) / 4; u += NTHREADS) ((LAS unsigned*)(lds + RING_BYTES))[u] = 0u;
  __syncthreads();
  const int wave_s = __builtin_amdgcn_readfirstlane((int)threadIdx.x >> 6);
  XcdBarrier xb = xcd_barrier_post(bar, (volatile LAS unsigned*)(lds + MISC_OFF + 32));
  constexpr Dm d = DMC;
#define GSYNC() xcd_barrier(xb)
  constexpr int NSEG = 64;
#define NPOS() __builtin_amdgcn_readfirstlane(__hip_atomic_load(p.npos, __ATOMIC_RELAXED, __HIP_MEMORY_SCOPE_AGENT))
  {
  IDS();
  f_mod_partial(p, tidb); f_rope_table(p, tid, nth); f_lora_weights(p, tid, nth);
  transpose_all(p.w_in, d.D, d.IN, p.WinT, gw, ngw, lane);
  for (long i = tid; i < (long)(INP - d.IN) * d.D; i += nth) p.WinT[(size_t)d.IN * d.D + i] = 0;
  transpose_all(p.w_uq, d.QL, d.MH * d.QK, p.WuqT, gw, ngw, lane);
  transpose_all(p.w_ukv, d.KL, d.MH * (d.DN + d.DV), p.WukvT, gw, ngw, lane);
  transpose_all(p.w_out, d.MIX, d.D, p.WoutT, gw, ngw, lane);
  for (int it = gw; it < d.NE * 768; it += ngw) { const int e = it / 768, r = it % 768; const bool first = r < 512; const int rr = first ? r : r - 512; const int N = first ? 2048 : 1024, nblk = N / 64, kb = rr / nblk, nb = rr % nblk;
    const float* src = (first ? p.exp_w1 + (size_t)e * 1024 * 2048 : p.exp_w2 + (size_t)e * 1024 * 1024) + (size_t)(kb * 64) * N + nb * 64 + lane; float x[64];
#pragma unroll
    for (int j = 0; j < 64; ++j) x[j] = src[(size_t)j * N];
    bf16_t* dst = (first ? p.W1T + (size_t)e * 2048 * 1024 : p.W2T + (size_t)e * 1024 * 1024) + (size_t)(nb * 64 + lane) * 1024 + kb * 64;
#pragma unroll
    for (int c = 0; c < 8; ++c) { v4u o; o.x = pk2(x[8 * c], x[8 * c + 1]); o.y = pk2(x[8 * c + 2], x[8 * c + 3]); o.z = pk2(x[8 * c + 4], x[8 * c + 5]); o.w = pk2(x[8 * c + 6], x[8 * c + 7]); *(v4u*)(dst + 8 * c) = o; } }
    }
  GSYNC();
  {
  IDS();

  f_mod_reduce(p, (LAS float*)lds, tidb); f_norm1(p, (const LAS float*)lds, gw, ngw, lane);   }
  GSYNC();
  {
  IDS();

  { float* P = p.P; const int IN = d.IN;
    run_gemm(lds, p.A1, p.WinT, d.NR, INP, d.D, [=](const pg8::Unit& u, int row, int col, pg8::f32x4 v0, pg8::f32x4 v1) {
      if (col < IN) { float* o = P + (size_t)row * IN + col; *(pg8::f32x4*)o = v0; *(pg8::f32x4*)(o + 4) = v1; } }, tidb); }
    }
  GSYNC();
  {
  IDS();

  f_mla_a(p, gw, ngw, lane); f_rwkv_s1(p, gw, ngw, lane);   }
  GSYNC();
  {
  IDS();

  { bf16_t* Q = p.Q; const float* ropet = p.ropet;
    run_gemm(lds, p.QN, p.WuqT, d.BT, 768, 256, [=](const pg8::Unit& u, int row, int col, pg8::f32x4 v0, pg8::f32x4 v1) {
      const int h = col / 192, i0 = col - h * 192, b = row >> 13, t = row & 8191;
      float x[8] = {v0[0], v0[1], v0[2], v0[3], v1[0], v1[1], v1[2], v1[3]}, pr[8];
#pragma unroll
      for (int e = 0; e < 8; ++e) pr[e] = __shfl_xor(x[e], 32);
      if (i0 >= 128) { const int i = i0 - 128, a = i >> 5, half = (i >> 4) & 1, f0 = i & 15; const float* ct = ropet + ((size_t)t * 32 + a * 16 + f0) * 2;
#pragma unroll
        for (int e = 0; e < 8; ++e) { const float c = ct[2 * e], s = ct[2 * e + 1]; x[e] = half ? x[e] * c + pr[e] * s : x[e] * c - pr[e] * s; } }
      v4u w; w.x = pk2(x[0], x[1]); w.y = pk2(x[2], x[3]); w.z = pk2(x[4], x[5]); w.w = pk2(x[6], x[7]);
      *(v4u*)(Q + ((size_t)(b * 4 + h) * 8192 + t) * 192 + i0) = w; }, tidb); }
  { bf16_t* K = p.K; bf16_t* V = p.V; const int BT = d.BT;
    run_gemm(lds, p.CN, p.WukvT, d.NR, 1024, 128, [=](const pg8::Unit& u, int row, int col, pg8::f32x4 v0, pg8::f32x4 v1) {
      const int h = col >> 8, i0 = col & 255; int b, key; if (row < BT) { b = row >> 13; key = 256 + (row & 8191); } else { b = (row - BT) >> 8; key = (row - BT) & 255; }
      v4u w; w.x = pk2(v0[0], v0[1]); w.y = pk2(v0[2], v0[3]); w.z = pk2(v1[0], v1[1]); w.w = pk2(v1[2], v1[3]);
      const size_t kr = (size_t)(b * 4 + h) * 8448 + key;
      if (i0 < 128) *(v4u*)(K + kr * 192 + i0) = w; else *(v4u*)(V + kr * 128 + (i0 - 128)) = w; }, tidb); }
  { float* Wd = p.Wd; float* Bb = p.Bb; float* Kd = p.Kd; const float* KK = p.KK; const float* Kraw = p.Kraw; const float* w0 = p.w0; const float* a0 = p.a0; const float* k_a = p.k_a; const size_t NRW = (size_t)d.NR * 512;
    run_gemm(lds, p.AL1, p.WlT, d.NR, 2048, 128, [=](const pg8::Unit& u, int row, int col, pg8::f32x4 v0, pg8::f32x4 v1) {
      float x[8] = {v0[0], v0[1], v0[2], v0[3], v1[0], v1[1], v1[2], v1[3]};
      if (col < 1024) { const int dd = col >> 9, c = col & 511; const float* wb = w0 + dd * 512 + c; float o[8];
#pragma unroll
        for (int e = 0; e < 8; ++e) o[e] = __expf(-0.60653065971263342f / (1.f + __expf(-(x[e] + wb[e]))));
        float* dst = Wd + (size_t)dd * NRW + (size_t)row * 512 + c; *(pg8::f32x4*)dst = (pg8::f32x4){o[0], o[1], o[2], o[3]}; *(pg8::f32x4*)(dst + 4) = (pg8::f32x4){o[4], o[5], o[6], o[7]}; }
      else { const int q = col - 1024, dd = q >> 9, c = q & 511; const float* ab = a0 + dd * 512 + c; const float* kkp = KK + (size_t)row * 512 + c; const float* kp = Kraw + (size_t)row * 512 + c; float ob[8], ok[8];
#pragma unroll
        for (int e = 0; e < 8; ++e) { const float a = 1.f / (1.f + __expf(-(x[e] + ab[e]))); ob[e] = kkp[e] * a; ok[e] = kp[e] * (1.f + (a - 1.f) * k_a[c + e]); }
        float* d1 = Bb + (size_t)dd * NRW + (size_t)row * 512 + c; float* d2 = Kd + (size_t)dd * NRW + (size_t)row * 512 + c;
        *(pg8::f32x4*)d1 = (pg8::f32x4){ob[0], ob[1], ob[2], ob[3]}; *(pg8::f32x4*)(d1 + 4) = (pg8::f32x4){ob[4], ob[5], ob[6], ob[7]};
        *(pg8::f32x4*)d2 = (pg8::f32x4){ok[0], ok[1], ok[2], ok[3]}; *(pg8::f32x4*)(d2 + 4) = (pg8::f32x4){ok[4], ok[5], ok[6], ok[7]}; } }, tidb); }
  { float* Gt = p.Gt;
    run_gemm(lds, p.AL2, p.G2T, d.BT, 512, 128, [=](const pg8::Unit& u, int row, int col, pg8::f32x4 v0, pg8::f32x4 v1) { float* o = Gt + (size_t)row * 512 + col; *(pg8::f32x4*)o = v0; *(pg8::f32x4*)(o + 4) = v1; }, tidb); }
    }
  GSYNC();
  {
  IDS();

  f_scan_a1(p, lds, wave, lane, gw, ngw, NSEG);   }
  GSYNC();
  {
  IDS();
  ph_scan_a2(p, gw, ngw, lane, NSEG);   }
  GSYNC();
  {
  IDS();

  ph_scan_a3(p, gw, ngw, lane, NSEG);
  for (int u = blockIdx.x; u < d.B * d.MH * (d.T / 256); u += gridDim.x) { const int bh = u % (d.B * d.MH), qb = u / (d.B * d.MH), b = bh / d.MH, h = bh % d.MH; const int NK = d.C + d.T;
    attn::attn_dense_body(p.Q + ((size_t)bh * d.T + (size_t)qb * 256) * attn::DQK, p.K + (size_t)bh * NK * attn::DQK, p.V + (size_t)bh * NK * attn::DV,
                          p.MIXb + ((size_t)b * d.T + (size_t)qb * 256) * d.MIX + d.RW + h * attn::DV, NK, (char*)lds_raw, tidb); }
    }
  GSYNC();
  {
  IDS();

  f_readout(p, gw, ngw, lane);   }
  GSYNC();
  {
  IDS();

  { float* x1 = p.x1; const float* x = p.x; const float* modv = p.modv; const int D = d.D, T = d.T;
    run_gemm(lds, p.MIXb, p.WoutT, d.BT, D, d.MIX, [=](const pg8::Unit& u, int row, int col, pg8::f32x4 v0, pg8::f32x4 v1) {
      const float* g = modv + (size_t)(row / T) * 6 * D + 2 * D + col; const float* xr = x + (size_t)row * D + col; float* o = x1 + (size_t)row * D + col;
      const pg8::f32x4 g0 = *(const pg8::f32x4*)g, g1 = *(const pg8::f32x4*)(g + 4), x0 = *(const pg8::f32x4*)xr, x1v = *(const pg8::f32x4*)(xr + 4);
      *(pg8::f32x4*)o = x0 + g0 * v0; *(pg8::f32x4*)(o + 4) = x1v + g1 * v1; }, tidb); }
    }
  GSYNC();
  {
  IDS();

  f_route(p, lds, wave, lane, tidb);
  }
  GSYNC();
  {
  IDS();
  f_place(p, lds, wave, lane, tidb);
  }
  GSYNC();
  {
  IDS();
  const int npos = NPOS();
  { bf16_t* ACT = p.ACTb; const float* b1 = p.exp_b1; const int DE = d.DE;
    run_gemm(lds, p.Xg, p.W1T, npos, 2 * d.DE, d.D, [=](const pg8::Unit& u, int row, int col, pg8::f32x4 v0, pg8::f32x4 v1) {
      const float* bb = b1 + (size_t)u.eb * 2 * DE + col; const pg8::f32x4 c0 = *(const pg8::f32x4*)bb, c1 = *(const pg8::f32x4*)(bb + 4);
      v0 = v0 + c0; v1 = v1 + c1; float o[4];
#pragma unroll
      for (int q = 0; q < 4; ++q) { const float gl = fminf(q < 2 ? v0[2 * q] : v1[2 * q - 4], 7.f), li = fminf(fmaxf(q < 2 ? v0[2 * q + 1] : v1[2 * q - 3], -7.f), 7.f);
        o[q] = gl * (li + 1.f) / (1.f + __expf(-1.702f * gl)); }
      uint2 w; w.x = pk2(o[0], o[1]); w.y = pk2(o[2], o[3]); *(uint2*)(ACT + (size_t)row * DE + (col >> 1)) = w; }, tidb, p.tile_e, (size_t)2 * d.DE * d.D * 2); }
    }
  GSYNC();
  {
  IDS();

  const int npos = NPOS();
  { bf16_t* Y = p.Yb; const float* b2 = p.exp_b2; const int D = d.D;
    run_gemm(lds, p.ACTb, p.W2T, npos, d.D, d.DE, [=](const pg8::Unit& u, int row, int col, pg8::f32x4 v0, pg8::f32x4 v1) {
      const float* bb = b2 + (size_t)u.eb * D + col; const pg8::f32x4 c0 = *(const pg8::f32x4*)bb, c1 = *(const pg8::f32x4*)(bb + 4);
      v0 = v0 + c0; v1 = v1 + c1; v4u w; w.x = pk2(v0[0], v0[1]); w.y = pk2(v0[2], v0[3]); w.z = pk2(v1[0], v1[1]); w.w = pk2(v1[2], v1[3]);
      *(v4u*)(Y + (size_t)row * D + col) = w; }, tidb, p.tile_e, (size_t)d.D * d.DE * 2); }
    }
  GSYNC();
  {
  IDS();

  f_final(p, gw, ngw, lane);
  }
}

static size_t carve(Pm& p, char* base) {
  const Dm& d = p.d; size_t off = 0;
#define CARVE(ptr, type, count) do { p.ptr = (type*)(base + off); off += (((size_t)(count) * sizeof(type)) + 255) / 256 * 256; } while (0)
  const size_t NRW = (size_t)d.NR * d.RW; const int NK = d.C + d.T;
  CARVE(modv, float, (size_t)(d.B + 1) * 6 * d.D); CARVE(modp, float, (size_t)16 * 3 * 6 * d.D); CARVE(ropet, float, (size_t)d.T * 64);
  CARVE(top_e, int, (size_t)d.BT * 4); CARVE(cnt, int, d.NE); CARVE(slot_pos, int, (size_t)d.BT * 4); CARVE(pos_tok, int, d.NPOSMAX); CARVE(tile_e, int, d.NPOSMAX / d.PADR + 1); CARVE(npos, int, 4);
  CARVE(gate, float, (size_t)d.BT * 4); CARVE(lrank, int, (size_t)d.BT * 4); CARVE(blkcnt, int, 1024 * 32);
  CARVE(WlT, bf16_t, (size_t)2048 * 128); CARVE(G2T, bf16_t, (size_t)512 * 128);
  CARVE(WinT, bf16_t, (size_t)INP * d.D); CARVE(WuqT, bf16_t, (size_t)d.MH * d.QK * d.QL); CARVE(WukvT, bf16_t, (size_t)d.MH * (d.DN + d.DV) * d.KL); CARVE(WoutT, bf16_t, (size_t)d.D * d.MIX);
  CARVE(W1T, bf16_t, (size_t)d.NE * 2 * d.DE * d.D); CARVE(W2T, bf16_t, (size_t)d.NE * d.D * d.DE);
  const size_t early0 = off;
  CARVE(P, float, (size_t)d.NR * d.IN); CARVE(A1, bf16_t, (size_t)d.NR * d.D);
  const size_t after_p = off;
  CARVE(Kraw, float, NRW); CARVE(AL1, bf16_t, (size_t)d.NR * 128); CARVE(AL2, bf16_t, (size_t)d.BT * 128); CARVE(Rr, float, NRW); CARVE(Vv, float, NRW); CARVE(KK, float, NRW); CARVE(Kd, float, 2 * NRW); CARVE(Wd, float, 2 * NRW); CARVE(Bb, float, 2 * NRW);
  CARVE(Gt, float, (size_t)d.BT * d.RW); CARVE(QN, bf16_t, (size_t)d.BT * d.QL); CARVE(CN, bf16_t, (size_t)d.NR * d.KL);
  CARVE(O2, float, (size_t)2 * d.BT * d.RW);
  CARVE(Q, bf16_t, (size_t)d.B * d.MH * d.T * d.QK); CARVE(K, bf16_t, (size_t)d.B * d.MH * NK * d.QK); CARVE(V, bf16_t, (size_t)d.B * d.MH * NK * d.DV);
  CARVE(MIXb, bf16_t, (size_t)d.BT * d.MIX);
  size_t end1 = off;
  off = early0; CARVE(Zt, float, (size_t)2 * d.BT * d.RW); CARVE(Fend, float, (size_t)2 * d.B * d.RH * 64 * 128 * 64); CARVE(Sst, float, (size_t)2 * d.B * d.RH * 64 * 64 * 64);
  if (off > after_p) return (size_t)-1;
  off = early0; CARVE(x1, float, (size_t)d.BT * d.D); CARVE(H2b, bf16_t, (size_t)d.BT * d.D);
  if (off > after_p) return (size_t)-1;
  off = after_p; CARVE(Xg, bf16_t, (size_t)d.NPOSMAX * d.D); CARVE(ACTb, bf16_t, (size_t)d.NPOSMAX * d.DE); CARVE(Yb, bf16_t, (size_t)d.NPOSMAX * d.D);
  if (off > end1) end1 = off;
#undef CARVE
  return end1;
}

extern "C" void kernel_launch(void* const* d_in, const int* in_sizes, int n_in, void* d_out, int out_size, void* d_ws, size_t ws_size, hipStream_t stream) {
  static int grid = 0;
  if (!grid) {
    int dev = 0, cus = 0;
    hipGetDevice(&dev); hipDeviceGetAttribute(&cus, hipDeviceAttributeMultiprocessorCount, dev);
    if (hipFuncSetAttribute((const void*)fwd, hipFuncAttributeMaxDynamicSharedMemorySize, LDS_BYTES) != hipSuccess) { fprintf(stderr, "kernel_launch: hipFuncSetAttribute failed\n"); grid = -1; return; }
    grid = cus;
  }
  if (grid < 0) return;
  Pm p; memset(&p, 0, sizeof(p));
  Dm& d = p.d; d.D = 1024; d.B = 2; d.T = 8192; d.GW = 64; d.C = 256; d.RH = 8; d.LW = 64; d.LA = 64; d.LG = 128; d.MH = 4; d.DN = 128; d.DR = 64; d.DV = 128; d.QL = 256; d.KL = 128;
  d.NE = 32; d.DE = 1024; d.PADR = 256; dm_finish(d);
  const float** ip = &p.x; for (int i = 0; i < 32; ++i) ip[i] = (const float*)d_in[i];
  p.out = (float*)d_out;
  unsigned* bar = (unsigned*)d_ws;
  const size_t used = carve(p, (char*)d_ws + 16384);
  if (used == (size_t)-1 || used + 16384 > ws_size) { fprintf(stderr, "kernel_launch: workspace too small (%zu needed, %zu given)\n", used + 16384, ws_size); return; }
  static bool once = false; if (!once) { once = true; fprintf(stderr, "ws used %zu of %zu\n", used + 16384, ws_size); }
  hipMemsetAsync(bar, 0, 16384, stream);
  hipLaunchKernelGGL(fwd, dim3(grid), dim3(NTHREADS), LDS_BYTES, stream, p, bar);
}
```

```cpp
#include <hip/hip_runtime.h>
#include <cstdio>
#include <cstring>
#include <cstdint>
#define HD __host__ __device__
#ifndef HD
#define HD
#endif
struct Dm {
  int D, B, T, GW, C, RH, LW, LA, LG, MH, DN, DR, DV, QL, KL, NE, DE;
  int RW, RC, QK, MC, IN, MIX, NF, BT, BC, NR, PADR, NPOSMAX, pad_;
};
HD constexpr void dm_finish(Dm& d) {
  d.RW = d.RH * 64; d.RC = 3 * d.RW + d.LW + d.LA + d.LG; d.QK = d.DN + d.DR; d.MC = d.QL + d.KL + d.DR; d.IN = d.RC + d.MC;
  d.MIX = d.RW + d.MH * d.DV; d.NF = d.DR / 4; d.BT = d.B * d.T; d.BC = d.B * d.C; d.NR = d.BT + d.BC;
  d.NPOSMAX = d.BT * 4 + d.NE * d.PADR;
}
typedef unsigned short bf16_t;
HD inline bf16_t f2bf(float f) { unsigned u = __builtin_bit_cast(unsigned, f); return (bf16_t)((u + 0x7fffu + ((u >> 16) & 1u)) >> 16); }
HD inline float bf2f(bf16_t h) { return __builtin_bit_cast(float, (unsigned)h << 16); }
HD constexpr Dm make_dmc() { Dm d{}; d.D = 1024; d.B = 2; d.T = 8192; d.GW = 64; d.C = 256; d.RH = 8; d.LW = 64; d.LA = 64; d.LG = 128; d.MH = 4; d.DN = 128; d.DR = 64; d.DV = 128; d.QL = 256; d.KL = 128;
  d.NE = 32; d.DE = 1024; d.PADR = 256; dm_finish(d); return d; }
constexpr Dm DMC = make_dmc();
typedef float f4q __attribute__((ext_vector_type(4)));
struct Pm {
  Dm d; int reps[24];
  const float *x, *c, *ctx, *c_ctx, *mod_w, *mod_b, *norm1_g, *w_in, *mu, *w0, *w2, *a0, *a2, *k_k, *k_a, *r_k, *g2, *ln_w, *ln_b, *q_norm, *w_uq, *kv_norm,
      *w_ukv, *w_out, *norm2_g, *router_w, *router_b, *exp_w1, *exp_b1, *exp_w2, *exp_b2, *final_g;
  float* out;
  float *modv, *modp, *ropet, *Kraw, *Gt, *O2, *Zt, *Fend, *Sst, *x1, *gate;
  bf16_t *A1, *QN, *CN, *MIXb, *WinT, *WuqT, *WukvT, *WoutT, *W1T, *W2T, *H2b, *Xg, *ACTb, *Yb, *Q, *K, *V, *AL1, *AL2, *WlT, *G2T, *P, *Rr, *Vv, *KK, *Kd, *Wd, *Bb;
  int *top_e, *cnt, *slot_pos, *pos_tok, *tile_e, *npos, *lrank, *blkcnt;
};
HD inline float sigmoidf_(float x) { return 1.f / (1.f + expf(-x)); }

template <int TM, class Epi>
HD inline void gemm_naive(const float* A, int lda, const float* Bm, int ldb, int M, int N, int K, long tid, long nth, Epi epi) {
  const long ngm = (M + TM - 1) / TM, items = ngm * N;
  for (long it = tid; it < items; it += nth) {
    const int n = (int)(it % N); const long m0 = (it / N) * TM;
    float acc[TM];
#pragma unroll
    for (int i = 0; i < TM; ++i) acc[i] = 0.f;
    const float* a[TM];
#pragma unroll
    for (int i = 0; i < TM; ++i) a[i] = A + (size_t)((m0 + i < M) ? (m0 + i) : (M - 1)) * lda;
    for (int k = 0; k < K; k += 4) {
      const float b0 = Bm[(size_t)k * ldb + n], b1 = Bm[(size_t)(k + 1) * ldb + n], b2 = Bm[(size_t)(k + 2) * ldb + n], b3 = Bm[(size_t)(k + 3) * ldb + n];
#pragma unroll
      for (int i = 0; i < TM; ++i) { acc[i] += a[i][k] * b0; acc[i] += a[i][k + 1] * b1; acc[i] += a[i][k + 2] * b2; acc[i] += a[i][k + 3] * b3; }
    }
#pragma unroll
    for (int i = 0; i < TM; ++i) if (m0 + i < M) epi(m0 + i, n, acc[i]);
  }
}

HD inline void row_pos(const Dm& d, long row, int& t, int& len, int& b, int& isctx) {
  if (row < d.BT) { b = (int)(row / d.T); t = (int)(row % d.T); len = d.T; isctx = 0; } else { const long r = row - d.BT; b = (int)(r / d.C); t = (int)(r % d.C); len = d.C; isctx = 1; }
}

HD inline void chain_step(const Dm& d, int dd, int b, int sg, size_t& row, bool& lat) {
  if (sg < d.C) { const int t = dd == 0 ? sg : d.C - 1 - sg; row = (size_t)d.BT + (size_t)b * d.C + t; lat = false; }
  else { const int s = sg - d.C; const int t = dd == 0 ? s : d.T - 1 - s; row = (size_t)b * d.T + t; lat = true; }
}
__device__ inline void ph_scan_a2(const Pm& p, int gw, int ngw, int lane, int NSEG) {
  constexpr Dm d = DMC; const int items = 2 * d.B * d.RH * 64;
  for (int it = gw; it < items; it += ngw) { const int v = it % 64, ch = it / 64; float S = 0.f; float pf[64], pn[64]; float sl, sln;
    { const float* fe = p.Fend + ((size_t)ch * NSEG) * 128 * 64; sl = fe[(size_t)v * 64 + lane];
#pragma unroll
      for (int i = 0; i < 64; ++i) pf[i] = fe[(size_t)(64 + i) * 64 + lane]; }
    for (int g = 0; g < NSEG; ++g) { p.Sst[(((size_t)ch * NSEG + g) * 64 + v) * 64 + lane] = S;
      const int gn = g + 1 < NSEG ? g + 1 : g; const float* fe = p.Fend + ((size_t)ch * NSEG + gn) * 128 * 64; sln = fe[(size_t)v * 64 + lane];
#pragma unroll
      for (int i = 0; i < 64; ++i) pn[i] = fe[(size_t)(64 + i) * 64 + lane];
      float a0 = sl, a1 = 0.f, a2 = 0.f, a3 = 0.f;
#pragma unroll
      for (int i = 0; i < 64; i += 4) { const int Sb = __builtin_bit_cast(int, S);
        a0 += __builtin_bit_cast(float, __builtin_amdgcn_readlane(Sb, i)) * pf[i]; a1 += __builtin_bit_cast(float, __builtin_amdgcn_readlane(Sb, i + 1)) * pf[i + 1];
        a2 += __builtin_bit_cast(float, __builtin_amdgcn_readlane(Sb, i + 2)) * pf[i + 2]; a3 += __builtin_bit_cast(float, __builtin_amdgcn_readlane(Sb, i + 3)) * pf[i + 3]; }
      S = (a0 + a1) + (a2 + a3); sl = sln;
#pragma unroll
      for (int i = 0; i < 64; ++i) pf[i] = pn[i]; } }
}
__device__ inline void ph_scan_a3(const Pm& p, int gw, int ngw, int lane, int NSEG) {
  constexpr Dm d = DMC; const int RW = d.RW; const int SL = (d.C + d.T) / NSEG; const size_t BTW = (size_t)d.BT * RW; constexpr int PARTS = 2;
  const int items = 2 * d.B * d.RH * NSEG * PARTS;
  for (int it = gw; it < items; it += ngw) { const int part = it % PARTS, g = (it / PARTS) % NSEG, ch = it / (PARTS * NSEG); const int h = ch % d.RH, b = (ch / d.RH) % d.B, dd = ch / (d.RH * d.B);
    const float* st = p.Sst + (((size_t)ch * NSEG + g) * 64 + lane) * 64; float S[64];
#pragma unroll
    for (int i = 0; i < 64; i += 4) { const f4q x = *(const f4q*)(st + i); S[i] = x.x; S[i + 1] = x.y; S[i + 2] = x.z; S[i + 3] = x.w; }
    const int s0 = g * SL + part * (SL / PARTS), s1 = part == PARTS - 1 ? (g + 1) * SL : s0 + SL / PARTS;
    for (int sg = s0; sg < s1; ++sg) { size_t row; bool lat; chain_step(d, dd, b, sg, row, lat); if (!lat) continue;
      const size_t o = row * RW + h * 64; const float* z = p.Zt + dd * BTW + o; float a = p.O2[dd * BTW + o + lane];
#pragma unroll
      for (int i = 0; i < 64; i += 4) { const f4q x = *(const f4q*)(z + i); a += S[i] * x.x + S[i + 1] * x.y + S[i + 2] * x.z + S[i + 3] * x.w; }
      p.O2[dd * BTW + o + lane] = a; } }
}

namespace pg8 {
#define PG8_LAS __attribute__((address_space(3)))
typedef unsigned short bf16_t;
typedef short bf16x8 __attribute__((ext_vector_type(8)));
typedef float f32x4 __attribute__((ext_vector_type(4)));
typedef unsigned u32x4 __attribute__((ext_vector_type(4)));
constexpr int BM = 256, BK = 64, HALF = 128, HTB = HALF * BK * 2  , STAGE_BYTES = 8 * HTB, NXCD = 8, WGM = 8;

__host__ __device__ __forceinline__ int lds_byte(int r, int c) { const int st = (r >> 4) * 2 + (c >> 5), rr = r & 15, cc = c & 31, ob = rr * 64 + cc * 2; return st * 1024 + (ob ^ (((ob >> 9) & 1) << 5)); }
__host__ __device__ __forceinline__ void stage_rc(int b, int& R, int& C) { const int st = b / 1024, sb = b % 1024, swz = sb ^ (((sb >> 9) & 1) << 5); R = (st >> 1) * 16 + swz / 64; C = (st & 1) * 32 + (swz % 64) / 2; }
__host__ __device__ __forceinline__ int perm32(int rho) { const int n = rho >> 4, i = rho & 15; return 8 * (i >> 2) + 4 * n + (i & 3); }

struct Unit { int pm, pn, eb; };
struct Gemm { const bf16_t* A; const bf16_t* Bt; int M, N, K; size_t bexp; };

struct StaticOrder {
    int nM, nN, nwg, G, c; const int* tile_e;
    __host__ __device__ void init(int M, int N, int G_, int c_, const int* te = nullptr) { nM = M / BM; nN = N / BM; nwg = nM * nN; G = G_; c = c_; tile_e = te; }
    __device__ bool next(int i, Unit& u) const {
        const long L = (long)i * G + c; if (L >= nwg) return false;
        int wgid = (int)L; { const int q = nwg / NXCD, r = nwg % NXCD, xcd = wgid % NXCD, off = wgid / NXCD; wgid = (xcd < r ? xcd * (q + 1) : r * (q + 1) + (xcd - r) * q) + off; }
        const int nig = WGM * nN, gid = wgid / nig, fm = gid * WGM, gsz = (nM - fm) < WGM ? (nM - fm) : WGM;
        u.pm = fm + ((wgid % nig) % gsz); u.pn = (wgid % nig) / gsz; u.eb = tile_e ? __builtin_amdgcn_readfirstlane(__hip_atomic_load(tile_e + u.pm, __ATOMIC_RELAXED, __HIP_MEMORY_SCOPE_AGENT)) : 0; return true;
    }
    __device__ __forceinline__ void a_ready(const Unit&) const {}
    __device__ __forceinline__ void done(const Unit&) const {}
};
__device__ __forceinline__ unsigned cvt_pk_bf16(float lo, float hi) { unsigned r; asm volatile("v_cvt_pk_bf16_f32 %0, %1, %2" : "=v"(r) : "v"(lo), "v"(hi)); return r; }
typedef float f32x2 __attribute__((ext_vector_type(2)));
template <class Epi, class Sched, bool ALIGN_EPI = false, bool SP2 = false>
__device__ __forceinline__ void gemm_phase(PG8_LAS unsigned char* lds, const Gemm g, const Sched& S, const Epi& E, const int tid_in) {
    int tid_ = tid_in; asm volatile("" : "+v"(tid_));
    const int tid = tid_, wid = __builtin_amdgcn_readfirstlane(tid >> 6), lane = tid & 63, wr = wid >> 2, wc = wid & 3, fr = lane & 15, fq = lane >> 4;
    const int K = g.K, nt = K / BK;
    unsigned voffA[2], voffB[2];
#pragma unroll
    for (int i = 0; i < 2; ++i) { int R, C; stage_rc(tid * 16 + i * 8192, R, C); const int Rb = Epi::PERM ? ((R & ~31) + perm32(R & 31)) : R;
        voffA[i] = (unsigned)(R * K + C) * 2u; voffB[i] = (unsigned)(Rb * K + C) * 2u; }
    const size_t kstep = (size_t)(BK * 2);
    const size_t hstep = (size_t)HALF * K * 2;
    const size_t tstep = 2 * hstep;
    const unsigned ldsw = (unsigned)wid * 1024u;
    const int aoff = lds_byte(wr * 64 + fr, fq * 8), boff = lds_byte(wc * 32 + fr, fq * 8);
#define PG8_SA(b, h) (((b) * 2 + (h)) * HTB)
#define PG8_SB(b, h) ((4 + (b) * 2 + (h)) * HTB)
#define PG8_STAGE(bufoff, gbase, voff) do { _Pragma("unroll") for (int _i = 0; _i < 2; ++_i) \
        __builtin_amdgcn_global_load_lds((const unsigned*)((const char*)(gbase) + (voff)[_i]), (PG8_LAS unsigned*)(lds + (bufoff) + ldsw + _i * 8192), 16, 0, 0); } while (0)
#define PG8_LDA(dst, b, h) do { _Pragma("unroll") for (int m = 0; m < 4; ++m) _Pragma("unroll") for (int k = 0; k < 2; ++k) dst[m][k] = *(const PG8_LAS bf16x8*)(lds + PG8_SA(b, h) + aoff + m * 2048 + k * 1024); } while (0)
#define PG8_LDB(dst, b, h) do { _Pragma("unroll") for (int n = 0; n < 2; ++n) _Pragma("unroll") for (int k = 0; k < 2; ++k) dst[n][k] = *(const PG8_LAS bf16x8*)(lds + PG8_SB(b, h) + boff + n * 2048 + k * 1024); } while (0)
#define PG8_MMA(ai, bj, At, Bt) do { __builtin_amdgcn_s_setprio(1); _Pragma("unroll") for (int m = 0; m < 4; ++m) _Pragma("unroll") for (int n = 0; n < 2; ++n) _Pragma("unroll") for (int k = 0; k < 2; ++k) \
        acc[ai][bj][m][n] = __builtin_amdgcn_mfma_f32_16x16x32_bf16(Bt[n][k], At[m][k], acc[ai][bj][m][n], 0, 0, 0); __builtin_amdgcn_s_setprio(0); } while (0)
#define PG8_WAIT_V(n) asm volatile("s_waitcnt vmcnt(" #n ")" ::: "memory")
#define PG8_WAIT_L(n) asm volatile("s_waitcnt lgkmcnt(" #n ")" ::: "memory")
#define PG8_BAR __builtin_amdgcn_s_barrier()
#define PG8_SCHED __builtin_amdgcn_sched_barrier(0)
    Unit cur, nxt; int ui = 0;
    if (!S.next(0, cur)) return;
    f32x4 acc[2][2][4][2];
#pragma unroll
    for (int a = 0; a < 2; ++a)
#pragma unroll
        for (int b = 0; b < 2; ++b)
#pragma unroll
            for (int m = 0; m < 4; ++m)
#pragma unroll
                for (int n = 0; n < 2; ++n) acc[a][b][m][n] = (f32x4){0.f, 0.f, 0.f, 0.f};
    bf16x8 At[4][2], B0[2][2], B1[2][2];
    const char* cA = (const char*)g.A + (size_t)cur.pm * tstep; const char* cB = (const char*)g.Bt + (size_t)cur.eb * g.bexp + (size_t)cur.pn * tstep;
    S.a_ready(cur);
    if constexpr (SP2) {
        PG8_STAGE(PG8_SB(0, 0), cB, voffB); PG8_STAGE(PG8_SB(0, 1), cB + hstep, voffB); PG8_STAGE(PG8_SA(0, 0), cA, voffA); PG8_STAGE(PG8_SA(0, 1), cA + hstep, voffA);
        if (wr == 1) PG8_BAR;
        PG8_WAIT_V(2); PG8_BAR;
        PG8_STAGE(PG8_SB(1, 0), cB + kstep, voffB); PG8_STAGE(PG8_SA(1, 0), cA + kstep, voffA); PG8_STAGE(PG8_SB(1, 1), cB + hstep + kstep, voffB);
        PG8_WAIT_V(6); PG8_BAR;
    } else {
        PG8_STAGE(PG8_SB(0, 0), cB, voffB); PG8_STAGE(PG8_SA(0, 0), cA, voffA); PG8_STAGE(PG8_SB(0, 1), cB + hstep, voffB); PG8_STAGE(PG8_SA(0, 1), cA + hstep, voffA);
        if (wr == 1) PG8_BAR;
        PG8_WAIT_V(4); PG8_BAR;
        PG8_STAGE(PG8_SB(1, 0), cB + kstep, voffB); PG8_STAGE(PG8_SA(1, 0), cA + kstep, voffA); PG8_STAGE(PG8_SB(1, 1), cB + hstep + kstep, voffB);
        PG8_WAIT_V(6); PG8_BAR;
    }
    for (;;) {
        const bool has_next = S.next(ui + 1, nxt);
        const char* nA = has_next ? (const char*)g.A + (size_t)nxt.pm * tstep : cA; const char* nB = has_next ? (const char*)g.Bt + (size_t)nxt.eb * g.bexp + (size_t)nxt.pn * tstep : cB;
        for (int t = 0; t < nt; t += 2) {
            const bool last = (t == nt - 2);
            const char* a1 = cA + (size_t)(t + 1) * kstep;
            const char* a2 = last ? nA : cA + (size_t)(t + 2) * kstep; const char* b2 = last ? nB : cB + (size_t)(t + 2) * kstep;
            const char* a3 = a2 + kstep; const char* b3 = b2 + kstep;
            if (last && has_next) S.a_ready(nxt);
            if constexpr (SP2) {
            PG8_LDB(B0, 0, 0); PG8_LDB(B1, 0, 1); PG8_SCHED; PG8_LDA(At, 0, 0); PG8_STAGE(PG8_SA(1, 1), a1 + hstep, voffA);
            PG8_WAIT_V(8); PG8_WAIT_L(0); PG8_BAR; PG8_MMA(0, 0, At, B0); PG8_MMA(0, 1, At, B1); PG8_BAR; PG8_SCHED;
            PG8_LDA(At, 0, 1); PG8_STAGE(PG8_SB(0, 0), b2, voffB); PG8_STAGE(PG8_SB(0, 1), b2 + hstep, voffB); PG8_STAGE(PG8_SA(0, 0), a2, voffA);
            PG8_WAIT_V(8); PG8_WAIT_L(0); PG8_BAR; PG8_MMA(1, 0, At, B0); PG8_MMA(1, 1, At, B1); PG8_BAR; PG8_SCHED;
            PG8_LDB(B0, 1, 0); PG8_LDB(B1, 1, 1); PG8_SCHED; PG8_LDA(At, 1, 0); PG8_STAGE(PG8_SA(0, 1), a2 + hstep, voffA);
            PG8_WAIT_V(8); PG8_WAIT_L(0); PG8_BAR; PG8_MMA(0, 0, At, B0); PG8_MMA(0, 1, At, B1); PG8_BAR; PG8_SCHED;
            PG8_LDA(At, 1, 1); PG8_STAGE(PG8_SB(1, 0), b3, voffB); PG8_STAGE(PG8_SB(1, 1), b3 + hstep, voffB); PG8_STAGE(PG8_SA(1, 0), a3, voffA);
            PG8_WAIT_V(8); PG8_WAIT_L(0); PG8_BAR; PG8_MMA(1, 0, At, B0); PG8_MMA(1, 1, At, B1); PG8_BAR; PG8_SCHED;
            } else {
            PG8_LDB(B0, 0, 0); PG8_SCHED; PG8_LDA(At, 0, 0); PG8_STAGE(PG8_SA(1, 1), a1 + hstep, voffA);
            PG8_WAIT_L(8); PG8_BAR; PG8_WAIT_L(0); PG8_MMA(0, 0, At, B0); PG8_BAR; PG8_SCHED;
            PG8_LDB(B1, 0, 1); PG8_STAGE(PG8_SB(0, 0), b2, voffB);
            PG8_BAR; PG8_WAIT_L(0); PG8_MMA(0, 1, At, B1); PG8_BAR;
            PG8_LDA(At, 0, 1); PG8_STAGE(PG8_SA(0, 0), a2, voffA);
            PG8_BAR; PG8_WAIT_L(0); PG8_MMA(1, 0, At, B0); PG8_BAR; PG8_SCHED;
            PG8_STAGE(PG8_SB(0, 1), b2 + hstep, voffB);
            PG8_WAIT_V(6); PG8_BAR; PG8_MMA(1, 1, At, B1); PG8_BAR;
            PG8_LDB(B0, 1, 0); PG8_SCHED; PG8_LDA(At, 1, 0); PG8_STAGE(PG8_SA(0, 1), a2 + hstep, voffA);
            PG8_WAIT_L(8); PG8_BAR; PG8_WAIT_L(0); PG8_MMA(0, 0, At, B0); PG8_BAR; PG8_SCHED;
            PG8_LDB(B1, 1, 1); PG8_STAGE(PG8_SB(1, 0), b3, voffB);
            PG8_BAR; PG8_WAIT_L(0); PG8_MMA(0, 1, At, B1); PG8_BAR;
            PG8_LDA(At, 1, 1); PG8_STAGE(PG8_SA(1, 0), a3, voffA);
            PG8_BAR; PG8_WAIT_L(0); PG8_MMA(1, 0, At, B0); PG8_BAR; PG8_SCHED;
            PG8_STAGE(PG8_SB(1, 1), b3 + hstep, voffB);
            PG8_WAIT_V(6); PG8_BAR; PG8_MMA(1, 1, At, B1); PG8_BAR;
            }
        }
        if constexpr (ALIGN_EPI) { if (wr == 0) PG8_BAR; }
        if constexpr (!Epi::AFTER_DRAIN) { E(acc, cur, wr, wc, fr, fq); S.done(cur); }
        if (!has_next) break;
#pragma unroll
        for (int a = 0; a < 2; ++a)
#pragma unroll
            for (int b = 0; b < 2; ++b)
#pragma unroll
                for (int m = 0; m < 4; ++m)
#pragma unroll
                    for (int n = 0; n < 2; ++n) acc[a][b][m][n] = (f32x4){0.f, 0.f, 0.f, 0.f};
        cur = nxt; cA = nA; cB = nB; ++ui;
        if constexpr (ALIGN_EPI) { if (wr == 1) PG8_BAR; }
    }
    PG8_WAIT_V(0);
    if constexpr (!ALIGN_EPI) { if (wr == 0) PG8_BAR; }
    PG8_BAR;
    if constexpr (Epi::AFTER_DRAIN) { E.fused(acc, cur, wr, wc, fr, fq, lds, wid, lane); S.done(cur); }
#undef PG8_SA
#undef PG8_SB
#undef PG8_STAGE
#undef PG8_LDA
#undef PG8_LDB
#undef PG8_MMA
#undef PG8_WAIT_V
#undef PG8_WAIT_L
#undef PG8_BAR
#undef PG8_SCHED
}
}

#define XB_TMO      128
#define XB_XCNT(j)  (256  + 64 * (j))
#define XB_XSUB(j)  (1280 + 64 * (j))
#define XB_XGEN(j)  (2304 + 64 * (j))
#define XB_TOP      3328
#define XB_TOPGEN   3392
#define XCD_BAR_WORDS 3456
#define XB_SPIN_CAP (1u << 22)
#define LAS __attribute__((address_space(3)))

__device__ __forceinline__ unsigned xb_ld(unsigned* p)              { return __hip_atomic_load(p, __ATOMIC_RELAXED, __HIP_MEMORY_SCOPE_AGENT); }
__device__ __forceinline__ unsigned xb_add(unsigned* p, unsigned v) { return __hip_atomic_fetch_add(p, v, __ATOMIC_RELAXED, __HIP_MEMORY_SCOPE_AGENT); }
__device__ __forceinline__ unsigned xb_xcc_id() { return (unsigned)__builtin_amdgcn_s_getreg((3 << 11) | 20) & 0xFu; }
#define XB_SPIN(cond, bar) do { unsigned _sp = 0; while (cond) { __builtin_amdgcn_s_sleep(1); \
    if ((++_sp & 255u) == 0u) { if (xb_ld(&(bar)[XB_TMO])) break; if (_sp > XB_SPIN_CAP) { atomicAdd(&(bar)[XB_TMO], 1u); break; } } } } while (0)

struct XcdBarrier {
    unsigned* bar; unsigned x; int wv;
    volatile LAS unsigned* st;
};

__device__ __forceinline__ XcdBarrier xcd_barrier_post(unsigned* bar, volatile LAS unsigned* st) {
    XcdBarrier b; b.bar = bar; b.x = xb_xcc_id(); b.st = st; b.wv = __builtin_amdgcn_readfirstlane((int)threadIdx.x >> 6);
    if (threadIdx.x == 0) (void)xb_add(&bar[XB_XCNT(b.x)], 1u);
    return b;
}
__device__ __forceinline__ void xcd_barrier_complete(unsigned* bar, unsigned x, unsigned& nloc, unsigned& nx) {
    const unsigned G = gridDim.x * gridDim.y * gridDim.z;
    unsigned sum, cnt, mine, sp = 0u;
    for (;;) {
        sum = 0u; cnt = 0u; mine = 0u;
#pragma unroll
        for (unsigned j = 0; j < 16; ++j) { const unsigned c = xb_ld(&bar[XB_XCNT(j)]); sum += c; cnt += (c > 0u) ? 1u : 0u; mine = (j == x) ? c : mine; }
        if (sum == G) break;
        __builtin_amdgcn_s_sleep(1);
        if ((++sp & 255u) == 0u) { if (xb_ld(&bar[XB_TMO])) break; if (sp > XB_SPIN_CAP) { atomicAdd(&bar[XB_TMO], 1u); break; } }
    }
    nloc = mine > 0u ? mine : 1u; nx = cnt > 0u ? cnt : 1u;
}

__device__ __forceinline__ void xcd_barrier(const XcdBarrier& b) {
    asm volatile("s_waitcnt vmcnt(0)" ::: "memory");
    __syncthreads();
    int ln_; asm volatile("v_mbcnt_lo_u32_b32 %0, -1, 0\n\tv_mbcnt_hi_u32_b32 %0, -1, %0" : "=v"(ln_));
    if (b.wv == 0 && ln_ == 0) {
        unsigned* bar = b.bar;
        __builtin_amdgcn_s_waitcnt(0);
        unsigned nloc = b.st[0], nx = b.st[1];
        if (nloc == 0u) { xcd_barrier_complete(bar, b.x, nloc, nx); b.st[0] = nloc; b.st[1] = nx; }
        const unsigned old = xb_add(&bar[XB_XSUB(b.x)], 1u);
        const unsigned gen = old / nloc;
        if (old + 1u == (gen + 1u) * nloc) {
            __builtin_amdgcn_fence(__ATOMIC_RELEASE, "agent");
            asm volatile("s_waitcnt vmcnt(0)" ::: "memory");
            const unsigned og = xb_add(&bar[XB_TOP], 1u);
            const unsigned tg = og / nx;
            if (og + 1u == (tg + 1u) * nx) xb_add(&bar[XB_TOPGEN], 1u);
            else XB_SPIN(xb_ld(&bar[XB_TOPGEN]) == tg, bar);
            __builtin_amdgcn_fence(__ATOMIC_ACQUIRE, "agent");
            xb_add(&bar[XB_XGEN(b.x)], 1u);
            asm volatile("s_waitcnt vmcnt(0)" ::: "memory");
        } else {
            XB_SPIN(xb_ld(&bar[XB_XGEN(b.x)]) == gen, bar);
            __builtin_amdgcn_fence(__ATOMIC_ACQUIRE, "agent");
            asm volatile("s_waitcnt vmcnt(0)" ::: "memory");
        }
    }
    __syncthreads();
}


namespace attn {
using bf16 = unsigned short;
constexpr int DQK = 192, DV = 128, NW = 8, QBLK = 32, KVBLK = 64;
constexpr float SCALE = 0.07216878364870322f;
constexpr float THR = 8.f;
constexpr int SDEPTH = 1;
constexpr int LDQ = DQK, LDK = DQK, LDV = DV, LDO = 1024;
constexpr size_t SHM_V = KVBLK * DV * 2, SHM_K = KVBLK * DQK * 2, SHM_ATTN = 2 * SHM_V + 2 * SHM_K + NW * 64 * 4;
using bf16x8 = __attribute__((ext_vector_type(8))) short;
using s16x4  = __attribute__((ext_vector_type(4))) short;
using f32x16 = __attribute__((ext_vector_type(16))) float;
using f32x8  = __attribute__((ext_vector_type(8))) float;
using u32x4  = __attribute__((ext_vector_type(4))) unsigned;
#define KSWZ(row, colB) ((row) * 384 + ((colB) ^ (((row) & 7) << 4)))
#define SBAR() __builtin_amdgcn_sched_barrier(0)
__device__ __forceinline__ int crow(int r, int hi) { return (r & 3) + 8 * (r >> 2) + 4 * hi; }
__device__ __forceinline__ unsigned cvtpk(float lo, float hi) {
  unsigned r; asm volatile("v_cvt_pk_bf16_f32 %0, %1, %2" : "=v"(r) : "v"(lo), "v"(hi)); return r;
}
struct St { using T = bf16x8;
  __device__ static __forceinline__ T ld8(const bf16* p) { return *reinterpret_cast<const bf16x8*>(p); }
  __device__ static __forceinline__ bf16x8 tobf(T x) { return x; } };
__device__ __forceinline__ void partialSM(f32x16& p0, f32x16& p1, float& m_reg, float& mn, float& alpha) {
  constexpr float C = SCALE * 1.4426950408889634f;
  float pmax = p0[0]; for (int r = 1; r < 16; ++r) pmax = fmaxf(pmax, p0[r]); for (int r = 0; r < 16; ++r) pmax = fmaxf(pmax, p1[r]);
  { auto rr = __builtin_amdgcn_permlane32_swap(__float_as_uint(pmax), __float_as_uint(pmax), false, false);
    pmax = fmaxf(__uint_as_float(rr[0]), __uint_as_float(rr[1])); }
  if (__builtin_expect(__all(pmax - m_reg <= THR / SCALE), 1)) { mn = m_reg; alpha = 1.f; }
  else { mn = fmaxf(m_reg, pmax); alpha = __builtin_amdgcn_exp2f((m_reg - mn) * C); m_reg = mn; }
  float mnC = -mn * C;
  for (int r = 0; r < 16; ++r) p0[r] = fmaf(p0[r], C, mnC); for (int r = 0; r < 16; ++r) p1[r] = fmaf(p1[r], C, mnC);
  for (int r = 0; r < 16; ++r) p0[r] = __builtin_amdgcn_exp2f(p0[r]);
}
__device__ __forceinline__ void finishSM(f32x16& p0, f32x16& p1, float alpha, float& l_reg, bf16x8& pa0, bf16x8& pa1, bf16x8& pa2, bf16x8& pa3) {
  for (int r = 0; r < 16; ++r) p1[r] = __builtin_amdgcn_exp2f(p1[r]);
  float ps = 0; for (int r = 0; r < 16; ++r) ps += p0[r]; for (int r = 0; r < 16; ++r) ps += p1[r];
  { auto rr = __builtin_amdgcn_permlane32_swap(__float_as_uint(ps), __float_as_uint(ps), false, false);
    ps = __uint_as_float(rr[0]) + __uint_as_float(rr[1]); }
  l_reg = l_reg * alpha + ps;
#define PK4(P, BASE, OUT) do { unsigned a0 = cvtpk(P[BASE + 0], P[BASE + 1]), a1 = cvtpk(P[BASE + 2], P[BASE + 3]);   \
    unsigned b0 = cvtpk(P[BASE + 4], P[BASE + 5]), b1 = cvtpk(P[BASE + 6], P[BASE + 7]);                              \
    auto r0 = __builtin_amdgcn_permlane32_swap(a0, b0, false, false); auto r1 = __builtin_amdgcn_permlane32_swap(a1, b1, false, false); \
    u32x4 w = {r0[0], r1[0], r0[1], r1[1]}; OUT = *reinterpret_cast<bf16x8*>(&w); } while (0)
  PK4(p0, 0, pa0); PK4(p0, 8, pa1); PK4(p1, 0, pa2); PK4(p1, 8, pa3);
#undef PK4
}
__device__ __forceinline__ void qkt(f32x16& p0, f32x16& p1, const bf16* Ks, const bf16x8* qr, int r32, int hi) {
  p0 = f32x16{}; p1 = f32x16{};
  for (int d0 = 0; d0 < 12; ++d0) { int cb = (d0 * 16 + hi * 8) * 2;
    bf16x8 b0 = *reinterpret_cast<const bf16x8*>((const char*)Ks + KSWZ(r32, cb));
    bf16x8 b1 = *reinterpret_cast<const bf16x8*>((const char*)Ks + KSWZ(32 + r32, cb));
    p0 = __builtin_amdgcn_mfma_f32_32x32x16_bf16(b0, qr[d0], p0, 0, 0, 0);
    p1 = __builtin_amdgcn_mfma_f32_32x32x16_bf16(b1, qr[d0], p1, 0, 0, 0); }
}
__device__ __forceinline__ int v_st(int k, int c) { const int kk = (k & ~0xC) | ((k & 4) << 1) | ((k & 8) >> 1); return ((kk >> 3) * 4 + (c >> 5)) * 512 + ((kk & 7) * 32 + (c & 31)) * 2; }
__device__ __forceinline__ int v_rd_base(int lane) { return ((lane & 3) << 3) | (((lane >> 2) & 3) << 6) | (((lane >> 4) & 1) << 5) | (((lane >> 5) & 1) << 8); }
constexpr int v_rd_off(int d0, int ks, int half) { return d0 * 512 + ks * 4096 + half * 2048; }
template <int OFF> __device__ __forceinline__ s16x4 tr_read(int vb) {
  s16x4 r; asm volatile("ds_read_b64_tr_b16 %0, %1 offset:%2" : "=&v"(r) : "v"(vb), "i"(OFF) : "memory"); return r;
}
template <int D0> __device__ __forceinline__ void pv_one(f32x16& od, int vb, bf16x8 pa0, bf16x8 pa1, bf16x8 pa2, bf16x8 pa3) {
  const s16x4 l0 = tr_read<v_rd_off(D0, 0, 0)>(vb), h0 = tr_read<v_rd_off(D0, 0, 1)>(vb), l1 = tr_read<v_rd_off(D0, 1, 0)>(vb), h1 = tr_read<v_rd_off(D0, 1, 1)>(vb);
  const s16x4 l2 = tr_read<v_rd_off(D0, 2, 0)>(vb), h2 = tr_read<v_rd_off(D0, 2, 1)>(vb), l3 = tr_read<v_rd_off(D0, 3, 0)>(vb), h3 = tr_read<v_rd_off(D0, 3, 1)>(vb);
  asm volatile("s_waitcnt lgkmcnt(0)" ::: "memory"); SBAR();
#define PK(L, H) (bf16x8){L[0], L[1], L[2], L[3], H[0], H[1], H[2], H[3]}
  od = __builtin_amdgcn_mfma_f32_32x32x16_bf16(pa0, PK(l0, h0), od, 0, 0, 0);
  od = __builtin_amdgcn_mfma_f32_32x32x16_bf16(pa1, PK(l1, h1), od, 0, 0, 0);
  od = __builtin_amdgcn_mfma_f32_32x32x16_bf16(pa2, PK(l2, h2), od, 0, 0, 0);
  od = __builtin_amdgcn_mfma_f32_32x32x16_bf16(pa3, PK(l3, h3), od, 0, 0, 0);
#undef PK
}
__device__ __forceinline__ void pv_d0(f32x16* o, int vb, bf16x8 pa0, bf16x8 pa1, bf16x8 pa2, bf16x8 pa3) {
  pv_one<0>(o[0], vb, pa0, pa1, pa2, pa3); pv_one<1>(o[1], vb, pa0, pa1, pa2, pa3); pv_one<2>(o[2], vb, pa0, pa1, pa2, pa3); pv_one<3>(o[3], vb, pa0, pa1, pa2, pa3);
}

__device__ __forceinline__ void attn_dense_body(const bf16* __restrict__ Qb, const bf16* __restrict__ Kh, const bf16* __restrict__ Vh,
                                                bf16* __restrict__ Ob, int seq, char* lds, const int tid_in) {
  int tid_ = tid_in; asm volatile("" : "+v"(tid_));
  const int tid = tid_, wid = tid >> 6, lane = tid & 63, r32 = lane & 31, hi = lane >> 5;
  bf16* V_lds = (bf16*)lds; bf16* K_lds = (bf16*)(lds + 2 * SHM_V);
  float* ws = (float*)(lds + 2 * SHM_V + 2 * SHM_K) + wid * 64; float* li_l = ws; float* al_l = ws + 32;
  float m_reg = -1e30f, l_reg = 0; f32x16 o[4] = {}; bf16x8 qr[12];
  const bf16* Qw = Qb + (long)(wid * QBLK + r32) * LDQ + hi * 8;
#pragma unroll
  for (int d0 = 0; d0 < 12; ++d0) qr[d0] = St::ld8(Qw + d0 * 16);
  const int sr = tid >> 4, sc = (tid & 15) * 8, vst0 = v_st(sr, sc), vst1 = v_st(32 + sr, sc);
  const int kr0 = tid / 24, kc0 = (tid % 24) * 8, kr1 = (tid + 512) / 24, kc1 = ((tid + 512) % 24) * 8, kr2 = (tid + 1024) / 24, kc2 = ((tid + 1024) % 24) * 8;
  const int vb0 = (int)(uintptr_t)V_lds + v_rd_base(lane);
  struct { St::T vs0, vs1, ks0, ks1, ks2; } sr_[SDEPTH];
#define SLOAD(i, k0) do { sr_[i].vs0 = St::ld8(&Vh[(long)((k0) + sr) * LDV + sc]); sr_[i].vs1 = St::ld8(&Vh[(long)((k0) + 32 + sr) * LDV + sc]); \
    sr_[i].ks0 = St::ld8(&Kh[(long)((k0) + kr0) * LDK + kc0]); sr_[i].ks1 = St::ld8(&Kh[(long)((k0) + kr1) * LDK + kc1]); sr_[i].ks2 = St::ld8(&Kh[(long)((k0) + kr2) * LDK + kc2]); } while (0)
#define SWRITE(b, i) do { *(bf16x8*)((char*)V_lds + (b) * SHM_V + vst0) = St::tobf(sr_[i].vs0);          \
    *(bf16x8*)((char*)V_lds + (b) * SHM_V + vst1) = St::tobf(sr_[i].vs1);                                \
    *(bf16x8*)((char*)K_lds + (b) * SHM_K + KSWZ(kr0, kc0 * 2)) = St::tobf(sr_[i].ks0);                  \
    *(bf16x8*)((char*)K_lds + (b) * SHM_K + KSWZ(kr1, kc1 * 2)) = St::tobf(sr_[i].ks1);                  \
    *(bf16x8*)((char*)K_lds + (b) * SHM_K + KSWZ(kr2, kc2 * 2)) = St::tobf(sr_[i].ks2); } while (0)
#define SWAIT() do { if constexpr (SDEPTH == 2) asm volatile("s_waitcnt vmcnt(5)" ::: "memory"); else asm volatile("s_waitcnt vmcnt(0)" ::: "memory"); } while (0)
#define RESC(a) do { if (__any((a) < 1.f)) { if (hi == 0) al_l[r32] = (a); asm volatile("s_waitcnt lgkmcnt(0)" ::: "memory"); \
    for (int d = 0; d < 4; ++d) for (int r = 0; r < 16; ++r) o[d][r] *= al_l[crow(r, hi)]; } } while (0)
  f32x16 p0, p1; float mn, al; bf16x8 pa0, pa1, pa2, pa3; const int NT = seq / KVBLK;
  SLOAD(0, 0); asm volatile("s_waitcnt vmcnt(0)" ::: "memory"); SWRITE(0, 0); __syncthreads();
  for (int j = 0; j < NT; ++j) {
    const int cur = j & 1; const bool more = j + 1 < NT;
    if (more) SLOAD(0, (j + 1) * KVBLK);
    SBAR(); qkt(p0, p1, (bf16*)((char*)K_lds + cur * SHM_K), qr, r32, hi);
    partialSM(p0, p1, m_reg, mn, al); RESC(al);
    finishSM(p0, p1, al, l_reg, pa0, pa1, pa2, pa3); SBAR();
    pv_d0(o, vb0 + cur * (int)SHM_V, pa0, pa1, pa2, pa3);
    if (more) { SWAIT(); SWRITE(cur ^ 1, 0); }
    __syncthreads();
  }
  if (hi == 0) li_l[r32] = l_reg; asm volatile("s_waitcnt lgkmcnt(0)" ::: "memory");
  float rli[16];
#pragma unroll
  for (int r = 0; r < 16; ++r) rli[r] = __builtin_amdgcn_rcpf(li_l[crow(r, hi)]);
  bf16* Ow = Ob + (long)(wid * QBLK) * LDO;
#pragma unroll
  for (int r = 0; r < 16; ++r) { int orow = crow(r, hi);
    for (int d0 = 0; d0 < 4; ++d0) Ow[(long)orow * LDO + d0 * 32 + r32] = f2bf(o[d0][r] * rli[r]); }
#undef SLOAD
#undef SWRITE
#undef SWAIT
#undef RESC
}

}


constexpr int NWAVES = 8, NTHREADS = 512;
constexpr int RING_BYTES = 151552, MISC_OFF = RING_BYTES + 320, LDS_BYTES = 163840;
#define GAS __attribute__((address_space(1)))
typedef unsigned v4u __attribute__((ext_vector_type(4)));
typedef float f32x4 __attribute__((ext_vector_type(4)));
#define LDS_WAIT() asm volatile("s_waitcnt lgkmcnt(0)" ::: "memory")
typedef float f4 __attribute__((ext_vector_type(4)));
typedef unsigned u2 __attribute__((ext_vector_type(2)));
typedef unsigned u4 __attribute__((ext_vector_type(4)));
__device__ __forceinline__ float wave_sum(float v) {
#pragma unroll
  for (int o = 1; o < 64; o <<= 1) v += __shfl_xor(v, o);
  return v;
}
__device__ __forceinline__ unsigned pkbf(float lo, float hi) { return (unsigned)f2bf(lo) | ((unsigned)f2bf(hi) << 16); }

constexpr int MOD_KS = 16, MOD_CG = 16, MOD_COLS = 384;
__device__ __forceinline__ void f_mod_partial(const Pm& p, int tidb) {
  const int N6 = 6 * 1024;
  for (int u = blockIdx.x; u < MOD_KS * MOD_CG; u += gridDim.x) { const int ks = u / MOD_CG, cg = u % MOD_CG;
    if (tidb < MOD_COLS) { const int n = cg * MOD_COLS + tidb; float a0 = 0.f, a1 = 0.f, a2 = 0.f;
      for (int k = ks * 64; k < ks * 64 + 64; ++k) { const float w = p.mod_w[(size_t)k * N6 + n]; const float c0 = p.c[k], c1 = p.c[1024 + k], c2 = p.c_ctx[k];
        a0 += c0 * sigmoidf_(c0) * w; a1 += c1 * sigmoidf_(c1) * w; a2 += c2 * sigmoidf_(c2) * w; }
      float* o = p.modp + (size_t)ks * 3 * N6 + n; o[0] = a0; o[N6] = a1; o[2 * N6] = a2; } }
}
__device__ __forceinline__ void f_mod_reduce(const Pm& p, LAS float* modL, int tidb) {
  const int N6 = 6 * 1024;
  for (int i = tidb; i < 3 * 2048; i += NTHREADS) { const int v = i / 2048, n = i % 2048; float a = p.mod_b[n];
#pragma unroll
    for (int ks = 0; ks < MOD_KS; ++ks) a += p.modp[((size_t)ks * 3 + v) * N6 + n];
    modL[i] = a; }
  const int per = (3 * N6 + gridDim.x - 1) / gridDim.x;
  for (int i = blockIdx.x * per + tidb; i < (int)(blockIdx.x + 1) * per && i < 3 * N6; i += NTHREADS) { const int v = i / N6, n = i % N6; float a = p.mod_b[n];
#pragma unroll
    for (int ks = 0; ks < MOD_KS; ++ks) a += p.modp[((size_t)ks * 3 + v) * N6 + n];
    p.modv[i] = a; }
  __syncthreads();
}
__device__ __forceinline__ void f_norm1(const Pm& p, const LAS float* modL, int gw, int ngw, int lane) {
  constexpr Dm d = DMC;
  for (int row = gw; row < d.NR; row += ngw) {
    const float* src = row < d.BT ? p.x + (size_t)row * 1024 : p.ctx + (size_t)(row - d.BT) * 1024; const int v = row < d.BT ? row / d.T : 2;
    f4 xv[4]; float ss = 0.f;
#pragma unroll
    for (int j = 0; j < 4; ++j) { xv[j] = *(const f4*)(src + 4 * lane + 256 * j); ss += xv[j].x * xv[j].x + xv[j].y * xv[j].y + xv[j].z * xv[j].z + xv[j].w * xv[j].w; }
    const float rs = 1.f / sqrtf(wave_sum(ss) * (1.f / 1024.f) + 1e-6f);
#pragma unroll
    for (int j = 0; j < 4; ++j) { const int k = 4 * lane + 256 * j; const f4 g = *(const f4*)(p.norm1_g + k); const LAS float* sh = modL + v * 2048 + k; const LAS float* sc = sh + 1024;
      const float o0 = xv[j].x * rs * g.x * (1.f + sc[0]) + sh[0], o1 = xv[j].y * rs * g.y * (1.f + sc[1]) + sh[1], o2 = xv[j].z * rs * g.z * (1.f + sc[2]) + sh[2], o3 = xv[j].w * rs * g.w * (1.f + sc[3]) + sh[3];
      u2 w; w.x = pkbf(o0, o1); w.y = pkbf(o2, o3); *(u2*)(p.A1 + (size_t)row * 1024 + k) = w; }
  }
}
__device__ __forceinline__ void f_rope_table(const Pm& p, long tid, long nth) {
  for (long i = tid; i < (long)8192 * 32; i += nth) { const int t = (int)(i >> 5), q = (int)(i & 31), a = q >> 4, f = q & 15;
    const float freq = expf(-(float)f * (1.f / 16.f) * 9.210340371976184f), pos = a == 0 ? (float)(t >> 6) : (float)(t & 63), ang = pos * freq;
    p.ropet[2 * i] = cosf(ang); p.ropet[2 * i + 1] = sinf(ang); }
}
__device__ __forceinline__ void f_mla_a(const Pm& p, int gw, int ngw, int lane) {
  constexpr Dm d = DMC; const int NK = d.C + d.T;
  for (int row = gw; row < d.NR; row += ngw) {
    const bf16_t* pm = p.P + (size_t)row * d.IN + d.RC; int t, len, b, ic; row_pos(d, row, t, len, b, ic);
    const u2 qw = *(const u2*)(pm + 4 * lane); const unsigned cw = *(const unsigned*)(pm + 256 + 2 * lane);
    const f4 q = {__builtin_bit_cast(float, qw.x << 16), __builtin_bit_cast(float, qw.x & 0xffff0000u), __builtin_bit_cast(float, qw.y << 16), __builtin_bit_cast(float, qw.y & 0xffff0000u)};
    const float c0 = __builtin_bit_cast(float, cw << 16), c1 = __builtin_bit_cast(float, cw & 0xffff0000u); const float kr = __builtin_bit_cast(float, (unsigned)pm[384 + lane] << 16);
    const float qs = wave_sum(q.x * q.x + q.y * q.y + q.z * q.z + q.w * q.w), cs2 = wave_sum(c0 * c0 + c1 * c1);
    if (!ic) { const float rs = 1.f / sqrtf(qs * (1.f / 256.f) + 1e-6f); const f4 g = *(const f4*)(p.q_norm + 4 * lane);
      u2 w; w.x = pkbf(q.x * rs * g.x, q.y * rs * g.y); w.y = pkbf(q.z * rs * g.z, q.w * rs * g.w); *(u2*)(p.QN + (size_t)row * 256 + 4 * lane) = w; }
    { const float rs = 1.f / sqrtf(cs2 * (1.f / 128.f) + 1e-6f); *(unsigned*)(p.CN + (size_t)row * 128 + 2 * lane) = pkbf(c0 * rs * p.kv_norm[2 * lane], c1 * rs * p.kv_norm[2 * lane + 1]); }
    const float partner = __shfl_xor(kr, 16); float cs = 1.f, sn = 0.f;
    if (!ic) { const float* ct = p.ropet + ((size_t)t * 32 + (lane >> 5) * 16 + (lane & 15)) * 2; cs = ct[0]; sn = ct[1]; }
    const float o = (lane & 16) ? kr * cs + partner * sn : kr * cs - partner * sn; const bf16_t ob = f2bf(o); const int key = ic ? t : d.C + t;
#pragma unroll
    for (int h = 0; h < 4; ++h) p.K[((size_t)(b * 4 + h) * NK + key) * 192 + 128 + lane] = ob;
  }
}
__device__ __forceinline__ void f_readout(const Pm& p, int gw, int ngw, int lane) {
  constexpr Dm d = DMC; const size_t NRW = (size_t)d.NR * 512, BTW = (size_t)d.BT * 512;
  for (int row = gw; row < d.BT; row += ngw) { const size_t o = (size_t)row * 512 + 8 * lane;
    float ov[8], rv[8], kv[8], vv[8], gv[8];
#pragma unroll
    for (int q = 0; q < 2; ++q) { const f4 a = *(const f4*)(p.O2 + o + 4 * q), b2 = *(const f4*)(p.O2 + BTW + o + 4 * q), g = *(const f4*)(p.Gt + o + 4 * q);
      const u2 r = *(const u2*)(p.Rr + o + 4 * q), k0 = *(const u2*)(p.Kd + o + 4 * q), k1 = *(const u2*)(p.Kd + NRW + o + 4 * q), v = *(const u2*)(p.Vv + o + 4 * q);
#define BL(u) __builtin_bit_cast(float, (u) << 16)
#define BH(u) __builtin_bit_cast(float, (u) & 0xffff0000u)
      const float rr[4] = {BL(r.x), BH(r.x), BL(r.y), BH(r.y)}, ka[4] = {BL(k0.x), BH(k0.x), BL(k0.y), BH(k0.y)}, kb[4] = {BL(k1.x), BH(k1.x), BL(k1.y), BH(k1.y)}, vq[4] = {BL(v.x), BH(v.x), BL(v.y), BH(v.y)};
#pragma unroll
      for (int e = 0; e < 4; ++e) { ov[4 * q + e] = a[e] + b2[e]; rv[4 * q + e] = rr[e]; kv[4 * q + e] = ka[e] + kb[e]; vv[4 * q + e] = vq[e]; gv[4 * q + e] = g[e]; } }
    float s = 0.f, bon = 0.f;
#pragma unroll
    for (int e = 0; e < 8; ++e) { s += ov[e]; bon += rv[e] * kv[e] * p.r_k[8 * lane + e]; }
#pragma unroll
    for (int m = 1; m < 8; m <<= 1) { s += __shfl_xor(s, m); bon += __shfl_xor(bon, m); }
    const float mean = s * (1.f / 64.f); float var = 0.f;
#pragma unroll
    for (int e = 0; e < 8; ++e) { const float q = ov[e] - mean; var += q * q; }
#pragma unroll
    for (int m = 1; m < 8; m <<= 1) var += __shfl_xor(var, m);
    const float rs = 1.f / sqrtf(var * (1.f / 64.f) + 64e-5f); float y[8];
#pragma unroll
    for (int e = 0; e < 8; ++e) y[e] = ((ov[e] - mean) * rs * p.ln_w[8 * lane + e] + p.ln_b[8 * lane + e] + bon * vv[e]) * gv[e];
    u4 w; w.x = pkbf(y[0], y[1]); w.y = pkbf(y[2], y[3]); w.z = pkbf(y[4], y[5]); w.w = pkbf(y[6], y[7]);
    *(u4*)(p.MIXb + (size_t)row * 1024 + 8 * lane) = w; }
}
__device__ __forceinline__ void f_final(const Pm& p, int gw, int ngw, int lane) {
  constexpr Dm d = DMC;
  for (int tok = gw; tok < d.BT; tok += ngw) { const int b = tok / d.T; const float* gt2 = p.modv + (size_t)b * 6144 + 5 * 1024; const float* xr = p.x1 + (size_t)tok * 1024;
    const f4 gq = *(const f4*)(p.gate + (size_t)tok * 4); const int4 sp = *(const int4*)(p.slot_pos + (size_t)tok * 4);
    const bf16_t* y0 = p.Yb + (size_t)sp.x * 1024; const bf16_t* y1 = p.Yb + (size_t)sp.y * 1024; const bf16_t* y2 = p.Yb + (size_t)sp.z * 1024; const bf16_t* y3 = p.Yb + (size_t)sp.w * 1024;
    f4 xv[4]; float ss = 0.f;
#pragma unroll
    for (int j = 0; j < 4; ++j) { const int k = 4 * lane + 256 * j; const f4 x = *(const f4*)(xr + k), g = *(const f4*)(gt2 + k);
      const u2 a = *(const u2*)(y0 + k), b2 = *(const u2*)(y1 + k), c = *(const u2*)(y2 + k), e = *(const u2*)(y3 + k);
#define BFLO(u) __builtin_bit_cast(float, (u) << 16)
#define BFHI(u) __builtin_bit_cast(float, (u) & 0xffff0000u)
      f4 f; f.x = gq.x * BFLO(a.x) + gq.y * BFLO(b2.x) + gq.z * BFLO(c.x) + gq.w * BFLO(e.x); f.y = gq.x * BFHI(a.x) + gq.y * BFHI(b2.x) + gq.z * BFHI(c.x) + gq.w * BFHI(e.x);
      f.z = gq.x * BFLO(a.y) + gq.y * BFLO(b2.y) + gq.z * BFLO(c.y) + gq.w * BFLO(e.y); f.w = gq.x * BFHI(a.y) + gq.y * BFHI(b2.y) + gq.z * BFHI(c.y) + gq.w * BFHI(e.y);
      xv[j] = x + g * f; ss += xv[j].x * xv[j].x + xv[j].y * xv[j].y + xv[j].z * xv[j].z + xv[j].w * xv[j].w; }
    const float rs = 1.f / sqrtf(wave_sum(ss) * (1.f / 1024.f) + 1e-6f);
#pragma unroll
    for (int j = 0; j < 4; ++j) { const int k = 4 * lane + 256 * j; const f4 fg = *(const f4*)(p.final_g + k); *(f4*)(p.out + (size_t)tok * 1024 + k) = xv[j] * rs * fg; }
  }
}

__device__ __forceinline__ void f_route(const Pm& p, LAS unsigned char* lds, int wave, int lane, int tidb) {
  constexpr Dm d = DMC; const int G = gridDim.x, TPB = (d.BT + G - 1) / G;
  LAS int* cnt_l = (LAS int*)(lds); LAS float* hrow = (LAS float*)(lds + 1024 + wave * 4096);
  if (tidb < 32) cnt_l[tidb] = 0;
  __syncthreads();
  const int t0 = blockIdx.x * TPB, t1 = (t0 + TPB < d.BT) ? t0 + TPB : d.BT;
  for (int tok = t0 + wave; tok < t1; tok += NWAVES) {
    const int b = tok / d.T; const float* xr = p.x1 + (size_t)tok * 1024; const float* sh = p.modv + (size_t)b * 6144 + 3 * 1024; const float* sc = sh + 1024;
    f4 xv[4]; float ss = 0.f;
#pragma unroll
    for (int j = 0; j < 4; ++j) { xv[j] = *(const f4*)(xr + 4 * lane + 256 * j); ss += xv[j].x * xv[j].x + xv[j].y * xv[j].y + xv[j].z * xv[j].z + xv[j].w * xv[j].w; }
    const float rs = 1.f / sqrtf(wave_sum(ss) * (1.f / 1024.f) + 1e-6f);
#pragma unroll
    for (int j = 0; j < 4; ++j) { const int k = 4 * lane + 256 * j; const f4 g = *(const f4*)(p.norm2_g + k), s4 = *(const f4*)(sh + k), c4 = *(const f4*)(sc + k);
      f4 hv; hv.x = xv[j].x * rs * g.x * (1.f + c4.x) + s4.x; hv.y = xv[j].y * rs * g.y * (1.f + c4.y) + s4.y; hv.z = xv[j].z * rs * g.z * (1.f + c4.z) + s4.z; hv.w = xv[j].w * rs * g.w * (1.f + c4.w) + s4.w;
      u2 w; w.x = pkbf(hv.x, hv.y); w.y = pkbf(hv.z, hv.w); *(u2*)(p.H2b + (size_t)tok * 1024 + k) = w; *(LAS f4*)(hrow + k) = hv; }
    asm volatile("s_waitcnt lgkmcnt(0)" ::: "memory");
    const int e = lane & 31, half = lane >> 5; const float* rw = p.router_w + (size_t)(half * 512) * 32 + e; const LAS float* hh = hrow + half * 512; float acc = 0.f;
#pragma unroll 8
    for (int k = 0; k < 512; ++k) acc += hh[k] * rw[(size_t)k * 32];
    acc += __shfl_xor(acc, 32);
    float lg = acc + p.router_b[e]; float tv[4]; int te[4];
#pragma unroll
    for (int kk = 0; kk < 4; ++kk) { float m = lg;
#pragma unroll
      for (int o = 1; o < 32; o <<= 1) m = fmaxf(m, __shfl_xor(m, o));
      const unsigned long long bal = __ballot(lg == m); const int bi = __builtin_ctzll(bal) & 31;
      tv[kk] = m; te[kk] = bi; if (e == bi) lg = -3e38f; }
    const float e1 = __expf(tv[1] - tv[0]), e2 = __expf(tv[2] - tv[0]), e3 = __expf(tv[3] - tv[0]), inv = 1.f / (1.f + e1 + e2 + e3);
    if (lane < 4) { const int me = lane == 0 ? te[0] : lane == 1 ? te[1] : lane == 2 ? te[2] : te[3]; const float mg = (lane == 0 ? 1.f : lane == 1 ? e1 : lane == 2 ? e2 : e3) * inv;
      const int rk = atomicAdd((int*)&cnt_l[me], 1);
      p.top_e[(size_t)tok * 4 + lane] = me; p.gate[(size_t)tok * 4 + lane] = mg; p.lrank[(size_t)tok * 4 + lane] = rk; }
  }
  __syncthreads();
  if (tidb < 32) p.blkcnt[(size_t)blockIdx.x * 32 + tidb] = cnt_l[tidb];
}
__device__ __forceinline__ void f_place(const Pm& p, LAS unsigned char* lds, int wave, int lane, int tidb) {
  constexpr Dm d = DMC; const int G = gridDim.x, TPB = (d.BT + G - 1) / G;
  LAS int* ps = (LAS int*)lds;
  LAS int* pb = ps + 512;
  LAS int* off = pb + 512;
  LAS int* base = off + 64;
  { const int e = tidb & 31, part = tidb >> 5; int sa = 0, sb = 0;
    for (int bb = part; bb < G; bb += 16) { const int c = __hip_atomic_load(p.blkcnt + (size_t)bb * 32 + e, __ATOMIC_RELAXED, __HIP_MEMORY_SCOPE_AGENT); sa += c; if (bb < (int)blockIdx.x) sb += c; }
    ps[part * 32 + e] = sa; pb[part * 32 + e] = sb; }
  __syncthreads();
  if (tidb < 32) { int sa = 0, sb = 0;
#pragma unroll
    for (int q = 0; q < 16; ++q) { sa += ps[q * 32 + tidb]; sb += pb[q * 32 + tidb]; }
    base[tidb] = sb; ps[tidb] = (sa + 255) / 256 * 256; }
  __syncthreads();
  if (tidb == 0) { int o = 0; for (int e = 0; e < 32; ++e) { off[e] = o; o += ps[e]; } off[32] = o; }
  __syncthreads();
  if (blockIdx.x == 0) { const int npos = off[32];
    for (int t = tidb; t < npos / 256; t += NTHREADS) { int e = 0; for (int q = 1; q < 32; ++q) if (t * 256 >= off[q]) e = q; p.tile_e[t] = e; }
    if (tidb == 0) p.npos[0] = npos; }
  const int t0 = blockIdx.x * TPB, t1 = (t0 + TPB < d.BT) ? t0 + TPB : d.BT;
  for (int tok = t0 + wave; tok < t1; tok += NWAVES) {
    const u4* src = (const u4*)(p.H2b + (size_t)tok * 1024) + lane * 2; const u4 a = src[0], b = src[1];
#pragma unroll
    for (int kk = 0; kk < 4; ++kk) { const int e = p.top_e[(size_t)tok * 4 + kk], rk = p.lrank[(size_t)tok * 4 + kk]; const int pos = off[e] + base[e] + rk;
      if (lane == 0) p.slot_pos[(size_t)tok * 4 + kk] = pos;
      u4* dst = (u4*)(p.Xg + (size_t)pos * 1024) + lane * 2; dst[0] = a; dst[1] = b; }
  }
}
__device__ __forceinline__ void f_rwkv_s1(const Pm& p, int gw, int ngw, int lane) {
  constexpr Dm d = DMC;
  for (int row = gw; row < d.NR; row += ngw) { int t, len, b, ic; row_pos(d, row, t, len, b, ic);
    const bf16_t* cur = p.P + (size_t)row * d.IN; const bool hp = t > 0, hn = t < len - 1; f4 ps[7];
#define S1_LD(ptr) ({ const u2 w_ = *(const u2*)(ptr); (f4){__builtin_bit_cast(float, w_.x << 16), __builtin_bit_cast(float, w_.x & 0xffff0000u), __builtin_bit_cast(float, w_.y << 16), __builtin_bit_cast(float, w_.y & 0xffff0000u)}; })
#pragma unroll
    for (int j = 0; j < 7; ++j) { const int c = 4 * lane + 256 * j; const f4 x = S1_LD(cur + c), mu = *(const f4*)(p.mu + c); f4 pr = {0.f, 0.f, 0.f, 0.f}, nx = pr;
      if (hp) pr = S1_LD(cur - d.IN + c); if (hn) nx = S1_LD(cur + d.IN + c);
      ps[j] = x + mu * (0.5f * (pr + nx) - x); }
#undef S1_LD
    const size_t o = (size_t)row * 512 + 4 * lane;
    { u2 w; w.x = pkbf(ps[0].x, ps[0].y); w.y = pkbf(ps[0].z, ps[0].w); *(u2*)(p.Rr + o) = w; w.x = pkbf(ps[1].x, ps[1].y); w.y = pkbf(ps[1].z, ps[1].w); *(u2*)(p.Rr + o + 256) = w;
      w.x = pkbf(ps[4].x, ps[4].y); w.y = pkbf(ps[4].z, ps[4].w); *(u2*)(p.Vv + o) = w; w.x = pkbf(ps[5].x, ps[5].y); w.y = pkbf(ps[5].z, ps[5].w); *(u2*)(p.Vv + o + 256) = w; }
#pragma unroll
    for (int j = 0; j < 2; ++j) { const f4 k = ps[2 + j]; const f4 kq = k * *(const f4*)(p.k_k + 4 * lane + 256 * j); float ss = kq.x * kq.x + kq.y * kq.y + kq.z * kq.z + kq.w * kq.w;
#pragma unroll
      for (int m = 1; m < 16; m <<= 1) ss += __shfl_xor(ss, m);
      const float inv = 1.f / sqrtf(fmaxf(ss, 1e-24f)); *(f4*)(p.Kraw + o + 256 * j) = k; const f4 kn = kq * inv; u2 w; w.x = pkbf(kn.x, kn.y); w.y = pkbf(kn.z, kn.w); *(u2*)(p.KK + o + 256 * j) = w; }
    const f4 x6 = ps[6];
    if (lane < 16) { u2 w; w.x = pkbf(tanhf(x6.x), tanhf(x6.y)); w.y = pkbf(tanhf(x6.z), tanhf(x6.w)); *(u2*)(p.AL1 + (size_t)row * 128 + 4 * lane) = w; }
    else if (lane < 32) { u2 w; w.x = pkbf(x6.x, x6.y); w.y = pkbf(x6.z, x6.w); *(u2*)(p.AL1 + (size_t)row * 128 + 4 * lane) = w; }
    else if (!ic) { u2 w; w.x = pkbf(sigmoidf_(x6.x), sigmoidf_(x6.y)); w.y = pkbf(sigmoidf_(x6.z), sigmoidf_(x6.w)); *(u2*)(p.AL2 + (size_t)row * 128 + 4 * (lane - 32)) = w; }
  }
}
__device__ __forceinline__ void f_lora_weights(const Pm& p, long tid, long nth) {
  for (long i = tid; i < (long)2048 * 128; i += nth) { const int n = (int)(i >> 7), k = (int)(i & 127); float v = 0.f;
    if (n < 1024) { if (k < 64) v = p.w2[((size_t)(n >> 9) * 64 + k) * 512 + (n & 511)]; } else { const int q = n - 1024; if (k >= 64) v = p.a2[((size_t)(q >> 9) * 64 + (k - 64)) * 512 + (q & 511)]; }
    p.WlT[i] = f2bf(v); }
  for (long i = tid; i < (long)512 * 128; i += nth) { const int n = (int)(i >> 7), k = (int)(i & 127); p.G2T[i] = f2bf(p.g2[(size_t)k * 512 + n]); }
}
__device__ __forceinline__ float fma_s(float a, float b, float c) { float r; asm("v_fma_f32 %0, %1, %2, %3" : "=v"(r) : "v"(a), "v"(b), "v"(c)); return r; }
__device__ __forceinline__ float fnma_s(float a, float b, float c) { float r; asm("v_fma_f32 %0, -%1, %2, %3" : "=v"(r) : "v"(a), "v"(b), "v"(c)); return r; }
__device__ __forceinline__ float mul_s(float a, float b) { float r; asm("v_mul_f32 %0, %1, %2" : "=v"(r) : "v"(a), "v"(b)); return r; }
__device__ __forceinline__ void f_scan_a2(const Pm& p, LAS unsigned char* lds, int wave, int lane, int NSEG) {
  constexpr Dm d = DMC; constexpr int R = 6, PD = 4, SLOT = 18432; const int NB = 2 * d.B * d.RH * 8;
  for (int ub = blockIdx.x; ub < NB; ub += gridDim.x) { const int ch = ub >> 3, v0 = (ub & 7) * 8, v = v0 + wave; const float* base = p.Fend + (size_t)ch * NSEG * 128 * 64;
#define A2_ISSUE(gq) do { const float* fe_ = base + (size_t)(gq) * 128 * 64; LAS unsigned char* sl_ = lds + ((gq) % R) * SLOT; \
      __builtin_amdgcn_global_load_lds((const unsigned*)(fe_ + 64 * 64 + (wave * 2) * 256 + lane * 4), (LAS unsigned*)(sl_ + (wave * 2) * 1024), 16, 0, 0); \
      __builtin_amdgcn_global_load_lds((const unsigned*)(fe_ + 64 * 64 + (wave * 2 + 1) * 256 + lane * 4), (LAS unsigned*)(sl_ + (wave * 2 + 1) * 1024), 16, 0, 0); \
      __builtin_amdgcn_global_load_lds((const unsigned*)(fe_ + (v0 + (wave & 1) * 4) * 64 + lane * 4), (LAS unsigned*)(sl_ + 16384 + (wave & 1) * 1024), 16, 0, 0); } while (0)
    for (int g = 0; g < PD; ++g) A2_ISSUE(g);
    asm volatile("s_waitcnt vmcnt(0)" ::: "memory"); __builtin_amdgcn_s_barrier();
    float S = 0.f;
    for (int g = 0; g < NSEG; ++g) {
      if (g + PD < NSEG) A2_ISSUE(g + PD);
      p.Sst[(((size_t)ch * NSEG + g) * 64 + v) * 64 + lane] = S;
      if (g + PD < NSEG) asm volatile("s_waitcnt vmcnt(17)" ::: "memory"); else asm volatile("s_waitcnt vmcnt(0)" ::: "memory");
      __builtin_amdgcn_s_barrier();
      const LAS float* P = (const LAS float*)(lds + (g % R) * SLOT) + lane; float a0 = ((const LAS float*)(lds + (g % R) * SLOT + 16384))[wave * 64 + lane], a1 = 0.f, a2 = 0.f, a3 = 0.f;
      LAS float* srow = (LAS float*)(lds + R * SLOT) + wave * 64; srow[lane] = S;
      asm volatile("s_waitcnt lgkmcnt(0)" ::: "memory");
#pragma unroll
      for (int i = 0; i < 64; i += 4) { const f4 s4 = *(const LAS f4*)(srow + i);
        a0 = fma_s(s4.x, P[i * 64], a0); a1 = fma_s(s4.y, P[(i + 1) * 64], a1); a2 = fma_s(s4.z, P[(i + 2) * 64], a2); a3 = fma_s(s4.w, P[(i + 3) * 64], a3); }
      S = (a0 + a1) + (a2 + a3);
    }
#undef A2_ISSUE
    asm volatile("s_waitcnt vmcnt(0)" ::: "memory"); __builtin_amdgcn_s_barrier();
  }
}

#define SB_BF(x) __builtin_bit_cast(float, (unsigned)(x) << 16)
#ifdef HOST_EMU
#define SB_EXP2(x) exp2f(x)
#else
#define SB_EXP2(x) __builtin_amdgcn_exp2f(x)
#endif
#ifdef HOST_EMU
#define SB_OPAQUE_LANE() do {} while (0)
#define SB_WAITL() emu_wave_sync()
#else
#define SB_OPAQUE_LANE() do { int lo_ = lane; asm volatile("" : "+v"(lo_)); lane = lo_; hi = lane >> 5; l31 = lane & 31; } while (0)
#define SB_WAITL() asm volatile("s_waitcnt lgkmcnt(0)" ::: "memory")
#endif
namespace sb {
typedef short bf16x8 __attribute__((ext_vector_type(8)));
typedef float f32x16 __attribute__((ext_vector_type(16)));
constexpr int P144 = 144, P80 = 80;
constexpr int O_PM = 0, O_QM = 4608, O_KH = 9216, O_RH = 13824, O_QT = 18432, O_KT = 23552, O_VT = 28672, O_PM32 = 33792, O_WT = 33792, O_UT = 41984,
              O_AKP = 47104, O_BRQ = 49664, O_BRK = 52224, O_F = 54784, O_GL = 73216, O_CUM = 73472, O_ROW = 74496, UNIT_BYTES = 74752;
constexpr int O_MCT = O_PM, O_REFF = O_KH;
__device__ __forceinline__ int crow(int r, int hi) { return (r & 3) + 8 * (r >> 2) + 4 * hi; }
__device__ __forceinline__ bf16x8 frag(const LAS unsigned char* base, int pitch, int row0, int k0, int lane) {
  return *(const LAS bf16x8*)(base + (row0 + (lane & 31)) * pitch + (k0 + 8 * (lane >> 5)) * 2);
}
#define SB_MMA(acc, a, b) acc = __builtin_amdgcn_mfma_f32_32x32x16_bf16(a, b, acc, 0, 0, 0)
template <int KK> __device__ __forceinline__ void mma_nat(f32x16& acc, const LAS unsigned char* A, int pa, int m0, const LAS unsigned char* B, int pb, int n0, int lane) {
#pragma unroll
  for (int k0 = 0; k0 < KK; k0 += 16) { const bf16x8 a = frag(A, pa, m0, k0, lane), b = frag(B, pb, n0, k0, lane); SB_MMA(acc, a, b); }
}
#ifdef HOST_EMU
inline unsigned pkb(float lo, float hi) { return (unsigned)f2bf(lo) | ((unsigned)f2bf(hi) << 16); }
inline float fnma_sv(float s, float v, float c) { return fmaf(-s, v, c); }
inline float fnma_vv(float s, float v, float c) { return fmaf(-s, v, c); }
#else
__device__ __forceinline__ unsigned pkb(float lo, float hi) { unsigned r; asm("v_cvt_pk_bf16_f32 %0, %1, %2" : "=v"(r) : "v"(lo), "v"(hi)); return r; }
__device__ __forceinline__ float fnma_vv(float a, float v, float c) { float r; asm("v_fma_f32 %0, -%1, %2, %3" : "=v"(r) : "v"(a), "v"(v), "v"(c)); return r; }
__device__ __forceinline__ float fnma_sv(float s, float v, float c) { float r; asm("v_fma_f32 %0, -%1, %2, %3" : "=v"(r) : "s"(s), "v"(v), "v"(c)); return r; }
#endif
__device__ __forceinline__ void store_t(LAS unsigned char* T, int pitch, const f32x16& c, int cofs, int rofs, int lane) {
  LAS unsigned char* rowp = T + (cofs + (lane & 31)) * pitch + (rofs + 4 * (lane >> 5)) * 2;
#pragma unroll
  for (int g = 0; g < 4; ++g) { u2 w; w.x = pkb(c[4 * g], c[4 * g + 1]); w.y = pkb(c[4 * g + 2], c[4 * g + 3]); *(LAS u2*)(rowp + 16 * g) = w; }
}

#define SB_LOAD_CHUNK(cq) do { const int sg = sbeg + (cq) * 32 + 8 * wq + (lane >> 3); size_t row = 0; bool lat = false; const bool ok = sg < send; if (ok) chain_step(d, dd, b, sg, row, lat); \
        const size_t o = row * RW + h * 64 + (lane & 7) * 8; const u4 z4 = {0u, 0u, 0u, 0u}; \
        ld[0] = ok ? *(const u4*)(p.Wd + dd * NRW + o) : z4; ld[1] = ok ? *(const u4*)(p.KK + o) : z4; ld[2] = ok ? *(const u4*)(p.Bb + dd * NRW + o) : z4; \
        ld[3] = ok ? *(const u4*)(p.Kd + dd * NRW + o) : z4; ld[4] = ok ? *(const u4*)(p.Vv + o) : z4; ld[5] = ok ? *(const u4*)(p.Rr + o) : z4; } while (0)
__device__ __forceinline__ void f_scan_b1(const Pm& p, LAS unsigned char* lds, int wave, int lane_in, int NSEG) {
  int lane = lane_in;
  constexpr Dm d = DMC; constexpr int RW = 512; const int SL = (d.C + d.T) / NSEG, NCH = (SL + 31) / 32; const size_t NRW = (size_t)d.NR * RW, BTW = (size_t)d.BT * RW;
  const int NU = 2 * d.B * d.RH * NSEG; const int uq = wave >> 2, wq = wave & 3; int hi = lane >> 5, l31 = lane & 31;
  LAS unsigned char* U = lds + uq * UNIT_BYTES;
  LAS float* GL = (LAS float*)(U + O_GL); LAS float* CUM = (LAS float*)(U + O_CUM); LAS int* ROWT = (LAS int*)(U + O_ROW); LAS float* PM32 = (LAS float*)(U + O_PM32);
  for (int ub = blockIdx.x; ub * 2 < NU; ub += gridDim.x) { const int unit = ub * 2 + uq; const int g = unit % NSEG, ch = unit / NSEG; const int h = ch % d.RH, b = (ch / d.RH) % d.B, dd = ch / (d.RH * d.B);
    const int sbeg = g * SL, send = (g + 1) * SL;
    for (int i = wq * 64 + lane; i < 128 * 32; i += 256) { const int row = i >> 5, c2 = i & 31; unsigned v = 0u; if (row < 64 && (row >> 1) == c2) v = (row & 1) ? 0x3f800000u : 0x00003f80u; *(LAS unsigned*)(U + O_F + row * P144 + c2 * 4) = v; }
    u4 ld[6];
    SB_LOAD_CHUNK(0);
    for (int c = 0; c < NCH; ++c) { const int s0 = sbeg + c * 32;
      f32x16 R[4] = {};
      SB_OPAQUE_LANE();
      {
#pragma unroll
        for (int i = 0; i < 8; ++i) { const int sg = s0 + 8 * wq + i; size_t row = 0; bool lat = false; const bool ok = sg < send; if (ok) chain_step(d, dd, b, sg, row, lat); if (lane == i) ROWT[8 * wq + i] = (ok && lat) ? (int)row : -1; }
        float w8[8], kk8[8], bv8[8], kd8[8], v8[8], r8[8];
        { LAS unsigned char* stg = U + wq * 6144;
#pragma unroll
          for (int v = 0; v < 6; ++v) *(LAS u4*)(stg + v * 1024 + lane * 16) = ld[v];
          SB_WAITL();
#pragma unroll
          for (int i = 0; i < 8; ++i) { const LAS unsigned short* sp = (const LAS unsigned short*)(stg + i * 128) + lane;
            w8[i] = SB_EXP2(SB_BF(sp[0])); kk8[i] = SB_BF(sp[512]); bv8[i] = SB_BF(sp[1024]); kd8[i] = SB_BF(sp[1536]); v8[i] = SB_BF(sp[2048]); r8[i] = SB_BF(sp[2560]); } }
        float cp[8]; cp[0] = w8[0];
#pragma unroll
        for (int i = 1; i < 8; ++i) cp[i] = cp[i - 1] * w8[i];
        CUM[wq * 64 + lane] = cp[7];
        __syncthreads();
        float pre = 1.f;
#pragma unroll
        for (int q = 0; q < 3; ++q) if (q < wq) pre *= CUM[q * 64 + lane];
        unsigned qt[4], kt[4], vt[4];
#pragma unroll
        for (int i = 0; i < 8; ++i) { const int t = 8 * wq + i; const float G = pre * cp[i], Gp = i == 0 ? pre : pre * cp[i - 1], Gi = 1.f / G;
          const float pm = Gp * kk8[i], qm = bv8[i] * Gi, kh = kd8[i] * Gi, rh = G * r8[i];
          *(LAS unsigned short*)(U + O_PM + t * P144 + lane * 2) = f2bf(pm); *(LAS unsigned short*)(U + O_QM + t * P144 + lane * 2) = f2bf(qm);
          *(LAS unsigned short*)(U + O_KH + t * P144 + lane * 2) = f2bf(kh); *(LAS unsigned short*)(U + O_RH + t * P144 + lane * 2) = f2bf(rh);
          PM32[t * 64 + lane] = pm;
          if (i & 1) { qt[i >> 1] |= (unsigned)f2bf(qm) << 16; kt[i >> 1] |= (unsigned)f2bf(kh) << 16; vt[i >> 1] |= (unsigned)f2bf(v8[i]) << 16; }
          else { qt[i >> 1] = f2bf(qm); kt[i >> 1] = f2bf(kh); vt[i >> 1] = f2bf(v8[i]); }
          if (t == 31) GL[lane] = G; }
        *(LAS u4*)(U + O_QT + lane * P80 + 16 * wq) = (u4){qt[0], qt[1], qt[2], qt[3]};
        *(LAS u4*)(U + O_KT + lane * P80 + 16 * wq) = (u4){kt[0], kt[1], kt[2], kt[3]};
        *(LAS u4*)(U + O_VT + lane * P80 + 16 * wq) = (u4){vt[0], vt[1], vt[2], vt[3]}; }
      if (c + 1 < NCH) SB_LOAD_CHUNK(c + 1);
      __syncthreads();
      SB_OPAQUE_LANE();
      if (wq < 2) { float xv[32];
        if (wq == 0) {
#pragma unroll
          for (int t = 0; t < 32; ++t) xv[t] = PM32[t * 64 + lane];
          SB_WAITL(); }
        else { f32x16 akp = {}; mma_nat<64>(akp, U + O_KH, P144, 0, U + O_PM, P144, 0, lane);
#pragma unroll
          for (int r = 0; r < 16; ++r) if (crow(r, hi) >= l31) akp[r] = 0.f;
          store_t(U + O_AKP, P80, akp, 0, 0, lane);
          SB_WAITL();
          f32x16 z0 = {}, z1 = {}; mma_nat<32>(z0, U + O_AKP, P80, 0, U + O_VT, P80, 0, lane); mma_nat<32>(z1, U + O_AKP, P80, 0, U + O_VT, P80, 32, lane);
#pragma unroll
          for (int r = 0; r < 16; ++r) { const float za_ = z0[r], zb_ = z1[r]; auto sw = __builtin_amdgcn_permlane32_swap(__builtin_bit_cast(unsigned, za_), __builtin_bit_cast(unsigned, zb_), false, false);
            const unsigned s0_ = sw[0], s1_ = sw[1]; xv[crow(r, 0)] = __builtin_bit_cast(float, s0_); xv[crow(r, 1)] = __builtin_bit_cast(float, s1_); } }
        f32x16 aqp = {}; mma_nat<64>(aqp, U + O_PM, P144, 0, U + O_QM, P144, 0, lane);
#pragma unroll
        for (int s = 0; s < 31; ++s) { const float xs = xv[s]; float as_[32];
#pragma unroll
          for (int t = s + 1; t < 32; ++t) { const int rt = (t & 3) + 4 * (t >> 3), ht = (t >> 2) & 1; const float af_ = aqp[rt]; const int av = __builtin_bit_cast(int, af_);
            as_[t] = __builtin_bit_cast(float, __builtin_amdgcn_readlane(av, s + 32 * ht)); }
#pragma unroll
          for (int t = s + 1; t < 32; ++t) xv[t] = fnma_sv(as_[t], xs, xv[t]); }
        LAS unsigned char* dst = U + (wq == 0 ? O_WT : O_UT) + lane * P80;
#pragma unroll
        for (int q = 0; q < 4; ++q) *(LAS u4*)(dst + 16 * q) = (u4){pkb(xv[8 * q], xv[8 * q + 1]), pkb(xv[8 * q + 2], xv[8 * q + 3]), pkb(xv[8 * q + 4], xv[8 * q + 5]), pkb(xv[8 * q + 6], xv[8 * q + 7])};
      } else if (wq == 2) { f32x16 t0 = {}; mma_nat<64>(t0, U + O_QM, P144, 0, U + O_RH, P144, 0, lane);
#pragma unroll
        for (int r = 0; r < 16; ++r) if (crow(r, hi) > l31) t0[r] = 0.f;
        store_t(U + O_BRQ, P80, t0, 0, 0, lane);
      } else { f32x16 t0 = {}; mma_nat<64>(t0, U + O_KH, P144, 0, U + O_RH, P144, 0, lane);
#pragma unroll
        for (int r = 0; r < 16; ++r) if (crow(r, hi) > l31) t0[r] = 0.f;
        store_t(U + O_BRK, P80, t0, 0, 0, lane);
        SB_WAITL();
        mma_nat<32>(R[0], U + O_BRK, P80, 0, U + O_VT, P80, 0, lane); mma_nat<32>(R[1], U + O_BRK, P80, 0, U + O_VT, P80, 32, lane); }
      __syncthreads();
      SB_OPAQUE_LANE();
      if (wq == 0) {
#pragma unroll
        for (int kt2 = 0; kt2 < 2; ++kt2) { f32x16 cc = {}; mma_nat<32>(cc, U + O_WT, P80, 32 * kt2, U + O_BRQ, P80, 0, lane);
          const LAS unsigned char* rhp = U + O_RH + l31 * P144 + (32 * kt2 + 4 * hi) * 2; LAS unsigned char* rfp = U + O_REFF + l31 * P144 + (32 * kt2 + 4 * hi) * 2;
#pragma unroll
          for (int gq = 0; gq < 4; ++gq) { const u2 rh = *(const LAS u2*)(rhp + 16 * gq);
            const float a0 = __builtin_bit_cast(float, rh.x << 16) - cc[4 * gq], a1 = __builtin_bit_cast(float, rh.x & 0xffff0000u) - cc[4 * gq + 1], a2 = __builtin_bit_cast(float, rh.y << 16) - cc[4 * gq + 2], a3 = __builtin_bit_cast(float, rh.y & 0xffff0000u) - cc[4 * gq + 3];
            u2 w; w.x = pkb(a0, a1); w.y = pkb(a2, a3); *(LAS u2*)(rfp + 16 * gq) = w; } }
      } else if (wq == 1) {
#pragma unroll
        for (int jt = 0; jt < 2; ++jt)
#pragma unroll
          for (int it = 0; it < 2; ++it) { f32x16 cc = {}; mma_nat<32>(cc, U + O_WT, P80, 32 * jt, U + O_QT, P80, 32 * it, lane);
            const float gl = GL[l31 + 32 * it];
#pragma unroll
            for (int r = 0; r < 16; ++r) cc[r] = gl * (((crow(r, hi) + 32 * jt) == (l31 + 32 * it) ? 1.f : 0.f) - cc[r]);
            store_t(U + O_MCT, P144, cc, 32 * it, 32 * jt, lane); }
      } else if (wq == 2) {
#pragma unroll
        for (int it = 0; it < 2; ++it)
#pragma unroll
          for (int vt2 = 0; vt2 < 2; ++vt2) { f32x16 ca = {}, cb = {}; mma_nat<32>(ca, U + O_KT, P80, 32 * it, U + O_VT, P80, 32 * vt2, lane); mma_nat<32>(cb, U + O_QT, P80, 32 * it, U + O_UT, P80, 32 * vt2, lane);
#pragma unroll
            for (int r = 0; r < 16; ++r) ca[r] = GL[crow(r, hi) + 32 * it] * (ca[r] - cb[r]);
            R[it * 2 + vt2] = ca; }
      } else {
        f32x16 c0 = {}, c1 = {}; mma_nat<32>(c0, U + O_BRQ, P80, 0, U + O_UT, P80, 0, lane); mma_nat<32>(c1, U + O_BRQ, P80, 0, U + O_UT, P80, 32, lane); R[0] = R[0] - c0; R[1] = R[1] - c1; }
      __syncthreads();
      SB_OPAQUE_LANE();
      if (wq == 0) {
        const int row = ROWT[l31];
#pragma unroll
        for (int jt = 0; jt < 2; ++jt) { f32x16 cc = {}; mma_nat<64>(cc, U + O_F, P144, 32 * jt, U + O_REFF, P144, 0, lane);
          if (row >= 0) { float* dst = p.Zt + dd * BTW + (size_t)row * RW + h * 64 + 32 * jt + 4 * hi;
#pragma unroll
            for (int gq = 0; gq < 4; ++gq) *(f4*)(dst + 8 * gq) = (f4){cc[4 * gq], cc[4 * gq + 1], cc[4 * gq + 2], cc[4 * gq + 3]}; } }
      } else if (wq == 3) {
        mma_nat<64>(R[0], U + O_REFF, P144, 0, U + O_F + 64 * P144, P144, 0, lane); mma_nat<64>(R[1], U + O_REFF, P144, 0, U + O_F + 64 * P144, P144, 32, lane);
#pragma unroll
        for (int r = 0; r < 16; ++r) { const int row = ROWT[crow(r, hi)]; if (row >= 0) { float* dst = p.O2 + dd * BTW + (size_t)row * RW + h * 64 + l31; dst[0] = R[0][r]; dst[32] = R[1][r]; } }
      } else {
        const int cbase = wq == 1 ? 0 : 64;
#pragma unroll
        for (int it = 0; it < 2; ++it)
#pragma unroll
          for (int ct = 0; ct < 2; ++ct) mma_nat<64>(R[it * 2 + ct], U + O_MCT, P144, 32 * it, U + O_F + cbase * P144, P144, 32 * ct, lane); }
      __syncthreads();
      if (wq == 1 || wq == 2) { const int cbase = wq == 1 ? 0 : 64;
#pragma unroll
        for (int it = 0; it < 2; ++it)
#pragma unroll
          for (int ct = 0; ct < 2; ++ct) store_t(U + O_F, P144, R[it * 2 + ct], cbase + 32 * ct, 32 * it, lane);
        if (c == NCH - 1) {
          float* fe = p.Fend + ((size_t)ch * NSEG + g) * 128 * 64 + (size_t)(wq == 1 ? 64 : 0) * 64;
#pragma unroll
          for (int it = 0; it < 2; ++it)
#pragma unroll
            for (int ct = 0; ct < 2; ++ct) { float* rp = fe + (size_t)(32 * ct + l31) * 64 + 32 * it + 4 * hi; const f32x16& cc = R[it * 2 + ct];
#pragma unroll
              for (int gq = 0; gq < 4; ++gq) *(f4*)(rp + 8 * gq) = (f4){cc[4 * gq], cc[4 * gq + 1], cc[4 * gq + 2], cc[4 * gq + 3]}; } } }
      __syncthreads();
    }
  }
}
}


template <class F> struct EpiFn {
  static constexpr bool PERM = true, AFTER_DRAIN = false; F f;
  __device__ __forceinline__ void operator()(const pg8::f32x4 (&acc)[2][2][4][2], const pg8::Unit& u, int wr, int wc, int fr, int fq) const {
#pragma unroll
    for (int ai = 0; ai < 2; ++ai)
#pragma unroll
      for (int m = 0; m < 4; ++m) { const int row = u.pm * 256 + ai * 128 + wr * 64 + m * 16 + fr;
#pragma unroll
        for (int bj = 0; bj < 2; ++bj) { const int col = u.pn * 256 + bj * 128 + wc * 32 + 8 * fq; f(u, row, col, acc[ai][bj][m][0], acc[ai][bj][m][1]); asm volatile("" ::: "memory"); } }
  }
};
template <class F> __device__ __forceinline__ void run_gemm(LAS unsigned char* lds, const bf16_t* A, const bf16_t* Bt, int M, int N, int K, F f, const int tid_in, const int* tile_e = nullptr, size_t bexp = 0) {
  asm volatile("" : "+s"(M), "+s"(N), "+s"(K));
  pg8::Gemm g{A, Bt, M, N, K, bexp}; pg8::StaticOrder S; S.init(M, N, (int)gridDim.x, (int)blockIdx.x, tile_e);
  EpiFn<F> E{f};
  pg8::gemm_phase<EpiFn<F>, pg8::StaticOrder, true, true>((PG8_LAS unsigned char*)lds, g, S, E, tid_in);
}

__device__ __forceinline__ unsigned pk2(float lo, float hi) { return (unsigned)f2bf(lo) | ((unsigned)f2bf(hi) << 16); }
__device__ __forceinline__ void transpose_all(const float* W, int K, int N, bf16_t* WT, int gw, int ngw, int lane) {
  const int nblk = N / 64, items = (K / 64) * nblk;
  for (int it = gw; it < items; it += ngw) { const int kb = it / nblk, nb = it % nblk; const float* src = W + (size_t)(kb * 64) * N + nb * 64 + lane; float x[64];
#pragma unroll
    for (int j = 0; j < 64; ++j) x[j] = src[(size_t)j * N];
    bf16_t* dst = WT + (size_t)(nb * 64 + lane) * K + kb * 64;
#pragma unroll
    for (int c = 0; c < 8; ++c) { v4u o; o.x = pk2(x[8 * c], x[8 * c + 1]); o.y = pk2(x[8 * c + 2], x[8 * c + 3]); o.z = pk2(x[8 * c + 4], x[8 * c + 5]); o.w = pk2(x[8 * c + 6], x[8 * c + 7]); *(v4u*)(dst + 8 * c) = o; } }
}

constexpr int INP = 2304;

__global__ void __launch_bounds__(NTHREADS, 2) fwd(Pm p, unsigned* bar) {
  extern __shared__ __attribute__((aligned(16))) unsigned char lds_raw[];
  LAS unsigned char* lds = (LAS unsigned char*)lds_raw;
#define IDS() int tidb; asm volatile("v_mbcnt_lo_u32_b32 %0, -1, 0\n\tv_mbcnt_hi_u32_b32 %0, -1, %0" : "=v"(tidb)); tidb += wave_s * 64; const int lane = tidb & 63, wave = __builtin_amdgcn_readfirstlane(tidb >> 6); \
    const long tid = (long)blockIdx.x * NTHREADS + tidb, nth = (long)gridDim.x * NTHREADS; const int gw = blockIdx.x * NWAVES + wave, ngw = gridDim.x * NWAVES; \
    (void)lane; (void)wave; (void)tid; (void)nth; (void)gw; (void)ngw
  for (int u = threadIdx.x; u < (LDS_BYTES - RING_BYTES) / 4; u += NTHREADS) ((LAS unsigned*)(lds + RING_BYTES))[u] = 0u;
  __syncthreads();
  const int wave_s = __builtin_amdgcn_readfirstlane((int)threadIdx.x >> 6);
  XcdBarrier xb = xcd_barrier_post(bar, (volatile LAS unsigned*)(lds + MISC_OFF + 32));
  constexpr Dm d = DMC;
#define GSYNC() xcd_barrier(xb)
  constexpr int NSEG = 32;
#define NPOS() __builtin_amdgcn_readfirstlane(__hip_atomic_load(p.npos, __ATOMIC_RELAXED, __HIP_MEMORY_SCOPE_AGENT))
  {
  IDS();
  f_mod_partial(p, tidb); f_rope_table(p, tid, nth); f_lora_weights(p, tid, nth);
  transpose_all(p.w_in, d.D, d.IN, p.WinT, gw, ngw, lane);
  for (long i = tid; i < (long)(INP - d.IN) * d.D; i += nth) p.WinT[(size_t)d.IN * d.D + i] = 0;
  transpose_all(p.w_uq, d.QL, d.MH * d.QK, p.WuqT, gw, ngw, lane);
  transpose_all(p.w_ukv, d.KL, d.MH * (d.DN + d.DV), p.WukvT, gw, ngw, lane);
  transpose_all(p.w_out, d.MIX, d.D, p.WoutT, gw, ngw, lane);
for (int it = gw; it < d.NE * 768; it += ngw) { const int e = it / 768, r = it % 768; const bool first = r < 512; const int rr = first ? r : r - 512; const int N = first ? 2048 : 1024, nblk = N / 64, kb = rr / nblk, nb = rr % nblk;
    const float* src = (first ? p.exp_w1 + (size_t)e * 1024 * 2048 : p.exp_w2 + (size_t)e * 1024 * 1024) + (size_t)(kb * 64) * N + nb * 64 + lane; float x[64];
#pragma unroll
    for (int j = 0; j < 64; ++j) x[j] = __builtin_nontemporal_load(src + (size_t)j * N);
    bf16_t* dst = (first ? p.W1T + (size_t)e * 2048 * 1024 : p.W2T + (size_t)e * 1024 * 1024) + (size_t)(nb * 64 + lane) * 1024 + kb * 64;
#pragma unroll
    for (int c = 0; c < 8; ++c) { v4u o; o.x = pk2(x[8 * c], x[8 * c + 1]); o.y = pk2(x[8 * c + 2], x[8 * c + 3]); o.z = pk2(x[8 * c + 4], x[8 * c + 5]); o.w = pk2(x[8 * c + 6], x[8 * c + 7]); *(v4u*)(dst + 8 * c) = o; } }
    }
  GSYNC();
  {
  IDS();

  { f_mod_reduce(p, (LAS float*)lds, tidb); f_norm1(p, (const LAS float*)lds, gw, ngw, lane); }   }
  GSYNC();
  {
  IDS();

{ bf16_t* P = p.P; const int IN = d.IN;
    run_gemm(lds, p.A1, p.WinT, d.NR, INP, d.D, [=](const pg8::Unit& u, int row, int col, pg8::f32x4 v0, pg8::f32x4 v1) {
      if (col < IN) { v4u w; w.x = pk2(v0[0], v0[1]); w.y = pk2(v0[2], v0[3]); w.z = pk2(v1[0], v1[1]); w.w = pk2(v1[2], v1[3]); *(v4u*)(P + (size_t)row * IN + col) = w; } }, tidb); }
  }
  GSYNC();
  {
  IDS();

  { f_mla_a(p, gw, ngw, lane); f_rwkv_s1(p, gw, ngw, lane); }   }
  GSYNC();
  {
  IDS();

{ bf16_t* Q = p.Q; const float* ropet = p.ropet;
    run_gemm(lds, p.QN, p.WuqT, d.BT, 768, 256, [=](const pg8::Unit& u, int row, int col, pg8::f32x4 v0, pg8::f32x4 v1) {
      const int h = col / 192, i0 = col - h * 192, b = row >> 13, t = row & 8191;
      float x[8] = {v0[0], v0[1], v0[2], v0[3], v1[0], v1[1], v1[2], v1[3]}, pr[8];
#pragma unroll
      for (int e = 0; e < 8; ++e) pr[e] = __shfl_xor(x[e], 32);
      if (i0 >= 128) { const int i = i0 - 128, a = i >> 5, half = (i >> 4) & 1, f0 = i & 15; const float* ct = ropet + ((size_t)t * 32 + a * 16 + f0) * 2;
#pragma unroll
        for (int e = 0; e < 8; ++e) { const float c = ct[2 * e], s = ct[2 * e + 1]; x[e] = half ? x[e] * c + pr[e] * s : x[e] * c - pr[e] * s; } }
      v4u w; w.x = pk2(x[0], x[1]); w.y = pk2(x[2], x[3]); w.z = pk2(x[4], x[5]); w.w = pk2(x[6], x[7]);
      *(v4u*)(Q + ((size_t)(b * 4 + h) * 8192 + t) * 192 + i0) = w; }, tidb); }
{ bf16_t* K = p.K; bf16_t* V = p.V; const int BT = d.BT;
    run_gemm(lds, p.CN, p.WukvT, d.NR, 1024, 128, [=](const pg8::Unit& u, int row, int col, pg8::f32x4 v0, pg8::f32x4 v1) {
      const int h = col >> 8, i0 = col & 255; int b, key; if (row < BT) { b = row >> 13; key = 256 + (row & 8191); } else { b = (row - BT) >> 8; key = (row - BT) & 255; }
      v4u w; w.x = pk2(v0[0], v0[1]); w.y = pk2(v0[2], v0[3]); w.z = pk2(v1[0], v1[1]); w.w = pk2(v1[2], v1[3]);
      const size_t kr = (size_t)(b * 4 + h) * 8448 + key;
      if (i0 < 128) *(v4u*)(K + kr * 192 + i0) = w; else *(v4u*)(V + kr * 128 + (i0 - 128)) = w; }, tidb); }
{ bf16_t* Wd = p.Wd; bf16_t* Bb = p.Bb; bf16_t* Kd = p.Kd; const bf16_t* KK = p.KK; const float* Kraw = p.Kraw; const float* w0 = p.w0; const float* a0 = p.a0; const float* k_a = p.k_a; const size_t NRW = (size_t)d.NR * 512;
    run_gemm(lds, p.AL1, p.WlT, d.NR, 2048, 128, [=](const pg8::Unit& u, int row, int col, pg8::f32x4 v0, pg8::f32x4 v1) {
      float x[8] = {v0[0], v0[1], v0[2], v0[3], v1[0], v1[1], v1[2], v1[3]};
      if (col < 1024) { const int dd = col >> 9, c = col & 511; const float* wb = w0 + dd * 512 + c; float o[8];
#pragma unroll
        for (int e = 0; e < 8; ++e) o[e] = -0.87503576f / (1.f + __expf(-(x[e] + wb[e])));
        v4u w; w.x = pk2(o[0], o[1]); w.y = pk2(o[2], o[3]); w.z = pk2(o[4], o[5]); w.w = pk2(o[6], o[7]); *(v4u*)(Wd + (size_t)dd * NRW + (size_t)row * 512 + c) = w; }
      else { const int q = col - 1024, dd = q >> 9, c = q & 511; const float* ab = a0 + dd * 512 + c; const v4u kk4 = *(const v4u*)(KK + (size_t)row * 512 + c); const float* kp = Kraw + (size_t)row * 512 + c; float ob[8], ok[8];
        const unsigned kw[4] = {kk4.x, kk4.y, kk4.z, kk4.w};
#pragma unroll
        for (int e = 0; e < 8; ++e) { const float a = 1.f / (1.f + __expf(-(x[e] + ab[e]))); const float kkv = __builtin_bit_cast(float, (e & 1) ? (kw[e >> 1] & 0xffff0000u) : (kw[e >> 1] << 16)); ob[e] = kkv * a; ok[e] = kp[e] * (1.f + (a - 1.f) * k_a[c + e]); }
        v4u w1; w1.x = pk2(ob[0], ob[1]); w1.y = pk2(ob[2], ob[3]); w1.z = pk2(ob[4], ob[5]); w1.w = pk2(ob[6], ob[7]); *(v4u*)(Bb + (size_t)dd * NRW + (size_t)row * 512 + c) = w1;
        v4u w2; w2.x = pk2(ok[0], ok[1]); w2.y = pk2(ok[2], ok[3]); w2.z = pk2(ok[4], ok[5]); w2.w = pk2(ok[6], ok[7]); *(v4u*)(Kd + (size_t)dd * NRW + (size_t)row * 512 + c) = w2; } }, tidb); }
  { float* Gt = p.Gt;
    run_gemm(lds, p.AL2, p.G2T, d.BT, 512, 128, [=](const pg8::Unit& u, int row, int col, pg8::f32x4 v0, pg8::f32x4 v1) { float* o = Gt + (size_t)row * 512 + col; *(pg8::f32x4*)o = v0; *(pg8::f32x4*)(o + 4) = v1; }, tidb); }
    }
  GSYNC();
  {
  IDS();

sb::f_scan_b1(p, lds, wave, lane, NSEG);   }
  GSYNC();
  {
  IDS();
f_scan_a2(p, lds, wave, lane, NSEG);   }
  GSYNC();
  {
  IDS();

ph_scan_a3(p, gw, ngw, lane, NSEG);
for (int u = blockIdx.x; u < d.B * d.MH * (d.T / 256); u += gridDim.x) { const int bh = u % (d.B * d.MH), qb = u / (d.B * d.MH), b = bh / d.MH, h = bh % d.MH; const int NK = d.C + d.T;
    attn::attn_dense_body(p.Q + ((size_t)bh * d.T + (size_t)qb * 256) * attn::DQK, p.K + (size_t)bh * NK * attn::DQK, p.V + (size_t)bh * NK * attn::DV,
                          p.MIXb + ((size_t)b * d.T + (size_t)qb * 256) * d.MIX + d.RW + h * attn::DV, NK, (char*)lds_raw, tidb); }
    }
  GSYNC();
  {
  IDS();

f_readout(p, gw, ngw, lane);   }
  GSYNC();
  {
  IDS();

{ float* x1 = p.x1; const float* x = p.x; const float* modv = p.modv; const int D = d.D, T = d.T;
    run_gemm(lds, p.MIXb, p.WoutT, d.BT, D, d.MIX, [=](const pg8::Unit& u, int row, int col, pg8::f32x4 v0, pg8::f32x4 v1) {
      const float* g = modv + (size_t)(row / T) * 6 * D + 2 * D + col; const float* xr = x + (size_t)row * D + col; float* o = x1 + (size_t)row * D + col;
      const pg8::f32x4 g0 = *(const pg8::f32x4*)g, g1 = *(const pg8::f32x4*)(g + 4), x0 = *(const pg8::f32x4*)xr, x1v = *(const pg8::f32x4*)(xr + 4);
      *(pg8::f32x4*)o = x0 + g0 * v0; *(pg8::f32x4*)(o + 4) = x1v + g1 * v1; }, tidb); }
    }
  GSYNC();
  {
  IDS();

f_route(p, lds, wave, lane, tidb);
  }
  GSYNC();
  {
  IDS();
f_place(p, lds, wave, lane, tidb);
  }
  GSYNC();
  {
  IDS();
  const int npos = NPOS();
{ bf16_t* ACT = p.ACTb; const float* b1 = p.exp_b1; const int DE = d.DE;
    run_gemm(lds, p.Xg, p.W1T, npos, 2 * d.DE, d.D, [=](const pg8::Unit& u, int row, int col, pg8::f32x4 v0, pg8::f32x4 v1) {
      const float* bb = b1 + (size_t)u.eb * 2 * DE + col; const pg8::f32x4 c0 = *(const pg8::f32x4*)bb, c1 = *(const pg8::f32x4*)(bb + 4);
      v0 = v0 + c0; v1 = v1 + c1; float o[4];
#pragma unroll
      for (int q = 0; q < 4; ++q) { const float gl = fminf(q < 2 ? v0[2 * q] : v1[2 * q - 4], 7.f), li = fminf(fmaxf(q < 2 ? v0[2 * q + 1] : v1[2 * q - 3], -7.f), 7.f);
        o[q] = gl * (li + 1.f) / (1.f + __expf(-1.702f * gl)); }
      uint2 w; w.x = pk2(o[0], o[1]); w.y = pk2(o[2], o[3]); *(uint2*)(ACT + (size_t)row * DE + (col >> 1)) = w; }, tidb, p.tile_e, (size_t)2 * d.DE * d.D * 2); }
    }
  GSYNC();
  {
  IDS();

  const int npos = NPOS();
{ bf16_t* Y = p.Yb; const float* b2 = p.exp_b2; const int D = d.D;
    run_gemm(lds, p.ACTb, p.W2T, npos, d.D, d.DE, [=](const pg8::Unit& u, int row, int col, pg8::f32x4 v0, pg8::f32x4 v1) {
      const float* bb = b2 + (size_t)u.eb * D + col; const pg8::f32x4 c0 = *(const pg8::f32x4*)bb, c1 = *(const pg8::f32x4*)(bb + 4);
      v0 = v0 + c0; v1 = v1 + c1; v4u w; w.x = pk2(v0[0], v0[1]); w.y = pk2(v0[2], v0[3]); w.z = pk2(v1[0], v1[1]); w.w = pk2(v1[2], v1[3]);
      *(v4u*)(Y + (size_t)row * D + col) = w; }, tidb, p.tile_e, (size_t)d.D * d.DE * 2); }
    }
  GSYNC();
  {
  IDS();

f_final(p, gw, ngw, lane);
  }
}

static size_t carve(Pm& p, char* base) {
  const Dm& d = p.d; size_t off = 0;
#define CARVE(ptr, type, count) do { p.ptr = (type*)(base + off); off += (((size_t)(count) * sizeof(type)) + 255) / 256 * 256; } while (0)
  const size_t NRW = (size_t)d.NR * d.RW; const int NK = d.C + d.T;
  CARVE(modv, float, (size_t)(d.B + 1) * 6 * d.D); CARVE(modp, float, (size_t)16 * 3 * 6 * d.D); CARVE(ropet, float, (size_t)d.T * 64);
  CARVE(top_e, int, (size_t)d.BT * 4); CARVE(cnt, int, d.NE); CARVE(slot_pos, int, (size_t)d.BT * 4); CARVE(pos_tok, int, d.NPOSMAX); CARVE(tile_e, int, d.NPOSMAX / d.PADR + 1); CARVE(npos, int, 4);
  CARVE(gate, float, (size_t)d.BT * 4); CARVE(lrank, int, (size_t)d.BT * 4); CARVE(blkcnt, int, 1024 * 32);
  CARVE(WlT, bf16_t, (size_t)2048 * 128); CARVE(G2T, bf16_t, (size_t)512 * 128);
  CARVE(WinT, bf16_t, (size_t)INP * d.D); CARVE(WuqT, bf16_t, (size_t)d.MH * d.QK * d.QL); CARVE(WukvT, bf16_t, (size_t)d.MH * (d.DN + d.DV) * d.KL); CARVE(WoutT, bf16_t, (size_t)d.D * d.MIX);
  CARVE(W1T, bf16_t, (size_t)d.NE * 2 * d.DE * d.D); CARVE(W2T, bf16_t, (size_t)d.NE * d.D * d.DE);
  const size_t early0 = off;
  CARVE(P, bf16_t, (size_t)d.NR * d.IN); CARVE(A1, bf16_t, (size_t)d.NR * d.D);
  const size_t after_p = off;
  CARVE(Kraw, float, NRW); CARVE(AL1, bf16_t, (size_t)d.NR * 128); CARVE(AL2, bf16_t, (size_t)d.BT * 128); CARVE(Rr, bf16_t, NRW); CARVE(Vv, bf16_t, NRW); CARVE(KK, bf16_t, NRW); CARVE(Kd, bf16_t, 2 * NRW); CARVE(Wd, bf16_t, 2 * NRW); CARVE(Bb, bf16_t, 2 * NRW);
  CARVE(Gt, float, (size_t)d.BT * d.RW); CARVE(QN, bf16_t, (size_t)d.BT * d.QL); CARVE(CN, bf16_t, (size_t)d.NR * d.KL);
  CARVE(O2, float, (size_t)2 * d.BT * d.RW);
  CARVE(Q, bf16_t, (size_t)d.B * d.MH * d.T * d.QK); CARVE(K, bf16_t, (size_t)d.B * d.MH * NK * d.QK); CARVE(V, bf16_t, (size_t)d.B * d.MH * NK * d.DV);
  CARVE(MIXb, bf16_t, (size_t)d.BT * d.MIX);
  size_t end1 = off;
  off = early0; CARVE(x1, float, (size_t)d.BT * d.D); CARVE(H2b, bf16_t, (size_t)d.BT * d.D);
  if (off > after_p) return (size_t)-1;
  off = after_p; CARVE(Xg, bf16_t, (size_t)d.NPOSMAX * d.D); CARVE(ACTb, bf16_t, (size_t)d.NPOSMAX * d.DE); CARVE(Yb, bf16_t, (size_t)d.NPOSMAX * d.D);
  if (off > end1) end1 = off;
  off = end1; CARVE(Zt, float, (size_t)2 * d.BT * d.RW); CARVE(Fend, float, (size_t)2 * d.B * d.RH * 32 * 128 * 64); CARVE(Sst, float, (size_t)2 * d.B * d.RH * 32 * 64 * 64); end1 = off;
#undef CARVE
  return end1;
}

extern "C" void kernel_launch(void* const* d_in, const int* in_sizes, int n_in, void* d_out, int out_size, void* d_ws, size_t ws_size, hipStream_t stream) {
  static int grid = 0;
  if (!grid) {
    int dev = 0, cus = 0;
    hipGetDevice(&dev); hipDeviceGetAttribute(&cus, hipDeviceAttributeMultiprocessorCount, dev);
    if (hipFuncSetAttribute((const void*)fwd, hipFuncAttributeMaxDynamicSharedMemorySize, LDS_BYTES) != hipSuccess) { fprintf(stderr, "kernel_launch: hipFuncSetAttribute failed\n"); grid = -1; return; }
    grid = cus;
  }
  if (grid < 0) return;
  Pm p; memset(&p, 0, sizeof(p));
  Dm& d = p.d; d.D = 1024; d.B = 2; d.T = 8192; d.GW = 64; d.C = 256; d.RH = 8; d.LW = 64; d.LA = 64; d.LG = 128; d.MH = 4; d.DN = 128; d.DR = 64; d.DV = 128; d.QL = 256; d.KL = 128;
  d.NE = 32; d.DE = 1024; d.PADR = 256; dm_finish(d);
  const float** ip = &p.x; for (int i = 0; i < 32; ++i) ip[i] = (const float*)d_in[i];
  p.out = (float*)d_out;
  unsigned* bar = (unsigned*)d_ws;
  const size_t used = carve(p, (char*)d_ws + 16384);
  if (used == (size_t)-1 || used + 16384 > ws_size) { fprintf(stderr, "kernel_launch: workspace too small (%zu needed, %zu given)\n", used + 16384, ws_size); return; }
  static bool once = false; if (!once) { once = true; fprintf(stderr, "ws used %zu of %zu\n", used + 16384, ws_size); }
  hipMemsetAsync(bar, 0, 16384, stream);
  hipLaunchKernelGGL(fwd, dim3(grid), dim3(NTHREADS), LDS_BYTES, stream, p, bar);
}
```

```cpp
#include <hip/hip_runtime.h>
#include <cstdio>
#include <cstring>
#include <cstdint>
#define HD __host__ __device__
#ifndef HD
#define HD
#endif
struct Dm {
  int D, B, T, GW, C, RH, LW, LA, LG, MH, DN, DR, DV, QL, KL, NE, DE;
  int RW, RC, QK, MC, IN, MIX, NF, BT, BC, NR, PADR, NPOSMAX, pad_;
};
HD constexpr void dm_finish(Dm& d) {
  d.RW = d.RH * 64; d.RC = 3 * d.RW + d.LW + d.LA + d.LG; d.QK = d.DN + d.DR; d.MC = d.QL + d.KL + d.DR; d.IN = d.RC + d.MC;
  d.MIX = d.RW + d.MH * d.DV; d.NF = d.DR / 4; d.BT = d.B * d.T; d.BC = d.B * d.C; d.NR = d.BT + d.BC;
  d.NPOSMAX = d.BT * 4 + d.NE * d.PADR;
}
typedef unsigned short bf16_t;
HD inline bf16_t f2bf(float f) { unsigned u = __builtin_bit_cast(unsigned, f); return (bf16_t)((u + 0x7fffu + ((u >> 16) & 1u)) >> 16); }
HD inline float bf2f(bf16_t h) { return __builtin_bit_cast(float, (unsigned)h << 16); }
HD constexpr Dm make_dmc() { Dm d{}; d.D = 1024; d.B = 2; d.T = 8192; d.GW = 64; d.C = 256; d.RH = 8; d.LW = 64; d.LA = 64; d.LG = 128; d.MH = 4; d.DN = 128; d.DR = 64; d.DV = 128; d.QL = 256; d.KL = 128;
  d.NE = 32; d.DE = 1024; d.PADR = 256; dm_finish(d); return d; }
constexpr Dm DMC = make_dmc();
typedef float f4q __attribute__((ext_vector_type(4)));
typedef unsigned u4q __attribute__((ext_vector_type(4)));
struct Pm {
  Dm d; int reps[24];
  const float *x, *c, *ctx, *c_ctx, *mod_w, *mod_b, *norm1_g, *w_in, *mu, *w0, *w2, *a0, *a2, *k_k, *k_a, *r_k, *g2, *ln_w, *ln_b, *q_norm, *w_uq, *kv_norm,
      *w_ukv, *w_out, *norm2_g, *router_w, *router_b, *exp_w1, *exp_b1, *exp_w2, *exp_b2, *final_g;
  float* out;
  float *modv, *modp, *ropet, *Kraw, *Gt, *O2, *Fend, *Sst, *x1, *gate;
  bf16_t *A1, *QN, *CN, *MIXb, *WinT, *WuqT, *WukvT, *WoutT, *W1T, *W2T, *H2b, *Xg, *ACTb, *Yb, *Q, *K, *V, *AL1, *AL2, *WlT, *G2T, *P, *Zt, *Rr, *Vv, *KK, *Kd, *Wd, *Bb;
  int *top_e, *cnt, *slot_pos, *pos_tok, *tile_e, *npos, *lrank, *blkcnt;
};
HD inline float sigmoidf_(float x) { return 1.f / (1.f + expf(-x)); }

template <int TM, class Epi>
HD inline void gemm_naive(const float* A, int lda, const float* Bm, int ldb, int M, int N, int K, long tid, long nth, Epi epi) {
  const long ngm = (M + TM - 1) / TM, items = ngm * N;
  for (long it = tid; it < items; it += nth) {
    const int n = (int)(it % N); const long m0 = (it / N) * TM;
    float acc[TM];
#pragma unroll
    for (int i = 0; i < TM; ++i) acc[i] = 0.f;
    const float* a[TM];
#pragma unroll
    for (int i = 0; i < TM; ++i) a[i] = A + (size_t)((m0 + i < M) ? (m0 + i) : (M - 1)) * lda;
    for (int k = 0; k < K; k += 4) {
      const float b0 = Bm[(size_t)k * ldb + n], b1 = Bm[(size_t)(k + 1) * ldb + n], b2 = Bm[(size_t)(k + 2) * ldb + n], b3 = Bm[(size_t)(k + 3) * ldb + n];
#pragma unroll
      for (int i = 0; i < TM; ++i) { acc[i] += a[i][k] * b0; acc[i] += a[i][k + 1] * b1; acc[i] += a[i][k + 2] * b2; acc[i] += a[i][k + 3] * b3; }
    }
#pragma unroll
    for (int i = 0; i < TM; ++i) if (m0 + i < M) epi(m0 + i, n, acc[i]);
  }
}

HD inline void row_pos(const Dm& d, long row, int& t, int& len, int& b, int& isctx) {
  if (row < d.BT) { b = (int)(row / d.T); t = (int)(row % d.T); len = d.T; isctx = 0; } else { const long r = row - d.BT; b = (int)(r / d.C); t = (int)(r % d.C); len = d.C; isctx = 1; }
}

HD inline void chain_step(const Dm& d, int dd, int b, int sg, size_t& row, bool& lat) {
  if (sg < d.C) { const int t = dd == 0 ? sg : d.C - 1 - sg; row = (size_t)d.BT + (size_t)b * d.C + t; lat = false; }
  else { const int s = sg - d.C; const int t = dd == 0 ? s : d.T - 1 - s; row = (size_t)b * d.T + t; lat = true; }
}
__device__ inline void ph_scan_a2(const Pm& p, int gw, int ngw, int lane, int NSEG) {
  constexpr Dm d = DMC; const int items = 2 * d.B * d.RH * 64;
  for (int it = gw; it < items; it += ngw) { const int v = it % 64, ch = it / 64; float S = 0.f; float pf[64], pn[64]; float sl, sln;
    { const float* fe = p.Fend + ((size_t)ch * NSEG) * 128 * 64; sl = fe[(size_t)v * 64 + lane];
#pragma unroll
      for (int i = 0; i < 64; ++i) pf[i] = fe[(size_t)(64 + i) * 64 + lane]; }
    for (int g = 0; g < NSEG; ++g) { p.Sst[(((size_t)ch * NSEG + g) * 64 + v) * 64 + lane] = S;
      const int gn = g + 1 < NSEG ? g + 1 : g; const float* fe = p.Fend + ((size_t)ch * NSEG + gn) * 128 * 64; sln = fe[(size_t)v * 64 + lane];
#pragma unroll
      for (int i = 0; i < 64; ++i) pn[i] = fe[(size_t)(64 + i) * 64 + lane];
      float a0 = sl, a1 = 0.f, a2 = 0.f, a3 = 0.f;
#pragma unroll
      for (int i = 0; i < 64; i += 4) { const int Sb = __builtin_bit_cast(int, S);
        a0 += __builtin_bit_cast(float, __builtin_amdgcn_readlane(Sb, i)) * pf[i]; a1 += __builtin_bit_cast(float, __builtin_amdgcn_readlane(Sb, i + 1)) * pf[i + 1];
        a2 += __builtin_bit_cast(float, __builtin_amdgcn_readlane(Sb, i + 2)) * pf[i + 2]; a3 += __builtin_bit_cast(float, __builtin_amdgcn_readlane(Sb, i + 3)) * pf[i + 3]; }
      S = (a0 + a1) + (a2 + a3); sl = sln;
#pragma unroll
      for (int i = 0; i < 64; ++i) pf[i] = pn[i]; } }
}
__device__ inline void ph_scan_a3(const Pm& p, int gw, int ngw, int lane, int NSEG) {
  constexpr Dm d = DMC; const int RW = d.RW; const int SL = (d.C + d.T) / NSEG; const size_t BTW = (size_t)d.BT * RW; constexpr int PARTS = 2;
  const int items = 2 * d.B * d.RH * NSEG * PARTS;
  for (int it = gw; it < items; it += ngw) { const int part = it % PARTS, g = (it / PARTS) % NSEG, ch = it / (PARTS * NSEG); const int h = ch % d.RH, b = (ch / d.RH) % d.B, dd = ch / (d.RH * d.B);
    const float* st = p.Sst + (((size_t)ch * NSEG + g) * 64 + lane) * 64; float S[64];
#pragma unroll
    for (int i = 0; i < 64; i += 4) { const f4q x = *(const f4q*)(st + i); S[i] = x.x; S[i + 1] = x.y; S[i + 2] = x.z; S[i + 3] = x.w; }
    const int s0 = g * SL + part * (SL / PARTS), s1 = part == PARTS - 1 ? (g + 1) * SL : s0 + SL / PARTS;
    for (int sg = s0; sg < s1; ++sg) { size_t row; bool lat; chain_step(d, dd, b, sg, row, lat); if (!lat) continue;
      const size_t o = row * RW + h * 64; const bf16_t* z = p.Zt + dd * BTW + o; float a = p.O2[dd * BTW + o + lane];
#pragma unroll
      for (int i = 0; i < 64; i += 8) { const u4q x = *(const u4q*)(z + i);
        a += S[i] * __builtin_bit_cast(float, x.x << 16) + S[i + 1] * __builtin_bit_cast(float, x.x & 0xffff0000u) + S[i + 2] * __builtin_bit_cast(float, x.y << 16) + S[i + 3] * __builtin_bit_cast(float, x.y & 0xffff0000u)
           + S[i + 4] * __builtin_bit_cast(float, x.z << 16) + S[i + 5] * __builtin_bit_cast(float, x.z & 0xffff0000u) + S[i + 6] * __builtin_bit_cast(float, x.w << 16) + S[i + 7] * __builtin_bit_cast(float, x.w & 0xffff0000u); }
      p.O2[dd * BTW + o + lane] = a; } }
}

namespace pg8 {
#define PG8_LAS __attribute__((address_space(3)))
typedef unsigned short bf16_t;
typedef short bf16x8 __attribute__((ext_vector_type(8)));
typedef float f32x4 __attribute__((ext_vector_type(4)));
typedef unsigned u32x4 __attribute__((ext_vector_type(4)));
constexpr int BM = 256, BK = 64, HALF = 128, HTB = HALF * BK * 2  , STAGE_BYTES = 8 * HTB, NXCD = 8, WGM = 8;

__host__ __device__ __forceinline__ int lds_byte(int r, int c) { const int st = (r >> 4) * 2 + (c >> 5), rr = r & 15, cc = c & 31, ob = rr * 64 + cc * 2; return st * 1024 + (ob ^ (((ob >> 9) & 1) << 5)); }
__host__ __device__ __forceinline__ void stage_rc(int b, int& R, int& C) { const int st = b / 1024, sb = b % 1024, swz = sb ^ (((sb >> 9) & 1) << 5); R = (st >> 1) * 16 + swz / 64; C = (st & 1) * 32 + (swz % 64) / 2; }
__host__ __device__ __forceinline__ int perm32(int rho) { const int n = rho >> 4, i = rho & 15; return 8 * (i >> 2) + 4 * n + (i & 3); }

struct Unit { int pm, pn, eb; };
struct Gemm { const bf16_t* A; const bf16_t* Bt; int M, N, K; size_t bexp; };

struct StaticOrder {
    int nM, nN, nwg, G, c; const int* tile_e;
    __host__ __device__ void init(int M, int N, int G_, int c_, const int* te = nullptr) { nM = M / BM; nN = N / BM; nwg = nM * nN; G = G_; c = c_; tile_e = te; }
    __device__ bool next(int i, Unit& u) const {
        const long L = (long)i * G + c; if (L >= nwg) return false;
        int wgid = (int)L; { const int q = nwg / NXCD, r = nwg % NXCD, xcd = wgid % NXCD, off = wgid / NXCD; wgid = (xcd < r ? xcd * (q + 1) : r * (q + 1) + (xcd - r) * q) + off; }
        const int nig = WGM * nN, gid = wgid / nig, fm = gid * WGM, gsz = (nM - fm) < WGM ? (nM - fm) : WGM;
        u.pm = fm + ((wgid % nig) % gsz); u.pn = (wgid % nig) / gsz; u.eb = tile_e ? __builtin_amdgcn_readfirstlane(__hip_atomic_load(tile_e + u.pm, __ATOMIC_RELAXED, __HIP_MEMORY_SCOPE_AGENT)) : 0; return true;
    }
    __device__ __forceinline__ void a_ready(const Unit&) const {}
    __device__ __forceinline__ void done(const Unit&) const {}
};
__device__ __forceinline__ unsigned cvt_pk_bf16(float lo, float hi) { unsigned r; asm volatile("v_cvt_pk_bf16_f32 %0, %1, %2" : "=v"(r) : "v"(lo), "v"(hi)); return r; }
typedef float f32x2 __attribute__((ext_vector_type(2)));
template <class Epi, class Sched, bool ALIGN_EPI = false, bool SP2 = false>
__device__ __forceinline__ void gemm_phase(PG8_LAS unsigned char* lds, const Gemm g, const Sched& S, const Epi& E, const int tid_in) {
    int tid_ = tid_in; asm volatile("" : "+v"(tid_));
    const int tid = tid_, wid = __builtin_amdgcn_readfirstlane(tid >> 6), lane = tid & 63, wr = wid >> 2, wc = wid & 3, fr = lane & 15, fq = lane >> 4;
    const int K = g.K, nt = K / BK;
    unsigned voffA[2], voffB[2];
#pragma unroll
    for (int i = 0; i < 2; ++i) { int R, C; stage_rc(tid * 16 + i * 8192, R, C); const int Rb = Epi::PERM ? ((R & ~31) + perm32(R & 31)) : R;
        voffA[i] = (unsigned)(R * K + C) * 2u; voffB[i] = (unsigned)(Rb * K + C) * 2u; }
    const size_t kstep = (size_t)(BK * 2);
    const size_t hstep = (size_t)HALF * K * 2;
    const size_t tstep = 2 * hstep;
    const unsigned ldsw = (unsigned)wid * 1024u;
    const int aoff = lds_byte(wr * 64 + fr, fq * 8), boff = lds_byte(wc * 32 + fr, fq * 8);
#define PG8_SA(b, h) (((b) * 2 + (h)) * HTB)
#define PG8_SB(b, h) ((4 + (b) * 2 + (h)) * HTB)
#define PG8_STAGE(bufoff, gbase, voff) do { _Pragma("unroll") for (int _i = 0; _i < 2; ++_i) \
        __builtin_amdgcn_global_load_lds((const unsigned*)((const char*)(gbase) + (voff)[_i]), (PG8_LAS unsigned*)(lds + (bufoff) + ldsw + _i * 8192), 16, 0, 0); } while (0)
#define PG8_LDA(dst, b, h) do { _Pragma("unroll") for (int m = 0; m < 4; ++m) _Pragma("unroll") for (int k = 0; k < 2; ++k) dst[m][k] = *(const PG8_LAS bf16x8*)(lds + PG8_SA(b, h) + aoff + m * 2048 + k * 1024); } while (0)
#define PG8_LDB(dst, b, h) do { _Pragma("unroll") for (int n = 0; n < 2; ++n) _Pragma("unroll") for (int k = 0; k < 2; ++k) dst[n][k] = *(const PG8_LAS bf16x8*)(lds + PG8_SB(b, h) + boff + n * 2048 + k * 1024); } while (0)
#define PG8_MMA(ai, bj, At, Bt) do { __builtin_amdgcn_s_setprio(1); _Pragma("unroll") for (int m = 0; m < 4; ++m) _Pragma("unroll") for (int n = 0; n < 2; ++n) _Pragma("unroll") for (int k = 0; k < 2; ++k) \
        acc[ai][bj][m][n] = __builtin_amdgcn_mfma_f32_16x16x32_bf16(Bt[n][k], At[m][k], acc[ai][bj][m][n], 0, 0, 0); __builtin_amdgcn_s_setprio(0); } while (0)
#define PG8_WAIT_V(n) asm volatile("s_waitcnt vmcnt(" #n ")" ::: "memory")
#define PG8_WAIT_L(n) asm volatile("s_waitcnt lgkmcnt(" #n ")" ::: "memory")
#define PG8_BAR __builtin_amdgcn_s_barrier()
#define PG8_SCHED __builtin_amdgcn_sched_barrier(0)
    Unit cur, nxt; int ui = 0;
    if (!S.next(0, cur)) return;
    f32x4 acc[2][2][4][2];
#pragma unroll
    for (int a = 0; a < 2; ++a)
#pragma unroll
        for (int b = 0; b < 2; ++b)
#pragma unroll
            for (int m = 0; m < 4; ++m)
#pragma unroll
                for (int n = 0; n < 2; ++n) acc[a][b][m][n] = (f32x4){0.f, 0.f, 0.f, 0.f};
    bf16x8 At[4][2], B0[2][2], B1[2][2];
    const char* cA = (const char*)g.A + (size_t)cur.pm * tstep; const char* cB = (const char*)g.Bt + (size_t)cur.eb * g.bexp + (size_t)cur.pn * tstep;
    S.a_ready(cur);
    if constexpr (SP2) {
        PG8_STAGE(PG8_SB(0, 0), cB, voffB); PG8_STAGE(PG8_SB(0, 1), cB + hstep, voffB); PG8_STAGE(PG8_SA(0, 0), cA, voffA); PG8_STAGE(PG8_SA(0, 1), cA + hstep, voffA);
        if (wr == 1) PG8_BAR;
        PG8_WAIT_V(2); PG8_BAR;
        PG8_STAGE(PG8_SB(1, 0), cB + kstep, voffB); PG8_STAGE(PG8_SA(1, 0), cA + kstep, voffA); PG8_STAGE(PG8_SB(1, 1), cB + hstep + kstep, voffB);
        PG8_WAIT_V(6); PG8_BAR;
    } else {
        PG8_STAGE(PG8_SB(0, 0), cB, voffB); PG8_STAGE(PG8_SA(0, 0), cA, voffA); PG8_STAGE(PG8_SB(0, 1), cB + hstep, voffB); PG8_STAGE(PG8_SA(0, 1), cA + hstep, voffA);
        if (wr == 1) PG8_BAR;
        PG8_WAIT_V(4); PG8_BAR;
        PG8_STAGE(PG8_SB(1, 0), cB + kstep, voffB); PG8_STAGE(PG8_SA(1, 0), cA + kstep, voffA); PG8_STAGE(PG8_SB(1, 1), cB + hstep + kstep, voffB);
        PG8_WAIT_V(6); PG8_BAR;
    }
    for (;;) {
        const bool has_next = S.next(ui + 1, nxt);
        const char* nA = has_next ? (const char*)g.A + (size_t)nxt.pm * tstep : cA; const char* nB = has_next ? (const char*)g.Bt + (size_t)nxt.eb * g.bexp + (size_t)nxt.pn * tstep : cB;
        for (int t = 0; t < nt; t += 2) {
            const bool last = (t == nt - 2);
            const char* a1 = cA + (size_t)(t + 1) * kstep;
            const char* a2 = last ? nA : cA + (size_t)(t + 2) * kstep; const char* b2 = last ? nB : cB + (size_t)(t + 2) * kstep;
            const char* a3 = a2 + kstep; const char* b3 = b2 + kstep;
            if (last && has_next) S.a_ready(nxt);
            if constexpr (SP2) {
            PG8_LDB(B0, 0, 0); PG8_LDB(B1, 0, 1); PG8_SCHED; PG8_LDA(At, 0, 0); PG8_STAGE(PG8_SA(1, 1), a1 + hstep, voffA);
            PG8_WAIT_V(8); PG8_WAIT_L(0); PG8_BAR; PG8_MMA(0, 0, At, B0); PG8_MMA(0, 1, At, B1); PG8_BAR; PG8_SCHED;
            PG8_LDA(At, 0, 1); PG8_STAGE(PG8_SB(0, 0), b2, voffB); PG8_STAGE(PG8_SB(0, 1), b2 + hstep, voffB); PG8_STAGE(PG8_SA(0, 0), a2, voffA);
            PG8_WAIT_V(8); PG8_WAIT_L(0); PG8_BAR; PG8_MMA(1, 0, At, B0); PG8_MMA(1, 1, At, B1); PG8_BAR; PG8_SCHED;
            PG8_LDB(B0, 1, 0); PG8_LDB(B1, 1, 1); PG8_SCHED; PG8_LDA(At, 1, 0); PG8_STAGE(PG8_SA(0, 1), a2 + hstep, voffA);
            PG8_WAIT_V(8); PG8_WAIT_L(0); PG8_BAR; PG8_MMA(0, 0, At, B0); PG8_MMA(0, 1, At, B1); PG8_BAR; PG8_SCHED;
            PG8_LDA(At, 1, 1); PG8_STAGE(PG8_SB(1, 0), b3, voffB); PG8_STAGE(PG8_SB(1, 1), b3 + hstep, voffB); PG8_STAGE(PG8_SA(1, 0), a3, voffA);
            PG8_WAIT_V(8); PG8_WAIT_L(0); PG8_BAR; PG8_MMA(1, 0, At, B0); PG8_MMA(1, 1, At, B1); PG8_BAR; PG8_SCHED;
            } else {
            PG8_LDB(B0, 0, 0); PG8_SCHED; PG8_LDA(At, 0, 0); PG8_STAGE(PG8_SA(1, 1), a1 + hstep, voffA);
            PG8_WAIT_L(8); PG8_BAR; PG8_WAIT_L(0); PG8_MMA(0, 0, At, B0); PG8_BAR; PG8_SCHED;
            PG8_LDB(B1, 0, 1); PG8_STAGE(PG8_SB(0, 0), b2, voffB);
            PG8_BAR; PG8_WAIT_L(0); PG8_MMA(0, 1, At, B1); PG8_BAR;
            PG8_LDA(At, 0, 1); PG8_STAGE(PG8_SA(0, 0), a2, voffA);
            PG8_BAR; PG8_WAIT_L(0); PG8_MMA(1, 0, At, B0); PG8_BAR; PG8_SCHED;
            PG8_STAGE(PG8_SB(0, 1), b2 + hstep, voffB);
            PG8_WAIT_V(6); PG8_BAR; PG8_MMA(1, 1, At, B1); PG8_BAR;
            PG8_LDB(B0, 1, 0); PG8_SCHED; PG8_LDA(At, 1, 0); PG8_STAGE(PG8_SA(0, 1), a2 + hstep, voffA);
            PG8_WAIT_L(8); PG8_BAR; PG8_WAIT_L(0); PG8_MMA(0, 0, At, B0); PG8_BAR; PG8_SCHED;
            PG8_LDB(B1, 1, 1); PG8_STAGE(PG8_SB(1, 0), b3, voffB);
            PG8_BAR; PG8_WAIT_L(0); PG8_MMA(0, 1, At, B1); PG8_BAR;
            PG8_LDA(At, 1, 1); PG8_STAGE(PG8_SA(1, 0), a3, voffA);
            PG8_BAR; PG8_WAIT_L(0); PG8_MMA(1, 0, At, B0); PG8_BAR; PG8_SCHED;
            PG8_STAGE(PG8_SB(1, 1), b3 + hstep, voffB);
            PG8_WAIT_V(6); PG8_BAR; PG8_MMA(1, 1, At, B1); PG8_BAR;
            }
        }
        if constexpr (ALIGN_EPI) { if (wr == 0) PG8_BAR; }
        if constexpr (!Epi::AFTER_DRAIN) { E(acc, cur, wr, wc, fr, fq); S.done(cur); }
        if (!has_next) break;
#pragma unroll
        for (int a = 0; a < 2; ++a)
#pragma unroll
            for (int b = 0; b < 2; ++b)
#pragma unroll
                for (int m = 0; m < 4; ++m)
#pragma unroll
                    for (int n = 0; n < 2; ++n) acc[a][b][m][n] = (f32x4){0.f, 0.f, 0.f, 0.f};
        cur = nxt; cA = nA; cB = nB; ++ui;
        if constexpr (ALIGN_EPI) { if (wr == 1) PG8_BAR; }
    }
    PG8_WAIT_V(0);
    if constexpr (!ALIGN_EPI) { if (wr == 0) PG8_BAR; }
    PG8_BAR;
    if constexpr (Epi::AFTER_DRAIN) { E.fused(acc, cur, wr, wc, fr, fq, lds, wid, lane); S.done(cur); }
#undef PG8_SA
#undef PG8_SB
#undef PG8_STAGE
#undef PG8_LDA
#undef PG8_LDB
#undef PG8_MMA
#undef PG8_WAIT_V
#undef PG8_WAIT_L
#undef PG8_BAR
#undef PG8_SCHED
}
}

#define XB_TMO      128
#define XB_XCNT(j)  (256  + 64 * (j))
#define XB_XSUB(j)  (1280 + 64 * (j))
#define XB_XGEN(j)  (2304 + 64 * (j))
#define XB_TOP      3328
#define XB_TOPGEN   3392
#define XCD_BAR_WORDS 3456
#define XB_SPIN_CAP (1u << 22)
#define LAS __attribute__((address_space(3)))

__device__ __forceinline__ unsigned xb_ld(unsigned* p)              { return __hip_atomic_load(p, __ATOMIC_RELAXED, __HIP_MEMORY_SCOPE_AGENT); }
__device__ __forceinline__ unsigned xb_add(unsigned* p, unsigned v) { return __hip_atomic_fetch_add(p, v, __ATOMIC_RELAXED, __HIP_MEMORY_SCOPE_AGENT); }
__device__ __forceinline__ unsigned xb_xcc_id() { return (unsigned)__builtin_amdgcn_s_getreg((3 << 11) | 20) & 0xFu; }
#define XB_SPIN(cond, bar) do { unsigned _sp = 0; while (cond) { __builtin_amdgcn_s_sleep(1); \
    if ((++_sp & 255u) == 0u) { if (xb_ld(&(bar)[XB_TMO])) break; if (_sp > XB_SPIN_CAP) { atomicAdd(&(bar)[XB_TMO], 1u); break; } } } } while (0)

struct XcdBarrier {
    unsigned* bar; unsigned x; int wv;
    volatile LAS unsigned* st;
};

__device__ __forceinline__ XcdBarrier xcd_barrier_post(unsigned* bar, volatile LAS unsigned* st) {
    XcdBarrier b; b.bar = bar; b.x = xb_xcc_id(); b.st = st; b.wv = __builtin_amdgcn_readfirstlane((int)threadIdx.x >> 6);
    if (threadIdx.x == 0) (void)xb_add(&bar[XB_XCNT(b.x)], 1u);
    return b;
}
__device__ __forceinline__ void xcd_barrier_complete(unsigned* bar, unsigned x, unsigned& nloc, unsigned& nx) {
    const unsigned G = gridDim.x * gridDim.y * gridDim.z;
    unsigned sum, cnt, mine, sp = 0u;
    for (;;) {
        sum = 0u; cnt = 0u; mine = 0u;
#pragma unroll
        for (unsigned j = 0; j < 16; ++j) { const unsigned c = xb_ld(&bar[XB_XCNT(j)]); sum += c; cnt += (c > 0u) ? 1u : 0u; mine = (j == x) ? c : mine; }
        if (sum == G) break;
        __builtin_amdgcn_s_sleep(1);
        if ((++sp & 255u) == 0u) { if (xb_ld(&bar[XB_TMO])) break; if (sp > XB_SPIN_CAP) { atomicAdd(&bar[XB_TMO], 1u); break; } }
    }
    nloc = mine > 0u ? mine : 1u; nx = cnt > 0u ? cnt : 1u;
}

__device__ __forceinline__ void xcd_barrier(const XcdBarrier& b) {
    asm volatile("s_waitcnt vmcnt(0)" ::: "memory");
    __syncthreads();
    int ln_; asm volatile("v_mbcnt_lo_u32_b32 %0, -1, 0\n\tv_mbcnt_hi_u32_b32 %0, -1, %0" : "=v"(ln_));
    if (b.wv == 0 && ln_ == 0) {
        unsigned* bar = b.bar;
        __builtin_amdgcn_s_waitcnt(0);
        unsigned nloc = b.st[0], nx = b.st[1];
        if (nloc == 0u) { xcd_barrier_complete(bar, b.x, nloc, nx); b.st[0] = nloc; b.st[1] = nx; }
        const unsigned old = xb_add(&bar[XB_XSUB(b.x)], 1u);
        const unsigned gen = old / nloc;
        if (old + 1u == (gen + 1u) * nloc) {
            __builtin_amdgcn_fence(__ATOMIC_RELEASE, "agent");
            asm volatile("s_waitcnt vmcnt(0)" ::: "memory");
            const unsigned og = xb_add(&bar[XB_TOP], 1u);
            const unsigned tg = og / nx;
            if (og + 1u == (tg + 1u) * nx) xb_add(&bar[XB_TOPGEN], 1u);
            else XB_SPIN(xb_ld(&bar[XB_TOPGEN]) == tg, bar);
            __builtin_amdgcn_fence(__ATOMIC_ACQUIRE, "agent");
            xb_add(&bar[XB_XGEN(b.x)], 1u);
            asm volatile("s_waitcnt vmcnt(0)" ::: "memory");
        } else {
            XB_SPIN(xb_ld(&bar[XB_XGEN(b.x)]) == gen, bar);
            __builtin_amdgcn_fence(__ATOMIC_ACQUIRE, "agent");
            asm volatile("s_waitcnt vmcnt(0)" ::: "memory");
        }
    }
    __syncthreads();
}


namespace attn {
using bf16 = unsigned short;
constexpr int DQK = 192, DV = 128, NW = 8, QBLK = 32, KVBLK = 64;
constexpr float SCALE = 0.07216878364870322f;
constexpr float THR = 8.f;
constexpr int SDEPTH = 1;
constexpr int LDQ = DQK, LDK = DQK, LDV = DV, LDO = 1024;
constexpr size_t SHM_V = KVBLK * DV * 2, SHM_K = KVBLK * DQK * 2, SHM_ATTN = 2 * SHM_V + 2 * SHM_K + NW * 64 * 4;
using bf16x8 = __attribute__((ext_vector_type(8))) short;
using s16x4  = __attribute__((ext_vector_type(4))) short;
using f32x16 = __attribute__((ext_vector_type(16))) float;
using f32x8  = __attribute__((ext_vector_type(8))) float;
using u32x4  = __attribute__((ext_vector_type(4))) unsigned;
#define KSWZ(row, colB) ((row) * 384 + ((colB) ^ (((row) & 7) << 4)))
#define SBAR() __builtin_amdgcn_sched_barrier(0)
__device__ __forceinline__ int crow(int r, int hi) { return (r & 3) + 8 * (r >> 2) + 4 * hi; }
__device__ __forceinline__ unsigned cvtpk(float lo, float hi) {
  unsigned r; asm volatile("v_cvt_pk_bf16_f32 %0, %1, %2" : "=v"(r) : "v"(lo), "v"(hi)); return r;
}
struct St { using T = bf16x8;
  __device__ static __forceinline__ T ld8(const bf16* p) { return *reinterpret_cast<const bf16x8*>(p); }
  __device__ static __forceinline__ bf16x8 tobf(T x) { return x; } };
__device__ __forceinline__ void partialSM(f32x16& p0, f32x16& p1, float& m_reg, float& mn, float& alpha) {
  constexpr float C = SCALE * 1.4426950408889634f;
  float pmax = p0[0]; for (int r = 1; r < 16; ++r) pmax = fmaxf(pmax, p0[r]); for (int r = 0; r < 16; ++r) pmax = fmaxf(pmax, p1[r]);
  { auto rr = __builtin_amdgcn_permlane32_swap(__float_as_uint(pmax), __float_as_uint(pmax), false, false);
    pmax = fmaxf(__uint_as_float(rr[0]), __uint_as_float(rr[1])); }
  if (__builtin_expect(__all(pmax - m_reg <= THR / SCALE), 1)) { mn = m_reg; alpha = 1.f; }
  else { mn = fmaxf(m_reg, pmax); alpha = __builtin_amdgcn_exp2f((m_reg - mn) * C); m_reg = mn; }
  float mnC = -mn * C;
  for (int r = 0; r < 16; ++r) p0[r] = fmaf(p0[r], C, mnC); for (int r = 0; r < 16; ++r) p1[r] = fmaf(p1[r], C, mnC);
  for (int r = 0; r < 16; ++r) p0[r] = __builtin_amdgcn_exp2f(p0[r]);
}
__device__ __forceinline__ void finishSM(f32x16& p0, f32x16& p1, float alpha, float& l_reg, bf16x8& pa0, bf16x8& pa1, bf16x8& pa2, bf16x8& pa3) {
  for (int r = 0; r < 16; ++r) p1[r] = __builtin_amdgcn_exp2f(p1[r]);
  float ps = 0; for (int r = 0; r < 16; ++r) ps += p0[r]; for (int r = 0; r < 16; ++r) ps += p1[r];
  { auto rr = __builtin_amdgcn_permlane32_swap(__float_as_uint(ps), __float_as_uint(ps), false, false);
    ps = __uint_as_float(rr[0]) + __uint_as_float(rr[1]); }
  l_reg = l_reg * alpha + ps;
#define PK4(P, BASE, OUT) do { unsigned a0 = cvtpk(P[BASE + 0], P[BASE + 1]), a1 = cvtpk(P[BASE + 2], P[BASE + 3]);   \
    unsigned b0 = cvtpk(P[BASE + 4], P[BASE + 5]), b1 = cvtpk(P[BASE + 6], P[BASE + 7]);                              \
    auto r0 = __builtin_amdgcn_permlane32_swap(a0, b0, false, false); auto r1 = __builtin_amdgcn_permlane32_swap(a1, b1, false, false); \
    u32x4 w = {r0[0], r1[0], r0[1], r1[1]}; OUT = *reinterpret_cast<bf16x8*>(&w); } while (0)
  PK4(p0, 0, pa0); PK4(p0, 8, pa1); PK4(p1, 0, pa2); PK4(p1, 8, pa3);
#undef PK4
}
__device__ __forceinline__ void qkt(f32x16& p0, f32x16& p1, const bf16* Ks, const bf16x8* qr, int r32, int hi) {
  p0 = f32x16{}; p1 = f32x16{};
  for (int d0 = 0; d0 < 12; ++d0) { int cb = (d0 * 16 + hi * 8) * 2;
    bf16x8 b0 = *reinterpret_cast<const bf16x8*>((const char*)Ks + KSWZ(r32, cb));
    bf16x8 b1 = *reinterpret_cast<const bf16x8*>((const char*)Ks + KSWZ(32 + r32, cb));
    p0 = __builtin_amdgcn_mfma_f32_32x32x16_bf16(b0, qr[d0], p0, 0, 0, 0);
    p1 = __builtin_amdgcn_mfma_f32_32x32x16_bf16(b1, qr[d0], p1, 0, 0, 0); }
}
__device__ __forceinline__ int v_st(int k, int c) { const int kk = (k & ~0xC) | ((k & 4) << 1) | ((k & 8) >> 1); return ((kk >> 3) * 4 + (c >> 5)) * 512 + ((kk & 7) * 32 + (c & 31)) * 2; }
__device__ __forceinline__ int v_rd_base(int lane) { return ((lane & 3) << 3) | (((lane >> 2) & 3) << 6) | (((lane >> 4) & 1) << 5) | (((lane >> 5) & 1) << 8); }
constexpr int v_rd_off(int d0, int ks, int half) { return d0 * 512 + ks * 4096 + half * 2048; }
template <int OFF> __device__ __forceinline__ s16x4 tr_read(int vb) {
  s16x4 r; asm volatile("ds_read_b64_tr_b16 %0, %1 offset:%2" : "=&v"(r) : "v"(vb), "i"(OFF) : "memory"); return r;
}
template <int D0> __device__ __forceinline__ void pv_one(f32x16& od, int vb, bf16x8 pa0, bf16x8 pa1, bf16x8 pa2, bf16x8 pa3) {
  const s16x4 l0 = tr_read<v_rd_off(D0, 0, 0)>(vb), h0 = tr_read<v_rd_off(D0, 0, 1)>(vb), l1 = tr_read<v_rd_off(D0, 1, 0)>(vb), h1 = tr_read<v_rd_off(D0, 1, 1)>(vb);
  const s16x4 l2 = tr_read<v_rd_off(D0, 2, 0)>(vb), h2 = tr_read<v_rd_off(D0, 2, 1)>(vb), l3 = tr_read<v_rd_off(D0, 3, 0)>(vb), h3 = tr_read<v_rd_off(D0, 3, 1)>(vb);
  asm volatile("s_waitcnt lgkmcnt(0)" ::: "memory"); SBAR();
#define PK(L, H) (bf16x8){L[0], L[1], L[2], L[3], H[0], H[1], H[2], H[3]}
  od = __builtin_amdgcn_mfma_f32_32x32x16_bf16(pa0, PK(l0, h0), od, 0, 0, 0);
  od = __builtin_amdgcn_mfma_f32_32x32x16_bf16(pa1, PK(l1, h1), od, 0, 0, 0);
  od = __builtin_amdgcn_mfma_f32_32x32x16_bf16(pa2, PK(l2, h2), od, 0, 0, 0);
  od = __builtin_amdgcn_mfma_f32_32x32x16_bf16(pa3, PK(l3, h3), od, 0, 0, 0);
#undef PK
}
__device__ __forceinline__ void pv_d0(f32x16* o, int vb, bf16x8 pa0, bf16x8 pa1, bf16x8 pa2, bf16x8 pa3) {
  pv_one<0>(o[0], vb, pa0, pa1, pa2, pa3); pv_one<1>(o[1], vb, pa0, pa1, pa2, pa3); pv_one<2>(o[2], vb, pa0, pa1, pa2, pa3); pv_one<3>(o[3], vb, pa0, pa1, pa2, pa3);
}

__device__ __forceinline__ void attn_dense_body(const bf16* __restrict__ Qb, const bf16* __restrict__ Kh, const bf16* __restrict__ Vh,
                                                bf16* __restrict__ Ob, int seq, char* lds, const int tid_in) {
  int tid_ = tid_in; asm volatile("" : "+v"(tid_));
  const int tid = tid_, wid = tid >> 6, lane = tid & 63, r32 = lane & 31, hi = lane >> 5;
  bf16* V_lds = (bf16*)lds; bf16* K_lds = (bf16*)(lds + 2 * SHM_V);
  float* ws = (float*)(lds + 2 * SHM_V + 2 * SHM_K) + wid * 64; float* li_l = ws; float* al_l = ws + 32;
  float m_reg = -1e30f, l_reg = 0; f32x16 o[4] = {}; bf16x8 qr[12];
  const bf16* Qw = Qb + (long)(wid * QBLK + r32) * LDQ + hi * 8;
#pragma unroll
  for (int d0 = 0; d0 < 12; ++d0) qr[d0] = St::ld8(Qw + d0 * 16);
  const int sr = tid >> 4, sc = (tid & 15) * 8, vst0 = v_st(sr, sc), vst1 = v_st(32 + sr, sc);
  const int kr0 = tid / 24, kc0 = (tid % 24) * 8, kr1 = (tid + 512) / 24, kc1 = ((tid + 512) % 24) * 8, kr2 = (tid + 1024) / 24, kc2 = ((tid + 1024) % 24) * 8;
  const int vb0 = (int)(uintptr_t)V_lds + v_rd_base(lane);
  struct { St::T vs0, vs1, ks0, ks1, ks2; } sr_[SDEPTH];
#define SLOAD(i, k0) do { sr_[i].vs0 = St::ld8(&Vh[(long)((k0) + sr) * LDV + sc]); sr_[i].vs1 = St::ld8(&Vh[(long)((k0) + 32 + sr) * LDV + sc]); \
    sr_[i].ks0 = St::ld8(&Kh[(long)((k0) + kr0) * LDK + kc0]); sr_[i].ks1 = St::ld8(&Kh[(long)((k0) + kr1) * LDK + kc1]); sr_[i].ks2 = St::ld8(&Kh[(long)((k0) + kr2) * LDK + kc2]); } while (0)
#define SWRITE(b, i) do { *(bf16x8*)((char*)V_lds + (b) * SHM_V + vst0) = St::tobf(sr_[i].vs0);          \
    *(bf16x8*)((char*)V_lds + (b) * SHM_V + vst1) = St::tobf(sr_[i].vs1);                                \
    *(bf16x8*)((char*)K_lds + (b) * SHM_K + KSWZ(kr0, kc0 * 2)) = St::tobf(sr_[i].ks0);                  \
    *(bf16x8*)((char*)K_lds + (b) * SHM_K + KSWZ(kr1, kc1 * 2)) = St::tobf(sr_[i].ks1);                  \
    *(bf16x8*)((char*)K_lds + (b) * SHM_K + KSWZ(kr2, kc2 * 2)) = St::tobf(sr_[i].ks2); } while (0)
#define SWAIT() do { if constexpr (SDEPTH == 2) asm volatile("s_waitcnt vmcnt(5)" ::: "memory"); else asm volatile("s_waitcnt vmcnt(0)" ::: "memory"); } while (0)
#define RESC(a) do { if (__any((a) < 1.f)) { if (hi == 0) al_l[r32] = (a); asm volatile("s_waitcnt lgkmcnt(0)" ::: "memory"); \
    for (int d = 0; d < 4; ++d) for (int r = 0; r < 16; ++r) o[d][r] *= al_l[crow(r, hi)]; } } while (0)
  f32x16 p0, p1; float mn, al; bf16x8 pa0, pa1, pa2, pa3; const int NT = seq / KVBLK;
  SLOAD(0, 0); asm volatile("s_waitcnt vmcnt(0)" ::: "memory"); SWRITE(0, 0); __syncthreads();
  for (int j = 0; j < NT; ++j) {
    const int cur = j & 1; const bool more = j + 1 < NT;
    if (more) SLOAD(0, (j + 1) * KVBLK);
    SBAR(); qkt(p0, p1, (bf16*)((char*)K_lds + cur * SHM_K), qr, r32, hi);
    partialSM(p0, p1, m_reg, mn, al); RESC(al);
    finishSM(p0, p1, al, l_reg, pa0, pa1, pa2, pa3); SBAR();
    pv_d0(o, vb0 + cur * (int)SHM_V, pa0, pa1, pa2, pa3);
    if (more) { SWAIT(); SWRITE(cur ^ 1, 0); }
    __syncthreads();
  }
  if (hi == 0) li_l[r32] = l_reg; asm volatile("s_waitcnt lgkmcnt(0)" ::: "memory");
  float rli[16];
#pragma unroll
  for (int r = 0; r < 16; ++r) rli[r] = __builtin_amdgcn_rcpf(li_l[crow(r, hi)]);
  bf16* Ow = Ob + (long)(wid * QBLK) * LDO;
#pragma unroll
  for (int r = 0; r < 16; ++r) { int orow = crow(r, hi);
    for (int d0 = 0; d0 < 4; ++d0) Ow[(long)orow * LDO + d0 * 32 + r32] = f2bf(o[d0][r] * rli[r]); }
#undef SLOAD
#undef SWRITE
#undef SWAIT
#undef RESC
}

}


constexpr int NWAVES = 8, NTHREADS = 512;
constexpr int RING_BYTES = 151552, MISC_OFF = RING_BYTES + 320, LDS_BYTES = 163840;
#define GAS __attribute__((address_space(1)))
typedef unsigned v4u __attribute__((ext_vector_type(4)));
typedef float f32x4 __attribute__((ext_vector_type(4)));
#define LDS_WAIT() asm volatile("s_waitcnt lgkmcnt(0)" ::: "memory")
typedef float f4 __attribute__((ext_vector_type(4)));
typedef unsigned u2 __attribute__((ext_vector_type(2)));
typedef unsigned u4 __attribute__((ext_vector_type(4)));
__device__ __forceinline__ float wave_sum(float v) {
#pragma unroll
  for (int o = 1; o < 64; o <<= 1) v += __shfl_xor(v, o);
  return v;
}
__device__ __forceinline__ unsigned pkbf(float lo, float hi) { return (unsigned)f2bf(lo) | ((unsigned)f2bf(hi) << 16); }

constexpr int MOD_KS = 16, MOD_CG = 16, MOD_COLS = 384;
__device__ __forceinline__ void f_mod_partial(const Pm& p, int tidb) {
  const int N6 = 6 * 1024;
  for (int u = blockIdx.x; u < MOD_KS * MOD_CG; u += gridDim.x) { const int ks = u / MOD_CG, cg = u % MOD_CG;
    if (tidb < MOD_COLS) { const int n = cg * MOD_COLS + tidb; float a0 = 0.f, a1 = 0.f, a2 = 0.f;
      for (int k = ks * 64; k < ks * 64 + 64; ++k) { const float w = p.mod_w[(size_t)k * N6 + n]; const float c0 = p.c[k], c1 = p.c[1024 + k], c2 = p.c_ctx[k];
        a0 += c0 * sigmoidf_(c0) * w; a1 += c1 * sigmoidf_(c1) * w; a2 += c2 * sigmoidf_(c2) * w; }
      float* o = p.modp + (size_t)ks * 3 * N6 + n; o[0] = a0; o[N6] = a1; o[2 * N6] = a2; } }
}
__device__ __forceinline__ void f_mod_reduce(const Pm& p, LAS float* modL, int tidb) {
  const int N6 = 6 * 1024;
  for (int i = tidb; i < 3 * 2048; i += NTHREADS) { const int v = i / 2048, n = i % 2048; float a = p.mod_b[n];
#pragma unroll
    for (int ks = 0; ks < MOD_KS; ++ks) a += p.modp[((size_t)ks * 3 + v) * N6 + n];
    modL[i] = a; }
  const int per = (3 * N6 + gridDim.x - 1) / gridDim.x;
  for (int i = blockIdx.x * per + tidb; i < (int)(blockIdx.x + 1) * per && i < 3 * N6; i += NTHREADS) { const int v = i / N6, n = i % N6; float a = p.mod_b[n];
#pragma unroll
    for (int ks = 0; ks < MOD_KS; ++ks) a += p.modp[((size_t)ks * 3 + v) * N6 + n];
    p.modv[i] = a; }
  __syncthreads();
}
__device__ __forceinline__ void f_norm1(const Pm& p, const LAS float* modL, int gw, int ngw, int lane) {
  constexpr Dm d = DMC;
  for (int row = gw; row < d.NR; row += ngw) {
    const float* src = row < d.BT ? p.x + (size_t)row * 1024 : p.ctx + (size_t)(row - d.BT) * 1024; const int v = row < d.BT ? row / d.T : 2;
    f4 xv[4]; float ss = 0.f;
#pragma unroll
    for (int j = 0; j < 4; ++j) { xv[j] = *(const f4*)(src + 4 * lane + 256 * j); ss += xv[j].x * xv[j].x + xv[j].y * xv[j].y + xv[j].z * xv[j].z + xv[j].w * xv[j].w; }
    const float rs = 1.f / sqrtf(wave_sum(ss) * (1.f / 1024.f) + 1e-6f);
#pragma unroll
    for (int j = 0; j < 4; ++j) { const int k = 4 * lane + 256 * j; const f4 g = *(const f4*)(p.norm1_g + k); const LAS float* sh = modL + v * 2048 + k; const LAS float* sc = sh + 1024;
      const float o0 = xv[j].x * rs * g.x * (1.f + sc[0]) + sh[0], o1 = xv[j].y * rs * g.y * (1.f + sc[1]) + sh[1], o2 = xv[j].z * rs * g.z * (1.f + sc[2]) + sh[2], o3 = xv[j].w * rs * g.w * (1.f + sc[3]) + sh[3];
      u2 w; w.x = pkbf(o0, o1); w.y = pkbf(o2, o3); *(u2*)(p.A1 + (size_t)row * 1024 + k) = w; }
  }
}
__device__ __forceinline__ void f_rope_table(const Pm& p, long tid, long nth) {
  for (long i = tid; i < (long)8192 * 32; i += nth) { const int t = (int)(i >> 5), q = (int)(i & 31), a = q >> 4, f = q & 15;
    const float freq = expf(-(float)f * (1.f / 16.f) * 9.210340371976184f), pos = a == 0 ? (float)(t >> 6) : (float)(t & 63), ang = pos * freq;
    p.ropet[2 * i] = cosf(ang); p.ropet[2 * i + 1] = sinf(ang); }
}
__device__ __forceinline__ void f_mla_a(const Pm& p, int gw, int ngw, int lane) {
  constexpr Dm d = DMC; const int NK = d.C + d.T;
  for (int row = gw; row < d.NR; row += ngw) {
    const bf16_t* pm = p.P + (size_t)row * d.IN + d.RC; int t, len, b, ic; row_pos(d, row, t, len, b, ic);
    const u2 qw = *(const u2*)(pm + 4 * lane); const unsigned cw = *(const unsigned*)(pm + 256 + 2 * lane);
    const f4 q = {__builtin_bit_cast(float, qw.x << 16), __builtin_bit_cast(float, qw.x & 0xffff0000u), __builtin_bit_cast(float, qw.y << 16), __builtin_bit_cast(float, qw.y & 0xffff0000u)};
    const float c0 = __builtin_bit_cast(float, cw << 16), c1 = __builtin_bit_cast(float, cw & 0xffff0000u); const float kr = __builtin_bit_cast(float, (unsigned)pm[384 + lane] << 16);
    const float qs = wave_sum(q.x * q.x + q.y * q.y + q.z * q.z + q.w * q.w), cs2 = wave_sum(c0 * c0 + c1 * c1);
    if (!ic) { const float rs = 1.f / sqrtf(qs * (1.f / 256.f) + 1e-6f); const f4 g = *(const f4*)(p.q_norm + 4 * lane);
      u2 w; w.x = pkbf(q.x * rs * g.x, q.y * rs * g.y); w.y = pkbf(q.z * rs * g.z, q.w * rs * g.w); *(u2*)(p.QN + (size_t)row * 256 + 4 * lane) = w; }
    { const float rs = 1.f / sqrtf(cs2 * (1.f / 128.f) + 1e-6f); *(unsigned*)(p.CN + (size_t)row * 128 + 2 * lane) = pkbf(c0 * rs * p.kv_norm[2 * lane], c1 * rs * p.kv_norm[2 * lane + 1]); }
    const float partner = __shfl_xor(kr, 16); float cs = 1.f, sn = 0.f;
    if (!ic) { const float* ct = p.ropet + ((size_t)t * 32 + (lane >> 5) * 16 + (lane & 15)) * 2; cs = ct[0]; sn = ct[1]; }
    const float o = (lane & 16) ? kr * cs + partner * sn : kr * cs - partner * sn; const bf16_t ob = f2bf(o); const int key = ic ? t : d.C + t;
#pragma unroll
    for (int h = 0; h < 4; ++h) p.K[((size_t)(b * 4 + h) * NK + key) * 192 + 128 + lane] = ob;
  }
}
__device__ __forceinline__ void f_readout(const Pm& p, int gw, int ngw, int lane) {
  constexpr Dm d = DMC; const size_t NRW = (size_t)d.NR * 512, BTW = (size_t)d.BT * 512;
  for (int row = gw; row < d.BT; row += ngw) { const size_t o = (size_t)row * 512 + 8 * lane;
    float ov[8], rv[8], kv[8], vv[8], gv[8];
#pragma unroll
    for (int q = 0; q < 2; ++q) { const f4 a = *(const f4*)(p.O2 + o + 4 * q), b2 = *(const f4*)(p.O2 + BTW + o + 4 * q), g = *(const f4*)(p.Gt + o + 4 * q);
      const u2 r = *(const u2*)(p.Rr + o + 4 * q), k0 = *(const u2*)(p.Kd + o + 4 * q), k1 = *(const u2*)(p.Kd + NRW + o + 4 * q), v = *(const u2*)(p.Vv + o + 4 * q);
#define BL(u) __builtin_bit_cast(float, (u) << 16)
#define BH(u) __builtin_bit_cast(float, (u) & 0xffff0000u)
      const float rr[4] = {BL(r.x), BH(r.x), BL(r.y), BH(r.y)}, ka[4] = {BL(k0.x), BH(k0.x), BL(k0.y), BH(k0.y)}, kb[4] = {BL(k1.x), BH(k1.x), BL(k1.y), BH(k1.y)}, vq[4] = {BL(v.x), BH(v.x), BL(v.y), BH(v.y)};
#pragma unroll
      for (int e = 0; e < 4; ++e) { ov[4 * q + e] = a[e] + b2[e]; rv[4 * q + e] = rr[e]; kv[4 * q + e] = ka[e] + kb[e]; vv[4 * q + e] = vq[e]; gv[4 * q + e] = g[e]; } }
    float s = 0.f, bon = 0.f;
#pragma unroll
    for (int e = 0; e < 8; ++e) { s += ov[e]; bon += rv[e] * kv[e] * p.r_k[8 * lane + e]; }
#pragma unroll
    for (int m = 1; m < 8; m <<= 1) { s += __shfl_xor(s, m); bon += __shfl_xor(bon, m); }
    const float mean = s * (1.f / 64.f); float var = 0.f;
#pragma unroll
    for (int e = 0; e < 8; ++e) { const float q = ov[e] - mean; var += q * q; }
#pragma unroll
    for (int m = 1; m < 8; m <<= 1) var += __shfl_xor(var, m);
    const float rs = 1.f / sqrtf(var * (1.f / 64.f) + 64e-5f); float y[8];
#pragma unroll
    for (int e = 0; e < 8; ++e) y[e] = ((ov[e] - mean) * rs * p.ln_w[8 * lane + e] + p.ln_b[8 * lane + e] + bon * vv[e]) * gv[e];
    u4 w; w.x = pkbf(y[0], y[1]); w.y = pkbf(y[2], y[3]); w.z = pkbf(y[4], y[5]); w.w = pkbf(y[6], y[7]);
    *(u4*)(p.MIXb + (size_t)row * 1024 + 8 * lane) = w; }
}
__device__ __forceinline__ void f_final(const Pm& p, int gw, int ngw, int lane) {
  constexpr Dm d = DMC;
  for (int tok = gw; tok < d.BT; tok += ngw) { const int b = tok / d.T; const float* gt2 = p.modv + (size_t)b * 6144 + 5 * 1024; const float* xr = p.x1 + (size_t)tok * 1024;
    const f4 gq = *(const f4*)(p.gate + (size_t)tok * 4); const int4 sp = *(const int4*)(p.slot_pos + (size_t)tok * 4);
    const bf16_t* y0 = p.Yb + (size_t)sp.x * 1024; const bf16_t* y1 = p.Yb + (size_t)sp.y * 1024; const bf16_t* y2 = p.Yb + (size_t)sp.z * 1024; const bf16_t* y3 = p.Yb + (size_t)sp.w * 1024;
    f4 xv[4]; float ss = 0.f;
#pragma unroll
    for (int j = 0; j < 4; ++j) { const int k = 4 * lane + 256 * j; const f4 x = *(const f4*)(xr + k), g = *(const f4*)(gt2 + k);
      const u2 a = *(const u2*)(y0 + k), b2 = *(const u2*)(y1 + k), c = *(const u2*)(y2 + k), e = *(const u2*)(y3 + k);
#define BFLO(u) __builtin_bit_cast(float, (u) << 16)
#define BFHI(u) __builtin_bit_cast(float, (u) & 0xffff0000u)
      f4 f; f.x = gq.x * BFLO(a.x) + gq.y * BFLO(b2.x) + gq.z * BFLO(c.x) + gq.w * BFLO(e.x); f.y = gq.x * BFHI(a.x) + gq.y * BFHI(b2.x) + gq.z * BFHI(c.x) + gq.w * BFHI(e.x);
      f.z = gq.x * BFLO(a.y) + gq.y * BFLO(b2.y) + gq.z * BFLO(c.y) + gq.w * BFLO(e.y); f.w = gq.x * BFHI(a.y) + gq.y * BFHI(b2.y) + gq.z * BFHI(c.y) + gq.w * BFHI(e.y);
      xv[j] = x + g * f; ss += xv[j].x * xv[j].x + xv[j].y * xv[j].y + xv[j].z * xv[j].z + xv[j].w * xv[j].w; }
    const float rs = 1.f / sqrtf(wave_sum(ss) * (1.f / 1024.f) + 1e-6f);
#pragma unroll
    for (int j = 0; j < 4; ++j) { const int k = 4 * lane + 256 * j; const f4 fg = *(const f4*)(p.final_g + k); *(f4*)(p.out + (size_t)tok * 1024 + k) = xv[j] * rs * fg; }
  }
}

__device__ __forceinline__ void f_route(const Pm& p, LAS unsigned char* lds, int wave, int lane, int tidb) {
  constexpr Dm d = DMC; const int G = gridDim.x, TPB = (d.BT + G - 1) / G;
  LAS float* rwL = (LAS float*)lds; LAS int* cnt_l = (LAS int*)(lds + 1024 * 144);
  for (int i = tidb; i < 1024 * 32; i += NTHREADS) rwL[(i >> 5) * 36 + (i & 31)] = p.router_w[i];
  if (tidb < 32) cnt_l[tidb] = 0;
  __syncthreads();
  const int t0 = blockIdx.x * TPB, t1 = (t0 + TPB < d.BT) ? t0 + TPB : d.BT;
  for (int tok = t0 + wave; tok < t1; tok += NWAVES) {
    const int b = tok / d.T; const float* xr = p.x1 + (size_t)tok * 1024; const float* sh = p.modv + (size_t)b * 6144 + 3 * 1024; const float* sc = sh + 1024;
    float ss = 0.f;
    { f4 xv[4];
#pragma unroll
      for (int j = 0; j < 4; ++j) { xv[j] = *(const f4*)(xr + 4 * lane + 256 * j); ss += xv[j].x * xv[j].x + xv[j].y * xv[j].y + xv[j].z * xv[j].z + xv[j].w * xv[j].w; }
      ss = wave_sum(ss);
      const float rs = 1.f / sqrtf(ss * (1.f / 1024.f) + 1e-6f);
#pragma unroll
      for (int j = 0; j < 4; ++j) { const int k = 4 * lane + 256 * j; const f4 g = *(const f4*)(p.norm2_g + k), s4 = *(const f4*)(sh + k), c4 = *(const f4*)(sc + k);
        f4 hv; hv.x = xv[j].x * rs * g.x * (1.f + c4.x) + s4.x; hv.y = xv[j].y * rs * g.y * (1.f + c4.y) + s4.y; hv.z = xv[j].z * rs * g.z * (1.f + c4.z) + s4.z; hv.w = xv[j].w * rs * g.w * (1.f + c4.w) + s4.w;
        u2 w; w.x = pkbf(hv.x, hv.y); w.y = pkbf(hv.z, hv.w); *(u2*)(p.H2b + (size_t)tok * 1024 + k) = w; } }
    const float rs = 1.f / sqrtf(ss * (1.f / 1024.f) + 1e-6f);
    float acc[32];
#pragma unroll
    for (int e = 0; e < 32; ++e) acc[e] = 0.f;
#pragma unroll 4
    for (int i = 0; i < 16; ++i) { const int k = lane + 64 * i; const float hv = xr[k] * rs * p.norm2_g[k] * (1.f + sc[k]) + sh[k]; const LAS float* rp = rwL + k * 36;
#pragma unroll
      for (int c = 0; c < 8; ++c) { const f4 r4 = *(const LAS f4*)(rp + 4 * c); acc[4 * c] += hv * r4.x; acc[4 * c + 1] += hv * r4.y; acc[4 * c + 2] += hv * r4.z; acc[4 * c + 3] += hv * r4.w; } }
#define RT_STEP(N, M) { const bool up_ = (lane & (M)) != 0; _Pragma("unroll") for (int i = 0; i < (N); ++i) { const float keep_ = up_ ? acc[i + (N)] : acc[i], send_ = up_ ? acc[i] : acc[i + (N)]; acc[i] = keep_ + __shfl_xor(send_, (M)); } }
    RT_STEP(16, 32) RT_STEP(8, 16) RT_STEP(4, 8) RT_STEP(2, 4) RT_STEP(1, 2)
#undef RT_STEP
    const int e = lane >> 1; float lg = acc[0] + __shfl_xor(acc[0], 1) + p.router_b[e]; float tv[4]; int te[4];
#pragma unroll
    for (int kk = 0; kk < 4; ++kk) { float m = lg;
#pragma unroll
      for (int o = 2; o < 64; o <<= 1) m = fmaxf(m, __shfl_xor(m, o));
      const unsigned long long bal = __ballot(lg == m); const int bi = (__builtin_ctzll(bal) >> 1) & 31;
      tv[kk] = m; te[kk] = bi; if (e == bi) lg = -3e38f; }
    const float e1 = __expf(tv[1] - tv[0]), e2 = __expf(tv[2] - tv[0]), e3 = __expf(tv[3] - tv[0]), inv = 1.f / (1.f + e1 + e2 + e3);
    if (lane < 4) { const int me = lane == 0 ? te[0] : lane == 1 ? te[1] : lane == 2 ? te[2] : te[3]; const float mg = (lane == 0 ? 1.f : lane == 1 ? e1 : lane == 2 ? e2 : e3) * inv;
      const int rk = atomicAdd((int*)&cnt_l[me], 1);
      p.top_e[(size_t)tok * 4 + lane] = me; p.gate[(size_t)tok * 4 + lane] = mg; p.lrank[(size_t)tok * 4 + lane] = rk; }
  }
  __syncthreads();
  if (tidb < 32) p.blkcnt[(size_t)blockIdx.x * 32 + tidb] = cnt_l[tidb];
}
__device__ __forceinline__ void f_place(const Pm& p, LAS unsigned char* lds, int wave, int lane, int tidb) {
  constexpr Dm d = DMC; const int G = gridDim.x, TPB = (d.BT + G - 1) / G;
  LAS int* ps = (LAS int*)lds;
  LAS int* pb = ps + 512;
  LAS int* off = pb + 512;
  LAS int* base = off + 64;
  { const int e = tidb & 31, part = tidb >> 5; int sa = 0, sb = 0;
    for (int bb = part; bb < G; bb += 16) { const int c = __hip_atomic_load(p.blkcnt + (size_t)bb * 32 + e, __ATOMIC_RELAXED, __HIP_MEMORY_SCOPE_AGENT); sa += c; if (bb < (int)blockIdx.x) sb += c; }
    ps[part * 32 + e] = sa; pb[part * 32 + e] = sb; }
  __syncthreads();
  if (tidb < 32) { int sa = 0, sb = 0;
#pragma unroll
    for (int q = 0; q < 16; ++q) { sa += ps[q * 32 + tidb]; sb += pb[q * 32 + tidb]; }
    base[tidb] = sb; ps[tidb] = (sa + 255) / 256 * 256; }
  __syncthreads();
  if (tidb == 0) { int o = 0; for (int e = 0; e < 32; ++e) { off[e] = o; o += ps[e]; } off[32] = o; }
  __syncthreads();
  if (blockIdx.x == 0) { const int npos = off[32];
    for (int t = tidb; t < npos / 256; t += NTHREADS) { int e = 0; for (int q = 1; q < 32; ++q) if (t * 256 >= off[q]) e = q; p.tile_e[t] = e; }
    if (tidb == 0) p.npos[0] = npos; }
  const int t0 = blockIdx.x * TPB, t1 = (t0 + TPB < d.BT) ? t0 + TPB : d.BT;
  for (int tok = t0 + wave; tok < t1; tok += NWAVES) {
    const u4* src = (const u4*)(p.H2b + (size_t)tok * 1024) + lane * 2; const u4 a = src[0], b = src[1];
#pragma unroll
    for (int kk = 0; kk < 4; ++kk) { const int e = p.top_e[(size_t)tok * 4 + kk], rk = p.lrank[(size_t)tok * 4 + kk]; const int pos = off[e] + base[e] + rk;
      if (lane == 0) p.slot_pos[(size_t)tok * 4 + kk] = pos;
      u4* dst = (u4*)(p.Xg + (size_t)pos * 1024) + lane * 2; dst[0] = a; dst[1] = b; }
  }
}
__device__ __forceinline__ void f_rwkv_s1(const Pm& p, int gw, int ngw, int lane) {
  constexpr Dm d = DMC;
  for (int row = gw; row < d.NR; row += ngw) { int t, len, b, ic; row_pos(d, row, t, len, b, ic);
    const bf16_t* cur = p.P + (size_t)row * d.IN; const bool hp = t > 0, hn = t < len - 1; f4 ps[7];
#define S1_LD(ptr) ({ const u2 w_ = *(const u2*)(ptr); (f4){__builtin_bit_cast(float, w_.x << 16), __builtin_bit_cast(float, w_.x & 0xffff0000u), __builtin_bit_cast(float, w_.y << 16), __builtin_bit_cast(float, w_.y & 0xffff0000u)}; })
#pragma unroll
    for (int j = 0; j < 7; ++j) { const int c = 4 * lane + 256 * j; const f4 x = S1_LD(cur + c), mu = *(const f4*)(p.mu + c); f4 pr = {0.f, 0.f, 0.f, 0.f}, nx = pr;
      if (hp) pr = S1_LD(cur - d.IN + c); if (hn) nx = S1_LD(cur + d.IN + c);
      ps[j] = x + mu * (0.5f * (pr + nx) - x); }
#undef S1_LD
    const size_t o = (size_t)row * 512 + 4 * lane;
    { u2 w; w.x = pkbf(ps[0].x, ps[0].y); w.y = pkbf(ps[0].z, ps[0].w); *(u2*)(p.Rr + o) = w; w.x = pkbf(ps[1].x, ps[1].y); w.y = pkbf(ps[1].z, ps[1].w); *(u2*)(p.Rr + o + 256) = w;
      w.x = pkbf(ps[4].x, ps[4].y); w.y = pkbf(ps[4].z, ps[4].w); *(u2*)(p.Vv + o) = w; w.x = pkbf(ps[5].x, ps[5].y); w.y = pkbf(ps[5].z, ps[5].w); *(u2*)(p.Vv + o + 256) = w; }
#pragma unroll
    for (int j = 0; j < 2; ++j) { const f4 k = ps[2 + j]; const f4 kq = k * *(const f4*)(p.k_k + 4 * lane + 256 * j); float ss = kq.x * kq.x + kq.y * kq.y + kq.z * kq.z + kq.w * kq.w;
#pragma unroll
      for (int m = 1; m < 16; m <<= 1) ss += __shfl_xor(ss, m);
      const float inv = 1.f / sqrtf(fmaxf(ss, 1e-24f)); *(f4*)(p.Kraw + o + 256 * j) = k; const f4 kn = kq * inv; u2 w; w.x = pkbf(kn.x, kn.y); w.y = pkbf(kn.z, kn.w); *(u2*)(p.KK + o + 256 * j) = w; }
    const f4 x6 = ps[6];
    if (lane < 16) { u2 w; w.x = pkbf(tanhf(x6.x), tanhf(x6.y)); w.y = pkbf(tanhf(x6.z), tanhf(x6.w)); *(u2*)(p.AL1 + (size_t)row * 128 + 4 * lane) = w; }
    else if (lane < 32) { u2 w; w.x = pkbf(x6.x, x6.y); w.y = pkbf(x6.z, x6.w); *(u2*)(p.AL1 + (size_t)row * 128 + 4 * lane) = w; }
    else if (!ic) { u2 w; w.x = pkbf(sigmoidf_(x6.x), sigmoidf_(x6.y)); w.y = pkbf(sigmoidf_(x6.z), sigmoidf_(x6.w)); *(u2*)(p.AL2 + (size_t)row * 128 + 4 * (lane - 32)) = w; }
  }
}
__device__ __forceinline__ void f_lora_weights(const Pm& p, long tid, long nth) {
  for (long i = tid; i < (long)2048 * 128; i += nth) { const int n = (int)(i >> 7), k = (int)(i & 127); float v = 0.f;
    if (n < 1024) { if (k < 64) v = p.w2[((size_t)(n >> 9) * 64 + k) * 512 + (n & 511)]; } else { const int q = n - 1024; if (k >= 64) v = p.a2[((size_t)(q >> 9) * 64 + (k - 64)) * 512 + (q & 511)]; }
    p.WlT[i] = f2bf(v); }
  for (long i = tid; i < (long)512 * 128; i += nth) { const int n = (int)(i >> 7), k = (int)(i & 127); p.G2T[i] = f2bf(p.g2[(size_t)k * 512 + n]); }
}
__device__ __forceinline__ float fma_s(float a, float b, float c) { float r; asm("v_fma_f32 %0, %1, %2, %3" : "=v"(r) : "v"(a), "v"(b), "v"(c)); return r; }
__device__ __forceinline__ float fnma_s(float a, float b, float c) { float r; asm("v_fma_f32 %0, -%1, %2, %3" : "=v"(r) : "v"(a), "v"(b), "v"(c)); return r; }
__device__ __forceinline__ float mul_s(float a, float b) { float r; asm("v_mul_f32 %0, %1, %2" : "=v"(r) : "v"(a), "v"(b)); return r; }
__device__ __forceinline__ void f_scan_a2(const Pm& p, LAS unsigned char* lds, int wave, int lane, int NSEG) {
  constexpr Dm d = DMC; constexpr int R = 6, PD = 4, SLOT = 18432; const int NB = 2 * d.B * d.RH * 8;
  for (int ub = blockIdx.x; ub < NB; ub += gridDim.x) { const int ch = ub >> 3, v0 = (ub & 7) * 8, v = v0 + wave; const float* base = p.Fend + (size_t)ch * NSEG * 128 * 64;
#define A2_ISSUE(gq) do { const float* fe_ = base + (size_t)(gq) * 128 * 64; LAS unsigned char* sl_ = lds + ((gq) % R) * SLOT; \
      __builtin_amdgcn_global_load_lds((const unsigned*)(fe_ + 64 * 64 + (wave * 2) * 256 + lane * 4), (LAS unsigned*)(sl_ + (wave * 2) * 1024), 16, 0, 0); \
      __builtin_amdgcn_global_load_lds((const unsigned*)(fe_ + 64 * 64 + (wave * 2 + 1) * 256 + lane * 4), (LAS unsigned*)(sl_ + (wave * 2 + 1) * 1024), 16, 0, 0); \
      __builtin_amdgcn_global_load_lds((const unsigned*)(fe_ + (v0 + (wave & 1) * 4) * 64 + lane * 4), (LAS unsigned*)(sl_ + 16384 + (wave & 1) * 1024), 16, 0, 0); } while (0)
    for (int g = 0; g < PD; ++g) A2_ISSUE(g);
    asm volatile("s_waitcnt vmcnt(0)" ::: "memory"); __builtin_amdgcn_s_barrier();
    float S = 0.f;
    for (int g = 0; g < NSEG; ++g) {
      if (g + PD < NSEG) A2_ISSUE(g + PD);
      p.Sst[(((size_t)ch * NSEG + g) * 64 + v) * 64 + lane] = S;
      if (g + PD < NSEG) asm volatile("s_waitcnt vmcnt(17)" ::: "memory"); else asm volatile("s_waitcnt vmcnt(0)" ::: "memory");
      __builtin_amdgcn_s_barrier();
      const LAS float* P = (const LAS float*)(lds + (g % R) * SLOT) + lane; float a0 = ((const LAS float*)(lds + (g % R) * SLOT + 16384))[wave * 64 + lane], a1 = 0.f, a2 = 0.f, a3 = 0.f;
      LAS float* srow = (LAS float*)(lds + R * SLOT) + wave * 64; srow[lane] = S;
      asm volatile("s_waitcnt lgkmcnt(0)" ::: "memory");
#pragma unroll
      for (int i = 0; i < 64; i += 4) { const f4 s4 = *(const LAS f4*)(srow + i);
        a0 = fma_s(s4.x, P[i * 64], a0); a1 = fma_s(s4.y, P[(i + 1) * 64], a1); a2 = fma_s(s4.z, P[(i + 2) * 64], a2); a3 = fma_s(s4.w, P[(i + 3) * 64], a3); }
      S = (a0 + a1) + (a2 + a3);
    }
#undef A2_ISSUE
    asm volatile("s_waitcnt vmcnt(0)" ::: "memory"); __builtin_amdgcn_s_barrier();
  }
}

#define SB_BF(x) __builtin_bit_cast(float, (unsigned)(x) << 16)
#ifdef HOST_EMU
#define SB_EXP2(x) exp2f(x)
#else
#define SB_EXP2(x) __builtin_amdgcn_exp2f(x)
#endif
#ifdef HOST_EMU
#define SB_OPAQUE_LANE() do {} while (0)
#define SB_WAITL() emu_wave_sync()
#else
#define SB_OPAQUE_LANE() do { int lo_ = lane; asm volatile("" : "+v"(lo_)); lane = lo_; hi = lane >> 5; l31 = lane & 31; } while (0)
#define SB_WAITL() asm volatile("s_waitcnt lgkmcnt(0)" ::: "memory")
#endif
namespace sb {
typedef short bf16x8 __attribute__((ext_vector_type(8)));
typedef float f32x16 __attribute__((ext_vector_type(16)));
constexpr int P144 = 144, P80 = 80;
constexpr int O_PM = 0, O_QM = 4608, O_KH = 9216, O_RH = 13824, O_QT = 18432, O_KT = 23552, O_VT = 28672, O_PM32 = 33792, O_WT = 33792, O_UT = 41984,
              O_AKP = 47104, O_BRQ = 49664, O_BRK = 52224, O_F = 54784, O_GL = 73216, O_CUM = 73472, O_ROW = 74496, UNIT_BYTES = 74752;
constexpr int O_MCT = O_PM, O_REFF = O_KH;
__device__ __forceinline__ int crow(int r, int hi) { return (r & 3) + 8 * (r >> 2) + 4 * hi; }
__device__ __forceinline__ bf16x8 frag(const LAS unsigned char* base, int pitch, int row0, int k0, int lane) {
  return *(const LAS bf16x8*)(base + (row0 + (lane & 31)) * pitch + (k0 + 8 * (lane >> 5)) * 2);
}
#define SB_MMA(acc, a, b) acc = __builtin_amdgcn_mfma_f32_32x32x16_bf16(a, b, acc, 0, 0, 0)
template <int KK> __device__ __forceinline__ void mma_nat(f32x16& acc, const LAS unsigned char* A, int pa, int m0, const LAS unsigned char* B, int pb, int n0, int lane) {
#pragma unroll
  for (int k0 = 0; k0 < KK; k0 += 16) { const bf16x8 a = frag(A, pa, m0, k0, lane), b = frag(B, pb, n0, k0, lane); SB_MMA(acc, a, b); }
}
#ifdef HOST_EMU
inline unsigned pkb(float lo, float hi) { return (unsigned)f2bf(lo) | ((unsigned)f2bf(hi) << 16); }
inline float fnma_sv(float s, float v, float c) { return fmaf(-s, v, c); }
inline float fnma_vv(float s, float v, float c) { return fmaf(-s, v, c); }
#else
__device__ __forceinline__ unsigned pkb(float lo, float hi) { unsigned r; asm("v_cvt_pk_bf16_f32 %0, %1, %2" : "=v"(r) : "v"(lo), "v"(hi)); return r; }
__device__ __forceinline__ float fnma_vv(float a, float v, float c) { float r; asm("v_fma_f32 %0, -%1, %2, %3" : "=v"(r) : "v"(a), "v"(v), "v"(c)); return r; }
__device__ __forceinline__ float fnma_sv(float s, float v, float c) { float r; asm("v_fma_f32 %0, -%1, %2, %3" : "=v"(r) : "s"(s), "v"(v), "v"(c)); return r; }
#endif
__device__ __forceinline__ void store_t(LAS unsigned char* T, int pitch, const f32x16& c, int cofs, int rofs, int lane) {
  LAS unsigned char* rowp = T + (cofs + (lane & 31)) * pitch + (rofs + 4 * (lane >> 5)) * 2;
#pragma unroll
  for (int g = 0; g < 4; ++g) { u2 w; w.x = pkb(c[4 * g], c[4 * g + 1]); w.y = pkb(c[4 * g + 2], c[4 * g + 3]); *(LAS u2*)(rowp + 16 * g) = w; }
}

#define SB_LOAD_CHUNK(cq) do { const int sg = sbeg + (cq) * 32 + 8 * wq + (lane >> 3); size_t row = 0; bool lat = false; const bool ok = sg < send; if (ok) chain_step(d, dd, b, sg, row, lat); \
        const size_t o = row * RW + h * 64 + (lane & 7) * 8; const u4 z4 = {0u, 0u, 0u, 0u}; \
        ld[0] = ok ? *(const u4*)(p.Wd + dd * NRW + o) : z4; ld[1] = ok ? *(const u4*)(p.KK + o) : z4; ld[2] = ok ? *(const u4*)(p.Bb + dd * NRW + o) : z4; \
        ld[3] = ok ? *(const u4*)(p.Kd + dd * NRW + o) : z4; ld[4] = ok ? *(const u4*)(p.Vv + o) : z4; ld[5] = ok ? *(const u4*)(p.Rr + o) : z4; } while (0)
#define XTR_SLOT_OK true
#ifndef HOST_EMU
__device__ __forceinline__ void xtr_item(const Pm& p, int it, int lane) {
  const int e = it / 768, r = it % 768; const bool first = r < 512; const int rr = first ? r : r - 512; const int N = first ? 2048 : 1024, nblk = N / 64, kb = rr / nblk, nb = rr % nblk;
  const float* src = (first ? p.exp_w1 + (size_t)e * 1024 * 2048 : p.exp_w2 + (size_t)e * 1024 * 1024) + (size_t)(kb * 64) * N + nb * 64 + lane; float x[64];
#pragma unroll
  for (int j = 0; j < 64; ++j) x[j] = __builtin_nontemporal_load(src + (size_t)j * N);
  bf16_t* dst = (first ? p.W1T + (size_t)e * 2048 * 1024 : p.W2T + (size_t)e * 1024 * 1024) + (size_t)(nb * 64 + lane) * 1024 + kb * 64;
#pragma unroll
  for (int c = 0; c < 8; ++c) { u4 o; o.x = pkb(x[8 * c], x[8 * c + 1]); o.y = pkb(x[8 * c + 2], x[8 * c + 3]); o.z = pkb(x[8 * c + 4], x[8 * c + 5]); o.w = pkb(x[8 * c + 6], x[8 * c + 7]); *(u4*)(dst + 8 * c) = o; }
}
#endif
__device__ __forceinline__ void f_scan_b1(const Pm& p, LAS unsigned char* lds, int wave, int lane_in, int NSEG, int xtr_first, int xtr_total) {
  int lane = lane_in;
  constexpr Dm d = DMC; constexpr int RW = 512; const int SL = (d.C + d.T) / NSEG, NCH = (SL + 31) / 32; const size_t NRW = (size_t)d.NR * RW, BTW = (size_t)d.BT * RW;
  const int NU = 2 * d.B * d.RH * NSEG; const int uq = wave >> 2, wq = wave & 3; int hi = lane >> 5, l31 = lane & 31;
  LAS unsigned char* U = lds + uq * UNIT_BYTES;
  LAS float* GL = (LAS float*)(U + O_GL); LAS float* CUM = (LAS float*)(U + O_CUM); LAS int* ROWT = (LAS int*)(U + O_ROW); LAS float* PM32 = (LAS float*)(U + O_PM32);
  int xslot = 0;
  for (int ub = blockIdx.x; ub * 2 < NU; ub += gridDim.x) { const int unit = ub * 2 + uq; const int g = unit % NSEG, ch = unit / NSEG; const int h = ch % d.RH, b = (ch / d.RH) % d.B, dd = ch / (d.RH * d.B);
    const int sbeg = g * SL, send = (g + 1) * SL;
    for (int i = wq * 64 + lane; i < 128 * 32; i += 256) { const int row = i >> 5, c2 = i & 31; unsigned v = 0u; if (row < 64 && (row >> 1) == c2) v = (row & 1) ? 0x3f800000u : 0x00003f80u; *(LAS unsigned*)(U + O_F + row * P144 + c2 * 4) = v; }
    u4 ld[6];
    SB_LOAD_CHUNK(0);
    for (int c = 0; c < NCH; ++c) { const int s0 = sbeg + c * 32;
      f32x16 R[4] = {};
      SB_OPAQUE_LANE();
      {
#pragma unroll
        for (int i = 0; i < 8; ++i) { const int sg = s0 + 8 * wq + i; size_t row = 0; bool lat = false; const bool ok = sg < send; if (ok) chain_step(d, dd, b, sg, row, lat); if (lane == i) ROWT[8 * wq + i] = (ok && lat) ? (int)row : -1; }
        float w8[8], kk8[8], bv8[8], kd8[8], v8[8], r8[8];
        { LAS unsigned char* stg = U + wq * 6144;
#pragma unroll
          for (int v = 0; v < 6; ++v) *(LAS u4*)(stg + v * 1024 + lane * 16) = ld[v];
          SB_WAITL();
#pragma unroll
          for (int i = 0; i < 8; ++i) { const LAS unsigned short* sp = (const LAS unsigned short*)(stg + i * 128) + lane;
            w8[i] = SB_EXP2(SB_BF(sp[0])); kk8[i] = SB_BF(sp[512]); bv8[i] = SB_BF(sp[1024]); kd8[i] = SB_BF(sp[1536]); v8[i] = SB_BF(sp[2048]); r8[i] = SB_BF(sp[2560]); } }
        float cp[8]; cp[0] = w8[0];
#pragma unroll
        for (int i = 1; i < 8; ++i) cp[i] = cp[i - 1] * w8[i];
        CUM[wq * 64 + lane] = cp[7];
        __syncthreads();
        float pre = 1.f;
#pragma unroll
        for (int q = 0; q < 3; ++q) if (q < wq) pre *= CUM[q * 64 + lane];
        unsigned qt[4], kt[4], vt[4];
#pragma unroll
        for (int i = 0; i < 8; ++i) { const int t = 8 * wq + i; const float G = pre * cp[i], Gp = i == 0 ? pre : pre * cp[i - 1], Gi = 1.f / G;
          const float pm = Gp * kk8[i], qm = bv8[i] * Gi, kh = kd8[i] * Gi, rh = G * r8[i];
          *(LAS unsigned short*)(U + O_PM + t * P144 + lane * 2) = f2bf(pm); *(LAS unsigned short*)(U + O_QM + t * P144 + lane * 2) = f2bf(qm);
          *(LAS unsigned short*)(U + O_KH + t * P144 + lane * 2) = f2bf(kh); *(LAS unsigned short*)(U + O_RH + t * P144 + lane * 2) = f2bf(rh);
          PM32[t * 64 + lane] = pm;
          if (i & 1) { qt[i >> 1] |= (unsigned)f2bf(qm) << 16; kt[i >> 1] |= (unsigned)f2bf(kh) << 16; vt[i >> 1] |= (unsigned)f2bf(v8[i]) << 16; }
          else { qt[i >> 1] = f2bf(qm); kt[i >> 1] = f2bf(kh); vt[i >> 1] = f2bf(v8[i]); }
          if (t == 31) GL[lane] = G; }
        *(LAS u4*)(U + O_QT + lane * P80 + 16 * wq) = (u4){qt[0], qt[1], qt[2], qt[3]};
        *(LAS u4*)(U + O_KT + lane * P80 + 16 * wq) = (u4){kt[0], kt[1], kt[2], kt[3]};
        *(LAS u4*)(U + O_VT + lane * P80 + 16 * wq) = (u4){vt[0], vt[1], vt[2], vt[3]}; }
      if (c + 1 < NCH) SB_LOAD_CHUNK(c + 1);
      __syncthreads();
      SB_OPAQUE_LANE();
      if (wq < 2) { float xv[32];
        if (wq == 0) {
#pragma unroll
          for (int t = 0; t < 32; ++t) xv[t] = PM32[t * 64 + lane];
          SB_WAITL(); }
        else { f32x16 akp = {}; mma_nat<64>(akp, U + O_KH, P144, 0, U + O_PM, P144, 0, lane);
#pragma unroll
          for (int r = 0; r < 16; ++r) if (crow(r, hi) >= l31) akp[r] = 0.f;
          store_t(U + O_AKP, P80, akp, 0, 0, lane);
          SB_WAITL();
          f32x16 z0 = {}, z1 = {}; mma_nat<32>(z0, U + O_AKP, P80, 0, U + O_VT, P80, 0, lane); mma_nat<32>(z1, U + O_AKP, P80, 0, U + O_VT, P80, 32, lane);
#pragma unroll
          for (int r = 0; r < 16; ++r) { const float za_ = z0[r], zb_ = z1[r]; auto sw = __builtin_amdgcn_permlane32_swap(__builtin_bit_cast(unsigned, za_), __builtin_bit_cast(unsigned, zb_), false, false);
            const unsigned s0_ = sw[0], s1_ = sw[1]; xv[crow(r, 0)] = __builtin_bit_cast(float, s0_); xv[crow(r, 1)] = __builtin_bit_cast(float, s1_); } }
        f32x16 aqp = {}; mma_nat<64>(aqp, U + O_PM, P144, 0, U + O_QM, P144, 0, lane);
#pragma unroll
        for (int s = 0; s < 31; ++s) { const float xs = xv[s]; float as_[32];
#pragma unroll
          for (int t = s + 1; t < 32; ++t) { const int rt = (t & 3) + 4 * (t >> 3), ht = (t >> 2) & 1; const float af_ = aqp[rt]; const int av = __builtin_bit_cast(int, af_);
            as_[t] = __builtin_bit_cast(float, __builtin_amdgcn_readlane(av, s + 32 * ht)); }
#pragma unroll
          for (int t = s + 1; t < 32; ++t) xv[t] = fnma_sv(as_[t], xs, xv[t]); }
#ifdef SB_PROBE_SUBST
        for (int rep_ = 1; rep_ < p.reps[22]; ++rep_) { float xc[32];
#pragma unroll
          for (int t = 0; t < 32; ++t) xc[t] = xv[t] + (float)rep_;
#pragma unroll
          for (int s = 0; s < 31; ++s) { const float xs = xc[s]; float as_[32];
#pragma unroll
            for (int t = s + 1; t < 32; ++t) { const int rt = (t & 3) + 4 * (t >> 3), ht = (t >> 2) & 1; const float af_ = aqp[rt]; const int av = __builtin_bit_cast(int, af_); as_[t] = __builtin_bit_cast(float, __builtin_amdgcn_readlane(av, s + 32 * ht)); }
#pragma unroll
            for (int t = s + 1; t < 32; ++t) xc[t] = fnma_sv(as_[t], xs, xc[t]); }
          float sink = 0.f;
#pragma unroll
          for (int t = 0; t < 32; ++t) sink += xc[t];
          asm volatile("" :: "v"(sink)); }
#endif
        LAS unsigned char* dst = U + (wq == 0 ? O_WT : O_UT) + lane * P80;
#pragma unroll
        for (int q = 0; q < 4; ++q) *(LAS u4*)(dst + 16 * q) = (u4){pkb(xv[8 * q], xv[8 * q + 1]), pkb(xv[8 * q + 2], xv[8 * q + 3]), pkb(xv[8 * q + 4], xv[8 * q + 5]), pkb(xv[8 * q + 6], xv[8 * q + 7])};
      } else if (wq == 2) { f32x16 t0 = {}; mma_nat<64>(t0, U + O_QM, P144, 0, U + O_RH, P144, 0, lane);
#pragma unroll
        for (int r = 0; r < 16; ++r) if (crow(r, hi) > l31) t0[r] = 0.f;
        store_t(U + O_BRQ, P80, t0, 0, 0, lane);
#ifndef HOST_EMU
        { const int it = xtr_first + (xslot * 4 + uq * 2) * (int)gridDim.x + (int)blockIdx.x; if (it < xtr_total && XTR_SLOT_OK) xtr_item(p, it, lane); }
#endif
      } else { f32x16 t0 = {}; mma_nat<64>(t0, U + O_KH, P144, 0, U + O_RH, P144, 0, lane);
#pragma unroll
        for (int r = 0; r < 16; ++r) if (crow(r, hi) > l31) t0[r] = 0.f;
        store_t(U + O_BRK, P80, t0, 0, 0, lane);
        SB_WAITL();
        mma_nat<32>(R[0], U + O_BRK, P80, 0, U + O_VT, P80, 0, lane); mma_nat<32>(R[1], U + O_BRK, P80, 0, U + O_VT, P80, 32, lane);
#ifndef HOST_EMU
        { const int it = xtr_first + (xslot * 4 + uq * 2 + 1) * (int)gridDim.x + (int)blockIdx.x; if (it < xtr_total && XTR_SLOT_OK) xtr_item(p, it, lane); }
#endif
      }
      ++xslot;
      __syncthreads();
      SB_OPAQUE_LANE();
      if (wq == 0) {
#pragma unroll
        for (int kt2 = 0; kt2 < 2; ++kt2) { f32x16 cc = {}; mma_nat<32>(cc, U + O_WT, P80, 32 * kt2, U + O_BRQ, P80, 0, lane);
          const LAS unsigned char* rhp = U + O_RH + l31 * P144 + (32 * kt2 + 4 * hi) * 2; LAS unsigned char* rfp = U + O_REFF + l31 * P144 + (32 * kt2 + 4 * hi) * 2;
#pragma unroll
          for (int gq = 0; gq < 4; ++gq) { const u2 rh = *(const LAS u2*)(rhp + 16 * gq);
            const float a0 = __builtin_bit_cast(float, rh.x << 16) - cc[4 * gq], a1 = __builtin_bit_cast(float, rh.x & 0xffff0000u) - cc[4 * gq + 1], a2 = __builtin_bit_cast(float, rh.y << 16) - cc[4 * gq + 2], a3 = __builtin_bit_cast(float, rh.y & 0xffff0000u) - cc[4 * gq + 3];
            u2 w; w.x = pkb(a0, a1); w.y = pkb(a2, a3); *(LAS u2*)(rfp + 16 * gq) = w; } }
      } else if (wq == 1) {
#pragma unroll
        for (int jt = 0; jt < 2; ++jt)
#pragma unroll
          for (int it = 0; it < 2; ++it) { f32x16 cc = {}; mma_nat<32>(cc, U + O_WT, P80, 32 * jt, U + O_QT, P80, 32 * it, lane);
            const float gl = GL[l31 + 32 * it];
#pragma unroll
            for (int r = 0; r < 16; ++r) cc[r] = gl * (((crow(r, hi) + 32 * jt) == (l31 + 32 * it) ? 1.f : 0.f) - cc[r]);
            store_t(U + O_MCT, P144, cc, 32 * it, 32 * jt, lane); }
      } else if (wq == 2) {
#pragma unroll
        for (int it = 0; it < 2; ++it)
#pragma unroll
          for (int vt2 = 0; vt2 < 2; ++vt2) { f32x16 ca = {}, cb = {}; mma_nat<32>(ca, U + O_KT, P80, 32 * it, U + O_VT, P80, 32 * vt2, lane); mma_nat<32>(cb, U + O_QT, P80, 32 * it, U + O_UT, P80, 32 * vt2, lane);
#pragma unroll
            for (int r = 0; r < 16; ++r) ca[r] = GL[crow(r, hi) + 32 * it] * (ca[r] - cb[r]);
            R[it * 2 + vt2] = ca; }
      } else {
        f32x16 c0 = {}, c1 = {}; mma_nat<32>(c0, U + O_BRQ, P80, 0, U + O_UT, P80, 0, lane); mma_nat<32>(c1, U + O_BRQ, P80, 0, U + O_UT, P80, 32, lane); R[0] = R[0] - c0; R[1] = R[1] - c1; }
      __syncthreads();
      SB_OPAQUE_LANE();
      if (wq == 0) {
        const int row = ROWT[l31];
#pragma unroll
        for (int jt = 0; jt < 2; ++jt) { f32x16 cc = {}; mma_nat<64>(cc, U + O_F, P144, 32 * jt, U + O_REFF, P144, 0, lane);
          if (row >= 0) { bf16_t* dst = p.Zt + dd * BTW + (size_t)row * RW + h * 64 + 32 * jt + 4 * hi;
#pragma unroll
            for (int gq = 0; gq < 4; ++gq) { u2 w; w.x = pkb(cc[4 * gq], cc[4 * gq + 1]); w.y = pkb(cc[4 * gq + 2], cc[4 * gq + 3]); *(u2*)(dst + 8 * gq) = w; } } }
      } else if (wq == 3) {
        mma_nat<64>(R[0], U + O_REFF, P144, 0, U + O_F + 64 * P144, P144, 0, lane); mma_nat<64>(R[1], U + O_REFF, P144, 0, U + O_F + 64 * P144, P144, 32, lane);
#pragma unroll
        for (int r = 0; r < 16; ++r) { const int row = ROWT[crow(r, hi)]; if (row >= 0) { float* dst = p.O2 + dd * BTW + (size_t)row * RW + h * 64 + l31; dst[0] = R[0][r]; dst[32] = R[1][r]; } }
      } else {
        const int cbase = wq == 1 ? 0 : 64;
#pragma unroll
        for (int it = 0; it < 2; ++it)
#pragma unroll
          for (int ct = 0; ct < 2; ++ct) mma_nat<64>(R[it * 2 + ct], U + O_MCT, P144, 32 * it, U + O_F + cbase * P144, P144, 32 * ct, lane); }
      __syncthreads();
      if (wq == 1 || wq == 2) { const int cbase = wq == 1 ? 0 : 64;
#pragma unroll
        for (int it = 0; it < 2; ++it)
#pragma unroll
          for (int ct = 0; ct < 2; ++ct) store_t(U + O_F, P144, R[it * 2 + ct], cbase + 32 * ct, 32 * it, lane);
        if (c == NCH - 1) {
          float* fe = p.Fend + ((size_t)ch * NSEG + g) * 128 * 64 + (size_t)(wq == 1 ? 64 : 0) * 64;
#pragma unroll
          for (int it = 0; it < 2; ++it)
#pragma unroll
            for (int ct = 0; ct < 2; ++ct) { float* rp = fe + (size_t)(32 * ct + l31) * 64 + 32 * it + 4 * hi; const f32x16& cc = R[it * 2 + ct];
#pragma unroll
              for (int gq = 0; gq < 4; ++gq) *(f4*)(rp + 8 * gq) = (f4){cc[4 * gq], cc[4 * gq + 1], cc[4 * gq + 2], cc[4 * gq + 3]}; } } }
      __syncthreads();
    }
  }
}
}


template <class F> struct EpiFn {
  static constexpr bool PERM = true, AFTER_DRAIN = false; F f;
  __device__ __forceinline__ void operator()(const pg8::f32x4 (&acc)[2][2][4][2], const pg8::Unit& u, int wr, int wc, int fr, int fq) const {
#pragma unroll
    for (int ai = 0; ai < 2; ++ai)
#pragma unroll
      for (int m = 0; m < 4; ++m) { const int row = u.pm * 256 + ai * 128 + wr * 64 + m * 16 + fr;
#pragma unroll
        for (int bj = 0; bj < 2; ++bj) { const int col = u.pn * 256 + bj * 128 + wc * 32 + 8 * fq; f(u, row, col, acc[ai][bj][m][0], acc[ai][bj][m][1]); asm volatile("" ::: "memory"); } }
  }
};
template <class F> __device__ __forceinline__ void run_gemm(LAS unsigned char* lds, const bf16_t* A, const bf16_t* Bt, int M, int N, int K, F f, const int tid_in, const int* tile_e = nullptr, size_t bexp = 0) {
  asm volatile("" : "+s"(M), "+s"(N), "+s"(K));
  pg8::Gemm g{A, Bt, M, N, K, bexp}; pg8::StaticOrder S; S.init(M, N, (int)gridDim.x, (int)blockIdx.x, tile_e);
  EpiFn<F> E{f};
  pg8::gemm_phase<EpiFn<F>, pg8::StaticOrder, true, true>((PG8_LAS unsigned char*)lds, g, S, E, tid_in);
}

__device__ __forceinline__ unsigned pk2(float lo, float hi) { return (unsigned)f2bf(lo) | ((unsigned)f2bf(hi) << 16); }
__device__ __forceinline__ void transpose_all(const float* W, int K, int N, bf16_t* WT, int gw, int ngw, int lane) {
  const int nblk = N / 64, items = (K / 64) * nblk;
  for (int it = gw; it < items; it += ngw) { const int kb = it / nblk, nb = it % nblk; const float* src = W + (size_t)(kb * 64) * N + nb * 64 + lane; float x[64];
#pragma unroll
    for (int j = 0; j < 64; ++j) x[j] = src[(size_t)j * N];
    bf16_t* dst = WT + (size_t)(nb * 64 + lane) * K + kb * 64;
#pragma unroll
    for (int c = 0; c < 8; ++c) { v4u o; o.x = pk2(x[8 * c], x[8 * c + 1]); o.y = pk2(x[8 * c + 2], x[8 * c + 3]); o.z = pk2(x[8 * c + 4], x[8 * c + 5]); o.w = pk2(x[8 * c + 6], x[8 * c + 7]); *(v4u*)(dst + 8 * c) = o; } }
}

constexpr int INP = 2304;

__global__ void __launch_bounds__(NTHREADS, 2) fwd(Pm p, unsigned* bar) {
  extern __shared__ __attribute__((aligned(16))) unsigned char lds_raw[];
  LAS unsigned char* lds = (LAS unsigned char*)lds_raw;
#define IDS() int tidb; asm volatile("v_mbcnt_lo_u32_b32 %0, -1, 0\n\tv_mbcnt_hi_u32_b32 %0, -1, %0" : "=v"(tidb)); tidb += wave_s * 64; const int lane = tidb & 63, wave = __builtin_amdgcn_readfirstlane(tidb >> 6); \
    const long tid = (long)blockIdx.x * NTHREADS + tidb, nth = (long)gridDim.x * NTHREADS; const int gw = blockIdx.x * NWAVES + wave, ngw = gridDim.x * NWAVES; \
    (void)lane; (void)wave; (void)tid; (void)nth; (void)gw; (void)ngw
  for (int u = threadIdx.x; u < (LDS_BYTES - RING_BYTES) / 4; u += NTHREADS) ((LAS unsigned*)(lds + RING_BYTES))[u] = 0u;
  __syncthreads();
  const int wave_s = __builtin_amdgcn_readfirstlane((int)threadIdx.x >> 6);
  XcdBarrier xb = xcd_barrier_post(bar, (volatile LAS unsigned*)(lds + MISC_OFF + 32));
  constexpr Dm d = DMC;
#define GSYNC() xcd_barrier(xb)
  constexpr int NSEG = 32;
  const int XTR_P0 = (gridDim.x == 256) ? d.NE * 768 - 72 * 256 : d.NE * 768;
#define NPOS() __builtin_amdgcn_readfirstlane(__hip_atomic_load(p.npos, __ATOMIC_RELAXED, __HIP_MEMORY_SCOPE_AGENT))
  {
  IDS();
  f_mod_partial(p, tidb); f_rope_table(p, tid, nth); f_lora_weights(p, tid, nth);
  {
  transpose_all(p.w_in, d.D, d.IN, p.WinT, gw, ngw, lane);
  for (long i = tid; i < (long)(INP - d.IN) * d.D; i += nth) p.WinT[(size_t)d.IN * d.D + i] = 0;
  transpose_all(p.w_uq, d.QL, d.MH * d.QK, p.WuqT, gw, ngw, lane);
  transpose_all(p.w_ukv, d.KL, d.MH * (d.DN + d.DV), p.WukvT, gw, ngw, lane);
  transpose_all(p.w_out, d.MIX, d.D, p.WoutT, gw, ngw, lane); }
for (int it = gw; it < XTR_P0; it += ngw) { const int e = it / 768, r = it % 768; const bool first = r < 512; const int rr = first ? r : r - 512; const int N = first ? 2048 : 1024, nblk = N / 64, kb = rr / nblk, nb = rr % nblk;
    const float* src = (first ? p.exp_w1 + (size_t)e * 1024 * 2048 : p.exp_w2 + (size_t)e * 1024 * 1024) + (size_t)(kb * 64) * N + nb * 64 + lane; float x[64];
#pragma unroll
    for (int j = 0; j < 64; ++j) x[j] = __builtin_nontemporal_load(src + (size_t)j * N);
    bf16_t* dst = (first ? p.W1T + (size_t)e * 2048 * 1024 : p.W2T + (size_t)e * 1024 * 1024) + (size_t)(nb * 64 + lane) * 1024 + kb * 64;
#pragma unroll
    for (int c = 0; c < 8; ++c) { v4u o; o.x = pk2(x[8 * c], x[8 * c + 1]); o.y = pk2(x[8 * c + 2], x[8 * c + 3]); o.z = pk2(x[8 * c + 4], x[8 * c + 5]); o.w = pk2(x[8 * c + 6], x[8 * c + 7]); *(v4u*)(dst + 8 * c) = o; } }
    }
  GSYNC();
  {
  IDS();

  { f_mod_reduce(p, (LAS float*)lds, tidb); f_norm1(p, (const LAS float*)lds, gw, ngw, lane); }   }
  GSYNC();
  {
  IDS();

{ bf16_t* P = p.P; const int IN = d.IN;
    run_gemm(lds, p.A1, p.WinT, d.NR, INP, d.D, [=](const pg8::Unit& u, int row, int col, pg8::f32x4 v0, pg8::f32x4 v1) {
      if (col < IN) { v4u w; w.x = pk2(v0[0], v0[1]); w.y = pk2(v0[2], v0[3]); w.z = pk2(v1[0], v1[1]); w.w = pk2(v1[2], v1[3]); *(v4u*)(P + (size_t)row * IN + col) = w; } }, tidb); }
  }
  GSYNC();
  {
  IDS();

  { f_mla_a(p, gw, ngw, lane); f_rwkv_s1(p, gw, ngw, lane); }   }
  GSYNC();
  {
  IDS();

{ bf16_t* Q = p.Q; const float* ropet = p.ropet;
    run_gemm(lds, p.QN, p.WuqT, d.BT, 768, 256, [=](const pg8::Unit& u, int row, int col, pg8::f32x4 v0, pg8::f32x4 v1) {
      const int h = col / 192, i0 = col - h * 192, b = row >> 13, t = row & 8191;
      float x[8] = {v0[0], v0[1], v0[2], v0[3], v1[0], v1[1], v1[2], v1[3]}, pr[8];
#pragma unroll
      for (int e = 0; e < 8; ++e) pr[e] = __shfl_xor(x[e], 32);
      if (i0 >= 128) { const int i = i0 - 128, a = i >> 5, half = (i >> 4) & 1, f0 = i & 15; const float* ct = ropet + ((size_t)t * 32 + a * 16 + f0) * 2;
#pragma unroll
        for (int e = 0; e < 8; ++e) { const float c = ct[2 * e], s = ct[2 * e + 1]; x[e] = half ? x[e] * c + pr[e] * s : x[e] * c - pr[e] * s; } }
      v4u w; w.x = pk2(x[0], x[1]); w.y = pk2(x[2], x[3]); w.z = pk2(x[4], x[5]); w.w = pk2(x[6], x[7]);
      *(v4u*)(Q + ((size_t)(b * 4 + h) * 8192 + t) * 192 + i0) = w; }, tidb); }
{ bf16_t* K = p.K; bf16_t* V = p.V; const int BT = d.BT;
    run_gemm(lds, p.CN, p.WukvT, d.NR, 1024, 128, [=](const pg8::Unit& u, int row, int col, pg8::f32x4 v0, pg8::f32x4 v1) {
      const int h = col >> 8, i0 = col & 255; int b, key; if (row < BT) { b = row >> 13; key = 256 + (row & 8191); } else { b = (row - BT) >> 8; key = (row - BT) & 255; }
      v4u w; w.x = pk2(v0[0], v0[1]); w.y = pk2(v0[2], v0[3]); w.z = pk2(v1[0], v1[1]); w.w = pk2(v1[2], v1[3]);
      const size_t kr = (size_t)(b * 4 + h) * 8448 + key;
      if (i0 < 128) *(v4u*)(K + kr * 192 + i0) = w; else *(v4u*)(V + kr * 128 + (i0 - 128)) = w; }, tidb); }
{ bf16_t* Wd = p.Wd; bf16_t* Bb = p.Bb; bf16_t* Kd = p.Kd; const bf16_t* KK = p.KK; const float* Kraw = p.Kraw; const float* w0 = p.w0; const float* a0 = p.a0; const float* k_a = p.k_a; const size_t NRW = (size_t)d.NR * 512;
    run_gemm(lds, p.AL1, p.WlT, d.NR, 2048, 128, [=](const pg8::Unit& u, int row, int col, pg8::f32x4 v0, pg8::f32x4 v1) {
      float x[8] = {v0[0], v0[1], v0[2], v0[3], v1[0], v1[1], v1[2], v1[3]};
      if (col < 1024) { const int dd = col >> 9, c = col & 511; const float* wb = w0 + dd * 512 + c; float o[8];
#pragma unroll
        for (int e = 0; e < 8; ++e) o[e] = -0.87503576f / (1.f + __expf(-(x[e] + wb[e])));
        v4u w; w.x = pk2(o[0], o[1]); w.y = pk2(o[2], o[3]); w.z = pk2(o[4], o[5]); w.w = pk2(o[6], o[7]); *(v4u*)(Wd + (size_t)dd * NRW + (size_t)row * 512 + c) = w; }
      else { const int q = col - 1024, dd = q >> 9, c = q & 511; const float* ab = a0 + dd * 512 + c; const v4u kk4 = *(const v4u*)(KK + (size_t)row * 512 + c); const float* kp = Kraw + (size_t)row * 512 + c; float ob[8], ok[8];
        const unsigned kw[4] = {kk4.x, kk4.y, kk4.z, kk4.w};
#pragma unroll
        for (int e = 0; e < 8; ++e) { const float a = 1.f / (1.f + __expf(-(x[e] + ab[e]))); const float kkv = __builtin_bit_cast(float, (e & 1) ? (kw[e >> 1] & 0xffff0000u) : (kw[e >> 1] << 16)); ob[e] = kkv * a; ok[e] = kp[e] * (1.f + (a - 1.f) * k_a[c + e]); }
        v4u w1; w1.x = pk2(ob[0], ob[1]); w1.y = pk2(ob[2], ob[3]); w1.z = pk2(ob[4], ob[5]); w1.w = pk2(ob[6], ob[7]); *(v4u*)(Bb + (size_t)dd * NRW + (size_t)row * 512 + c) = w1;
        v4u w2; w2.x = pk2(ok[0], ok[1]); w2.y = pk2(ok[2], ok[3]); w2.z = pk2(ok[4], ok[5]); w2.w = pk2(ok[6], ok[7]); *(v4u*)(Kd + (size_t)dd * NRW + (size_t)row * 512 + c) = w2; } }, tidb); }
  { float* Gt = p.Gt;
    run_gemm(lds, p.AL2, p.G2T, d.BT, 512, 128, [=](const pg8::Unit& u, int row, int col, pg8::f32x4 v0, pg8::f32x4 v1) { float* o = Gt + (size_t)row * 512 + col; *(pg8::f32x4*)o = v0; *(pg8::f32x4*)(o + 4) = v1; }, tidb); }
    }
  GSYNC();
  {
  IDS();

sb::f_scan_b1(p, lds, wave, lane, NSEG, XTR_P0, d.NE * 768);   }
  GSYNC();
  {
  IDS();
f_scan_a2(p, lds, wave, lane, NSEG);   }
  GSYNC();
  {
  IDS();

ph_scan_a3(p, gw, ngw, lane, NSEG);
for (int u = blockIdx.x; u < d.B * d.MH * (d.T / 256); u += gridDim.x) { const int bh = u % (d.B * d.MH), qb = u / (d.B * d.MH), b = bh / d.MH, h = bh % d.MH; const int NK = d.C + d.T;
    attn::attn_dense_body(p.Q + ((size_t)bh * d.T + (size_t)qb * 256) * attn::DQK, p.K + (size_t)bh * NK * attn::DQK, p.V + (size_t)bh * NK * attn::DV,
                          p.MIXb + ((size_t)b * d.T + (size_t)qb * 256) * d.MIX + d.RW + h * attn::DV, NK, (char*)lds_raw, tidb); }
    }
  GSYNC();
  {
  IDS();

f_readout(p, gw, ngw, lane);   }
  GSYNC();
  {
  IDS();

{ float* x1 = p.x1; const float* x = p.x; const float* modv = p.modv; const int D = d.D, T = d.T;
    run_gemm(lds, p.MIXb, p.WoutT, d.BT, D, d.MIX, [=](const pg8::Unit& u, int row, int col, pg8::f32x4 v0, pg8::f32x4 v1) {
      const float* g = modv + (size_t)(row / T) * 6 * D + 2 * D + col; const float* xr = x + (size_t)row * D + col; float* o = x1 + (size_t)row * D + col;
      const pg8::f32x4 g0 = *(const pg8::f32x4*)g, g1 = *(const pg8::f32x4*)(g + 4), x0 = *(const pg8::f32x4*)xr, x1v = *(const pg8::f32x4*)(xr + 4);
      *(pg8::f32x4*)o = x0 + g0 * v0; *(pg8::f32x4*)(o + 4) = x1v + g1 * v1; }, tidb); }
    }
  GSYNC();
  {
  IDS();

f_route(p, lds, wave, lane, tidb);
  }
  GSYNC();
  {
  IDS();
f_place(p, lds, wave, lane, tidb);
  }
  GSYNC();
  {
  IDS();
  const int npos = NPOS();
{ bf16_t* ACT = p.ACTb; const float* b1 = p.exp_b1; const int DE = d.DE;
    run_gemm(lds, p.Xg, p.W1T, npos, 2 * d.DE, d.D, [=](const pg8::Unit& u, int row, int col, pg8::f32x4 v0, pg8::f32x4 v1) {
      const float* bb = b1 + (size_t)u.eb * 2 * DE + col; const pg8::f32x4 c0 = *(const pg8::f32x4*)bb, c1 = *(const pg8::f32x4*)(bb + 4);
      v0 = v0 + c0; v1 = v1 + c1; float o[4];
#pragma unroll
      for (int q = 0; q < 4; ++q) { const float gl = fminf(q < 2 ? v0[2 * q] : v1[2 * q - 4], 7.f), li = fminf(fmaxf(q < 2 ? v0[2 * q + 1] : v1[2 * q - 3], -7.f), 7.f);
        o[q] = gl * (li + 1.f) / (1.f + __expf(-1.702f * gl)); }
      uint2 w; w.x = pk2(o[0], o[1]); w.y = pk2(o[2], o[3]); *(uint2*)(ACT + (size_t)row * DE + (col >> 1)) = w; }, tidb, p.tile_e, (size_t)2 * d.DE * d.D * 2); }
    }
  GSYNC();
  {
  IDS();

  const int npos = NPOS();
{ bf16_t* Y = p.Yb; const float* b2 = p.exp_b2; const int D = d.D;
    run_gemm(lds, p.ACTb, p.W2T, npos, d.D, d.DE, [=](const pg8::Unit& u, int row, int col, pg8::f32x4 v0, pg8::f32x4 v1) {
      const float* bb = b2 + (size_t)u.eb * D + col; const pg8::f32x4 c0 = *(const pg8::f32x4*)bb, c1 = *(const pg8::f32x4*)(bb + 4);
      v0 = v0 + c0; v1 = v1 + c1; v4u w; w.x = pk2(v0[0], v0[1]); w.y = pk2(v0[2], v0[3]); w.z = pk2(v1[0], v1[1]); w.w = pk2(v1[2], v1[3]);
      *(v4u*)(Y + (size_t)row * D + col) = w; }, tidb, p.tile_e, (size_t)d.D * d.DE * 2); }
    }
  GSYNC();
  {
  IDS();

f_final(p, gw, ngw, lane);
  }
}

static size_t carve(Pm& p, char* base) {
  const Dm& d = p.d; size_t off = 0;
#define CARVE(ptr, type, count) do { p.ptr = (type*)(base + off); off += (((size_t)(count) * sizeof(type)) + 255) / 256 * 256; } while (0)
  const size_t NRW = (size_t)d.NR * d.RW; const int NK = d.C + d.T;
  CARVE(modv, float, (size_t)(d.B + 1) * 6 * d.D); CARVE(modp, float, (size_t)16 * 3 * 6 * d.D); CARVE(ropet, float, (size_t)d.T * 64);
  CARVE(top_e, int, (size_t)d.BT * 4); CARVE(cnt, int, d.NE); CARVE(slot_pos, int, (size_t)d.BT * 4); CARVE(pos_tok, int, d.NPOSMAX); CARVE(tile_e, int, d.NPOSMAX / d.PADR + 1); CARVE(npos, int, 4);
  CARVE(gate, float, (size_t)d.BT * 4); CARVE(lrank, int, (size_t)d.BT * 4); CARVE(blkcnt, int, 1024 * 32);
  CARVE(WlT, bf16_t, (size_t)2048 * 128); CARVE(G2T, bf16_t, (size_t)512 * 128);
  CARVE(WinT, bf16_t, (size_t)INP * d.D); CARVE(WuqT, bf16_t, (size_t)d.MH * d.QK * d.QL); CARVE(WukvT, bf16_t, (size_t)d.MH * (d.DN + d.DV) * d.KL); CARVE(WoutT, bf16_t, (size_t)d.D * d.MIX);
  CARVE(W1T, bf16_t, (size_t)d.NE * 2 * d.DE * d.D); CARVE(W2T, bf16_t, (size_t)d.NE * d.D * d.DE);
  const size_t early0 = off;
  CARVE(P, bf16_t, (size_t)d.NR * d.IN); CARVE(A1, bf16_t, (size_t)d.NR * d.D);
  const size_t after_p = off;
  CARVE(Kraw, float, NRW); CARVE(AL1, bf16_t, (size_t)d.NR * 128); CARVE(AL2, bf16_t, (size_t)d.BT * 128); CARVE(Rr, bf16_t, NRW); CARVE(Vv, bf16_t, NRW); CARVE(KK, bf16_t, NRW); CARVE(Kd, bf16_t, 2 * NRW); CARVE(Wd, bf16_t, 2 * NRW); CARVE(Bb, bf16_t, 2 * NRW);
  CARVE(Gt, float, (size_t)d.BT * d.RW); CARVE(QN, bf16_t, (size_t)d.BT * d.QL); CARVE(CN, bf16_t, (size_t)d.NR * d.KL);
  CARVE(O2, float, (size_t)2 * d.BT * d.RW);
  CARVE(Q, bf16_t, (size_t)d.B * d.MH * d.T * d.QK); CARVE(K, bf16_t, (size_t)d.B * d.MH * NK * d.QK); CARVE(V, bf16_t, (size_t)d.B * d.MH * NK * d.DV);
  CARVE(MIXb, bf16_t, (size_t)d.BT * d.MIX);
  size_t end1 = off;
  off = early0; CARVE(x1, float, (size_t)d.BT * d.D); CARVE(H2b, bf16_t, (size_t)d.BT * d.D);
  if (off > after_p) return (size_t)-1;
  off = after_p; CARVE(Xg, bf16_t, (size_t)d.NPOSMAX * d.D); CARVE(ACTb, bf16_t, (size_t)d.NPOSMAX * d.DE); CARVE(Yb, bf16_t, (size_t)d.NPOSMAX * d.D);
  if (off > end1) end1 = off;
  off = end1; CARVE(Zt, bf16_t, (size_t)2 * d.BT * d.RW); CARVE(Fend, float, (size_t)2 * d.B * d.RH * 32 * 128 * 64); CARVE(Sst, float, (size_t)2 * d.B * d.RH * 32 * 64 * 64); end1 = off;
#undef CARVE
  return end1;
}

extern "C" void kernel_launch(void* const* d_in, const int* in_sizes, int n_in, void* d_out, int out_size, void* d_ws, size_t ws_size, hipStream_t stream) {
  static int grid = 0;
  if (!grid) {
    int dev = 0, cus = 0;
    hipGetDevice(&dev); hipDeviceGetAttribute(&cus, hipDeviceAttributeMultiprocessorCount, dev);
    if (hipFuncSetAttribute((const void*)fwd, hipFuncAttributeMaxDynamicSharedMemorySize, LDS_BYTES) != hipSuccess) { fprintf(stderr, "kernel_launch: hipFuncSetAttribute failed\n"); grid = -1; return; }
    grid = cus;
  }
  if (grid < 0) return;
  Pm p; memset(&p, 0, sizeof(p));
  Dm& d = p.d; d.D = 1024; d.B = 2; d.T = 8192; d.GW = 64; d.C = 256; d.RH = 8; d.LW = 64; d.LA = 64; d.LG = 128; d.MH = 4; d.DN = 128; d.DR = 64; d.DV = 128; d.QL = 256; d.KL = 128;
  d.NE = 32; d.DE = 1024; d.PADR = 256; dm_finish(d);
  const float** ip = &p.x; for (int i = 0; i < 32; ++i) ip[i] = (const float*)d_in[i];
  p.out = (float*)d_out;
  unsigned* bar = (unsigned*)d_ws;
  const size_t used = carve(p, (char*)d_ws + 16384);
  if (used == (size_t)-1 || used + 16384 > ws_size) { fprintf(stderr, "kernel_launch: workspace too small (%zu needed, %zu given)\n", used + 16384, ws_size); return; }
  static bool once = false; if (!once) { once = true; fprintf(stderr, "ws used %zu of %zu\n", used + 16384, ws_size); }
  hipMemsetAsync(bar, 0, 16384, stream);
  hipLaunchKernelGGL(fwd, dim3(grid), dim3(NTHREADS), LDS_BYTES, stream, p, bar);
}
```

```cpp
#include <hip/hip_runtime.h>
#include <cstdio>
#include <cstring>
#include <cstdint>
#define HD __host__ __device__
#ifndef HD
#define HD
#endif
struct Dm {
  int D, B, T, GW, C, RH, LW, LA, LG, MH, DN, DR, DV, QL, KL, NE, DE;
  int RW, RC, QK, MC, IN, MIX, NF, BT, BC, NR, PADR, NPOSMAX, pad_;
};
HD constexpr void dm_finish(Dm& d) {
  d.RW = d.RH * 64; d.RC = 3 * d.RW + d.LW + d.LA + d.LG; d.QK = d.DN + d.DR; d.MC = d.QL + d.KL + d.DR; d.IN = d.RC + d.MC;
  d.MIX = d.RW + d.MH * d.DV; d.NF = d.DR / 4; d.BT = d.B * d.T; d.BC = d.B * d.C; d.NR = d.BT + d.BC;
  d.NPOSMAX = d.BT * 4 + d.NE * d.PADR;
}
typedef unsigned short bf16_t;
HD inline bf16_t f2bf(float f) { unsigned u = __builtin_bit_cast(unsigned, f); return (bf16_t)((u + 0x7fffu + ((u >> 16) & 1u)) >> 16); }
HD inline float bf2f(bf16_t h) { return __builtin_bit_cast(float, (unsigned)h << 16); }
HD constexpr Dm make_dmc() { Dm d{}; d.D = 1024; d.B = 2; d.T = 8192; d.GW = 64; d.C = 256; d.RH = 8; d.LW = 64; d.LA = 64; d.LG = 128; d.MH = 4; d.DN = 128; d.DR = 64; d.DV = 128; d.QL = 256; d.KL = 128;
  d.NE = 32; d.DE = 1024; d.PADR = 256; dm_finish(d); return d; }
constexpr Dm DMC = make_dmc();
typedef float f4q __attribute__((ext_vector_type(4)));
typedef unsigned u4q __attribute__((ext_vector_type(4)));
struct Pm {
  Dm d; int reps[24];
  const float *x, *c, *ctx, *c_ctx, *mod_w, *mod_b, *norm1_g, *w_in, *mu, *w0, *w2, *a0, *a2, *k_k, *k_a, *r_k, *g2, *ln_w, *ln_b, *q_norm, *w_uq, *kv_norm,
      *w_ukv, *w_out, *norm2_g, *router_w, *router_b, *exp_w1, *exp_b1, *exp_w2, *exp_b2, *final_g;
  float* out;
  float *modv, *modp, *ropet, *Kraw, *Gt, *O2, *Fend, *Sst, *x1, *gate;
  bf16_t *A1, *QN, *CN, *MIXb, *WinT, *WuqT, *WukvT, *WoutT, *W1T, *W2T, *H2b, *Xg, *ACTb, *Yb, *Q, *K, *V, *AL1, *AL2, *WlT, *G2T, *P, *Zt, *Rr, *Vv, *KK, *Kd, *Wd, *Bb;
  int *top_e, *cnt, *slot_pos, *pos_tok, *tile_e, *npos, *lrank, *blkcnt;
};
HD inline float sigmoidf_(float x) { return 1.f / (1.f + expf(-x)); }

template <int TM, class Epi>
HD inline void gemm_naive(const float* A, int lda, const float* Bm, int ldb, int M, int N, int K, long tid, long nth, Epi epi) {
  const long ngm = (M + TM - 1) / TM, items = ngm * N;
  for (long it = tid; it < items; it += nth) {
    const int n = (int)(it % N); const long m0 = (it / N) * TM;
    float acc[TM];
#pragma unroll
    for (int i = 0; i < TM; ++i) acc[i] = 0.f;
    const float* a[TM];
#pragma unroll
    for (int i = 0; i < TM; ++i) a[i] = A + (size_t)((m0 + i < M) ? (m0 + i) : (M - 1)) * lda;
    for (int k = 0; k < K; k += 4) {
      const float b0 = Bm[(size_t)k * ldb + n], b1 = Bm[(size_t)(k + 1) * ldb + n], b2 = Bm[(size_t)(k + 2) * ldb + n], b3 = Bm[(size_t)(k + 3) * ldb + n];
#pragma unroll
      for (int i = 0; i < TM; ++i) { acc[i] += a[i][k] * b0; acc[i] += a[i][k + 1] * b1; acc[i] += a[i][k + 2] * b2; acc[i] += a[i][k + 3] * b3; }
    }
#pragma unroll
    for (int i = 0; i < TM; ++i) if (m0 + i < M) epi(m0 + i, n, acc[i]);
  }
}

HD inline void row_pos(const Dm& d, long row, int& t, int& len, int& b, int& isctx) {
  if (row < d.BT) { b = (int)(row / d.T); t = (int)(row % d.T); len = d.T; isctx = 0; } else { const long r = row - d.BT; b = (int)(r / d.C); t = (int)(r % d.C); len = d.C; isctx = 1; }
}

HD inline void chain_step(const Dm& d, int dd, int b, int sg, size_t& row, bool& lat) {
  if (sg < d.C) { const int t = dd == 0 ? sg : d.C - 1 - sg; row = (size_t)d.BT + (size_t)b * d.C + t; lat = false; }
  else { const int s = sg - d.C; const int t = dd == 0 ? s : d.T - 1 - s; row = (size_t)b * d.T + t; lat = true; }
}
__device__ inline void ph_scan_a2(const Pm& p, int gw, int ngw, int lane, int NSEG) {
  constexpr Dm d = DMC; const int items = 2 * d.B * d.RH * 64;
  for (int it = gw; it < items; it += ngw) { const int v = it % 64, ch = it / 64; float S = 0.f; float pf[64], pn[64]; float sl, sln;
    { const float* fe = p.Fend + ((size_t)ch * NSEG) * 128 * 64; sl = fe[(size_t)v * 64 + lane];
#pragma unroll
      for (int i = 0; i < 64; ++i) pf[i] = fe[(size_t)(64 + i) * 64 + lane]; }
    for (int g = 0; g < NSEG; ++g) { p.Sst[(((size_t)ch * NSEG + g) * 64 + v) * 64 + lane] = S;
      const int gn = g + 1 < NSEG ? g + 1 : g; const float* fe = p.Fend + ((size_t)ch * NSEG + gn) * 128 * 64; sln = fe[(size_t)v * 64 + lane];
#pragma unroll
      for (int i = 0; i < 64; ++i) pn[i] = fe[(size_t)(64 + i) * 64 + lane];
      float a0 = sl, a1 = 0.f, a2 = 0.f, a3 = 0.f;
#pragma unroll
      for (int i = 0; i < 64; i += 4) { const int Sb = __builtin_bit_cast(int, S);
        a0 += __builtin_bit_cast(float, __builtin_amdgcn_readlane(Sb, i)) * pf[i]; a1 += __builtin_bit_cast(float, __builtin_amdgcn_readlane(Sb, i + 1)) * pf[i + 1];
        a2 += __builtin_bit_cast(float, __builtin_amdgcn_readlane(Sb, i + 2)) * pf[i + 2]; a3 += __builtin_bit_cast(float, __builtin_amdgcn_readlane(Sb, i + 3)) * pf[i + 3]; }
      S = (a0 + a1) + (a2 + a3); sl = sln;
#pragma unroll
      for (int i = 0; i < 64; ++i) pf[i] = pn[i]; } }
}
__device__ inline void ph_scan_a3(const Pm& p, int gw, int ngw, int lane, int NSEG) {
  constexpr Dm d = DMC; const int RW = d.RW; const int SL = (d.C + d.T) / NSEG; const size_t BTW = (size_t)d.BT * RW; constexpr int PARTS = 2;
  const int items = 2 * d.B * d.RH * NSEG * PARTS;
  for (int it = gw; it < items; it += ngw) { const int part = it % PARTS, g = (it / PARTS) % NSEG, ch = it / (PARTS * NSEG); const int h = ch % d.RH, b = (ch / d.RH) % d.B, dd = ch / (d.RH * d.B);
    const float* st = p.Sst + (((size_t)ch * NSEG + g) * 64 + lane) * 64; float S[64];
#pragma unroll
    for (int i = 0; i < 64; i += 4) { const f4q x = *(const f4q*)(st + i); S[i] = x.x; S[i + 1] = x.y; S[i + 2] = x.z; S[i + 3] = x.w; }
    const int s0 = g * SL + part * (SL / PARTS), s1 = part == PARTS - 1 ? (g + 1) * SL : s0 + SL / PARTS;
    for (int sg = s0; sg < s1; ++sg) { size_t row; bool lat; chain_step(d, dd, b, sg, row, lat); if (!lat) continue;
      const size_t o = row * RW + h * 64; const bf16_t* z = p.Zt + dd * BTW + o; u4q zx[8];
#pragma unroll
      for (int i = 0; i < 8; ++i) zx[i] = *(const u4q*)(z + 8 * i);
      float a = p.O2[dd * BTW + o + lane], a1 = 0.f, a2 = 0.f, a3 = 0.f;
#pragma unroll
      for (int i = 0; i < 8; ++i) { const u4q x = zx[i];
        a += S[8 * i] * __builtin_bit_cast(float, x.x << 16) + S[8 * i + 4] * __builtin_bit_cast(float, x.z << 16); a1 += S[8 * i + 1] * __builtin_bit_cast(float, x.x & 0xffff0000u) + S[8 * i + 5] * __builtin_bit_cast(float, x.z & 0xffff0000u);
        a2 += S[8 * i + 2] * __builtin_bit_cast(float, x.y << 16) + S[8 * i + 6] * __builtin_bit_cast(float, x.w << 16); a3 += S[8 * i + 3] * __builtin_bit_cast(float, x.y & 0xffff0000u) + S[8 * i + 7] * __builtin_bit_cast(float, x.w & 0xffff0000u); }
      a = (a + a1) + (a2 + a3);
      p.O2[dd * BTW + o + lane] = a; } }
}

namespace pg8 {
#define PG8_LAS __attribute__((address_space(3)))
typedef unsigned short bf16_t;
typedef short bf16x8 __attribute__((ext_vector_type(8)));
typedef float f32x4 __attribute__((ext_vector_type(4)));
typedef unsigned u32x4 __attribute__((ext_vector_type(4)));
constexpr int BM = 256, BK = 64, HALF = 128, HTB = HALF * BK * 2  , STAGE_BYTES = 8 * HTB, NXCD = 8, WGM = 8;

__host__ __device__ __forceinline__ int lds_byte(int r, int c) { const int st = (r >> 4) * 2 + (c >> 5), rr = r & 15, cc = c & 31, ob = rr * 64 + cc * 2; return st * 1024 + (ob ^ (((ob >> 9) & 1) << 5)); }
__host__ __device__ __forceinline__ void stage_rc(int b, int& R, int& C) { const int st = b / 1024, sb = b % 1024, swz = sb ^ (((sb >> 9) & 1) << 5); R = (st >> 1) * 16 + swz / 64; C = (st & 1) * 32 + (swz % 64) / 2; }
__host__ __device__ __forceinline__ int perm32(int rho) { const int n = rho >> 4, i = rho & 15; return 8 * (i >> 2) + 4 * n + (i & 3); }

struct Unit { int pm, pn, eb; };
struct Gemm { const bf16_t* A; const bf16_t* Bt; int M, N, K; size_t bexp; };

struct StaticOrder {
    int nM, nN, nwg, G, c; const int* tile_e;
    __host__ __device__ void init(int M, int N, int G_, int c_, const int* te = nullptr) { nM = M / BM; nN = N / BM; nwg = nM * nN; G = G_; c = c_; tile_e = te; }
    __device__ bool next(int i, Unit& u) const {
        const long L = (long)i * G + c; if (L >= nwg) return false;
        int wgid = (int)L; { const int q = nwg / NXCD, r = nwg % NXCD, xcd = wgid % NXCD, off = wgid / NXCD; wgid = (xcd < r ? xcd * (q + 1) : r * (q + 1) + (xcd - r) * q) + off; }
        const int nig = WGM * nN, gid = wgid / nig, fm = gid * WGM, gsz = (nM - fm) < WGM ? (nM - fm) : WGM;
        u.pm = fm + ((wgid % nig) % gsz); u.pn = (wgid % nig) / gsz; u.eb = tile_e ? __builtin_amdgcn_readfirstlane(__hip_atomic_load(tile_e + u.pm, __ATOMIC_RELAXED, __HIP_MEMORY_SCOPE_AGENT)) : 0; return true;
    }
    __device__ __forceinline__ void a_ready(const Unit&) const {}
    __device__ __forceinline__ void done(const Unit&) const {}
};
__device__ __forceinline__ unsigned cvt_pk_bf16(float lo, float hi) { unsigned r; asm volatile("v_cvt_pk_bf16_f32 %0, %1, %2" : "=v"(r) : "v"(lo), "v"(hi)); return r; }
typedef float f32x2 __attribute__((ext_vector_type(2)));
template <class Epi, class Sched, bool ALIGN_EPI = false, bool SP2 = false>
__device__ __forceinline__ void gemm_phase(PG8_LAS unsigned char* lds, const Gemm g, const Sched& S, const Epi& E, const int tid_in) {
    int tid_ = tid_in; asm volatile("" : "+v"(tid_));
    const int tid = tid_, wid = __builtin_amdgcn_readfirstlane(tid >> 6), lane = tid & 63, wr = wid >> 2, wc = wid & 3, fr = lane & 15, fq = lane >> 4;
    const int K = g.K, nt = K / BK;
    unsigned voffA[2], voffB[2];
#pragma unroll
    for (int i = 0; i < 2; ++i) { int R, C; stage_rc(tid * 16 + i * 8192, R, C); const int Rb = Epi::PERM ? ((R & ~31) + perm32(R & 31)) : R;
        voffA[i] = (unsigned)(R * K + C) * 2u; voffB[i] = (unsigned)(Rb * K + C) * 2u; }
    const size_t kstep = (size_t)(BK * 2);
    const size_t hstep = (size_t)HALF * K * 2;
    const size_t tstep = 2 * hstep;
    const unsigned ldsw = (unsigned)wid * 1024u;
    const int aoff = lds_byte(wr * 64 + fr, fq * 8), boff = lds_byte(wc * 32 + fr, fq * 8);
#define PG8_SA(b, h) (((b) * 2 + (h)) * HTB)
#define PG8_SB(b, h) ((4 + (b) * 2 + (h)) * HTB)
#define PG8_STAGE(bufoff, gbase, voff) do { _Pragma("unroll") for (int _i = 0; _i < 2; ++_i) \
        __builtin_amdgcn_global_load_lds((const unsigned*)((const char*)(gbase) + (voff)[_i]), (PG8_LAS unsigned*)(lds + (bufoff) + ldsw + _i * 8192), 16, 0, 0); } while (0)
#define PG8_LDA(dst, b, h) do { _Pragma("unroll") for (int m = 0; m < 4; ++m) _Pragma("unroll") for (int k = 0; k < 2; ++k) dst[m][k] = *(const PG8_LAS bf16x8*)(lds + PG8_SA(b, h) + aoff + m * 2048 + k * 1024); } while (0)
#define PG8_LDB(dst, b, h) do { _Pragma("unroll") for (int n = 0; n < 2; ++n) _Pragma("unroll") for (int k = 0; k < 2; ++k) dst[n][k] = *(const PG8_LAS bf16x8*)(lds + PG8_SB(b, h) + boff + n * 2048 + k * 1024); } while (0)
#define PG8_MMA(ai, bj, At, Bt) do { __builtin_amdgcn_s_setprio(1); _Pragma("unroll") for (int m = 0; m < 4; ++m) _Pragma("unroll") for (int n = 0; n < 2; ++n) _Pragma("unroll") for (int k = 0; k < 2; ++k) \
        acc[ai][bj][m][n] = __builtin_amdgcn_mfma_f32_16x16x32_bf16(Bt[n][k], At[m][k], acc[ai][bj][m][n], 0, 0, 0); __builtin_amdgcn_s_setprio(0); } while (0)
#define PG8_WAIT_V(n) asm volatile("s_waitcnt vmcnt(" #n ")" ::: "memory")
#define PG8_WAIT_L(n) asm volatile("s_waitcnt lgkmcnt(" #n ")" ::: "memory")
#define PG8_BAR __builtin_amdgcn_s_barrier()
#define PG8_SCHED __builtin_amdgcn_sched_barrier(0)
    Unit cur, nxt; int ui = 0;
    if (!S.next(0, cur)) return;
    f32x4 acc[2][2][4][2];
#pragma unroll
    for (int a = 0; a < 2; ++a)
#pragma unroll
        for (int b = 0; b < 2; ++b)
#pragma unroll
            for (int m = 0; m < 4; ++m)
#pragma unroll
                for (int n = 0; n < 2; ++n) acc[a][b][m][n] = (f32x4){0.f, 0.f, 0.f, 0.f};
    bf16x8 At[4][2], B0[2][2], B1[2][2];
    const char* cA = (const char*)g.A + (size_t)cur.pm * tstep; const char* cB = (const char*)g.Bt + (size_t)cur.eb * g.bexp + (size_t)cur.pn * tstep;
    S.a_ready(cur);
    if constexpr (SP2) {
        PG8_STAGE(PG8_SB(0, 0), cB, voffB); PG8_STAGE(PG8_SB(0, 1), cB + hstep, voffB); PG8_STAGE(PG8_SA(0, 0), cA, voffA); PG8_STAGE(PG8_SA(0, 1), cA + hstep, voffA);
        if (wr == 1) PG8_BAR;
        PG8_WAIT_V(2); PG8_BAR;
        PG8_STAGE(PG8_SB(1, 0), cB + kstep, voffB); PG8_STAGE(PG8_SA(1, 0), cA + kstep, voffA); PG8_STAGE(PG8_SB(1, 1), cB + hstep + kstep, voffB);
        PG8_WAIT_V(6); PG8_BAR;
    } else {
        PG8_STAGE(PG8_SB(0, 0), cB, voffB); PG8_STAGE(PG8_SA(0, 0), cA, voffA); PG8_STAGE(PG8_SB(0, 1), cB + hstep, voffB); PG8_STAGE(PG8_SA(0, 1), cA + hstep, voffA);
        if (wr == 1) PG8_BAR;
        PG8_WAIT_V(4); PG8_BAR;
        PG8_STAGE(PG8_SB(1, 0), cB + kstep, voffB); PG8_STAGE(PG8_SA(1, 0), cA + kstep, voffA); PG8_STAGE(PG8_SB(1, 1), cB + hstep + kstep, voffB);
        PG8_WAIT_V(6); PG8_BAR;
    }
    for (;;) {
        const bool has_next = S.next(ui + 1, nxt);
        const char* nA = has_next ? (const char*)g.A + (size_t)nxt.pm * tstep : cA; const char* nB = has_next ? (const char*)g.Bt + (size_t)nxt.eb * g.bexp + (size_t)nxt.pn * tstep : cB;
        for (int t = 0; t < nt; t += 2) {
            const bool last = (t == nt - 2);
            const char* a1 = cA + (size_t)(t + 1) * kstep;
            const char* a2 = last ? nA : cA + (size_t)(t + 2) * kstep; const char* b2 = last ? nB : cB + (size_t)(t + 2) * kstep;
            const char* a3 = a2 + kstep; const char* b3 = b2 + kstep;
            if (last && has_next) S.a_ready(nxt);
            if constexpr (SP2) {
            PG8_LDB(B0, 0, 0); PG8_LDB(B1, 0, 1); PG8_SCHED; PG8_LDA(At, 0, 0); PG8_STAGE(PG8_SA(1, 1), a1 + hstep, voffA);
            PG8_WAIT_V(8); PG8_WAIT_L(0); PG8_BAR; PG8_MMA(0, 0, At, B0); PG8_MMA(0, 1, At, B1); PG8_BAR; PG8_SCHED;
            PG8_LDA(At, 0, 1); PG8_STAGE(PG8_SB(0, 0), b2, voffB); PG8_STAGE(PG8_SB(0, 1), b2 + hstep, voffB); PG8_STAGE(PG8_SA(0, 0), a2, voffA);
            PG8_WAIT_V(8); PG8_WAIT_L(0); PG8_BAR; PG8_MMA(1, 0, At, B0); PG8_MMA(1, 1, At, B1); PG8_BAR; PG8_SCHED;
            PG8_LDB(B0, 1, 0); PG8_LDB(B1, 1, 1); PG8_SCHED; PG8_LDA(At, 1, 0); PG8_STAGE(PG8_SA(0, 1), a2 + hstep, voffA);
            PG8_WAIT_V(8); PG8_WAIT_L(0); PG8_BAR; PG8_MMA(0, 0, At, B0); PG8_MMA(0, 1, At, B1); PG8_BAR; PG8_SCHED;
            PG8_LDA(At, 1, 1); PG8_STAGE(PG8_SB(1, 0), b3, voffB); PG8_STAGE(PG8_SB(1, 1), b3 + hstep, voffB); PG8_STAGE(PG8_SA(1, 0), a3, voffA);
            PG8_WAIT_V(8); PG8_WAIT_L(0); PG8_BAR; PG8_MMA(1, 0, At, B0); PG8_MMA(1, 1, At, B1); PG8_BAR; PG8_SCHED;
            } else {
            PG8_LDB(B0, 0, 0); PG8_SCHED; PG8_LDA(At, 0, 0); PG8_STAGE(PG8_SA(1, 1), a1 + hstep, voffA);
            PG8_WAIT_L(8); PG8_BAR; PG8_WAIT_L(0); PG8_MMA(0, 0, At, B0); PG8_BAR; PG8_SCHED;
            PG8_LDB(B1, 0, 1); PG8_STAGE(PG8_SB(0, 0), b2, voffB);
            PG8_BAR; PG8_WAIT_L(0); PG8_MMA(0, 1, At, B1); PG8_BAR;
            PG8_LDA(At, 0, 1); PG8_STAGE(PG8_SA(0, 0), a2, voffA);
            PG8_BAR; PG8_WAIT_L(0); PG8_MMA(1, 0, At, B0); PG8_BAR; PG8_SCHED;
            PG8_STAGE(PG8_SB(0, 1), b2 + hstep, voffB);
            PG8_WAIT_V(6); PG8_BAR; PG8_MMA(1, 1, At, B1); PG8_BAR;
            PG8_LDB(B0, 1, 0); PG8_SCHED; PG8_LDA(At, 1, 0); PG8_STAGE(PG8_SA(0, 1), a2 + hstep, voffA);
            PG8_WAIT_L(8); PG8_BAR; PG8_WAIT_L(0); PG8_MMA(0, 0, At, B0); PG8_BAR; PG8_SCHED;
            PG8_LDB(B1, 1, 1); PG8_STAGE(PG8_SB(1, 0), b3, voffB);
            PG8_BAR; PG8_WAIT_L(0); PG8_MMA(0, 1, At, B1); PG8_BAR;
            PG8_LDA(At, 1, 1); PG8_STAGE(PG8_SA(1, 0), a3, voffA);
            PG8_BAR; PG8_WAIT_L(0); PG8_MMA(1, 0, At, B0); PG8_BAR; PG8_SCHED;
            PG8_STAGE(PG8_SB(1, 1), b3 + hstep, voffB);
            PG8_WAIT_V(6); PG8_BAR; PG8_MMA(1, 1, At, B1); PG8_BAR;
            }
        }
        if constexpr (ALIGN_EPI) { if (wr == 0) PG8_BAR; }
        if constexpr (!Epi::AFTER_DRAIN) { E(acc, cur, wr, wc, fr, fq); S.done(cur); }
        if (!has_next) break;
#pragma unroll
        for (int a = 0; a < 2; ++a)
#pragma unroll
            for (int b = 0; b < 2; ++b)
#pragma unroll
                for (int m = 0; m < 4; ++m)
#pragma unroll
                    for (int n = 0; n < 2; ++n) acc[a][b][m][n] = (f32x4){0.f, 0.f, 0.f, 0.f};
        cur = nxt; cA = nA; cB = nB; ++ui;
        if constexpr (ALIGN_EPI) { if (wr == 1) PG8_BAR; }
    }
    PG8_WAIT_V(0);
    if constexpr (!ALIGN_EPI) { if (wr == 0) PG8_BAR; }
    PG8_BAR;
    if constexpr (Epi::AFTER_DRAIN) { E.fused(acc, cur, wr, wc, fr, fq, lds, wid, lane); S.done(cur); }
#undef PG8_SA
#undef PG8_SB
#undef PG8_STAGE
#undef PG8_LDA
#undef PG8_LDB
#undef PG8_MMA
#undef PG8_WAIT_V
#undef PG8_WAIT_L
#undef PG8_BAR
#undef PG8_SCHED
}
}

#define XB_TMO      128
#define XB_XCNT(j)  (256  + 64 * (j))
#define XB_XSUB(j)  (1280 + 64 * (j))
#define XB_XGEN(j)  (2304 + 64 * (j))
#define XB_TOP      3328
#define XB_TOPGEN   3392
#define XCD_BAR_WORDS 3456
#define XB_SPIN_CAP (1u << 22)
#define LAS __attribute__((address_space(3)))

__device__ __forceinline__ unsigned xb_ld(unsigned* p)              { return __hip_atomic_load(p, __ATOMIC_RELAXED, __HIP_MEMORY_SCOPE_AGENT); }
__device__ __forceinline__ unsigned xb_add(unsigned* p, unsigned v) { return __hip_atomic_fetch_add(p, v, __ATOMIC_RELAXED, __HIP_MEMORY_SCOPE_AGENT); }
__device__ __forceinline__ unsigned xb_xcc_id() { return (unsigned)__builtin_amdgcn_s_getreg((3 << 11) | 20) & 0xFu; }
#define XB_SPIN(cond, bar) do { unsigned _sp = 0; while (cond) { __builtin_amdgcn_s_sleep(1); \
    if ((++_sp & 255u) == 0u) { if (xb_ld(&(bar)[XB_TMO])) break; if (_sp > XB_SPIN_CAP) { atomicAdd(&(bar)[XB_TMO], 1u); break; } } } } while (0)

struct XcdBarrier {
    unsigned* bar; unsigned x; int wv;
    volatile LAS unsigned* st;
};

__device__ __forceinline__ XcdBarrier xcd_barrier_post(unsigned* bar, volatile LAS unsigned* st) {
    XcdBarrier b; b.bar = bar; b.x = xb_xcc_id(); b.st = st; b.wv = __builtin_amdgcn_readfirstlane((int)threadIdx.x >> 6);
    if (threadIdx.x == 0) (void)xb_add(&bar[XB_XCNT(b.x)], 1u);
    return b;
}
__device__ __forceinline__ void xcd_barrier_complete(unsigned* bar, unsigned x, unsigned& nloc, unsigned& nx) {
    const unsigned G = gridDim.x * gridDim.y * gridDim.z;
    unsigned sum, cnt, mine, sp = 0u;
    for (;;) {
        sum = 0u; cnt = 0u; mine = 0u;
#pragma unroll
        for (unsigned j = 0; j < 16; ++j) { const unsigned c = xb_ld(&bar[XB_XCNT(j)]); sum += c; cnt += (c > 0u) ? 1u : 0u; mine = (j == x) ? c : mine; }
        if (sum == G) break;
        __builtin_amdgcn_s_sleep(1);
        if ((++sp & 255u) == 0u) { if (xb_ld(&bar[XB_TMO])) break; if (sp > XB_SPIN_CAP) { atomicAdd(&bar[XB_TMO], 1u); break; } }
    }
    nloc = mine > 0u ? mine : 1u; nx = cnt > 0u ? cnt : 1u;
}

__device__ __forceinline__ void xcd_barrier(const XcdBarrier& b) {
    asm volatile("s_waitcnt vmcnt(0)" ::: "memory");
    __syncthreads();
    int ln_; asm volatile("v_mbcnt_lo_u32_b32 %0, -1, 0\n\tv_mbcnt_hi_u32_b32 %0, -1, %0" : "=v"(ln_));
    if (b.wv == 0 && ln_ == 0) {
        unsigned* bar = b.bar;
        __builtin_amdgcn_s_waitcnt(0);
        unsigned nloc = b.st[0], nx = b.st[1];
        if (nloc == 0u) { xcd_barrier_complete(bar, b.x, nloc, nx); b.st[0] = nloc; b.st[1] = nx; }
        const unsigned old = xb_add(&bar[XB_XSUB(b.x)], 1u);
        const unsigned gen = old / nloc;
        if (old + 1u == (gen + 1u) * nloc) {
            __builtin_amdgcn_fence(__ATOMIC_RELEASE, "agent");
            asm volatile("s_waitcnt vmcnt(0)" ::: "memory");
            const unsigned og = xb_add(&bar[XB_TOP], 1u);
            const unsigned tg = og / nx;
            if (og + 1u == (tg + 1u) * nx) xb_add(&bar[XB_TOPGEN], 1u);
            else XB_SPIN(xb_ld(&bar[XB_TOPGEN]) == tg, bar);
            __builtin_amdgcn_fence(__ATOMIC_ACQUIRE, "agent");
            xb_add(&bar[XB_XGEN(b.x)], 1u);
            asm volatile("s_waitcnt vmcnt(0)" ::: "memory");
        } else {
            XB_SPIN(xb_ld(&bar[XB_XGEN(b.x)]) == gen, bar);
            __builtin_amdgcn_fence(__ATOMIC_ACQUIRE, "agent");
            asm volatile("s_waitcnt vmcnt(0)" ::: "memory");
        }
    }
    __syncthreads();
}


namespace attn {
using bf16 = unsigned short;
constexpr int DQK = 192, DV = 128, NW = 8, QBLK = 32, KVBLK = 64;
constexpr float SCALE = 0.07216878364870322f;
constexpr float THR = 8.f;
constexpr int SDEPTH = 1;
constexpr int LDQ = DQK, LDK = DQK, LDV = DV, LDO = 1024;
constexpr size_t SHM_V = KVBLK * DV * 2, SHM_K = KVBLK * DQK * 2, SHM_ATTN = 2 * SHM_V + 2 * SHM_K + NW * 64 * 4;
using bf16x8 = __attribute__((ext_vector_type(8))) short;
using s16x4  = __attribute__((ext_vector_type(4))) short;
using f32x16 = __attribute__((ext_vector_type(16))) float;
using f32x8  = __attribute__((ext_vector_type(8))) float;
using u32x4  = __attribute__((ext_vector_type(4))) unsigned;
#define KSWZ(row, colB) ((row) * 384 + ((colB) ^ (((row) & 7) << 4)))
#define SBAR() __builtin_amdgcn_sched_barrier(0)
__device__ __forceinline__ int crow(int r, int hi) { return (r & 3) + 8 * (r >> 2) + 4 * hi; }
__device__ __forceinline__ unsigned cvtpk(float lo, float hi) {
  unsigned r; asm volatile("v_cvt_pk_bf16_f32 %0, %1, %2" : "=v"(r) : "v"(lo), "v"(hi)); return r;
}
struct St { using T = bf16x8;
  __device__ static __forceinline__ T ld8(const bf16* p) { return *reinterpret_cast<const bf16x8*>(p); }
  __device__ static __forceinline__ bf16x8 tobf(T x) { return x; } };
__device__ __forceinline__ void partialSM(f32x16& p0, f32x16& p1, float& m_reg, float& mn, float& alpha) {
  constexpr float C = SCALE * 1.4426950408889634f;
  float pmax = p0[0]; for (int r = 1; r < 16; ++r) pmax = fmaxf(pmax, p0[r]); for (int r = 0; r < 16; ++r) pmax = fmaxf(pmax, p1[r]);
  { auto rr = __builtin_amdgcn_permlane32_swap(__float_as_uint(pmax), __float_as_uint(pmax), false, false);
    pmax = fmaxf(__uint_as_float(rr[0]), __uint_as_float(rr[1])); }
  if (__builtin_expect(__all(pmax - m_reg <= THR / SCALE), 1)) { mn = m_reg; alpha = 1.f; }
  else { mn = fmaxf(m_reg, pmax); alpha = __builtin_amdgcn_exp2f((m_reg - mn) * C); m_reg = mn; }
  float mnC = -mn * C;
  for (int r = 0; r < 16; ++r) p0[r] = fmaf(p0[r], C, mnC); for (int r = 0; r < 16; ++r) p1[r] = fmaf(p1[r], C, mnC);
  for (int r = 0; r < 16; ++r) p0[r] = __builtin_amdgcn_exp2f(p0[r]);
}
__device__ __forceinline__ void finishSM(f32x16& p0, f32x16& p1, float alpha, float& l_reg, bf16x8& pa0, bf16x8& pa1, bf16x8& pa2, bf16x8& pa3) {
  for (int r = 0; r < 16; ++r) p1[r] = __builtin_amdgcn_exp2f(p1[r]);
  float ps = 0; for (int r = 0; r < 16; ++r) ps += p0[r]; for (int r = 0; r < 16; ++r) ps += p1[r];
  { auto rr = __builtin_amdgcn_permlane32_swap(__float_as_uint(ps), __float_as_uint(ps), false, false);
    ps = __uint_as_float(rr[0]) + __uint_as_float(rr[1]); }
  l_reg = l_reg * alpha + ps;
#define PK4(P, BASE, OUT) do { unsigned a0 = cvtpk(P[BASE + 0], P[BASE + 1]), a1 = cvtpk(P[BASE + 2], P[BASE + 3]);   \
    unsigned b0 = cvtpk(P[BASE + 4], P[BASE + 5]), b1 = cvtpk(P[BASE + 6], P[BASE + 7]);                              \
    auto r0 = __builtin_amdgcn_permlane32_swap(a0, b0, false, false); auto r1 = __builtin_amdgcn_permlane32_swap(a1, b1, false, false); \
    u32x4 w = {r0[0], r1[0], r0[1], r1[1]}; OUT = *reinterpret_cast<bf16x8*>(&w); } while (0)
  PK4(p0, 0, pa0); PK4(p0, 8, pa1); PK4(p1, 0, pa2); PK4(p1, 8, pa3);
#undef PK4
}
__device__ __forceinline__ void qkt(f32x16& p0, f32x16& p1, const bf16* Ks, const bf16x8* qr, int r32, int hi) {
  p0 = f32x16{}; p1 = f32x16{};
  for (int d0 = 0; d0 < 12; ++d0) { int cb = (d0 * 16 + hi * 8) * 2;
    bf16x8 b0 = *reinterpret_cast<const bf16x8*>((const char*)Ks + KSWZ(r32, cb));
    bf16x8 b1 = *reinterpret_cast<const bf16x8*>((const char*)Ks + KSWZ(32 + r32, cb));
    p0 = __builtin_amdgcn_mfma_f32_32x32x16_bf16(b0, qr[d0], p0, 0, 0, 0);
    p1 = __builtin_amdgcn_mfma_f32_32x32x16_bf16(b1, qr[d0], p1, 0, 0, 0); }
}
__device__ __forceinline__ int v_st(int k, int c) { const int kk = (k & ~0xC) | ((k & 4) << 1) | ((k & 8) >> 1); return ((kk >> 3) * 4 + (c >> 5)) * 512 + ((kk & 7) * 32 + (c & 31)) * 2; }
__device__ __forceinline__ int v_rd_base(int lane) { return ((lane & 3) << 3) | (((lane >> 2) & 3) << 6) | (((lane >> 4) & 1) << 5) | (((lane >> 5) & 1) << 8); }
constexpr int v_rd_off(int d0, int ks, int half) { return d0 * 512 + ks * 4096 + half * 2048; }
template <int OFF> __device__ __forceinline__ s16x4 tr_read(int vb) {
  s16x4 r; asm volatile("ds_read_b64_tr_b16 %0, %1 offset:%2" : "=&v"(r) : "v"(vb), "i"(OFF) : "memory"); return r;
}
template <int D0> __device__ __forceinline__ void pv_one(f32x16& od, int vb, bf16x8 pa0, bf16x8 pa1, bf16x8 pa2, bf16x8 pa3) {
  const s16x4 l0 = tr_read<v_rd_off(D0, 0, 0)>(vb), h0 = tr_read<v_rd_off(D0, 0, 1)>(vb), l1 = tr_read<v_rd_off(D0, 1, 0)>(vb), h1 = tr_read<v_rd_off(D0, 1, 1)>(vb);
  const s16x4 l2 = tr_read<v_rd_off(D0, 2, 0)>(vb), h2 = tr_read<v_rd_off(D0, 2, 1)>(vb), l3 = tr_read<v_rd_off(D0, 3, 0)>(vb), h3 = tr_read<v_rd_off(D0, 3, 1)>(vb);
  asm volatile("s_waitcnt lgkmcnt(0)" ::: "memory"); SBAR();
#define PK(L, H) (bf16x8){L[0], L[1], L[2], L[3], H[0], H[1], H[2], H[3]}
  od = __builtin_amdgcn_mfma_f32_32x32x16_bf16(pa0, PK(l0, h0), od, 0, 0, 0);
  od = __builtin_amdgcn_mfma_f32_32x32x16_bf16(pa1, PK(l1, h1), od, 0, 0, 0);
  od = __builtin_amdgcn_mfma_f32_32x32x16_bf16(pa2, PK(l2, h2), od, 0, 0, 0);
  od = __builtin_amdgcn_mfma_f32_32x32x16_bf16(pa3, PK(l3, h3), od, 0, 0, 0);
#undef PK
}
__device__ __forceinline__ void pv_d0(f32x16* o, int vb, bf16x8 pa0, bf16x8 pa1, bf16x8 pa2, bf16x8 pa3) {
  pv_one<0>(o[0], vb, pa0, pa1, pa2, pa3); pv_one<1>(o[1], vb, pa0, pa1, pa2, pa3); pv_one<2>(o[2], vb, pa0, pa1, pa2, pa3); pv_one<3>(o[3], vb, pa0, pa1, pa2, pa3);
}

__device__ __forceinline__ void attn_dense_body(const bf16* __restrict__ Qb, const bf16* __restrict__ Kh, const bf16* __restrict__ Vh,
                                                bf16* __restrict__ Ob, int seq, char* lds, const int tid_in) {
  int tid_ = tid_in; asm volatile("" : "+v"(tid_));
  const int tid = tid_, wid = tid >> 6, lane = tid & 63, r32 = lane & 31, hi = lane >> 5;
  bf16* V_lds = (bf16*)lds; bf16* K_lds = (bf16*)(lds + 2 * SHM_V);
  float* ws = (float*)(lds + 2 * SHM_V + 2 * SHM_K) + wid * 64; float* li_l = ws; float* al_l = ws + 32;
  float m_reg = -1e30f, l_reg = 0; f32x16 o[4] = {}; bf16x8 qr[12];
  const bf16* Qw = Qb + (long)(wid * QBLK + r32) * LDQ + hi * 8;
#pragma unroll
  for (int d0 = 0; d0 < 12; ++d0) qr[d0] = St::ld8(Qw + d0 * 16);
  const int sr = tid >> 4, sc = (tid & 15) * 8, vst0 = v_st(sr, sc), vst1 = v_st(32 + sr, sc);
  const int kr0 = tid / 24, kc0 = (tid % 24) * 8, kr1 = (tid + 512) / 24, kc1 = ((tid + 512) % 24) * 8, kr2 = (tid + 1024) / 24, kc2 = ((tid + 1024) % 24) * 8;
  const int vb0 = (int)(uintptr_t)V_lds + v_rd_base(lane);
  struct { St::T vs0, vs1, ks0, ks1, ks2; } sr_[SDEPTH];
#define SLOAD(i, k0) do { sr_[i].vs0 = St::ld8(&Vh[(long)((k0) + sr) * LDV + sc]); sr_[i].vs1 = St::ld8(&Vh[(long)((k0) + 32 + sr) * LDV + sc]); \
    sr_[i].ks0 = St::ld8(&Kh[(long)((k0) + kr0) * LDK + kc0]); sr_[i].ks1 = St::ld8(&Kh[(long)((k0) + kr1) * LDK + kc1]); sr_[i].ks2 = St::ld8(&Kh[(long)((k0) + kr2) * LDK + kc2]); } while (0)
#define SWRITE(b, i) do { *(bf16x8*)((char*)V_lds + (b) * SHM_V + vst0) = St::tobf(sr_[i].vs0);          \
    *(bf16x8*)((char*)V_lds + (b) * SHM_V + vst1) = St::tobf(sr_[i].vs1);                                \
    *(bf16x8*)((char*)K_lds + (b) * SHM_K + KSWZ(kr0, kc0 * 2)) = St::tobf(sr_[i].ks0);                  \
    *(bf16x8*)((char*)K_lds + (b) * SHM_K + KSWZ(kr1, kc1 * 2)) = St::tobf(sr_[i].ks1);                  \
    *(bf16x8*)((char*)K_lds + (b) * SHM_K + KSWZ(kr2, kc2 * 2)) = St::tobf(sr_[i].ks2); } while (0)
#define SWAIT() do { if constexpr (SDEPTH == 2) asm volatile("s_waitcnt vmcnt(5)" ::: "memory"); else asm volatile("s_waitcnt vmcnt(0)" ::: "memory"); } while (0)
#define RESC(a) do { if (__any((a) < 1.f)) { if (hi == 0) al_l[r32] = (a); asm volatile("s_waitcnt lgkmcnt(0)" ::: "memory"); \
    for (int d = 0; d < 4; ++d) for (int r = 0; r < 16; ++r) o[d][r] *= al_l[crow(r, hi)]; } } while (0)
  f32x16 p0, p1; float mn, al; bf16x8 pa0, pa1, pa2, pa3; const int NT = seq / KVBLK;
  SLOAD(0, 0); asm volatile("s_waitcnt vmcnt(0)" ::: "memory"); SWRITE(0, 0); __syncthreads();
  for (int j = 0; j < NT; ++j) {
    const int cur = j & 1; const bool more = j + 1 < NT;
    if (more) SLOAD(0, (j + 1) * KVBLK);
    SBAR(); qkt(p0, p1, (bf16*)((char*)K_lds + cur * SHM_K), qr, r32, hi);
    partialSM(p0, p1, m_reg, mn, al); RESC(al);
    finishSM(p0, p1, al, l_reg, pa0, pa1, pa2, pa3); SBAR();
    pv_d0(o, vb0 + cur * (int)SHM_V, pa0, pa1, pa2, pa3);
    if (more) { SWAIT(); SWRITE(cur ^ 1, 0); }
    __syncthreads();
  }
  if (hi == 0) li_l[r32] = l_reg; asm volatile("s_waitcnt lgkmcnt(0)" ::: "memory");
  float rli[16];
#pragma unroll
  for (int r = 0; r < 16; ++r) rli[r] = __builtin_amdgcn_rcpf(li_l[crow(r, hi)]);
  bf16* Ow = Ob + (long)(wid * QBLK) * LDO;
#pragma unroll
  for (int r = 0; r < 16; ++r) { int orow = crow(r, hi);
    for (int d0 = 0; d0 < 4; ++d0) Ow[(long)orow * LDO + d0 * 32 + r32] = f2bf(o[d0][r] * rli[r]); }
#undef SLOAD
#undef SWRITE
#undef SWAIT
#undef RESC
}

}


constexpr int NWAVES = 8, NTHREADS = 512;
constexpr int RING_BYTES = 157696, MISC_OFF = RING_BYTES + 320, LDS_BYTES = 163840;
#define GAS __attribute__((address_space(1)))
typedef unsigned v4u __attribute__((ext_vector_type(4)));
typedef float f32x4 __attribute__((ext_vector_type(4)));
#define LDS_WAIT() asm volatile("s_waitcnt lgkmcnt(0)" ::: "memory")
typedef float f4 __attribute__((ext_vector_type(4)));
typedef unsigned u2 __attribute__((ext_vector_type(2)));
typedef unsigned u4 __attribute__((ext_vector_type(4)));
__device__ __forceinline__ float wave_sum(float v) {
#pragma unroll
  for (int o = 1; o < 64; o <<= 1) v += __shfl_xor(v, o);
  return v;
}
__device__ __forceinline__ unsigned pkbf(float lo, float hi) { return (unsigned)f2bf(lo) | ((unsigned)f2bf(hi) << 16); }

constexpr int MOD_KS = 16, MOD_CG = 16, MOD_COLS = 384;
__device__ __forceinline__ void f_mod_partial(const Pm& p, int tidb) {
  const int N6 = 6 * 1024;
  for (int u = blockIdx.x; u < MOD_KS * MOD_CG; u += gridDim.x) { const int ks = u / MOD_CG, cg = u % MOD_CG;
    if (tidb < MOD_COLS) { const int n = cg * MOD_COLS + tidb; float a0 = 0.f, a1 = 0.f, a2 = 0.f;
      for (int k = ks * 64; k < ks * 64 + 64; ++k) { const float w = p.mod_w[(size_t)k * N6 + n]; const float c0 = p.c[k], c1 = p.c[1024 + k], c2 = p.c_ctx[k];
        a0 += c0 * sigmoidf_(c0) * w; a1 += c1 * sigmoidf_(c1) * w; a2 += c2 * sigmoidf_(c2) * w; }
      float* o = p.modp + (size_t)ks * 3 * N6 + n; o[0] = a0; o[N6] = a1; o[2 * N6] = a2; } }
}
__device__ __forceinline__ void f_mod_reduce(const Pm& p, LAS float* modL, int tidb) {
  const int N6 = 6 * 1024;
  for (int i = tidb; i < 3 * 2048; i += NTHREADS) { const int v = i / 2048, n = i % 2048; float a = p.mod_b[n];
#pragma unroll
    for (int ks = 0; ks < MOD_KS; ++ks) a += p.modp[((size_t)ks * 3 + v) * N6 + n];
    modL[i] = a; }
  const int per = (3 * N6 + gridDim.x - 1) / gridDim.x;
  for (int i = blockIdx.x * per + tidb; i < (int)(blockIdx.x + 1) * per && i < 3 * N6; i += NTHREADS) { const int v = i / N6, n = i % N6; float a = p.mod_b[n];
#pragma unroll
    for (int ks = 0; ks < MOD_KS; ++ks) a += p.modp[((size_t)ks * 3 + v) * N6 + n];
    p.modv[i] = a; }
  __syncthreads();
}
__device__ __forceinline__ void f_norm1(const Pm& p, const LAS float* modL, int gw, int ngw, int lane) {
  constexpr Dm d = DMC;
  for (int row = gw; row < d.NR; row += ngw) {
    const float* src = row < d.BT ? p.x + (size_t)row * 1024 : p.ctx + (size_t)(row - d.BT) * 1024; const int v = row < d.BT ? row / d.T : 2;
    f4 xv[4]; float ss = 0.f;
#pragma unroll
    for (int j = 0; j < 4; ++j) { xv[j] = *(const f4*)(src + 4 * lane + 256 * j); ss += xv[j].x * xv[j].x + xv[j].y * xv[j].y + xv[j].z * xv[j].z + xv[j].w * xv[j].w; }
    const float rs = 1.f / sqrtf(wave_sum(ss) * (1.f / 1024.f) + 1e-6f);
#pragma unroll
    for (int j = 0; j < 4; ++j) { const int k = 4 * lane + 256 * j; const f4 g = *(const f4*)(p.norm1_g + k); const LAS float* sh = modL + v * 2048 + k; const LAS float* sc = sh + 1024;
      const float o0 = xv[j].x * rs * g.x * (1.f + sc[0]) + sh[0], o1 = xv[j].y * rs * g.y * (1.f + sc[1]) + sh[1], o2 = xv[j].z * rs * g.z * (1.f + sc[2]) + sh[2], o3 = xv[j].w * rs * g.w * (1.f + sc[3]) + sh[3];
      u2 w; w.x = pkbf(o0, o1); w.y = pkbf(o2, o3); *(u2*)(p.A1 + (size_t)row * 1024 + k) = w; }
  }
}
__device__ __forceinline__ void f_rope_table(const Pm& p, long tid, long nth) {
  for (long i = tid; i < (long)8192 * 32; i += nth) { const int t = (int)(i >> 5), q = (int)(i & 31), a = q >> 4, f = q & 15;
    const float freq = expf(-(float)f * (1.f / 16.f) * 9.210340371976184f), pos = a == 0 ? (float)(t >> 6) : (float)(t & 63), ang = pos * freq;
    p.ropet[2 * i] = cosf(ang); p.ropet[2 * i + 1] = sinf(ang); }
}
__device__ __forceinline__ void f_mla_a(const Pm& p, int gw, int ngw, int lane) {
  constexpr Dm d = DMC; const int NK = d.C + d.T;
  for (int row = gw; row < d.NR; row += ngw) {
    const bf16_t* pm = p.P + (size_t)row * d.IN + d.RC; int t, len, b, ic; row_pos(d, row, t, len, b, ic);
    const u2 qw = *(const u2*)(pm + 4 * lane); const unsigned cw = *(const unsigned*)(pm + 256 + 2 * lane);
    const f4 q = {__builtin_bit_cast(float, qw.x << 16), __builtin_bit_cast(float, qw.x & 0xffff0000u), __builtin_bit_cast(float, qw.y << 16), __builtin_bit_cast(float, qw.y & 0xffff0000u)};
    const float c0 = __builtin_bit_cast(float, cw << 16), c1 = __builtin_bit_cast(float, cw & 0xffff0000u); const float kr = __builtin_bit_cast(float, (unsigned)pm[384 + lane] << 16);
    const float qs = wave_sum(q.x * q.x + q.y * q.y + q.z * q.z + q.w * q.w), cs2 = wave_sum(c0 * c0 + c1 * c1);
    if (!ic) { const float rs = 1.f / sqrtf(qs * (1.f / 256.f) + 1e-6f); const f4 g = *(const f4*)(p.q_norm + 4 * lane);
      u2 w; w.x = pkbf(q.x * rs * g.x, q.y * rs * g.y); w.y = pkbf(q.z * rs * g.z, q.w * rs * g.w); *(u2*)(p.QN + (size_t)row * 256 + 4 * lane) = w; }
    { const float rs = 1.f / sqrtf(cs2 * (1.f / 128.f) + 1e-6f); *(unsigned*)(p.CN + (size_t)row * 128 + 2 * lane) = pkbf(c0 * rs * p.kv_norm[2 * lane], c1 * rs * p.kv_norm[2 * lane + 1]); }
    const float partner = __shfl_xor(kr, 16); float cs = 1.f, sn = 0.f;
    if (!ic) { const float* ct = p.ropet + ((size_t)t * 32 + (lane >> 5) * 16 + (lane & 15)) * 2; cs = ct[0]; sn = ct[1]; }
    const float o = (lane & 16) ? kr * cs + partner * sn : kr * cs - partner * sn; const bf16_t ob = f2bf(o); const int key = ic ? t : d.C + t;
#pragma unroll
    for (int h = 0; h < 4; ++h) p.K[((size_t)(b * 4 + h) * NK + key) * 192 + 128 + lane] = ob;
  }
}
__device__ __forceinline__ void f_readout(const Pm& p, int gw, int ngw, int lane) {
  constexpr Dm d = DMC; const size_t NRW = (size_t)d.NR * 512, BTW = (size_t)d.BT * 512;
  for (int row = gw; row < d.BT; row += ngw) { const size_t o = (size_t)row * 512 + 8 * lane;
    float ov[8], rv[8], kv[8], vv[8], gv[8];
#pragma unroll
    for (int q = 0; q < 2; ++q) { const f4 a = *(const f4*)(p.O2 + o + 4 * q), b2 = *(const f4*)(p.O2 + BTW + o + 4 * q), g = *(const f4*)(p.Gt + o + 4 * q);
      const u2 r = *(const u2*)(p.Rr + o + 4 * q), k0 = *(const u2*)(p.Kd + o + 4 * q), k1 = *(const u2*)(p.Kd + NRW + o + 4 * q), v = *(const u2*)(p.Vv + o + 4 * q);
#define BL(u) __builtin_bit_cast(float, (u) << 16)
#define BH(u) __builtin_bit_cast(float, (u) & 0xffff0000u)
      const float rr[4] = {BL(r.x), BH(r.x), BL(r.y), BH(r.y)}, ka[4] = {BL(k0.x), BH(k0.x), BL(k0.y), BH(k0.y)}, kb[4] = {BL(k1.x), BH(k1.x), BL(k1.y), BH(k1.y)}, vq[4] = {BL(v.x), BH(v.x), BL(v.y), BH(v.y)};
#pragma unroll
      for (int e = 0; e < 4; ++e) { ov[4 * q + e] = a[e] + b2[e]; rv[4 * q + e] = rr[e]; kv[4 * q + e] = ka[e] + kb[e]; vv[4 * q + e] = vq[e]; gv[4 * q + e] = g[e]; } }
    float s = 0.f, bon = 0.f;
#pragma unroll
    for (int e = 0; e < 8; ++e) { s += ov[e]; bon += rv[e] * kv[e] * p.r_k[8 * lane + e]; }
#pragma unroll
    for (int m = 1; m < 8; m <<= 1) { s += __shfl_xor(s, m); bon += __shfl_xor(bon, m); }
    const float mean = s * (1.f / 64.f); float var = 0.f;
#pragma unroll
    for (int e = 0; e < 8; ++e) { const float q = ov[e] - mean; var += q * q; }
#pragma unroll
    for (int m = 1; m < 8; m <<= 1) var += __shfl_xor(var, m);
    const float rs = 1.f / sqrtf(var * (1.f / 64.f) + 64e-5f); float y[8];
#pragma unroll
    for (int e = 0; e < 8; ++e) y[e] = ((ov[e] - mean) * rs * p.ln_w[8 * lane + e] + p.ln_b[8 * lane + e] + bon * vv[e]) * gv[e];
    u4 w; w.x = pkbf(y[0], y[1]); w.y = pkbf(y[2], y[3]); w.z = pkbf(y[4], y[5]); w.w = pkbf(y[6], y[7]);
    *(u4*)(p.MIXb + (size_t)row * 1024 + 8 * lane) = w; }
}
__device__ __forceinline__ void f_final(const Pm& p, int gw, int ngw, int lane) {
  constexpr Dm d = DMC;
  for (int tok = gw; tok < d.BT; tok += ngw) { const int b = tok / d.T; const float* gt2 = p.modv + (size_t)b * 6144 + 5 * 1024; const float* xr = p.x1 + (size_t)tok * 1024;
    const f4 gq = *(const f4*)(p.gate + (size_t)tok * 4); const int4 sp = *(const int4*)(p.slot_pos + (size_t)tok * 4);
    const bf16_t* y0 = p.Yb + (size_t)sp.x * 1024; const bf16_t* y1 = p.Yb + (size_t)sp.y * 1024; const bf16_t* y2 = p.Yb + (size_t)sp.z * 1024; const bf16_t* y3 = p.Yb + (size_t)sp.w * 1024;
    f4 xv[4]; float ss = 0.f;
#pragma unroll
    for (int j = 0; j < 4; ++j) { const int k = 4 * lane + 256 * j; const f4 x = *(const f4*)(xr + k), g = *(const f4*)(gt2 + k);
      const u2 a = *(const u2*)(y0 + k), b2 = *(const u2*)(y1 + k), c = *(const u2*)(y2 + k), e = *(const u2*)(y3 + k);
#define BFLO(u) __builtin_bit_cast(float, (u) << 16)
#define BFHI(u) __builtin_bit_cast(float, (u) & 0xffff0000u)
      f4 f; f.x = gq.x * BFLO(a.x) + gq.y * BFLO(b2.x) + gq.z * BFLO(c.x) + gq.w * BFLO(e.x); f.y = gq.x * BFHI(a.x) + gq.y * BFHI(b2.x) + gq.z * BFHI(c.x) + gq.w * BFHI(e.x);
      f.z = gq.x * BFLO(a.y) + gq.y * BFLO(b2.y) + gq.z * BFLO(c.y) + gq.w * BFLO(e.y); f.w = gq.x * BFHI(a.y) + gq.y * BFHI(b2.y) + gq.z * BFHI(c.y) + gq.w * BFHI(e.y);
      xv[j] = x + g * f; ss += xv[j].x * xv[j].x + xv[j].y * xv[j].y + xv[j].z * xv[j].z + xv[j].w * xv[j].w; }
    const float rs = 1.f / sqrtf(wave_sum(ss) * (1.f / 1024.f) + 1e-6f);
#pragma unroll
    for (int j = 0; j < 4; ++j) { const int k = 4 * lane + 256 * j; const f4 fg = *(const f4*)(p.final_g + k); *(f4*)(p.out + (size_t)tok * 1024 + k) = xv[j] * rs * fg; }
  }
}

__device__ __forceinline__ void f_route(const Pm& p, LAS unsigned char* lds, int wave, int lane, int tidb) {
  constexpr Dm d = DMC; const int G = gridDim.x, TPB = (d.BT + G - 1) / G;
  LAS float* rwL = (LAS float*)lds; LAS int* cnt_l = (LAS int*)(lds + 1024 * 144); LAS float* lgL = (LAS float*)(lds + 1024 * 144 + 256) + wave * 256;
  for (int i = tidb; i < 1024 * 32; i += NTHREADS) { const int k = i >> 5; const int r = ((k >> 2) & 63) + 64 * ((k & 3) + 4 * (k >> 8)); rwL[r * 36 + (i & 31)] = p.router_w[i]; }
  if (tidb < 32) cnt_l[tidb] = 0;
  __syncthreads();
  const int t0 = blockIdx.x * TPB, t1 = (t0 + TPB < d.BT) ? t0 + TPB : d.BT;
  f4 xn[4];
  if (t0 + wave < t1) {
#pragma unroll
    for (int j = 0; j < 4; ++j) xn[j] = *(const f4*)(p.x1 + (size_t)(t0 + wave) * 1024 + 4 * lane + 256 * j); }
  for (int tok = t0 + wave; tok < t1; tok += NWAVES) {
    const int b = tok / d.T; const float* sh = p.modv + (size_t)b * 6144 + 3 * 1024; const float* sc = sh + 1024;
    float ss = 0.f; f4 xv[4], hv[4];
#pragma unroll
    for (int j = 0; j < 4; ++j) { xv[j] = xn[j]; ss += xv[j].x * xv[j].x + xv[j].y * xv[j].y + xv[j].z * xv[j].z + xv[j].w * xv[j].w; }
    if (tok + NWAVES < t1) {
#pragma unroll
      for (int j = 0; j < 4; ++j) xn[j] = *(const f4*)(p.x1 + (size_t)(tok + NWAVES) * 1024 + 4 * lane + 256 * j); }
    ss = wave_sum(ss);
    const float rs = 1.f / sqrtf(ss * (1.f / 1024.f) + 1e-6f);
#pragma unroll
    for (int j = 0; j < 4; ++j) { const int k = 4 * lane + 256 * j; const f4 g = *(const f4*)(p.norm2_g + k), s4 = *(const f4*)(sh + k), c4 = *(const f4*)(sc + k);
      hv[j].x = xv[j].x * rs * g.x * (1.f + c4.x) + s4.x; hv[j].y = xv[j].y * rs * g.y * (1.f + c4.y) + s4.y; hv[j].z = xv[j].z * rs * g.z * (1.f + c4.z) + s4.z; hv[j].w = xv[j].w * rs * g.w * (1.f + c4.w) + s4.w;
      u2 w; w.x = pkbf(hv[j].x, hv[j].y); w.y = pkbf(hv[j].z, hv[j].w); *(u2*)(p.H2b + (size_t)tok * 1024 + k) = w; }
    float acc[32];
#pragma unroll
    for (int e = 0; e < 32; ++e) acc[e] = 0.f;
#pragma unroll
    for (int j = 0; j < 4; ++j) {
#pragma unroll
      for (int c2 = 0; c2 < 4; c2 += 2) { f4 r4[16];
#pragma unroll
        for (int q = 0; q < 2; ++q)
#pragma unroll
          for (int c = 0; c < 8; ++c) r4[q * 8 + c] = *(const LAS f4*)(rwL + (lane + 64 * (c2 + q + 4 * j)) * 36 + 4 * c);
#pragma unroll
        for (int q = 0; q < 2; ++q) { const float h = hv[j][c2 + q];
#pragma unroll
          for (int c = 0; c < 8; ++c) { acc[4 * c] += h * r4[q * 8 + c].x; acc[4 * c + 1] += h * r4[q * 8 + c].y; acc[4 * c + 2] += h * r4[q * 8 + c].z; acc[4 * c + 3] += h * r4[q * 8 + c].w; } } } }
#define RT_STEP(N, M) { const bool up_ = (lane & (M)) != 0; _Pragma("unroll") for (int i = 0; i < (N); ++i) { const float keep_ = up_ ? acc[i + (N)] : acc[i], send_ = up_ ? acc[i] : acc[i + (N)]; acc[i] = keep_ + __shfl_xor(send_, (M)); } }
    RT_STEP(16, 32) RT_STEP(8, 16) RT_STEP(4, 8) RT_STEP(2, 4) RT_STEP(1, 2)
#undef RT_STEP
    const int e = lane >> 1; const float lg = acc[0] + __shfl_xor(acc[0], 1) + p.router_b[e];
    if ((lane & 1) == 0) lgL[((tok - t0 - wave) / NWAVES) * 32 + e] = lg;
  }
  asm volatile("s_waitcnt lgkmcnt(0)" ::: "memory");
  { const int ti = lane, tok = t0 + wave + ti * NWAVES;
    if (ti < 8 && tok < t1) { float lv[32];
#pragma unroll
      for (int c = 0; c < 8; ++c) { const f4 v4 = *(const LAS f4*)(lgL + ti * 32 + 4 * c); lv[4 * c] = v4.x; lv[4 * c + 1] = v4.y; lv[4 * c + 2] = v4.z; lv[4 * c + 3] = v4.w; }
      float tv[4]; int te[4];
#pragma unroll
      for (int kk = 0; kk < 4; ++kk) { float bv = -3e38f; int bi = 0;
#pragma unroll
        for (int q = 0; q < 32; ++q) if (lv[q] > bv) { bv = lv[q]; bi = q; }
#pragma unroll
        for (int q = 0; q < 32; ++q) if (q == bi) lv[q] = -3e38f;
        tv[kk] = bv; te[kk] = bi; }
      const float e1 = __expf(tv[1] - tv[0]), e2 = __expf(tv[2] - tv[0]), e3 = __expf(tv[3] - tv[0]), inv = 1.f / (1.f + e1 + e2 + e3);
      const float gq[4] = {inv, e1 * inv, e2 * inv, e3 * inv};
#pragma unroll
      for (int kk = 0; kk < 4; ++kk) { const int rk = atomicAdd((int*)&cnt_l[te[kk]], 1); p.top_e[(size_t)tok * 4 + kk] = te[kk]; p.gate[(size_t)tok * 4 + kk] = gq[kk]; p.lrank[(size_t)tok * 4 + kk] = rk; } } }
  __syncthreads();
  if (tidb < 32) p.blkcnt[(size_t)blockIdx.x * 32 + tidb] = cnt_l[tidb];
}
__device__ __forceinline__ void f_place(const Pm& p, LAS unsigned char* lds, int wave, int lane, int tidb) {
  constexpr Dm d = DMC; const int G = gridDim.x, TPB = (d.BT + G - 1) / G;
  LAS int* ps = (LAS int*)lds;
  LAS int* pb = ps + 512;
  LAS int* off = pb + 512;
  LAS int* base = off + 64;
  { const int e = tidb & 31, part = tidb >> 5; int sa = 0, sb = 0;
    for (int bb = part; bb < G; bb += 16) { const int c = __hip_atomic_load(p.blkcnt + (size_t)bb * 32 + e, __ATOMIC_RELAXED, __HIP_MEMORY_SCOPE_AGENT); sa += c; if (bb < (int)blockIdx.x) sb += c; }
    ps[part * 32 + e] = sa; pb[part * 32 + e] = sb; }
  __syncthreads();
  if (tidb < 32) { int sa = 0, sb = 0;
#pragma unroll
    for (int q = 0; q < 16; ++q) { sa += ps[q * 32 + tidb]; sb += pb[q * 32 + tidb]; }
    base[tidb] = sb; ps[tidb] = (sa + 255) / 256 * 256; }
  __syncthreads();
  if (tidb == 0) { int o = 0; for (int e = 0; e < 32; ++e) { off[e] = o; o += ps[e]; } off[32] = o; }
  __syncthreads();
  if (blockIdx.x == 0) { const int npos = off[32];
    for (int t = tidb; t < npos / 256; t += NTHREADS) { int e = 0; for (int q = 1; q < 32; ++q) if (t * 256 >= off[q]) e = q; p.tile_e[t] = e; }
    if (tidb == 0) p.npos[0] = npos; }
  const int t0 = blockIdx.x * TPB, t1 = (t0 + TPB < d.BT) ? t0 + TPB : d.BT;
  for (int tok = t0 + wave; tok < t1; tok += NWAVES) {
    const u4* src = (const u4*)(p.H2b + (size_t)tok * 1024) + lane * 2; const u4 a = src[0], b = src[1];
#pragma unroll
    for (int kk = 0; kk < 4; ++kk) { const int e = p.top_e[(size_t)tok * 4 + kk], rk = p.lrank[(size_t)tok * 4 + kk]; const int pos = off[e] + base[e] + rk;
      if (lane == 0) p.slot_pos[(size_t)tok * 4 + kk] = pos;
      u4* dst = (u4*)(p.Xg + (size_t)pos * 1024) + lane * 2; dst[0] = a; dst[1] = b; }
  }
}
__device__ __forceinline__ void f_rwkv_s1(const Pm& p, int gw, int ngw, int lane) {
  constexpr Dm d = DMC;
  for (int row = gw; row < d.NR; row += ngw) { int t, len, b, ic; row_pos(d, row, t, len, b, ic);
    const bf16_t* cur = p.P + (size_t)row * d.IN; const bool hp = t > 0, hn = t < len - 1; f4 ps[7];
#define S1_LD(ptr) ({ const u2 w_ = *(const u2*)(ptr); (f4){__builtin_bit_cast(float, w_.x << 16), __builtin_bit_cast(float, w_.x & 0xffff0000u), __builtin_bit_cast(float, w_.y << 16), __builtin_bit_cast(float, w_.y & 0xffff0000u)}; })
#pragma unroll
    for (int j = 0; j < 7; ++j) { const int c = 4 * lane + 256 * j; const f4 x = S1_LD(cur + c), mu = *(const f4*)(p.mu + c); f4 pr = {0.f, 0.f, 0.f, 0.f}, nx = pr;
      if (hp) pr = S1_LD(cur - d.IN + c); if (hn) nx = S1_LD(cur + d.IN + c);
      ps[j] = x + mu * (0.5f * (pr + nx) - x); }
#undef S1_LD
    const size_t o = (size_t)row * 512 + 4 * lane;
    { u2 w; w.x = pkbf(ps[0].x, ps[0].y); w.y = pkbf(ps[0].z, ps[0].w); *(u2*)(p.Rr + o) = w; w.x = pkbf(ps[1].x, ps[1].y); w.y = pkbf(ps[1].z, ps[1].w); *(u2*)(p.Rr + o + 256) = w;
      w.x = pkbf(ps[4].x, ps[4].y); w.y = pkbf(ps[4].z, ps[4].w); *(u2*)(p.Vv + o) = w; w.x = pkbf(ps[5].x, ps[5].y); w.y = pkbf(ps[5].z, ps[5].w); *(u2*)(p.Vv + o + 256) = w; }
#pragma unroll
    for (int j = 0; j < 2; ++j) { const f4 k = ps[2 + j]; const f4 kq = k * *(const f4*)(p.k_k + 4 * lane + 256 * j); float ss = kq.x * kq.x + kq.y * kq.y + kq.z * kq.z + kq.w * kq.w;
#pragma unroll
      for (int m = 1; m < 16; m <<= 1) ss += __shfl_xor(ss, m);
      const float inv = 1.f / sqrtf(fmaxf(ss, 1e-24f)); *(f4*)(p.Kraw + o + 256 * j) = k; const f4 kn = kq * inv; u2 w; w.x = pkbf(kn.x, kn.y); w.y = pkbf(kn.z, kn.w); *(u2*)(p.KK + o + 256 * j) = w; }
    const f4 x6 = ps[6];
    if (lane < 16) { u2 w; w.x = pkbf(tanhf(x6.x), tanhf(x6.y)); w.y = pkbf(tanhf(x6.z), tanhf(x6.w)); *(u2*)(p.AL1 + (size_t)row * 128 + 4 * lane) = w; }
    else if (lane < 32) { u2 w; w.x = pkbf(x6.x, x6.y); w.y = pkbf(x6.z, x6.w); *(u2*)(p.AL1 + (size_t)row * 128 + 4 * lane) = w; }
    else if (!ic) { u2 w; w.x = pkbf(sigmoidf_(x6.x), sigmoidf_(x6.y)); w.y = pkbf(sigmoidf_(x6.z), sigmoidf_(x6.w)); *(u2*)(p.AL2 + (size_t)row * 128 + 4 * (lane - 32)) = w; }
  }
}
__device__ __forceinline__ void f_lora_weights(const Pm& p, long tid, long nth) {
  for (long i = tid; i < (long)2048 * 128; i += nth) { const int n = (int)(i >> 7), k = (int)(i & 127); float v = 0.f;
    if (n < 1024) { if (k < 64) v = p.w2[((size_t)(n >> 9) * 64 + k) * 512 + (n & 511)]; } else { const int q = n - 1024; if (k >= 64) v = p.a2[((size_t)(q >> 9) * 64 + (k - 64)) * 512 + (q & 511)]; }
    p.WlT[i] = f2bf(v); }
  for (long i = tid; i < (long)512 * 128; i += nth) { const int n = (int)(i >> 7), k = (int)(i & 127); p.G2T[i] = f2bf(p.g2[(size_t)k * 512 + n]); }
}
__device__ __forceinline__ float fma_s(float a, float b, float c) { float r; asm("v_fma_f32 %0, %1, %2, %3" : "=v"(r) : "v"(a), "v"(b), "v"(c)); return r; }
__device__ __forceinline__ float fnma_s(float a, float b, float c) { float r; asm("v_fma_f32 %0, -%1, %2, %3" : "=v"(r) : "v"(a), "v"(b), "v"(c)); return r; }
__device__ __forceinline__ float mul_s(float a, float b) { float r; asm("v_mul_f32 %0, %1, %2" : "=v"(r) : "v"(a), "v"(b)); return r; }
__device__ __forceinline__ void f_scan_a2(const Pm& p, LAS unsigned char* lds, int wave, int lane, int NSEG) {
  constexpr Dm d = DMC; constexpr int R = 6, PD = 4, SLOT = 18432; const int NB = 2 * d.B * d.RH * 8;
  for (int ub = blockIdx.x; ub < NB; ub += gridDim.x) { const int ch = ub >> 3, v0 = (ub & 7) * 8, v = v0 + wave; const float* base = p.Fend + (size_t)ch * NSEG * 128 * 64;
#define A2_ISSUE(gq) do { const float* fe_ = base + (size_t)(gq) * 128 * 64; LAS unsigned char* sl_ = lds + ((gq) % R) * SLOT; \
      __builtin_amdgcn_global_load_lds((const unsigned*)(fe_ + 64 * 64 + (wave * 2) * 256 + lane * 4), (LAS unsigned*)(sl_ + (wave * 2) * 1024), 16, 0, 0); \
      __builtin_amdgcn_global_load_lds((const unsigned*)(fe_ + 64 * 64 + (wave * 2 + 1) * 256 + lane * 4), (LAS unsigned*)(sl_ + (wave * 2 + 1) * 1024), 16, 0, 0); \
      __builtin_amdgcn_global_load_lds((const unsigned*)(fe_ + (v0 + (wave & 1) * 4) * 64 + lane * 4), (LAS unsigned*)(sl_ + 16384 + (wave & 1) * 1024), 16, 0, 0); } while (0)
    for (int g = 0; g < PD; ++g) A2_ISSUE(g);
    asm volatile("s_waitcnt vmcnt(0)" ::: "memory"); __builtin_amdgcn_s_barrier();
    float S = 0.f;
    for (int g = 0; g < NSEG; ++g) {
      if (g + PD < NSEG) A2_ISSUE(g + PD);
      p.Sst[(((size_t)ch * NSEG + g) * 64 + v) * 64 + lane] = S;
      if (g + PD < NSEG) asm volatile("s_waitcnt vmcnt(17)" ::: "memory"); else asm volatile("s_waitcnt vmcnt(0)" ::: "memory");
      __builtin_amdgcn_s_barrier();
      const LAS float* P = (const LAS float*)(lds + (g % R) * SLOT) + lane; float a0 = ((const LAS float*)(lds + (g % R) * SLOT + 16384))[wave * 64 + lane], a1 = 0.f, a2 = 0.f, a3 = 0.f;
      LAS float* srow = (LAS float*)(lds + R * SLOT) + wave * 64; srow[lane] = S;
      asm volatile("s_waitcnt lgkmcnt(0)" ::: "memory");
      float pv[64]; f4 sv[16];
#pragma unroll
      for (int i = 0; i < 64; ++i) pv[i] = P[i * 64];
#pragma unroll
      for (int i = 0; i < 16; ++i) sv[i] = *(const LAS f4*)(srow + 4 * i);
      asm volatile("s_waitcnt lgkmcnt(0)" ::: "memory");
#pragma unroll
      for (int i = 0; i < 16; ++i) { a0 = fma_s(sv[i].x, pv[4 * i], a0); a1 = fma_s(sv[i].y, pv[4 * i + 1], a1); a2 = fma_s(sv[i].z, pv[4 * i + 2], a2); a3 = fma_s(sv[i].w, pv[4 * i + 3], a3); }
      S = (a0 + a1) + (a2 + a3);
    }
#undef A2_ISSUE
    asm volatile("s_waitcnt vmcnt(0)" ::: "memory"); __builtin_amdgcn_s_barrier();
  }
}

#define SB_BF(x) __builtin_bit_cast(float, (unsigned)(x) << 16)
#ifdef HOST_EMU
#define SB_EXP2(x) exp2f(x)
#else
#define SB_EXP2(x) __builtin_amdgcn_exp2f(x)
#endif
#ifdef HOST_EMU
#define SB_OPAQUE_LANE() do {} while (0)
#define SB_WAITL() emu_wave_sync()
#else
#define SB_OPAQUE_LANE() do { int lo_ = lane; asm volatile("" : "+v"(lo_)); lane = lo_; hi = lane >> 5; l31 = lane & 31; } while (0)
#define SB_WAITL() asm volatile("s_waitcnt lgkmcnt(0)" ::: "memory")
#endif
namespace sb {
typedef short bf16x8 __attribute__((ext_vector_type(8)));
typedef float f32x16 __attribute__((ext_vector_type(16)));
constexpr int P144 = 144, P80 = 80;
constexpr int O_PM = 0, O_QM = 4608, O_KH = 9216, O_RH = 13824, O_QT = 18432, O_KT = 23552, O_VT = 28672, O_PM32 = 33792, O_WT = 33792, O_UT = 41984,
              O_AKP = 47104, O_BRQ = 49664, O_BRK = 52224, O_F = 54784, O_GL = 73216, O_CUM = 73472, O_ROW = 74496, UNIT_BYTES = 74752;
constexpr int O_MCT = O_PM, O_REFF = O_KH;
__device__ __forceinline__ int crow(int r, int hi) { return (r & 3) + 8 * (r >> 2) + 4 * hi; }
__device__ __forceinline__ bf16x8 frag(const LAS unsigned char* base, int pitch, int row0, int k0, int lane) {
  return *(const LAS bf16x8*)(base + (row0 + (lane & 31)) * pitch + (k0 + 8 * (lane >> 5)) * 2);
}
#define SB_MMA(acc, a, b) acc = __builtin_amdgcn_mfma_f32_32x32x16_bf16(a, b, acc, 0, 0, 0)
template <int KK> __device__ __forceinline__ void mma_nat(f32x16& acc, const LAS unsigned char* A, int pa, int m0, const LAS unsigned char* B, int pb, int n0, int lane) {
  bf16x8 a[KK / 16], b[KK / 16];
#pragma unroll
  for (int k = 0; k < KK / 16; ++k) { a[k] = frag(A, pa, m0, 16 * k, lane); b[k] = frag(B, pb, n0, 16 * k, lane); }
#pragma unroll
  for (int k = 0; k < KK / 16; ++k) SB_MMA(acc, a[k], b[k]);
}
#ifdef HOST_EMU
inline unsigned pkb(float lo, float hi) { return (unsigned)f2bf(lo) | ((unsigned)f2bf(hi) << 16); }
inline float fnma_sv(float s, float v, float c) { return fmaf(-s, v, c); }
inline float fnma_vv(float s, float v, float c) { return fmaf(-s, v, c); }
#else
__device__ __forceinline__ unsigned pkb(float lo, float hi) { unsigned r; asm("v_cvt_pk_bf16_f32 %0, %1, %2" : "=v"(r) : "v"(lo), "v"(hi)); return r; }
__device__ __forceinline__ float fnma_vv(float a, float v, float c) { float r; asm("v_fma_f32 %0, -%1, %2, %3" : "=v"(r) : "v"(a), "v"(v), "v"(c)); return r; }
__device__ __forceinline__ float fnma_sv(float s, float v, float c) { float r; asm("v_fma_f32 %0, -%1, %2, %3" : "=v"(r) : "s"(s), "v"(v), "v"(c)); return r; }
#endif
__device__ __forceinline__ void store_t(LAS unsigned char* T, int pitch, const f32x16& c, int cofs, int rofs, int lane) {
  LAS unsigned char* rowp = T + (cofs + (lane & 31)) * pitch + (rofs + 4 * (lane >> 5)) * 2;
#pragma unroll
  for (int g = 0; g < 4; ++g) { u2 w; w.x = pkb(c[4 * g], c[4 * g + 1]); w.y = pkb(c[4 * g + 2], c[4 * g + 3]); *(LAS u2*)(rowp + 16 * g) = w; }
}

#define SB_LOAD_CHUNK(cq) do { const int sg = sbeg + (cq) * 32 + 8 * wq + (lane >> 3); size_t row = 0; bool lat = false; const bool ok = sg < send; if (ok) chain_step(d, dd, b, sg, row, lat); \
        const size_t o = row * RW + h * 64 + (lane & 7) * 8; const u4 z4 = {0u, 0u, 0u, 0u}; \
        ld[0] = ok ? *(const u4*)(p.Wd + dd * NRW + o) : z4; ld[1] = ok ? *(const u4*)(p.KK + o) : z4; ld[2] = ok ? *(const u4*)(p.Bb + dd * NRW + o) : z4; \
        ld[3] = ok ? *(const u4*)(p.Kd + dd * NRW + o) : z4; ld[4] = ok ? *(const u4*)(p.Vv + o) : z4; ld[5] = ok ? *(const u4*)(p.Rr + o) : z4; } while (0)
#define XTR_SLOT_OK true
#ifndef HOST_EMU
__device__ __forceinline__ void xtr_item(const Pm& p, int it, int lane) {
  const int e = it / 768, r = it % 768; const bool first = r < 512; const int rr = first ? r : r - 512; const int N = first ? 2048 : 1024, nblk = N / 64, kb = rr / nblk, nb = rr % nblk;
  const float* src = (first ? p.exp_w1 + (size_t)e * 1024 * 2048 : p.exp_w2 + (size_t)e * 1024 * 1024) + (size_t)(kb * 64) * N + nb * 64 + lane; float x[64];
#pragma unroll
  for (int j = 0; j < 64; ++j) x[j] = __builtin_nontemporal_load(src + (size_t)j * N);
  bf16_t* dst = (first ? p.W1T + (size_t)e * 2048 * 1024 : p.W2T + (size_t)e * 1024 * 1024) + (size_t)(nb * 64 + lane) * 1024 + kb * 64;
#pragma unroll
  for (int c = 0; c < 8; ++c) { u4 o; o.x = pkb(x[8 * c], x[8 * c + 1]); o.y = pkb(x[8 * c + 2], x[8 * c + 3]); o.z = pkb(x[8 * c + 4], x[8 * c + 5]); o.w = pkb(x[8 * c + 6], x[8 * c + 7]); *(u4*)(dst + 8 * c) = o; }
}
#endif
__device__ __forceinline__ void f_scan_b1(const Pm& p, LAS unsigned char* lds, int wave, int lane_in, int NSEG, int xtr_first, int xtr_total) {
  int lane = lane_in;
  constexpr Dm d = DMC; constexpr int RW = 512; const int SL = (d.C + d.T) / NSEG, NCH = (SL + 31) / 32; const size_t NRW = (size_t)d.NR * RW, BTW = (size_t)d.BT * RW;
  const int NU = 2 * d.B * d.RH * NSEG; const int uq = wave >> 2, wq = wave & 3; int hi = lane >> 5, l31 = lane & 31;
  LAS unsigned char* U = lds + uq * UNIT_BYTES;
  LAS float* GL = (LAS float*)(U + O_GL); LAS float* CUM = (LAS float*)(U + O_CUM); LAS int* ROWT = (LAS int*)(U + O_ROW); LAS float* PM32 = (LAS float*)(U + O_PM32);
  int xslot = 0;
  for (int ub = blockIdx.x; ub * 2 < NU; ub += gridDim.x) { const int unit = ub * 2 + uq; const int g = unit % NSEG, ch = unit / NSEG; const int h = ch % d.RH, b = (ch / d.RH) % d.B, dd = ch / (d.RH * d.B);
    const int sbeg = g * SL, send = (g + 1) * SL;
    for (int i = wq * 64 + lane; i < 128 * 32; i += 256) { const int row = i >> 5, c2 = i & 31; unsigned v = 0u; if (row < 64 && (row >> 1) == c2) v = (row & 1) ? 0x3f800000u : 0x00003f80u; *(LAS unsigned*)(U + O_F + row * P144 + c2 * 4) = v; }
    u4 ld[6];
    SB_LOAD_CHUNK(0);
    for (int c = 0; c < NCH; ++c) { const int s0 = sbeg + c * 32;
      f32x16 R[4] = {};
      SB_OPAQUE_LANE();
      {
#pragma unroll
        for (int i = 0; i < 8; ++i) { const int sg = s0 + 8 * wq + i; size_t row = 0; bool lat = false; const bool ok = sg < send; if (ok) chain_step(d, dd, b, sg, row, lat); if (lane == i) ROWT[8 * wq + i] = (ok && lat) ? (int)row : -1; }
        float w8[8], kk8[8], bv8[8], kd8[8], v8[8], r8[8];
        { LAS unsigned char* stg = U + wq * 6144;
#pragma unroll
          for (int v = 0; v < 6; ++v) *(LAS u4*)(stg + v * 1024 + lane * 16) = ld[v];
          SB_WAITL();
#pragma unroll
          for (int i = 0; i < 8; ++i) { const LAS unsigned short* sp = (const LAS unsigned short*)(stg + i * 128) + lane;
            w8[i] = SB_EXP2(SB_BF(sp[0])); kk8[i] = SB_BF(sp[512]); bv8[i] = SB_BF(sp[1024]); kd8[i] = SB_BF(sp[1536]); v8[i] = SB_BF(sp[2048]); r8[i] = SB_BF(sp[2560]); } }
        float cp[8]; cp[0] = w8[0];
#pragma unroll
        for (int i = 1; i < 8; ++i) cp[i] = cp[i - 1] * w8[i];
        CUM[wq * 64 + lane] = cp[7];
        __syncthreads();
        float pre = 1.f;
#pragma unroll
        for (int q = 0; q < 3; ++q) if (q < wq) pre *= CUM[q * 64 + lane];
        unsigned qt[4], kt[4], vt[4];
#pragma unroll
        for (int i = 0; i < 8; ++i) { const int t = 8 * wq + i; const float G = pre * cp[i], Gp = i == 0 ? pre : pre * cp[i - 1], Gi = 1.f / G;
          const float pm = Gp * kk8[i], qm = bv8[i] * Gi, kh = kd8[i] * Gi, rh = G * r8[i];
          *(LAS unsigned short*)(U + O_PM + t * P144 + lane * 2) = f2bf(pm); *(LAS unsigned short*)(U + O_QM + t * P144 + lane * 2) = f2bf(qm);
          *(LAS unsigned short*)(U + O_KH + t * P144 + lane * 2) = f2bf(kh); *(LAS unsigned short*)(U + O_RH + t * P144 + lane * 2) = f2bf(rh);
          PM32[t * 64 + lane] = pm;
          if (i & 1) { qt[i >> 1] |= (unsigned)f2bf(qm) << 16; kt[i >> 1] |= (unsigned)f2bf(kh) << 16; vt[i >> 1] |= (unsigned)f2bf(v8[i]) << 16; }
          else { qt[i >> 1] = f2bf(qm); kt[i >> 1] = f2bf(kh); vt[i >> 1] = f2bf(v8[i]); }
          if (t == 31) GL[lane] = G; }
        *(LAS u4*)(U + O_QT + lane * P80 + 16 * wq) = (u4){qt[0], qt[1], qt[2], qt[3]};
        *(LAS u4*)(U + O_KT + lane * P80 + 16 * wq) = (u4){kt[0], kt[1], kt[2], kt[3]};
        *(LAS u4*)(U + O_VT + lane * P80 + 16 * wq) = (u4){vt[0], vt[1], vt[2], vt[3]}; }
      if (c + 1 < NCH) SB_LOAD_CHUNK(c + 1);
      __syncthreads();
      SB_OPAQUE_LANE();
      if (wq < 2) { float xv[32];
        if (wq == 0) {
#pragma unroll
          for (int t = 0; t < 32; ++t) xv[t] = PM32[t * 64 + lane];
          SB_WAITL(); }
        else { f32x16 akp = {}; mma_nat<64>(akp, U + O_KH, P144, 0, U + O_PM, P144, 0, lane);
#pragma unroll
          for (int r = 0; r < 16; ++r) if (crow(r, hi) >= l31) akp[r] = 0.f;
          store_t(U + O_AKP, P80, akp, 0, 0, lane);
          SB_WAITL();
          f32x16 z0 = {}, z1 = {}; mma_nat<32>(z0, U + O_AKP, P80, 0, U + O_VT, P80, 0, lane); mma_nat<32>(z1, U + O_AKP, P80, 0, U + O_VT, P80, 32, lane);
#pragma unroll
          for (int r = 0; r < 16; ++r) { const float za_ = z0[r], zb_ = z1[r]; auto sw = __builtin_amdgcn_permlane32_swap(__builtin_bit_cast(unsigned, za_), __builtin_bit_cast(unsigned, zb_), false, false);
            const unsigned s0_ = sw[0], s1_ = sw[1]; xv[crow(r, 0)] = __builtin_bit_cast(float, s0_); xv[crow(r, 1)] = __builtin_bit_cast(float, s1_); } }
        f32x16 aqp = {}; mma_nat<64>(aqp, U + O_PM, P144, 0, U + O_QM, P144, 0, lane);
#pragma unroll
        for (int s = 0; s < 31; ++s) { const float xs = xv[s]; float as_[32];
#pragma unroll
          for (int t = s + 1; t < 32; ++t) { const int rt = (t & 3) + 4 * (t >> 3), ht = (t >> 2) & 1; const float af_ = aqp[rt]; const int av = __builtin_bit_cast(int, af_);
            as_[t] = __builtin_bit_cast(float, __builtin_amdgcn_readlane(av, s + 32 * ht)); }
#pragma unroll
          for (int t = s + 1; t < 32; ++t) xv[t] = fnma_sv(as_[t], xs, xv[t]); }
#ifdef SB_PROBE_SUBST
        for (int rep_ = 1; rep_ < p.reps[22]; ++rep_) { float xc[32];
#pragma unroll
          for (int t = 0; t < 32; ++t) xc[t] = xv[t] + (float)rep_;
#pragma unroll
          for (int s = 0; s < 31; ++s) { const float xs = xc[s]; float as_[32];
#pragma unroll
            for (int t = s + 1; t < 32; ++t) { const int rt = (t & 3) + 4 * (t >> 3), ht = (t >> 2) & 1; const float af_ = aqp[rt]; const int av = __builtin_bit_cast(int, af_); as_[t] = __builtin_bit_cast(float, __builtin_amdgcn_readlane(av, s + 32 * ht)); }
#pragma unroll
            for (int t = s + 1; t < 32; ++t) xc[t] = fnma_sv(as_[t], xs, xc[t]); }
          float sink = 0.f;
#pragma unroll
          for (int t = 0; t < 32; ++t) sink += xc[t];
          asm volatile("" :: "v"(sink)); }
#endif
        LAS unsigned char* dst = U + (wq == 0 ? O_WT : O_UT) + lane * P80;
#pragma unroll
        for (int q = 0; q < 4; ++q) *(LAS u4*)(dst + 16 * q) = (u4){pkb(xv[8 * q], xv[8 * q + 1]), pkb(xv[8 * q + 2], xv[8 * q + 3]), pkb(xv[8 * q + 4], xv[8 * q + 5]), pkb(xv[8 * q + 6], xv[8 * q + 7])};
      } else if (wq == 2) { f32x16 t0 = {}; mma_nat<64>(t0, U + O_QM, P144, 0, U + O_RH, P144, 0, lane);
#pragma unroll
        for (int r = 0; r < 16; ++r) if (crow(r, hi) > l31) t0[r] = 0.f;
        store_t(U + O_BRQ, P80, t0, 0, 0, lane);
#ifndef HOST_EMU
        { const int it = xtr_first + (xslot * 4 + uq * 2) * (int)gridDim.x + (int)blockIdx.x; if (it < xtr_total && XTR_SLOT_OK) xtr_item(p, it, lane); }
#endif
      } else { f32x16 t0 = {}; mma_nat<64>(t0, U + O_KH, P144, 0, U + O_RH, P144, 0, lane);
#pragma unroll
        for (int r = 0; r < 16; ++r) if (crow(r, hi) > l31) t0[r] = 0.f;
        store_t(U + O_BRK, P80, t0, 0, 0, lane);
        SB_WAITL();
        mma_nat<32>(R[0], U + O_BRK, P80, 0, U + O_VT, P80, 0, lane); mma_nat<32>(R[1], U + O_BRK, P80, 0, U + O_VT, P80, 32, lane);
#ifndef HOST_EMU
        { const int it = xtr_first + (xslot * 4 + uq * 2 + 1) * (int)gridDim.x + (int)blockIdx.x; if (it < xtr_total && XTR_SLOT_OK) xtr_item(p, it, lane); }
#endif
      }
      ++xslot;
      __syncthreads();
      SB_OPAQUE_LANE();
      if (wq == 0) {
#pragma unroll
        for (int kt2 = 0; kt2 < 2; ++kt2) { f32x16 cc = {}; mma_nat<32>(cc, U + O_WT, P80, 32 * kt2, U + O_BRQ, P80, 0, lane);
          const LAS unsigned char* rhp = U + O_RH + l31 * P144 + (32 * kt2 + 4 * hi) * 2; LAS unsigned char* rfp = U + O_REFF + l31 * P144 + (32 * kt2 + 4 * hi) * 2;
#pragma unroll
          for (int gq = 0; gq < 4; ++gq) { const u2 rh = *(const LAS u2*)(rhp + 16 * gq);
            const float a0 = __builtin_bit_cast(float, rh.x << 16) - cc[4 * gq], a1 = __builtin_bit_cast(float, rh.x & 0xffff0000u) - cc[4 * gq + 1], a2 = __builtin_bit_cast(float, rh.y << 16) - cc[4 * gq + 2], a3 = __builtin_bit_cast(float, rh.y & 0xffff0000u) - cc[4 * gq + 3];
            u2 w; w.x = pkb(a0, a1); w.y = pkb(a2, a3); *(LAS u2*)(rfp + 16 * gq) = w; } }
      } else if (wq == 1) {
#pragma unroll
        for (int jt = 0; jt < 2; ++jt)
#pragma unroll
          for (int it = 0; it < 2; ++it) { f32x16 cc = {}; mma_nat<32>(cc, U + O_WT, P80, 32 * jt, U + O_QT, P80, 32 * it, lane);
            const float gl = GL[l31 + 32 * it];
#pragma unroll
            for (int r = 0; r < 16; ++r) cc[r] = gl * (((crow(r, hi) + 32 * jt) == (l31 + 32 * it) ? 1.f : 0.f) - cc[r]);
            store_t(U + O_MCT, P144, cc, 32 * it, 32 * jt, lane); }
      } else if (wq == 2) {
#pragma unroll
        for (int it = 0; it < 2; ++it)
#pragma unroll
          for (int vt2 = 0; vt2 < 2; ++vt2) { f32x16 ca = {}, cb = {}; mma_nat<32>(ca, U + O_KT, P80, 32 * it, U + O_VT, P80, 32 * vt2, lane); mma_nat<32>(cb, U + O_QT, P80, 32 * it, U + O_UT, P80, 32 * vt2, lane);
#pragma unroll
            for (int r = 0; r < 16; ++r) ca[r] = GL[crow(r, hi) + 32 * it] * (ca[r] - cb[r]);
            R[it * 2 + vt2] = ca; }
      } else {
        f32x16 c0 = {}, c1 = {}; mma_nat<32>(c0, U + O_BRQ, P80, 0, U + O_UT, P80, 0, lane); mma_nat<32>(c1, U + O_BRQ, P80, 0, U + O_UT, P80, 32, lane); R[0] = R[0] - c0; R[1] = R[1] - c1; }
      __syncthreads();
      SB_OPAQUE_LANE();
      if (wq == 0) {
        const int row = ROWT[l31];
#pragma unroll
        for (int jt = 0; jt < 2; ++jt) { f32x16 cc = {}; mma_nat<64>(cc, U + O_F, P144, 32 * jt, U + O_REFF, P144, 0, lane);
          if (row >= 0) { bf16_t* dst = p.Zt + dd * BTW + (size_t)row * RW + h * 64 + 32 * jt + 4 * hi;
#pragma unroll
            for (int gq = 0; gq < 4; ++gq) { u2 w; w.x = pkb(cc[4 * gq], cc[4 * gq + 1]); w.y = pkb(cc[4 * gq + 2], cc[4 * gq + 3]); *(u2*)(dst + 8 * gq) = w; } } }
      } else if (wq == 3) {
        mma_nat<64>(R[0], U + O_REFF, P144, 0, U + O_F + 64 * P144, P144, 0, lane); mma_nat<64>(R[1], U + O_REFF, P144, 0, U + O_F + 64 * P144, P144, 32, lane);
#pragma unroll
        for (int r = 0; r < 16; ++r) { const int row = ROWT[crow(r, hi)]; if (row >= 0) { float* dst = p.O2 + dd * BTW + (size_t)row * RW + h * 64 + l31; dst[0] = R[0][r]; dst[32] = R[1][r]; } }
      } else {
        const int cbase = wq == 1 ? 0 : 64;
#pragma unroll
        for (int it = 0; it < 2; ++it)
#pragma unroll
          for (int ct = 0; ct < 2; ++ct) mma_nat<64>(R[it * 2 + ct], U + O_MCT, P144, 32 * it, U + O_F + cbase * P144, P144, 32 * ct, lane); }
      __syncthreads();
      if (wq == 1 || wq == 2) { const int cbase = wq == 1 ? 0 : 64;
#pragma unroll
        for (int it = 0; it < 2; ++it)
#pragma unroll
          for (int ct = 0; ct < 2; ++ct) store_t(U + O_F, P144, R[it * 2 + ct], cbase + 32 * ct, 32 * it, lane);
        if (c == NCH - 1) {
          float* fe = p.Fend + ((size_t)ch * NSEG + g) * 128 * 64 + (size_t)(wq == 1 ? 64 : 0) * 64;
#pragma unroll
          for (int it = 0; it < 2; ++it)
#pragma unroll
            for (int ct = 0; ct < 2; ++ct) { float* rp = fe + (size_t)(32 * ct + l31) * 64 + 32 * it + 4 * hi; const f32x16& cc = R[it * 2 + ct];
#pragma unroll
              for (int gq = 0; gq < 4; ++gq) *(f4*)(rp + 8 * gq) = (f4){cc[4 * gq], cc[4 * gq + 1], cc[4 * gq + 2], cc[4 * gq + 3]}; } } }
      __syncthreads();
    }
  }
}
}


template <class F> struct EpiFn {
  static constexpr bool PERM = true, AFTER_DRAIN = false; F f;
  __device__ __forceinline__ void operator()(const pg8::f32x4 (&acc)[2][2][4][2], const pg8::Unit& u, int wr, int wc, int fr, int fq) const {
#pragma unroll
    for (int ai = 0; ai < 2; ++ai)
#pragma unroll
      for (int m = 0; m < 4; ++m) { const int row = u.pm * 256 + ai * 128 + wr * 64 + m * 16 + fr;
#pragma unroll
        for (int bj = 0; bj < 2; ++bj) { const int col = u.pn * 256 + bj * 128 + wc * 32 + 8 * fq; f(u, row, col, acc[ai][bj][m][0], acc[ai][bj][m][1]); asm volatile("" ::: "memory"); } }
  }
};
template <class F> __device__ __forceinline__ void run_gemm(LAS unsigned char* lds, const bf16_t* A, const bf16_t* Bt, int M, int N, int K, F f, const int tid_in, const int* tile_e = nullptr, size_t bexp = 0) {
  asm volatile("" : "+s"(M), "+s"(N), "+s"(K));
  pg8::Gemm g{A, Bt, M, N, K, bexp}; pg8::StaticOrder S; S.init(M, N, (int)gridDim.x, (int)blockIdx.x, tile_e);
  EpiFn<F> E{f};
  pg8::gemm_phase<EpiFn<F>, pg8::StaticOrder, true, true>((PG8_LAS unsigned char*)lds, g, S, E, tid_in);
}

__device__ __forceinline__ unsigned pk2(float lo, float hi) { return (unsigned)f2bf(lo) | ((unsigned)f2bf(hi) << 16); }
__device__ __forceinline__ void transpose_all(const float* W, int K, int N, bf16_t* WT, int gw, int ngw, int lane) {
  const int nblk = N / 64, items = (K / 64) * nblk;
  for (int it = gw; it < items; it += ngw) { const int kb = it / nblk, nb = it % nblk; const float* src = W + (size_t)(kb * 64) * N + nb * 64 + lane; float x[64];
#pragma unroll
    for (int j = 0; j < 64; ++j) x[j] = src[(size_t)j * N];
    bf16_t* dst = WT + (size_t)(nb * 64 + lane) * K + kb * 64;
#pragma unroll
    for (int c = 0; c < 8; ++c) { v4u o; o.x = pk2(x[8 * c], x[8 * c + 1]); o.y = pk2(x[8 * c + 2], x[8 * c + 3]); o.z = pk2(x[8 * c + 4], x[8 * c + 5]); o.w = pk2(x[8 * c + 6], x[8 * c + 7]); *(v4u*)(dst + 8 * c) = o; } }
}

constexpr int INP = 2304;

__global__ void __launch_bounds__(NTHREADS, 2) fwd(Pm p, unsigned* bar) {
  extern __shared__ __attribute__((aligned(16))) unsigned char lds_raw[];
  LAS unsigned char* lds = (LAS unsigned char*)lds_raw;
#define IDS() int tidb; asm volatile("v_mbcnt_lo_u32_b32 %0, -1, 0\n\tv_mbcnt_hi_u32_b32 %0, -1, %0" : "=v"(tidb)); tidb += wave_s * 64; const int lane = tidb & 63, wave = __builtin_amdgcn_readfirstlane(tidb >> 6); \
    const long tid = (long)blockIdx.x * NTHREADS + tidb, nth = (long)gridDim.x * NTHREADS; const int gw = blockIdx.x * NWAVES + wave, ngw = gridDim.x * NWAVES; \
    (void)lane; (void)wave; (void)tid; (void)nth; (void)gw; (void)ngw
  for (int u = threadIdx.x; u < (LDS_BYTES - RING_BYTES) / 4; u += NTHREADS) ((LAS unsigned*)(lds + RING_BYTES))[u] = 0u;
  __syncthreads();
  const int wave_s = __builtin_amdgcn_readfirstlane((int)threadIdx.x >> 6);
  XcdBarrier xb = xcd_barrier_post(bar, (volatile LAS unsigned*)(lds + MISC_OFF + 32));
  constexpr Dm d = DMC;
#define GSYNC() xcd_barrier(xb)
  constexpr int NSEG = 32;
  const int XTR_P0 = (gridDim.x == 256) ? d.NE * 768 - 72 * 256 : d.NE * 768;
#define NPOS() __builtin_amdgcn_readfirstlane(__hip_atomic_load(p.npos, __ATOMIC_RELAXED, __HIP_MEMORY_SCOPE_AGENT))
  {
  IDS();
  f_mod_partial(p, tidb); f_rope_table(p, tid, nth); f_lora_weights(p, tid, nth);
  {
  transpose_all(p.w_in, d.D, d.IN, p.WinT, gw, ngw, lane);
  for (long i = tid; i < (long)(INP - d.IN) * d.D; i += nth) p.WinT[(size_t)d.IN * d.D + i] = 0;
  transpose_all(p.w_uq, d.QL, d.MH * d.QK, p.WuqT, gw, ngw, lane);
  transpose_all(p.w_ukv, d.KL, d.MH * (d.DN + d.DV), p.WukvT, gw, ngw, lane);
  transpose_all(p.w_out, d.MIX, d.D, p.WoutT, gw, ngw, lane); }
for (int it = gw; it < XTR_P0; it += ngw) { const int e = it / 768, r = it % 768; const bool first = r < 512; const int rr = first ? r : r - 512; const int N = first ? 2048 : 1024, nblk = N / 64, kb = rr / nblk, nb = rr % nblk;
    const float* src = (first ? p.exp_w1 + (size_t)e * 1024 * 2048 : p.exp_w2 + (size_t)e * 1024 * 1024) + (size_t)(kb * 64) * N + nb * 64 + lane; float x[64];
#pragma unroll
    for (int j = 0; j < 64; ++j) x[j] = __builtin_nontemporal_load(src + (size_t)j * N);
    bf16_t* dst = (first ? p.W1T + (size_t)e * 2048 * 1024 : p.W2T + (size_t)e * 1024 * 1024) + (size_t)(nb * 64 + lane) * 1024 + kb * 64;
#pragma unroll
    for (int c = 0; c < 8; ++c) { v4u o; o.x = pk2(x[8 * c], x[8 * c + 1]); o.y = pk2(x[8 * c + 2], x[8 * c + 3]); o.z = pk2(x[8 * c + 4], x[8 * c + 5]); o.w = pk2(x[8 * c + 6], x[8 * c + 7]); *(v4u*)(dst + 8 * c) = o; } }
    }
  GSYNC();
  {
  IDS();

  { f_mod_reduce(p, (LAS float*)lds, tidb); f_norm1(p, (const LAS float*)lds, gw, ngw, lane); }   }
  GSYNC();
  {
  IDS();

{ bf16_t* P = p.P; const int IN = d.IN;
    run_gemm(lds, p.A1, p.WinT, d.NR, INP, d.D, [=](const pg8::Unit& u, int row, int col, pg8::f32x4 v0, pg8::f32x4 v1) {
      if (col < IN) { v4u w; w.x = pk2(v0[0], v0[1]); w.y = pk2(v0[2], v0[3]); w.z = pk2(v1[0], v1[1]); w.w = pk2(v1[2], v1[3]); *(v4u*)(P + (size_t)row * IN + col) = w; } }, tidb); }
  }
  GSYNC();
  {
  IDS();

  { f_mla_a(p, gw, ngw, lane); f_rwkv_s1(p, gw, ngw, lane); }   }
  GSYNC();
  {
  IDS();

{ bf16_t* Q = p.Q; const float* ropet = p.ropet;
    run_gemm(lds, p.QN, p.WuqT, d.BT, 768, 256, [=](const pg8::Unit& u, int row, int col, pg8::f32x4 v0, pg8::f32x4 v1) {
      const int h = col / 192, i0 = col - h * 192, b = row >> 13, t = row & 8191;
      float x[8] = {v0[0], v0[1], v0[2], v0[3], v1[0], v1[1], v1[2], v1[3]}, pr[8];
#pragma unroll
      for (int e = 0; e < 8; ++e) pr[e] = __shfl_xor(x[e], 32);
      if (i0 >= 128) { const int i = i0 - 128, a = i >> 5, half = (i >> 4) & 1, f0 = i & 15; const float* ct = ropet + ((size_t)t * 32 + a * 16 + f0) * 2;
#pragma unroll
        for (int e = 0; e < 8; ++e) { const float c = ct[2 * e], s = ct[2 * e + 1]; x[e] = half ? x[e] * c + pr[e] * s : x[e] * c - pr[e] * s; } }
      v4u w; w.x = pk2(x[0], x[1]); w.y = pk2(x[2], x[3]); w.z = pk2(x[4], x[5]); w.w = pk2(x[6], x[7]);
      *(v4u*)(Q + ((size_t)(b * 4 + h) * 8192 + t) * 192 + i0) = w; }, tidb); }
{ bf16_t* K = p.K; bf16_t* V = p.V; const int BT = d.BT;
    run_gemm(lds, p.CN, p.WukvT, d.NR, 1024, 128, [=](const pg8::Unit& u, int row, int col, pg8::f32x4 v0, pg8::f32x4 v1) {
      const int h = col >> 8, i0 = col & 255; int b, key; if (row < BT) { b = row >> 13; key = 256 + (row & 8191); } else { b = (row - BT) >> 8; key = (row - BT) & 255; }
      v4u w; w.x = pk2(v0[0], v0[1]); w.y = pk2(v0[2], v0[3]); w.z = pk2(v1[0], v1[1]); w.w = pk2(v1[2], v1[3]);
      const size_t kr = (size_t)(b * 4 + h) * 8448 + key;
      if (i0 < 128) *(v4u*)(K + kr * 192 + i0) = w; else *(v4u*)(V + kr * 128 + (i0 - 128)) = w; }, tidb); }
{ bf16_t* Wd = p.Wd; bf16_t* Bb = p.Bb; bf16_t* Kd = p.Kd; const bf16_t* KK = p.KK; const float* Kraw = p.Kraw; const float* w0 = p.w0; const float* a0 = p.a0; const float* k_a = p.k_a; const size_t NRW = (size_t)d.NR * 512;
    run_gemm(lds, p.AL1, p.WlT, d.NR, 2048, 128, [=](const pg8::Unit& u, int row, int col, pg8::f32x4 v0, pg8::f32x4 v1) {
      float x[8] = {v0[0], v0[1], v0[2], v0[3], v1[0], v1[1], v1[2], v1[3]};
      if (col < 1024) { const int dd = col >> 9, c = col & 511; const float* wb = w0 + dd * 512 + c; float o[8];
#pragma unroll
        for (int e = 0; e < 8; ++e) o[e] = -0.87503576f / (1.f + __expf(-(x[e] + wb[e])));
        v4u w; w.x = pk2(o[0], o[1]); w.y = pk2(o[2], o[3]); w.z = pk2(o[4], o[5]); w.w = pk2(o[6], o[7]); *(v4u*)(Wd + (size_t)dd * NRW + (size_t)row * 512 + c) = w; }
      else { const int q = col - 1024, dd = q >> 9, c = q & 511; const float* ab = a0 + dd * 512 + c; const v4u kk4 = *(const v4u*)(KK + (size_t)row * 512 + c); const float* kp = Kraw + (size_t)row * 512 + c; float ob[8], ok[8];
        const unsigned kw[4] = {kk4.x, kk4.y, kk4.z, kk4.w};
#pragma unroll
        for (int e = 0; e < 8; ++e) { const float a = 1.f / (1.f + __expf(-(x[e] + ab[e]))); const float kkv = __builtin_bit_cast(float, (e & 1) ? (kw[e >> 1] & 0xffff0000u) : (kw[e >> 1] << 16)); ob[e] = kkv * a; ok[e] = kp[e] * (1.f + (a - 1.f) * k_a[c + e]); }
        v4u w1; w1.x = pk2(ob[0], ob[1]); w1.y = pk2(ob[2], ob[3]); w1.z = pk2(ob[4], ob[5]); w1.w = pk2(ob[6], ob[7]); *(v4u*)(Bb + (size_t)dd * NRW + (size_t)row * 512 + c) = w1;
        v4u w2; w2.x = pk2(ok[0], ok[1]); w2.y = pk2(ok[2], ok[3]); w2.z = pk2(ok[4], ok[5]); w2.w = pk2(ok[6], ok[7]); *(v4u*)(Kd + (size_t)dd * NRW + (size_t)row * 512 + c) = w2; } }, tidb); }
  { float* Gt = p.Gt;
    run_gemm(lds, p.AL2, p.G2T, d.BT, 512, 128, [=](const pg8::Unit& u, int row, int col, pg8::f32x4 v0, pg8::f32x4 v1) { float* o = Gt + (size_t)row * 512 + col; *(pg8::f32x4*)o = v0; *(pg8::f32x4*)(o + 4) = v1; }, tidb); }
    }
  GSYNC();
  {
  IDS();

sb::f_scan_b1(p, lds, wave, lane, NSEG, XTR_P0, d.NE * 768);   }
  GSYNC();
  {
  IDS();
f_scan_a2(p, lds, wave, lane, NSEG);   }
  GSYNC();
  {
  IDS();

ph_scan_a3(p, gw, ngw, lane, NSEG);
for (int u = blockIdx.x; u < d.B * d.MH * (d.T / 256); u += gridDim.x) { const int bh = u % (d.B * d.MH), qb = u / (d.B * d.MH), b = bh / d.MH, h = bh % d.MH; const int NK = d.C + d.T;
    attn::attn_dense_body(p.Q + ((size_t)bh * d.T + (size_t)qb * 256) * attn::DQK, p.K + (size_t)bh * NK * attn::DQK, p.V + (size_t)bh * NK * attn::DV,
                          p.MIXb + ((size_t)b * d.T + (size_t)qb * 256) * d.MIX + d.RW + h * attn::DV, NK, (char*)lds_raw, tidb); }
    }
  GSYNC();
  {
  IDS();

f_readout(p, gw, ngw, lane);   }
  GSYNC();
  {
  IDS();

{ float* x1 = p.x1; const float* x = p.x; const float* modv = p.modv; const int D = d.D, T = d.T;
    run_gemm(lds, p.MIXb, p.WoutT, d.BT, D, d.MIX, [=](const pg8::Unit& u, int row, int col, pg8::f32x4 v0, pg8::f32x4 v1) {
      const float* g = modv + (size_t)(row / T) * 6 * D + 2 * D + col; const float* xr = x + (size_t)row * D + col; float* o = x1 + (size_t)row * D + col;
      const pg8::f32x4 g0 = *(const pg8::f32x4*)g, g1 = *(const pg8::f32x4*)(g + 4), x0 = *(const pg8::f32x4*)xr, x1v = *(const pg8::f32x4*)(xr + 4);
      *(pg8::f32x4*)o = x0 + g0 * v0; *(pg8::f32x4*)(o + 4) = x1v + g1 * v1; }, tidb); }
    }
  GSYNC();
  {
  IDS();

f_route(p, lds, wave, lane, tidb);
  }
  GSYNC();
  {
  IDS();
f_place(p, lds, wave, lane, tidb);
  }
  GSYNC();
  {
  IDS();
  const int npos = NPOS();
{ bf16_t* ACT = p.ACTb; const float* b1 = p.exp_b1; const int DE = d.DE;
    run_gemm(lds, p.Xg, p.W1T, npos, 2 * d.DE, d.D, [=](const pg8::Unit& u, int row, int col, pg8::f32x4 v0, pg8::f32x4 v1) {
      const float* bb = b1 + (size_t)u.eb * 2 * DE + col; const pg8::f32x4 c0 = *(const pg8::f32x4*)bb, c1 = *(const pg8::f32x4*)(bb + 4);
      v0 = v0 + c0; v1 = v1 + c1; float o[4];
#pragma unroll
      for (int q = 0; q < 4; ++q) { const float gl = fminf(q < 2 ? v0[2 * q] : v1[2 * q - 4], 7.f), li = fminf(fmaxf(q < 2 ? v0[2 * q + 1] : v1[2 * q - 3], -7.f), 7.f);
        o[q] = gl * (li + 1.f) / (1.f + __expf(-1.702f * gl)); }
      uint2 w; w.x = pk2(o[0], o[1]); w.y = pk2(o[2], o[3]); *(uint2*)(ACT + (size_t)row * DE + (col >> 1)) = w; }, tidb, p.tile_e, (size_t)2 * d.DE * d.D * 2); }
    }
  GSYNC();
  {
  IDS();

  const int npos = NPOS();
{ bf16_t* Y = p.Yb; const float* b2 = p.exp_b2; const int D = d.D;
    run_gemm(lds, p.ACTb, p.W2T, npos, d.D, d.DE, [=](const pg8::Unit& u, int row, int col, pg8::f32x4 v0, pg8::f32x4 v1) {
      const float* bb = b2 + (size_t)u.eb * D + col; const pg8::f32x4 c0 = *(const pg8::f32x4*)bb, c1 = *(const pg8::f32x4*)(bb + 4);
      v0 = v0 + c0; v1 = v1 + c1; v4u w; w.x = pk2(v0[0], v0[1]); w.y = pk2(v0[2], v0[3]); w.z = pk2(v1[0], v1[1]); w.w = pk2(v1[2], v1[3]);
      *(v4u*)(Y + (size_t)row * D + col) = w; }, tidb, p.tile_e, (size_t)d.D * d.DE * 2); }
    }
  GSYNC();
  {
  IDS();

f_final(p, gw, ngw, lane);
  }
}

static size_t carve(Pm& p, char* base) {
  const Dm& d = p.d; size_t off = 0;
#define CARVE(ptr, type, count) do { p.ptr = (type*)(base + off); off += (((size_t)(count) * sizeof(type)) + 255) / 256 * 256; } while (0)
  const size_t NRW = (size_t)d.NR * d.RW; const int NK = d.C + d.T;
  CARVE(modv, float, (size_t)(d.B + 1) * 6 * d.D); CARVE(modp, float, (size_t)16 * 3 * 6 * d.D); CARVE(ropet, float, (size_t)d.T * 64);
  CARVE(top_e, int, (size_t)d.BT * 4); CARVE(cnt, int, d.NE); CARVE(slot_pos, int, (size_t)d.BT * 4); CARVE(pos_tok, int, d.NPOSMAX); CARVE(tile_e, int, d.NPOSMAX / d.PADR + 1); CARVE(npos, int, 4);
  CARVE(gate, float, (size_t)d.BT * 4); CARVE(lrank, int, (size_t)d.BT * 4); CARVE(blkcnt, int, 1024 * 32);
  CARVE(WlT, bf16_t, (size_t)2048 * 128); CARVE(G2T, bf16_t, (size_t)512 * 128);
  CARVE(WinT, bf16_t, (size_t)INP * d.D); CARVE(WuqT, bf16_t, (size_t)d.MH * d.QK * d.QL); CARVE(WukvT, bf16_t, (size_t)d.MH * (d.DN + d.DV) * d.KL); CARVE(WoutT, bf16_t, (size_t)d.D * d.MIX);
  CARVE(W1T, bf16_t, (size_t)d.NE * 2 * d.DE * d.D); CARVE(W2T, bf16_t, (size_t)d.NE * d.D * d.DE);
  const size_t early0 = off;
  CARVE(P, bf16_t, (size_t)d.NR * d.IN); CARVE(A1, bf16_t, (size_t)d.NR * d.D);
  const size_t after_p = off;
  CARVE(Kraw, float, NRW); CARVE(AL1, bf16_t, (size_t)d.NR * 128); CARVE(AL2, bf16_t, (size_t)d.BT * 128); CARVE(Rr, bf16_t, NRW); CARVE(Vv, bf16_t, NRW); CARVE(KK, bf16_t, NRW); CARVE(Kd, bf16_t, 2 * NRW); CARVE(Wd, bf16_t, 2 * NRW); CARVE(Bb, bf16_t, 2 * NRW);
  CARVE(Gt, float, (size_t)d.BT * d.RW); CARVE(QN, bf16_t, (size_t)d.BT * d.QL); CARVE(CN, bf16_t, (size_t)d.NR * d.KL);
  CARVE(O2, float, (size_t)2 * d.BT * d.RW);
  CARVE(Q, bf16_t, (size_t)d.B * d.MH * d.T * d.QK); CARVE(K, bf16_t, (size_t)d.B * d.MH * NK * d.QK); CARVE(V, bf16_t, (size_t)d.B * d.MH * NK * d.DV);
  CARVE(MIXb, bf16_t, (size_t)d.BT * d.MIX);
  size_t end1 = off;
  off = early0; CARVE(x1, float, (size_t)d.BT * d.D); CARVE(H2b, bf16_t, (size_t)d.BT * d.D);
  if (off > after_p) return (size_t)-1;
  off = after_p; CARVE(Xg, bf16_t, (size_t)d.NPOSMAX * d.D); CARVE(ACTb, bf16_t, (size_t)d.NPOSMAX * d.DE); CARVE(Yb, bf16_t, (size_t)d.NPOSMAX * d.D);
  if (off > end1) end1 = off;
  off = end1; CARVE(Zt, bf16_t, (size_t)2 * d.BT * d.RW); CARVE(Fend, float, (size_t)2 * d.B * d.RH * 32 * 128 * 64); CARVE(Sst, float, (size_t)2 * d.B * d.RH * 32 * 64 * 64); end1 = off;
#undef CARVE
  return end1;
}

extern "C" void kernel_launch(void* const* d_in, const int* in_sizes, int n_in, void* d_out, int out_size, void* d_ws, size_t ws_size, hipStream_t stream) {
  static int grid = 0;
  if (!grid) {
    int dev = 0, cus = 0;
    hipGetDevice(&dev); hipDeviceGetAttribute(&cus, hipDeviceAttributeMultiprocessorCount, dev);
    if (hipFuncSetAttribute((const void*)fwd, hipFuncAttributeMaxDynamicSharedMemorySize, LDS_BYTES) != hipSuccess) { fprintf(stderr, "kernel_launch: hipFuncSetAttribute failed\n"); grid = -1; return; }
    grid = cus;
  }
  if (grid < 0) return;
  Pm p; memset(&p, 0, sizeof(p));
  Dm& d = p.d; d.D = 1024; d.B = 2; d.T = 8192; d.GW = 64; d.C = 256; d.RH = 8; d.LW = 64; d.LA = 64; d.LG = 128; d.MH = 4; d.DN = 128; d.DR = 64; d.DV = 128; d.QL = 256; d.KL = 128;
  d.NE = 32; d.DE = 1024; d.PADR = 256; dm_finish(d);
  const float** ip = &p.x; for (int i = 0; i < 32; ++i) ip[i] = (const float*)d_in[i];
  p.out = (float*)d_out;
  unsigned* bar = (unsigned*)d_ws;
  const size_t used = carve(p, (char*)d_ws + 16384);
  if (used == (size_t)-1 || used + 16384 > ws_size) { fprintf(stderr, "kernel_launch: workspace too small (%zu needed, %zu given)\n", used + 16384, ws_size); return; }
  static bool once = false; if (!once) { once = true; fprintf(stderr, "ws used %zu of %zu\n", used + 16384, ws_size); }
  hipMemsetAsync(bar, 0, 16384, stream);
  hipLaunchKernelGGL(fwd, dim3(grid), dim3(NTHREADS), LDS_BYTES, stream, p, bar);
}
```

```cpp
#include <hip/hip_runtime.h>
#include <cstdio>
#include <cstring>
#include <cstdint>
#define HD __host__ __device__
#define SB_PROBE_SUBST 1
#ifndef HD
#define HD
#endif
struct Dm {
  int D, B, T, GW, C, RH, LW, LA, LG, MH, DN, DR, DV, QL, KL, NE, DE;
  int RW, RC, QK, MC, IN, MIX, NF, BT, BC, NR, PADR, NPOSMAX, pad_;
};
HD constexpr void dm_finish(Dm& d) {
  d.RW = d.RH * 64; d.RC = 3 * d.RW + d.LW + d.LA + d.LG; d.QK = d.DN + d.DR; d.MC = d.QL + d.KL + d.DR; d.IN = d.RC + d.MC;
  d.MIX = d.RW + d.MH * d.DV; d.NF = d.DR / 4; d.BT = d.B * d.T; d.BC = d.B * d.C; d.NR = d.BT + d.BC;
  d.NPOSMAX = d.BT * 4 + d.NE * d.PADR;
}
typedef unsigned short bf16_t;
HD inline bf16_t f2bf(float f) { unsigned u = __builtin_bit_cast(unsigned, f); return (bf16_t)((u + 0x7fffu + ((u >> 16) & 1u)) >> 16); }
HD inline float bf2f(bf16_t h) { return __builtin_bit_cast(float, (unsigned)h << 16); }
HD constexpr Dm make_dmc() { Dm d{}; d.D = 1024; d.B = 2; d.T = 8192; d.GW = 64; d.C = 256; d.RH = 8; d.LW = 64; d.LA = 64; d.LG = 128; d.MH = 4; d.DN = 128; d.DR = 64; d.DV = 128; d.QL = 256; d.KL = 128;
  d.NE = 32; d.DE = 1024; d.PADR = 256; dm_finish(d); return d; }
constexpr Dm DMC = make_dmc();
typedef float f4q __attribute__((ext_vector_type(4)));
typedef unsigned u4q __attribute__((ext_vector_type(4)));
struct Pm {
  Dm d; int reps[24];
  const float *x, *c, *ctx, *c_ctx, *mod_w, *mod_b, *norm1_g, *w_in, *mu, *w0, *w2, *a0, *a2, *k_k, *k_a, *r_k, *g2, *ln_w, *ln_b, *q_norm, *w_uq, *kv_norm,
      *w_ukv, *w_out, *norm2_g, *router_w, *router_b, *exp_w1, *exp_b1, *exp_w2, *exp_b2, *final_g;
  float* out;
  float *modv, *modp, *ropet, *Kraw, *Gt, *O2, *Fend, *Sst, *x1, *gate;
  bf16_t *A1, *QN, *CN, *MIXb, *WinT, *WuqT, *WukvT, *WoutT, *W1T, *W2T, *H2b, *Xg, *ACTb, *Yb, *Q, *K, *V, *AL1, *AL2, *WlT, *G2T, *P, *Zt, *Rr, *Vv, *KK, *Kd, *Wd, *Bb;
  int *top_e, *cnt, *slot_pos, *pos_tok, *tile_e, *npos, *lrank, *blkcnt;
};
HD inline float sigmoidf_(float x) { return 1.f / (1.f + expf(-x)); }

template <int TM, class Epi>
HD inline void gemm_naive(const float* A, int lda, const float* Bm, int ldb, int M, int N, int K, long tid, long nth, Epi epi) {
  const long ngm = (M + TM - 1) / TM, items = ngm * N;
  for (long it = tid; it < items; it += nth) {
    const int n = (int)(it % N); const long m0 = (it / N) * TM;
    float acc[TM];
#pragma unroll
    for (int i = 0; i < TM; ++i) acc[i] = 0.f;
    const float* a[TM];
#pragma unroll
    for (int i = 0; i < TM; ++i) a[i] = A + (size_t)((m0 + i < M) ? (m0 + i) : (M - 1)) * lda;
    for (int k = 0; k < K; k += 4) {
      const float b0 = Bm[(size_t)k * ldb + n], b1 = Bm[(size_t)(k + 1) * ldb + n], b2 = Bm[(size_t)(k + 2) * ldb + n], b3 = Bm[(size_t)(k + 3) * ldb + n];
#pragma unroll
      for (int i = 0; i < TM; ++i) { acc[i] += a[i][k] * b0; acc[i] += a[i][k + 1] * b1; acc[i] += a[i][k + 2] * b2; acc[i] += a[i][k + 3] * b3; }
    }
#pragma unroll
    for (int i = 0; i < TM; ++i) if (m0 + i < M) epi(m0 + i, n, acc[i]);
  }
}

HD inline void row_pos(const Dm& d, long row, int& t, int& len, int& b, int& isctx) {
  if (row < d.BT) { b = (int)(row / d.T); t = (int)(row % d.T); len = d.T; isctx = 0; } else { const long r = row - d.BT; b = (int)(r / d.C); t = (int)(r % d.C); len = d.C; isctx = 1; }
}

HD inline void chain_step(const Dm& d, int dd, int b, int sg, size_t& row, bool& lat) {
  if (sg < d.C) { const int t = dd == 0 ? sg : d.C - 1 - sg; row = (size_t)d.BT + (size_t)b * d.C + t; lat = false; }
  else { const int s = sg - d.C; const int t = dd == 0 ? s : d.T - 1 - s; row = (size_t)b * d.T + t; lat = true; }
}
__device__ inline void ph_scan_a2(const Pm& p, int gw, int ngw, int lane, int NSEG) {
  constexpr Dm d = DMC; const int items = 2 * d.B * d.RH * 64;
  for (int it = gw; it < items; it += ngw) { const int v = it % 64, ch = it / 64; float S = 0.f; float pf[64], pn[64]; float sl, sln;
    { const float* fe = p.Fend + ((size_t)ch * NSEG) * 128 * 64; sl = fe[(size_t)v * 64 + lane];
#pragma unroll
      for (int i = 0; i < 64; ++i) pf[i] = fe[(size_t)(64 + i) * 64 + lane]; }
    for (int g = 0; g < NSEG; ++g) { p.Sst[(((size_t)ch * NSEG + g) * 64 + v) * 64 + lane] = S;
      const int gn = g + 1 < NSEG ? g + 1 : g; const float* fe = p.Fend + ((size_t)ch * NSEG + gn) * 128 * 64; sln = fe[(size_t)v * 64 + lane];
#pragma unroll
      for (int i = 0; i < 64; ++i) pn[i] = fe[(size_t)(64 + i) * 64 + lane];
      float a0 = sl, a1 = 0.f, a2 = 0.f, a3 = 0.f;
#pragma unroll
      for (int i = 0; i < 64; i += 4) { const int Sb = __builtin_bit_cast(int, S);
        a0 += __builtin_bit_cast(float, __builtin_amdgcn_readlane(Sb, i)) * pf[i]; a1 += __builtin_bit_cast(float, __builtin_amdgcn_readlane(Sb, i + 1)) * pf[i + 1];
        a2 += __builtin_bit_cast(float, __builtin_amdgcn_readlane(Sb, i + 2)) * pf[i + 2]; a3 += __builtin_bit_cast(float, __builtin_amdgcn_readlane(Sb, i + 3)) * pf[i + 3]; }
      S = (a0 + a1) + (a2 + a3); sl = sln;
#pragma unroll
      for (int i = 0; i < 64; ++i) pf[i] = pn[i]; } }
}
__device__ inline void ph_scan_a3(const Pm& p, int gw, int ngw, int lane, int NSEG) {
  constexpr Dm d = DMC; const int RW = d.RW; const int SL = (d.C + d.T) / NSEG; const size_t BTW = (size_t)d.BT * RW; constexpr int PARTS = 4;
  const int items = 2 * d.B * d.RH * NSEG * PARTS;
  for (int it = gw; it < items; it += ngw) { const int part = it % PARTS, g = (it / PARTS) % NSEG, ch = it / (PARTS * NSEG); const int h = ch % d.RH, b = (ch / d.RH) % d.B, dd = ch / (d.RH * d.B);
    const float* st = p.Sst + (((size_t)ch * NSEG + g) * 64 + lane) * 64; float S[64];
#pragma unroll
    for (int i = 0; i < 64; i += 4) { const f4q x = *(const f4q*)(st + i); S[i] = x.x; S[i + 1] = x.y; S[i + 2] = x.z; S[i + 3] = x.w; }
    const int s0 = g * SL + part * (SL / PARTS), s1 = part == PARTS - 1 ? (g + 1) * SL : s0 + SL / PARTS;
    for (int sg = s0; sg < s1; ++sg) { size_t row; bool lat; chain_step(d, dd, b, sg, row, lat); if (!lat) continue;
      const size_t o = row * RW + h * 64; const bf16_t* z = p.Zt + dd * BTW + o; u4q zx[8];
#pragma unroll
      for (int i = 0; i < 8; ++i) zx[i] = *(const u4q*)(z + 8 * i);
      float a = p.O2[dd * BTW + o + lane], a1 = 0.f, a2 = 0.f, a3 = 0.f;
#pragma unroll
      for (int i = 0; i < 8; ++i) { const u4q x = zx[i];
        a += S[8 * i] * __builtin_bit_cast(float, x.x << 16) + S[8 * i + 4] * __builtin_bit_cast(float, x.z << 16); a1 += S[8 * i + 1] * __builtin_bit_cast(float, x.x & 0xffff0000u) + S[8 * i + 5] * __builtin_bit_cast(float, x.z & 0xffff0000u);
        a2 += S[8 * i + 2] * __builtin_bit_cast(float, x.y << 16) + S[8 * i + 6] * __builtin_bit_cast(float, x.w << 16); a3 += S[8 * i + 3] * __builtin_bit_cast(float, x.y & 0xffff0000u) + S[8 * i + 7] * __builtin_bit_cast(float, x.w & 0xffff0000u); }
      a = (a + a1) + (a2 + a3);
      p.O2[dd * BTW + o + lane] = a; } }
}

namespace pg8 {
#define PG8_LAS __attribute__((address_space(3)))
typedef unsigned short bf16_t;
typedef short bf16x8 __attribute__((ext_vector_type(8)));
typedef float f32x4 __attribute__((ext_vector_type(4)));
typedef unsigned u32x4 __attribute__((ext_vector_type(4)));
constexpr int BM = 256, BK = 64, HALF = 128, HTB = HALF * BK * 2  , STAGE_BYTES = 8 * HTB, NXCD = 8, WGM = 8;

__host__ __device__ __forceinline__ int lds_byte(int r, int c) { const int st = (r >> 4) * 2 + (c >> 5), rr = r & 15, cc = c & 31, ob = rr * 64 + cc * 2; return st * 1024 + (ob ^ (((ob >> 9) & 1) << 5)); }
__host__ __device__ __forceinline__ void stage_rc(int b, int& R, int& C) { const int st = b / 1024, sb = b % 1024, swz = sb ^ (((sb >> 9) & 1) << 5); R = (st >> 1) * 16 + swz / 64; C = (st & 1) * 32 + (swz % 64) / 2; }
__host__ __device__ __forceinline__ int perm32(int rho) { const int n = rho >> 4, i = rho & 15; return 8 * (i >> 2) + 4 * n + (i & 3); }

struct Unit { int pm, pn, eb; };
struct Gemm { const bf16_t* A; const bf16_t* Bt; int M, N, K; size_t bexp; };

struct StaticOrder {
    int nM, nN, nwg, G, c; const int* tile_e;
    __host__ __device__ void init(int M, int N, int G_, int c_, const int* te = nullptr) { nM = M / BM; nN = N / BM; nwg = nM * nN; G = G_; c = c_; tile_e = te; }
    __device__ bool next(int i, Unit& u) const {
        const long L = (long)i * G + c; if (L >= nwg) return false;
        int wgid = (int)L; { const int q = nwg / NXCD, r = nwg % NXCD, xcd = wgid % NXCD, off = wgid / NXCD; wgid = (xcd < r ? xcd * (q + 1) : r * (q + 1) + (xcd - r) * q) + off; }
        const int nig = WGM * nN, gid = wgid / nig, fm = gid * WGM, gsz = (nM - fm) < WGM ? (nM - fm) : WGM;
        u.pm = fm + ((wgid % nig) % gsz); u.pn = (wgid % nig) / gsz; u.eb = tile_e ? __builtin_amdgcn_readfirstlane(__hip_atomic_load(tile_e + u.pm, __ATOMIC_RELAXED, __HIP_MEMORY_SCOPE_AGENT)) : 0; return true;
    }
    __device__ __forceinline__ void a_ready(const Unit&) const {}
    __device__ __forceinline__ void done(const Unit&) const {}
};
__device__ __forceinline__ unsigned cvt_pk_bf16(float lo, float hi) { unsigned r; asm volatile("v_cvt_pk_bf16_f32 %0, %1, %2" : "=v"(r) : "v"(lo), "v"(hi)); return r; }
typedef float f32x2 __attribute__((ext_vector_type(2)));
template <class Epi, class Sched, bool ALIGN_EPI = false, bool SP2 = false>
__device__ __forceinline__ void gemm_phase(PG8_LAS unsigned char* lds, const Gemm g, const Sched& S, const Epi& E, const int tid_in) {
    int tid_ = tid_in; asm volatile("" : "+v"(tid_));
    const int tid = tid_, wid = __builtin_amdgcn_readfirstlane(tid >> 6), lane = tid & 63, wr = wid >> 2, wc = wid & 3, fr = lane & 15, fq = lane >> 4;
    const int K = g.K, nt = K / BK;
    unsigned voffA[2], voffB[2];
#pragma unroll
    for (int i = 0; i < 2; ++i) { int R, C; stage_rc(tid * 16 + i * 8192, R, C); const int Rb = Epi::PERM ? ((R & ~31) + perm32(R & 31)) : R;
        voffA[i] = (unsigned)(R * K + C) * 2u; voffB[i] = (unsigned)(Rb * K + C) * 2u; }
    const size_t kstep = (size_t)(BK * 2);
    const size_t hstep = (size_t)HALF * K * 2;
    const size_t tstep = 2 * hstep;
    const unsigned ldsw = (unsigned)wid * 1024u;
    const int aoff = lds_byte(wr * 64 + fr, fq * 8), boff = lds_byte(wc * 32 + fr, fq * 8);
#define PG8_SA(b, h) (((b) * 2 + (h)) * HTB)
#define PG8_SB(b, h) ((4 + (b) * 2 + (h)) * HTB)
#define PG8_STAGE(bufoff, gbase, voff) do { _Pragma("unroll") for (int _i = 0; _i < 2; ++_i) \
        __builtin_amdgcn_global_load_lds((const unsigned*)((const char*)(gbase) + (voff)[_i]), (PG8_LAS unsigned*)(lds + (bufoff) + ldsw + _i * 8192), 16, 0, 0); } while (0)
#define PG8_LDA(dst, b, h) do { _Pragma("unroll") for (int m = 0; m < 4; ++m) _Pragma("unroll") for (int k = 0; k < 2; ++k) dst[m][k] = *(const PG8_LAS bf16x8*)(lds + PG8_SA(b, h) + aoff + m * 2048 + k * 1024); } while (0)
#define PG8_LDB(dst, b, h) do { _Pragma("unroll") for (int n = 0; n < 2; ++n) _Pragma("unroll") for (int k = 0; k < 2; ++k) dst[n][k] = *(const PG8_LAS bf16x8*)(lds + PG8_SB(b, h) + boff + n * 2048 + k * 1024); } while (0)
#define PG8_MMA(ai, bj, At, Bt) do { __builtin_amdgcn_s_setprio(1); _Pragma("unroll") for (int m = 0; m < 4; ++m) _Pragma("unroll") for (int n = 0; n < 2; ++n) _Pragma("unroll") for (int k = 0; k < 2; ++k) \
        acc[ai][bj][m][n] = __builtin_amdgcn_mfma_f32_16x16x32_bf16(Bt[n][k], At[m][k], acc[ai][bj][m][n], 0, 0, 0); __builtin_amdgcn_s_setprio(0); } while (0)
#define PG8_WAIT_V(n) asm volatile("s_waitcnt vmcnt(" #n ")" ::: "memory")
#define PG8_WAIT_L(n) asm volatile("s_waitcnt lgkmcnt(" #n ")" ::: "memory")
#define PG8_BAR __builtin_amdgcn_s_barrier()
#define PG8_SCHED __builtin_amdgcn_sched_barrier(0)
    Unit cur, nxt; int ui = 0;
    if (!S.next(0, cur)) return;
    f32x4 acc[2][2][4][2];
#pragma unroll
    for (int a = 0; a < 2; ++a)
#pragma unroll
        for (int b = 0; b < 2; ++b)
#pragma unroll
            for (int m = 0; m < 4; ++m)
#pragma unroll
                for (int n = 0; n < 2; ++n) acc[a][b][m][n] = (f32x4){0.f, 0.f, 0.f, 0.f};
    bf16x8 At[4][2], B0[2][2], B1[2][2];
    const char* cA = (const char*)g.A + (size_t)cur.pm * tstep; const char* cB = (const char*)g.Bt + (size_t)cur.eb * g.bexp + (size_t)cur.pn * tstep;
    S.a_ready(cur);
    if constexpr (SP2) {
        PG8_STAGE(PG8_SB(0, 0), cB, voffB); PG8_STAGE(PG8_SB(0, 1), cB + hstep, voffB); PG8_STAGE(PG8_SA(0, 0), cA, voffA); PG8_STAGE(PG8_SA(0, 1), cA + hstep, voffA);
        if (wr == 1) PG8_BAR;
        PG8_WAIT_V(2); PG8_BAR;
        PG8_STAGE(PG8_SB(1, 0), cB + kstep, voffB); PG8_STAGE(PG8_SA(1, 0), cA + kstep, voffA); PG8_STAGE(PG8_SB(1, 1), cB + hstep + kstep, voffB);
        PG8_WAIT_V(6); PG8_BAR;
    } else {
        PG8_STAGE(PG8_SB(0, 0), cB, voffB); PG8_STAGE(PG8_SA(0, 0), cA, voffA); PG8_STAGE(PG8_SB(0, 1), cB + hstep, voffB); PG8_STAGE(PG8_SA(0, 1), cA + hstep, voffA);
        if (wr == 1) PG8_BAR;
        PG8_WAIT_V(4); PG8_BAR;
        PG8_STAGE(PG8_SB(1, 0), cB + kstep, voffB); PG8_STAGE(PG8_SA(1, 0), cA + kstep, voffA); PG8_STAGE(PG8_SB(1, 1), cB + hstep + kstep, voffB);
        PG8_WAIT_V(6); PG8_BAR;
    }
    for (;;) {
        const bool has_next = S.next(ui + 1, nxt);
        const char* nA = has_next ? (const char*)g.A + (size_t)nxt.pm * tstep : cA; const char* nB = has_next ? (const char*)g.Bt + (size_t)nxt.eb * g.bexp + (size_t)nxt.pn * tstep : cB;
        for (int t = 0; t < nt; t += 2) {
            const bool last = (t == nt - 2);
            const char* a1 = cA + (size_t)(t + 1) * kstep;
            const char* a2 = last ? nA : cA + (size_t)(t + 2) * kstep; const char* b2 = last ? nB : cB + (size_t)(t + 2) * kstep;
            const char* a3 = a2 + kstep; const char* b3 = b2 + kstep;
            if (last && has_next) S.a_ready(nxt);
            if constexpr (SP2) {
            PG8_LDB(B0, 0, 0); PG8_LDB(B1, 0, 1); PG8_SCHED; PG8_LDA(At, 0, 0); PG8_STAGE(PG8_SA(1, 1), a1 + hstep, voffA);
            PG8_WAIT_V(8); PG8_WAIT_L(0); PG8_BAR; PG8_MMA(0, 0, At, B0); PG8_MMA(0, 1, At, B1); PG8_BAR; PG8_SCHED;
            PG8_LDA(At, 0, 1); PG8_STAGE(PG8_SB(0, 0), b2, voffB); PG8_STAGE(PG8_SB(0, 1), b2 + hstep, voffB); PG8_STAGE(PG8_SA(0, 0), a2, voffA);
            PG8_WAIT_V(8); PG8_WAIT_L(0); PG8_BAR; PG8_MMA(1, 0, At, B0); PG8_MMA(1, 1, At, B1); PG8_BAR; PG8_SCHED;
            PG8_LDB(B0, 1, 0); PG8_LDB(B1, 1, 1); PG8_SCHED; PG8_LDA(At, 1, 0); PG8_STAGE(PG8_SA(0, 1), a2 + hstep, voffA);
            PG8_WAIT_V(8); PG8_WAIT_L(0); PG8_BAR; PG8_MMA(0, 0, At, B0); PG8_MMA(0, 1, At, B1); PG8_BAR; PG8_SCHED;
            PG8_LDA(At, 1, 1); PG8_STAGE(PG8_SB(1, 0), b3, voffB); PG8_STAGE(PG8_SB(1, 1), b3 + hstep, voffB); PG8_STAGE(PG8_SA(1, 0), a3, voffA);
            PG8_WAIT_V(8); PG8_WAIT_L(0); PG8_BAR; PG8_MMA(1, 0, At, B0); PG8_MMA(1, 1, At, B1); PG8_BAR; PG8_SCHED;
            } else {
            PG8_LDB(B0, 0, 0); PG8_SCHED; PG8_LDA(At, 0, 0); PG8_STAGE(PG8_SA(1, 1), a1 + hstep, voffA);
            PG8_WAIT_L(8); PG8_BAR; PG8_WAIT_L(0); PG8_MMA(0, 0, At, B0); PG8_BAR; PG8_SCHED;
            PG8_LDB(B1, 0, 1); PG8_STAGE(PG8_SB(0, 0), b2, voffB);
            PG8_BAR; PG8_WAIT_L(0); PG8_MMA(0, 1, At, B1); PG8_BAR;
            PG8_LDA(At, 0, 1); PG8_STAGE(PG8_SA(0, 0), a2, voffA);
            PG8_BAR; PG8_WAIT_L(0); PG8_MMA(1, 0, At, B0); PG8_BAR; PG8_SCHED;
            PG8_STAGE(PG8_SB(0, 1), b2 + hstep, voffB);
            PG8_WAIT_V(6); PG8_BAR; PG8_MMA(1, 1, At, B1); PG8_BAR;
            PG8_LDB(B0, 1, 0); PG8_SCHED; PG8_LDA(At, 1, 0); PG8_STAGE(PG8_SA(0, 1), a2 + hstep, voffA);
            PG8_WAIT_L(8); PG8_BAR; PG8_WAIT_L(0); PG8_MMA(0, 0, At, B0); PG8_BAR; PG8_SCHED;
            PG8_LDB(B1, 1, 1); PG8_STAGE(PG8_SB(1, 0), b3, voffB);
            PG8_BAR; PG8_WAIT_L(0); PG8_MMA(0, 1, At, B1); PG8_BAR;
            PG8_LDA(At, 1, 1); PG8_STAGE(PG8_SA(1, 0), a3, voffA);
            PG8_BAR; PG8_WAIT_L(0); PG8_MMA(1, 0, At, B0); PG8_BAR; PG8_SCHED;
            PG8_STAGE(PG8_SB(1, 1), b3 + hstep, voffB);
            PG8_WAIT_V(6); PG8_BAR; PG8_MMA(1, 1, At, B1); PG8_BAR;
            }
        }
        if constexpr (ALIGN_EPI) { if (wr == 0) PG8_BAR; }
        if constexpr (!Epi::AFTER_DRAIN) { E(acc, cur, wr, wc, fr, fq); S.done(cur); }
        if (!has_next) break;
#pragma unroll
        for (int a = 0; a < 2; ++a)
#pragma unroll
            for (int b = 0; b < 2; ++b)
#pragma unroll
                for (int m = 0; m < 4; ++m)
#pragma unroll
                    for (int n = 0; n < 2; ++n) acc[a][b][m][n] = (f32x4){0.f, 0.f, 0.f, 0.f};
        cur = nxt; cA = nA; cB = nB; ++ui;
        if constexpr (ALIGN_EPI) { if (wr == 1) PG8_BAR; }
    }
    PG8_WAIT_V(0);
    if constexpr (!ALIGN_EPI) { if (wr == 0) PG8_BAR; }
    PG8_BAR;
    if constexpr (Epi::AFTER_DRAIN) { E.fused(acc, cur, wr, wc, fr, fq, lds, wid, lane); S.done(cur); }
#undef PG8_SA
#undef PG8_SB
#undef PG8_STAGE
#undef PG8_LDA
#undef PG8_LDB
#undef PG8_MMA
#undef PG8_WAIT_V
#undef PG8_WAIT_L
#undef PG8_BAR
#undef PG8_SCHED
}
}

#define XB_TMO      128
#define XB_XCNT(j)  (256  + 64 * (j))
#define XB_XSUB(j)  (1280 + 64 * (j))
#define XB_XGEN(j)  (2304 + 64 * (j))
#define XB_TOP      3328
#define XB_TOPGEN   3392
#define XCD_BAR_WORDS 3456
#define XB_SPIN_CAP (1u << 22)
#define LAS __attribute__((address_space(3)))

__device__ __forceinline__ unsigned xb_ld(unsigned* p)              { return __hip_atomic_load(p, __ATOMIC_RELAXED, __HIP_MEMORY_SCOPE_AGENT); }
__device__ __forceinline__ unsigned xb_add(unsigned* p, unsigned v) { return __hip_atomic_fetch_add(p, v, __ATOMIC_RELAXED, __HIP_MEMORY_SCOPE_AGENT); }
__device__ __forceinline__ unsigned xb_xcc_id() { return (unsigned)__builtin_amdgcn_s_getreg((3 << 11) | 20) & 0xFu; }
#define XB_SPIN(cond, bar) do { unsigned _sp = 0; while (cond) { __builtin_amdgcn_s_sleep(1); \
    if ((++_sp & 255u) == 0u) { if (xb_ld(&(bar)[XB_TMO])) break; if (_sp > XB_SPIN_CAP) { atomicAdd(&(bar)[XB_TMO], 1u); break; } } } } while (0)

struct XcdBarrier {
    unsigned* bar; unsigned x; int wv;
    volatile LAS unsigned* st;
};

__device__ __forceinline__ XcdBarrier xcd_barrier_post(unsigned* bar, volatile LAS unsigned* st) {
    XcdBarrier b; b.bar = bar; b.x = xb_xcc_id(); b.st = st; b.wv = __builtin_amdgcn_readfirstlane((int)threadIdx.x >> 6);
    if (threadIdx.x == 0) (void)xb_add(&bar[XB_XCNT(b.x)], 1u);
    return b;
}
__device__ __forceinline__ void xcd_barrier_complete(unsigned* bar, unsigned x, unsigned& nloc, unsigned& nx) {
    const unsigned G = gridDim.x * gridDim.y * gridDim.z;
    unsigned sum, cnt, mine, sp = 0u;
    for (;;) {
        sum = 0u; cnt = 0u; mine = 0u;
#pragma unroll
        for (unsigned j = 0; j < 16; ++j) { const unsigned c = xb_ld(&bar[XB_XCNT(j)]); sum += c; cnt += (c > 0u) ? 1u : 0u; mine = (j == x) ? c : mine; }
        if (sum == G) break;
        __builtin_amdgcn_s_sleep(1);
        if ((++sp & 255u) == 0u) { if (xb_ld(&bar[XB_TMO])) break; if (sp > XB_SPIN_CAP) { atomicAdd(&bar[XB_TMO], 1u); break; } }
    }
    nloc = mine > 0u ? mine : 1u; nx = cnt > 0u ? cnt : 1u;
}

__device__ __forceinline__ void xcd_barrier(const XcdBarrier& b) {
    asm volatile("s_waitcnt vmcnt(0)" ::: "memory");
    __syncthreads();
    int ln_; asm volatile("v_mbcnt_lo_u32_b32 %0, -1, 0\n\tv_mbcnt_hi_u32_b32 %0, -1, %0" : "=v"(ln_));
    if (b.wv == 0 && ln_ == 0) {
        unsigned* bar = b.bar;
        __builtin_amdgcn_s_waitcnt(0);
        unsigned nloc = b.st[0], nx = b.st[1];
        if (nloc == 0u) { xcd_barrier_complete(bar, b.x, nloc, nx); b.st[0] = nloc; b.st[1] = nx; }
        const unsigned old = xb_add(&bar[XB_XSUB(b.x)], 1u);
        const unsigned gen = old / nloc;
        if (old + 1u == (gen + 1u) * nloc) {
            __builtin_amdgcn_fence(__ATOMIC_RELEASE, "agent");
            asm volatile("s_waitcnt vmcnt(0)" ::: "memory");
            const unsigned og = xb_add(&bar[XB_TOP], 1u);
            const unsigned tg = og / nx;
            if (og + 1u == (tg + 1u) * nx) xb_add(&bar[XB_TOPGEN], 1u);
            else XB_SPIN(xb_ld(&bar[XB_TOPGEN]) == tg, bar);
            __builtin_amdgcn_fence(__ATOMIC_ACQUIRE, "agent");
            xb_add(&bar[XB_XGEN(b.x)], 1u);
            asm volatile("s_waitcnt vmcnt(0)" ::: "memory");
        } else {
            XB_SPIN(xb_ld(&bar[XB_XGEN(b.x)]) == gen, bar);
            __builtin_amdgcn_fence(__ATOMIC_ACQUIRE, "agent");
            asm volatile("s_waitcnt vmcnt(0)" ::: "memory");
        }
    }
    __syncthreads();
}


namespace attn {
using bf16 = unsigned short;
constexpr int DQK = 192, DV = 128, NW = 8, QBLK = 32, KVBLK = 64;
constexpr float SCALE = 0.07216878364870322f;
constexpr float THR = 8.f;
constexpr int SDEPTH = 1;
constexpr int LDQ = DQK, LDK = DQK, LDV = DV, LDO = 1024;
constexpr size_t SHM_V = KVBLK * DV * 2, SHM_K = KVBLK * DQK * 2, SHM_ATTN = 2 * SHM_V + 2 * SHM_K + NW * 64 * 4;
using bf16x8 = __attribute__((ext_vector_type(8))) short;
using s16x4  = __attribute__((ext_vector_type(4))) short;
using f32x16 = __attribute__((ext_vector_type(16))) float;
using f32x8  = __attribute__((ext_vector_type(8))) float;
using u32x4  = __attribute__((ext_vector_type(4))) unsigned;
#define KSWZ(row, colB) ((row) * 384 + ((colB) ^ (((row) & 7) << 4)))
#define SBAR() __builtin_amdgcn_sched_barrier(0)
__device__ __forceinline__ int crow(int r, int hi) { return (r & 3) + 8 * (r >> 2) + 4 * hi; }
__device__ __forceinline__ unsigned cvtpk(float lo, float hi) {
  unsigned r; asm volatile("v_cvt_pk_bf16_f32 %0, %1, %2" : "=v"(r) : "v"(lo), "v"(hi)); return r;
}
struct St { using T = bf16x8;
  __device__ static __forceinline__ T ld8(const bf16* p) { return *reinterpret_cast<const bf16x8*>(p); }
  __device__ static __forceinline__ bf16x8 tobf(T x) { return x; } };
__device__ __forceinline__ void partialSM(f32x16& p0, f32x16& p1, float& m_reg, float& mn, float& alpha) {
  constexpr float C = SCALE * 1.4426950408889634f;
  float pmax = p0[0]; for (int r = 1; r < 16; ++r) pmax = fmaxf(pmax, p0[r]); for (int r = 0; r < 16; ++r) pmax = fmaxf(pmax, p1[r]);
  { auto rr = __builtin_amdgcn_permlane32_swap(__float_as_uint(pmax), __float_as_uint(pmax), false, false);
    pmax = fmaxf(__uint_as_float(rr[0]), __uint_as_float(rr[1])); }
  if (__builtin_expect(__all(pmax - m_reg <= THR / SCALE), 1)) { mn = m_reg; alpha = 1.f; }
  else { mn = fmaxf(m_reg, pmax); alpha = __builtin_amdgcn_exp2f((m_reg - mn) * C); m_reg = mn; }
  float mnC = -mn * C;
  for (int r = 0; r < 16; ++r) p0[r] = fmaf(p0[r], C, mnC); for (int r = 0; r < 16; ++r) p1[r] = fmaf(p1[r], C, mnC);
  for (int r = 0; r < 16; ++r) p0[r] = __builtin_amdgcn_exp2f(p0[r]);
}
__device__ __forceinline__ void finishSM(f32x16& p0, f32x16& p1, float alpha, float& l_reg, bf16x8& pa0, bf16x8& pa1, bf16x8& pa2, bf16x8& pa3) {
  for (int r = 0; r < 16; ++r) p1[r] = __builtin_amdgcn_exp2f(p1[r]);
  float ps = 0; for (int r = 0; r < 16; ++r) ps += p0[r]; for (int r = 0; r < 16; ++r) ps += p1[r];
  { auto rr = __builtin_amdgcn_permlane32_swap(__float_as_uint(ps), __float_as_uint(ps), false, false);
    ps = __uint_as_float(rr[0]) + __uint_as_float(rr[1]); }
  l_reg = l_reg * alpha + ps;
#define PK4(P, BASE, OUT) do { unsigned a0 = cvtpk(P[BASE + 0], P[BASE + 1]), a1 = cvtpk(P[BASE + 2], P[BASE + 3]);   \
    unsigned b0 = cvtpk(P[BASE + 4], P[BASE + 5]), b1 = cvtpk(P[BASE + 6], P[BASE + 7]);                              \
    auto r0 = __builtin_amdgcn_permlane32_swap(a0, b0, false, false); auto r1 = __builtin_amdgcn_permlane32_swap(a1, b1, false, false); \
    u32x4 w = {r0[0], r1[0], r0[1], r1[1]}; OUT = *reinterpret_cast<bf16x8*>(&w); } while (0)
  PK4(p0, 0, pa0); PK4(p0, 8, pa1); PK4(p1, 0, pa2); PK4(p1, 8, pa3);
#undef PK4
}
__device__ __forceinline__ void qkt(f32x16& p0, f32x16& p1, const bf16* Ks, const bf16x8* qr, int r32, int hi) {
  p0 = f32x16{}; p1 = f32x16{};
  for (int d0 = 0; d0 < 12; ++d0) { int cb = (d0 * 16 + hi * 8) * 2;
    bf16x8 b0 = *reinterpret_cast<const bf16x8*>((const char*)Ks + KSWZ(r32, cb));
    bf16x8 b1 = *reinterpret_cast<const bf16x8*>((const char*)Ks + KSWZ(32 + r32, cb));
    p0 = __builtin_amdgcn_mfma_f32_32x32x16_bf16(b0, qr[d0], p0, 0, 0, 0);
    p1 = __builtin_amdgcn_mfma_f32_32x32x16_bf16(b1, qr[d0], p1, 0, 0, 0); }
}
__device__ __forceinline__ int v_st(int k, int c) { const int kk = (k & ~0xC) | ((k & 4) << 1) | ((k & 8) >> 1); return ((kk >> 3) * 4 + (c >> 5)) * 512 + ((kk & 7) * 32 + (c & 31)) * 2; }
__device__ __forceinline__ int v_rd_base(int lane) { return ((lane & 3) << 3) | (((lane >> 2) & 3) << 6) | (((lane >> 4) & 1) << 5) | (((lane >> 5) & 1) << 8); }
constexpr int v_rd_off(int d0, int ks, int half) { return d0 * 512 + ks * 4096 + half * 2048; }
template <int OFF> __device__ __forceinline__ s16x4 tr_read(int vb) {
  s16x4 r; asm volatile("ds_read_b64_tr_b16 %0, %1 offset:%2" : "=&v"(r) : "v"(vb), "i"(OFF) : "memory"); return r;
}
template <int D0> __device__ __forceinline__ void pv_one(f32x16& od, int vb, bf16x8 pa0, bf16x8 pa1, bf16x8 pa2, bf16x8 pa3) {
  const s16x4 l0 = tr_read<v_rd_off(D0, 0, 0)>(vb), h0 = tr_read<v_rd_off(D0, 0, 1)>(vb), l1 = tr_read<v_rd_off(D0, 1, 0)>(vb), h1 = tr_read<v_rd_off(D0, 1, 1)>(vb);
  const s16x4 l2 = tr_read<v_rd_off(D0, 2, 0)>(vb), h2 = tr_read<v_rd_off(D0, 2, 1)>(vb), l3 = tr_read<v_rd_off(D0, 3, 0)>(vb), h3 = tr_read<v_rd_off(D0, 3, 1)>(vb);
  asm volatile("s_waitcnt lgkmcnt(0)" ::: "memory"); SBAR();
#define PK(L, H) (bf16x8){L[0], L[1], L[2], L[3], H[0], H[1], H[2], H[3]}
  od = __builtin_amdgcn_mfma_f32_32x32x16_bf16(pa0, PK(l0, h0), od, 0, 0, 0);
  od = __builtin_amdgcn_mfma_f32_32x32x16_bf16(pa1, PK(l1, h1), od, 0, 0, 0);
  od = __builtin_amdgcn_mfma_f32_32x32x16_bf16(pa2, PK(l2, h2), od, 0, 0, 0);
  od = __builtin_amdgcn_mfma_f32_32x32x16_bf16(pa3, PK(l3, h3), od, 0, 0, 0);
#undef PK
}
__device__ __forceinline__ void pv_d0(f32x16* o, int vb, bf16x8 pa0, bf16x8 pa1, bf16x8 pa2, bf16x8 pa3) {
  pv_one<0>(o[0], vb, pa0, pa1, pa2, pa3); pv_one<1>(o[1], vb, pa0, pa1, pa2, pa3); pv_one<2>(o[2], vb, pa0, pa1, pa2, pa3); pv_one<3>(o[3], vb, pa0, pa1, pa2, pa3);
}

__device__ __forceinline__ void attn_dense_body(const bf16* __restrict__ Qb, const bf16* __restrict__ Kh, const bf16* __restrict__ Vh,
                                                bf16* __restrict__ Ob, int seq, char* lds, const int tid_in) {
  int tid_ = tid_in; asm volatile("" : "+v"(tid_));
  const int tid = tid_, wid = tid >> 6, lane = tid & 63, r32 = lane & 31, hi = lane >> 5;
  bf16* V_lds = (bf16*)lds; bf16* K_lds = (bf16*)(lds + 2 * SHM_V);
  float* ws = (float*)(lds + 2 * SHM_V + 2 * SHM_K) + wid * 64; float* li_l = ws; float* al_l = ws + 32;
  float m_reg = -1e30f, l_reg = 0; f32x16 o[4] = {}; bf16x8 qr[12];
  const bf16* Qw = Qb + (long)(wid * QBLK + r32) * LDQ + hi * 8;
#pragma unroll
  for (int d0 = 0; d0 < 12; ++d0) qr[d0] = St::ld8(Qw + d0 * 16);
  const int sr = tid >> 4, sc = (tid & 15) * 8, vst0 = v_st(sr, sc), vst1 = v_st(32 + sr, sc);
  const int kr0 = tid / 24, kc0 = (tid % 24) * 8, kr1 = (tid + 512) / 24, kc1 = ((tid + 512) % 24) * 8, kr2 = (tid + 1024) / 24, kc2 = ((tid + 1024) % 24) * 8;
  const int vb0 = (int)(uintptr_t)V_lds + v_rd_base(lane);
  struct { St::T vs0, vs1, ks0, ks1, ks2; } sr_[SDEPTH];
#define SLOAD(i, k0) do { sr_[i].vs0 = St::ld8(&Vh[(long)((k0) + sr) * LDV + sc]); sr_[i].vs1 = St::ld8(&Vh[(long)((k0) + 32 + sr) * LDV + sc]); \
    sr_[i].ks0 = St::ld8(&Kh[(long)((k0) + kr0) * LDK + kc0]); sr_[i].ks1 = St::ld8(&Kh[(long)((k0) + kr1) * LDK + kc1]); sr_[i].ks2 = St::ld8(&Kh[(long)((k0) + kr2) * LDK + kc2]); } while (0)
#define SWRITE(b, i) do { *(bf16x8*)((char*)V_lds + (b) * SHM_V + vst0) = St::tobf(sr_[i].vs0);          \
    *(bf16x8*)((char*)V_lds + (b) * SHM_V + vst1) = St::tobf(sr_[i].vs1);                                \
    *(bf16x8*)((char*)K_lds + (b) * SHM_K + KSWZ(kr0, kc0 * 2)) = St::tobf(sr_[i].ks0);                  \
    *(bf16x8*)((char*)K_lds + (b) * SHM_K + KSWZ(kr1, kc1 * 2)) = St::tobf(sr_[i].ks1);                  \
    *(bf16x8*)((char*)K_lds + (b) * SHM_K + KSWZ(kr2, kc2 * 2)) = St::tobf(sr_[i].ks2); } while (0)
#define SWAIT() do { if constexpr (SDEPTH == 2) asm volatile("s_waitcnt vmcnt(5)" ::: "memory"); else asm volatile("s_waitcnt vmcnt(0)" ::: "memory"); } while (0)
#define RESC(a) do { if (__any((a) < 1.f)) { if (hi == 0) al_l[r32] = (a); asm volatile("s_waitcnt lgkmcnt(0)" ::: "memory"); \
    for (int d = 0; d < 4; ++d) for (int r = 0; r < 16; ++r) o[d][r] *= al_l[crow(r, hi)]; } } while (0)
  f32x16 p0, p1; float mn, al; bf16x8 pa0, pa1, pa2, pa3; const int NT = seq / KVBLK;
  SLOAD(0, 0); asm volatile("s_waitcnt vmcnt(0)" ::: "memory"); SWRITE(0, 0); __syncthreads();
  for (int j = 0; j < NT; ++j) {
    const int cur = j & 1; const bool more = j + 1 < NT;
    if (more) SLOAD(0, (j + 1) * KVBLK);
    SBAR(); qkt(p0, p1, (bf16*)((char*)K_lds + cur * SHM_K), qr, r32, hi);
    partialSM(p0, p1, m_reg, mn, al); RESC(al);
    finishSM(p0, p1, al, l_reg, pa0, pa1, pa2, pa3); SBAR();
    pv_d0(o, vb0 + cur * (int)SHM_V, pa0, pa1, pa2, pa3);
    if (more) { SWAIT(); SWRITE(cur ^ 1, 0); }
    __syncthreads();
  }
  if (hi == 0) li_l[r32] = l_reg; asm volatile("s_waitcnt lgkmcnt(0)" ::: "memory");
  float rli[16];
#pragma unroll
  for (int r = 0; r < 16; ++r) rli[r] = __builtin_amdgcn_rcpf(li_l[crow(r, hi)]);
  bf16* Ow = Ob + (long)(wid * QBLK) * LDO;
#pragma unroll
  for (int r = 0; r < 16; ++r) { int orow = crow(r, hi);
    for (int d0 = 0; d0 < 4; ++d0) Ow[(long)orow * LDO + d0 * 32 + r32] = f2bf(o[d0][r] * rli[r]); }
#undef SLOAD
#undef SWRITE
#undef SWAIT
#undef RESC
}

}


constexpr int NWAVES = 8, NTHREADS = 512;
constexpr int RING_BYTES = 157696, MISC_OFF = RING_BYTES + 320, LDS_BYTES = 163840;
#define GAS __attribute__((address_space(1)))
typedef unsigned v4u __attribute__((ext_vector_type(4)));
typedef float f32x4 __attribute__((ext_vector_type(4)));
#define LDS_WAIT() asm volatile("s_waitcnt lgkmcnt(0)" ::: "memory")
typedef float f4 __attribute__((ext_vector_type(4)));
typedef unsigned u2 __attribute__((ext_vector_type(2)));
typedef unsigned u4 __attribute__((ext_vector_type(4)));
__device__ __forceinline__ float wave_sum(float v) {
#pragma unroll
  for (int o = 1; o < 64; o <<= 1) v += __shfl_xor(v, o);
  return v;
}
__device__ __forceinline__ unsigned pkbf(float lo, float hi) { return (unsigned)f2bf(lo) | ((unsigned)f2bf(hi) << 16); }

constexpr int MOD_KS = 16, MOD_CG = 16, MOD_COLS = 384;
__device__ __forceinline__ void f_mod_partial(const Pm& p, int tidb) {
  const int N6 = 6 * 1024;
  for (int u = blockIdx.x; u < MOD_KS * MOD_CG; u += gridDim.x) { const int ks = u / MOD_CG, cg = u % MOD_CG;
    if (tidb < MOD_COLS) { const int n = cg * MOD_COLS + tidb; float a0 = 0.f, a1 = 0.f, a2 = 0.f;
      for (int k = ks * 64; k < ks * 64 + 64; ++k) { const float w = p.mod_w[(size_t)k * N6 + n]; const float c0 = p.c[k], c1 = p.c[1024 + k], c2 = p.c_ctx[k];
        a0 += c0 * sigmoidf_(c0) * w; a1 += c1 * sigmoidf_(c1) * w; a2 += c2 * sigmoidf_(c2) * w; }
      float* o = p.modp + (size_t)ks * 3 * N6 + n; o[0] = a0; o[N6] = a1; o[2 * N6] = a2; } }
}
__device__ __forceinline__ void f_mod_reduce(const Pm& p, LAS float* modL, int tidb) {
  const int N6 = 6 * 1024;
  for (int i = tidb; i < 3 * 2048; i += NTHREADS) { const int v = i / 2048, n = i % 2048; float a = p.mod_b[n];
#pragma unroll
    for (int ks = 0; ks < MOD_KS; ++ks) a += p.modp[((size_t)ks * 3 + v) * N6 + n];
    modL[i] = a; }
  const int per = (3 * N6 + gridDim.x - 1) / gridDim.x;
  for (int i = blockIdx.x * per + tidb; i < (int)(blockIdx.x + 1) * per && i < 3 * N6; i += NTHREADS) { const int v = i / N6, n = i % N6; float a = p.mod_b[n];
#pragma unroll
    for (int ks = 0; ks < MOD_KS; ++ks) a += p.modp[((size_t)ks * 3 + v) * N6 + n];
    p.modv[i] = a; }
  __syncthreads();
}
__device__ __forceinline__ void f_norm1(const Pm& p, const LAS float* modL, int gw, int ngw, int lane) {
  constexpr Dm d = DMC;
  for (int row0 = gw; row0 < d.NR; row0 += 2 * ngw) { f4 xv[2][4]; const int nr = row0 + ngw < d.NR ? 2 : 1;
#pragma unroll
    for (int q = 0; q < 2; ++q) if (q < nr) { const int row = row0 + q * ngw; const float* src = row < d.BT ? p.x + (size_t)row * 1024 : p.ctx + (size_t)(row - d.BT) * 1024;
#pragma unroll
      for (int j = 0; j < 4; ++j) xv[q][j] = *(const f4*)(src + 4 * lane + 256 * j); }
#pragma unroll
    for (int q = 0; q < 2; ++q) if (q < nr) { const int row = row0 + q * ngw; const int v = row < d.BT ? row / d.T : 2; float ss = 0.f;
#pragma unroll
      for (int j = 0; j < 4; ++j) ss += xv[q][j].x * xv[q][j].x + xv[q][j].y * xv[q][j].y + xv[q][j].z * xv[q][j].z + xv[q][j].w * xv[q][j].w;
      const float rs = 1.f / sqrtf(wave_sum(ss) * (1.f / 1024.f) + 1e-6f);
#pragma unroll
      for (int j = 0; j < 4; ++j) { const int k = 4 * lane + 256 * j; const f4 g = *(const f4*)(p.norm1_g + k); const LAS float* sh = modL + v * 2048 + k; const LAS float* sc = sh + 1024; const f4 x = xv[q][j];
        const float o0 = x.x * rs * g.x * (1.f + sc[0]) + sh[0], o1 = x.y * rs * g.y * (1.f + sc[1]) + sh[1], o2 = x.z * rs * g.z * (1.f + sc[2]) + sh[2], o3 = x.w * rs * g.w * (1.f + sc[3]) + sh[3];
        u2 w; w.x = pkbf(o0, o1); w.y = pkbf(o2, o3); *(u2*)(p.A1 + (size_t)row * 1024 + k) = w; } }
  }
}
__device__ __forceinline__ void f_rope_table(const Pm& p, long tid, long nth) {
  for (long i = tid; i < (long)192 * 16; i += nth) { const int pq = (int)(i >> 4), f = (int)(i & 15);
    const float freq = expf(-(float)f * (1.f / 16.f) * 9.210340371976184f), pos = pq < 128 ? (float)pq : (float)(pq - 128), ang = pos * freq;
    p.ropet[2 * i] = cosf(ang); p.ropet[2 * i + 1] = sinf(ang); }
}
#define ROPE_IDX(t, a, f) ((((a) == 0 ? ((t) >> 6) : 128 + ((t) & 63)) * 16 + (f)) * 2)
__device__ __forceinline__ void f_mla_a(const Pm& p, int gw, int ngw, int lane) {
  constexpr Dm d = DMC; const int NK = d.C + d.T;
  for (int row = gw; row < d.NR; row += ngw) {
    const bf16_t* pm = p.P + (size_t)row * d.IN + d.RC; int t, len, b, ic; row_pos(d, row, t, len, b, ic);
    const u2 qw = *(const u2*)(pm + 4 * lane); const unsigned cw = *(const unsigned*)(pm + 256 + 2 * lane);
    const f4 q = {__builtin_bit_cast(float, qw.x << 16), __builtin_bit_cast(float, qw.x & 0xffff0000u), __builtin_bit_cast(float, qw.y << 16), __builtin_bit_cast(float, qw.y & 0xffff0000u)};
    const float c0 = __builtin_bit_cast(float, cw << 16), c1 = __builtin_bit_cast(float, cw & 0xffff0000u); const float kr = __builtin_bit_cast(float, (unsigned)pm[384 + lane] << 16);
    const float qs = wave_sum(q.x * q.x + q.y * q.y + q.z * q.z + q.w * q.w), cs2 = wave_sum(c0 * c0 + c1 * c1);
    if (!ic) { const float rs = 1.f / sqrtf(qs * (1.f / 256.f) + 1e-6f); const f4 g = *(const f4*)(p.q_norm + 4 * lane);
      u2 w; w.x = pkbf(q.x * rs * g.x, q.y * rs * g.y); w.y = pkbf(q.z * rs * g.z, q.w * rs * g.w); *(u2*)(p.QN + (size_t)row * 256 + 4 * lane) = w; }
    { const float rs = 1.f / sqrtf(cs2 * (1.f / 128.f) + 1e-6f); *(unsigned*)(p.CN + (size_t)row * 128 + 2 * lane) = pkbf(c0 * rs * p.kv_norm[2 * lane], c1 * rs * p.kv_norm[2 * lane + 1]); }
    const float partner = __shfl_xor(kr, 16); float cs = 1.f, sn = 0.f;
    if (!ic) { const float* ct = p.ropet + ROPE_IDX(t, lane >> 5, lane & 15); cs = ct[0]; sn = ct[1]; }
    const float o = (lane & 16) ? kr * cs + partner * sn : kr * cs - partner * sn; const bf16_t ob = f2bf(o); const int key = ic ? t : d.C + t;
#pragma unroll
    for (int h = 0; h < 4; ++h) p.K[((size_t)(b * 4 + h) * NK + key) * 192 + 128 + lane] = ob;
  }
}
__device__ __forceinline__ void f_readout(const Pm& p, int gw, int ngw, int lane) {
  constexpr Dm d = DMC; const size_t NRW = (size_t)d.NR * 512, BTW = (size_t)d.BT * 512;
  for (int row = gw; row < d.BT; row += ngw) { const size_t o = (size_t)row * 512 + 8 * lane;
    float ov[8], rv[8], kv[8], vv[8], gv[8];
#pragma unroll
    for (int q = 0; q < 2; ++q) { const f4 a = *(const f4*)(p.O2 + o + 4 * q), b2 = *(const f4*)(p.O2 + BTW + o + 4 * q), g = *(const f4*)(p.Gt + o + 4 * q);
      const u2 r = *(const u2*)(p.Rr + o + 4 * q), k0 = *(const u2*)(p.Kd + o + 4 * q), k1 = *(const u2*)(p.Kd + NRW + o + 4 * q), v = *(const u2*)(p.Vv + o + 4 * q);
#define BL(u) __builtin_bit_cast(float, (u) << 16)
#define BH(u) __builtin_bit_cast(float, (u) & 0xffff0000u)
      const float rr[4] = {BL(r.x), BH(r.x), BL(r.y), BH(r.y)}, ka[4] = {BL(k0.x), BH(k0.x), BL(k0.y), BH(k0.y)}, kb[4] = {BL(k1.x), BH(k1.x), BL(k1.y), BH(k1.y)}, vq[4] = {BL(v.x), BH(v.x), BL(v.y), BH(v.y)};
#pragma unroll
      for (int e = 0; e < 4; ++e) { ov[4 * q + e] = a[e] + b2[e]; rv[4 * q + e] = rr[e]; kv[4 * q + e] = ka[e] + kb[e]; vv[4 * q + e] = vq[e]; gv[4 * q + e] = g[e]; } }
    float s = 0.f, bon = 0.f;
#pragma unroll
    for (int e = 0; e < 8; ++e) { s += ov[e]; bon += rv[e] * kv[e] * p.r_k[8 * lane + e]; }
#pragma unroll
    for (int m = 1; m < 8; m <<= 1) { s += __shfl_xor(s, m); bon += __shfl_xor(bon, m); }
    const float mean = s * (1.f / 64.f); float var = 0.f;
#pragma unroll
    for (int e = 0; e < 8; ++e) { const float q = ov[e] - mean; var += q * q; }
#pragma unroll
    for (int m = 1; m < 8; m <<= 1) var += __shfl_xor(var, m);
    const float rs = 1.f / sqrtf(var * (1.f / 64.f) + 64e-5f); float y[8];
#pragma unroll
    for (int e = 0; e < 8; ++e) y[e] = ((ov[e] - mean) * rs * p.ln_w[8 * lane + e] + p.ln_b[8 * lane + e] + bon * vv[e]) * gv[e];
    u4 w; w.x = pkbf(y[0], y[1]); w.y = pkbf(y[2], y[3]); w.z = pkbf(y[4], y[5]); w.w = pkbf(y[6], y[7]);
    *(u4*)(p.MIXb + (size_t)row * 1024 + 8 * lane) = w; }
}
__device__ __forceinline__ void f_final(const Pm& p, int gw, int ngw, int lane) {
  constexpr Dm d = DMC;
  for (int tok = gw; tok < d.BT; tok += ngw) { const int b = tok / d.T; const float* gt2 = p.modv + (size_t)b * 6144 + 5 * 1024; const float* xr = p.x1 + (size_t)tok * 1024;
    const f4 gq = *(const f4*)(p.gate + (size_t)tok * 4); const int4 sp = *(const int4*)(p.slot_pos + (size_t)tok * 4);
    const bf16_t* y0 = p.Yb + (size_t)sp.x * 1024; const bf16_t* y1 = p.Yb + (size_t)sp.y * 1024; const bf16_t* y2 = p.Yb + (size_t)sp.z * 1024; const bf16_t* y3 = p.Yb + (size_t)sp.w * 1024;
    f4 xv[4]; float ss = 0.f;
#pragma unroll
    for (int j = 0; j < 4; ++j) { const int k = 4 * lane + 256 * j; const f4 x = *(const f4*)(xr + k), g = *(const f4*)(gt2 + k);
      const u2 a = *(const u2*)(y0 + k), b2 = *(const u2*)(y1 + k), c = *(const u2*)(y2 + k), e = *(const u2*)(y3 + k);
#define BFLO(u) __builtin_bit_cast(float, (u) << 16)
#define BFHI(u) __builtin_bit_cast(float, (u) & 0xffff0000u)
      f4 f; f.x = gq.x * BFLO(a.x) + gq.y * BFLO(b2.x) + gq.z * BFLO(c.x) + gq.w * BFLO(e.x); f.y = gq.x * BFHI(a.x) + gq.y * BFHI(b2.x) + gq.z * BFHI(c.x) + gq.w * BFHI(e.x);
      f.z = gq.x * BFLO(a.y) + gq.y * BFLO(b2.y) + gq.z * BFLO(c.y) + gq.w * BFLO(e.y); f.w = gq.x * BFHI(a.y) + gq.y * BFHI(b2.y) + gq.z * BFHI(c.y) + gq.w * BFHI(e.y);
      xv[j] = x + g * f; ss += xv[j].x * xv[j].x + xv[j].y * xv[j].y + xv[j].z * xv[j].z + xv[j].w * xv[j].w; }
    const float rs = 1.f / sqrtf(wave_sum(ss) * (1.f / 1024.f) + 1e-6f);
#pragma unroll
    for (int j = 0; j < 4; ++j) { const int k = 4 * lane + 256 * j; const f4 fg = *(const f4*)(p.final_g + k); *(f4*)(p.out + (size_t)tok * 1024 + k) = xv[j] * rs * fg; }
  }
}

__device__ __forceinline__ void f_route(const Pm& p, LAS unsigned char* lds, int wave, int lane, int tidb) {
  constexpr Dm d = DMC; const int G = gridDim.x, TPB = (d.BT + G - 1) / G;
  LAS float* rwL = (LAS float*)lds; LAS int* cnt_l = (LAS int*)(lds + 1024 * 144); LAS float* lgL = (LAS float*)(lds + 1024 * 144 + 256) + wave * 256;
  for (int i = tidb; i < 1024 * 32; i += NTHREADS) { const int k = i >> 5; const int r = ((k >> 2) & 63) + 64 * ((k & 3) + 4 * (k >> 8)); rwL[r * 36 + (i & 31)] = p.router_w[i]; }
  if (tidb < 32) cnt_l[tidb] = 0;
  __syncthreads();
  const int t0 = blockIdx.x * TPB, t1 = (t0 + TPB < d.BT) ? t0 + TPB : d.BT;
  f4 xn[4];
  if (t0 + wave < t1) {
#pragma unroll
    for (int j = 0; j < 4; ++j) xn[j] = *(const f4*)(p.x1 + (size_t)(t0 + wave) * 1024 + 4 * lane + 256 * j); }
  for (int tok = t0 + wave; tok < t1; tok += NWAVES) {
    const int b = tok / d.T; const float* sh = p.modv + (size_t)b * 6144 + 3 * 1024; const float* sc = sh + 1024;
    float ss = 0.f; f4 xv[4], hv[4];
#pragma unroll
    for (int j = 0; j < 4; ++j) { xv[j] = xn[j]; ss += xv[j].x * xv[j].x + xv[j].y * xv[j].y + xv[j].z * xv[j].z + xv[j].w * xv[j].w; }
    if (tok + NWAVES < t1) {
#pragma unroll
      for (int j = 0; j < 4; ++j) xn[j] = *(const f4*)(p.x1 + (size_t)(tok + NWAVES) * 1024 + 4 * lane + 256 * j); }
    ss = wave_sum(ss);
    const float rs = 1.f / sqrtf(ss * (1.f / 1024.f) + 1e-6f);
#pragma unroll
    for (int j = 0; j < 4; ++j) { const int k = 4 * lane + 256 * j; const f4 g = *(const f4*)(p.norm2_g + k), s4 = *(const f4*)(sh + k), c4 = *(const f4*)(sc + k);
      hv[j].x = xv[j].x * rs * g.x * (1.f + c4.x) + s4.x; hv[j].y = xv[j].y * rs * g.y * (1.f + c4.y) + s4.y; hv[j].z = xv[j].z * rs * g.z * (1.f + c4.z) + s4.z; hv[j].w = xv[j].w * rs * g.w * (1.f + c4.w) + s4.w;
      u2 w; w.x = pkbf(hv[j].x, hv[j].y); w.y = pkbf(hv[j].z, hv[j].w); *(u2*)(p.H2b + (size_t)tok * 1024 + k) = w; }
    float acc[32];
#pragma unroll
    for (int e = 0; e < 32; ++e) acc[e] = 0.f;
#pragma unroll
    for (int j = 0; j < 4; ++j) {
#pragma unroll
      for (int c2 = 0; c2 < 4; c2 += 2) { f4 r4[16];
#pragma unroll
        for (int q = 0; q < 2; ++q)
#pragma unroll
          for (int c = 0; c < 8; ++c) r4[q * 8 + c] = *(const LAS f4*)(rwL + (lane + 64 * (c2 + q + 4 * j)) * 36 + 4 * c);
#pragma unroll
        for (int q = 0; q < 2; ++q) { const float h = hv[j][c2 + q];
#pragma unroll
          for (int c = 0; c < 8; ++c) { acc[4 * c] += h * r4[q * 8 + c].x; acc[4 * c + 1] += h * r4[q * 8 + c].y; acc[4 * c + 2] += h * r4[q * 8 + c].z; acc[4 * c + 3] += h * r4[q * 8 + c].w; } } } }
#define RT_STEP(N, M) { const bool up_ = (lane & (M)) != 0; _Pragma("unroll") for (int i = 0; i < (N); ++i) { const float keep_ = up_ ? acc[i + (N)] : acc[i], send_ = up_ ? acc[i] : acc[i + (N)]; acc[i] = keep_ + __shfl_xor(send_, (M)); } }
    RT_STEP(16, 32) RT_STEP(8, 16) RT_STEP(4, 8) RT_STEP(2, 4) RT_STEP(1, 2)
#undef RT_STEP
    const int e = lane >> 1; const float lg = acc[0] + __shfl_xor(acc[0], 1) + p.router_b[e];
    if ((lane & 1) == 0) lgL[((tok - t0 - wave) / NWAVES) * 32 + e] = lg;
  }
  asm volatile("s_waitcnt lgkmcnt(0)" ::: "memory");
  { const int ti = lane, tok = t0 + wave + ti * NWAVES;
    if (ti < 8 && tok < t1) { float lv[32];
#pragma unroll
      for (int c = 0; c < 8; ++c) { const f4 v4 = *(const LAS f4*)(lgL + ti * 32 + 4 * c); lv[4 * c] = v4.x; lv[4 * c + 1] = v4.y; lv[4 * c + 2] = v4.z; lv[4 * c + 3] = v4.w; }
      float tv[4]; int te[4];
#pragma unroll
      for (int kk = 0; kk < 4; ++kk) { float bv = -3e38f; int bi = 0;
#pragma unroll
        for (int q = 0; q < 32; ++q) if (lv[q] > bv) { bv = lv[q]; bi = q; }
#pragma unroll
        for (int q = 0; q < 32; ++q) if (q == bi) lv[q] = -3e38f;
        tv[kk] = bv; te[kk] = bi; }
      const float e1 = __expf(tv[1] - tv[0]), e2 = __expf(tv[2] - tv[0]), e3 = __expf(tv[3] - tv[0]), inv = 1.f / (1.f + e1 + e2 + e3);
      const float gq[4] = {inv, e1 * inv, e2 * inv, e3 * inv};
#pragma unroll
      for (int kk = 0; kk < 4; ++kk) { const int rk = atomicAdd((int*)&cnt_l[te[kk]], 1); p.top_e[(size_t)tok * 4 + kk] = te[kk]; p.gate[(size_t)tok * 4 + kk] = gq[kk]; p.lrank[(size_t)tok * 4 + kk] = rk; } } }
  __syncthreads();
  if (tidb < 32) p.blkcnt[(size_t)blockIdx.x * 32 + tidb] = cnt_l[tidb];
}
__device__ __forceinline__ void f_place(const Pm& p, LAS unsigned char* lds, int wave, int lane, int tidb) {
  constexpr Dm d = DMC; const int G = gridDim.x, TPB = (d.BT + G - 1) / G;
  LAS int* ps = (LAS int*)lds;
  LAS int* pb = ps + 512;
  LAS int* off = pb + 512;
  LAS int* base = off + 64;
  { const int e = tidb & 31, part = tidb >> 5; int sa = 0, sb = 0;
    for (int bb = part; bb < G; bb += 16) { const int c = __hip_atomic_load(p.blkcnt + (size_t)bb * 32 + e, __ATOMIC_RELAXED, __HIP_MEMORY_SCOPE_AGENT); sa += c; if (bb < (int)blockIdx.x) sb += c; }
    ps[part * 32 + e] = sa; pb[part * 32 + e] = sb; }
  __syncthreads();
  if (tidb < 32) { int sa = 0, sb = 0;
#pragma unroll
    for (int q = 0; q < 16; ++q) { sa += ps[q * 32 + tidb]; sb += pb[q * 32 + tidb]; }
    base[tidb] = sb; ps[tidb] = (sa + 255) / 256 * 256; }
  __syncthreads();
  if (tidb == 0) { int o = 0; for (int e = 0; e < 32; ++e) { off[e] = o; o += ps[e]; } off[32] = o; }
  __syncthreads();
  if (blockIdx.x == 0) { const int npos = off[32];
    for (int t = tidb; t < npos / 256; t += NTHREADS) { int e = 0; for (int q = 1; q < 32; ++q) if (t * 256 >= off[q]) e = q; p.tile_e[t] = e; }
    if (tidb == 0) p.npos[0] = npos; }
  const int t0 = blockIdx.x * TPB, t1 = (t0 + TPB < d.BT) ? t0 + TPB : d.BT;
  for (int tok = t0 + wave; tok < t1; tok += NWAVES) {
    const u4* src = (const u4*)(p.H2b + (size_t)tok * 1024) + lane * 2; const u4 a = src[0], b = src[1];
#pragma unroll
    for (int kk = 0; kk < 4; ++kk) { const int e = p.top_e[(size_t)tok * 4 + kk], rk = p.lrank[(size_t)tok * 4 + kk]; const int pos = off[e] + base[e] + rk;
      if (lane == 0) p.slot_pos[(size_t)tok * 4 + kk] = pos;
      u4* dst = (u4*)(p.Xg + (size_t)pos * 1024) + lane * 2; dst[0] = a; dst[1] = b; }
  }
}
__device__ __forceinline__ void f_rwkv_s1(const Pm& p, int gw, int ngw, int lane) {
  constexpr Dm d = DMC;
  for (int row = gw; row < d.NR; row += ngw) { int t, len, b, ic; row_pos(d, row, t, len, b, ic);
    const bf16_t* cur = p.P + (size_t)row * d.IN; const bool hp = t > 0, hn = t < len - 1; f4 ps[7];
#define S1_LD(ptr) ({ const u2 w_ = *(const u2*)(ptr); (f4){__builtin_bit_cast(float, w_.x << 16), __builtin_bit_cast(float, w_.x & 0xffff0000u), __builtin_bit_cast(float, w_.y << 16), __builtin_bit_cast(float, w_.y & 0xffff0000u)}; })
#pragma unroll
    for (int j = 0; j < 7; ++j) { const int c = 4 * lane + 256 * j; const f4 x = S1_LD(cur + c), mu = *(const f4*)(p.mu + c); f4 pr = {0.f, 0.f, 0.f, 0.f}, nx = pr;
      if (hp) pr = S1_LD(cur - d.IN + c); if (hn) nx = S1_LD(cur + d.IN + c);
      ps[j] = x + mu * (0.5f * (pr + nx) - x); }
#undef S1_LD
    const size_t o = (size_t)row * 512 + 4 * lane;
    { u2 w; w.x = pkbf(ps[0].x, ps[0].y); w.y = pkbf(ps[0].z, ps[0].w); *(u2*)(p.Rr + o) = w; w.x = pkbf(ps[1].x, ps[1].y); w.y = pkbf(ps[1].z, ps[1].w); *(u2*)(p.Rr + o + 256) = w;
      w.x = pkbf(ps[4].x, ps[4].y); w.y = pkbf(ps[4].z, ps[4].w); *(u2*)(p.Vv + o) = w; w.x = pkbf(ps[5].x, ps[5].y); w.y = pkbf(ps[5].z, ps[5].w); *(u2*)(p.Vv + o + 256) = w; }
#pragma unroll
    for (int j = 0; j < 2; ++j) { const f4 k = ps[2 + j]; const f4 kq = k * *(const f4*)(p.k_k + 4 * lane + 256 * j); float ss = kq.x * kq.x + kq.y * kq.y + kq.z * kq.z + kq.w * kq.w;
#pragma unroll
      for (int m = 1; m < 16; m <<= 1) ss += __shfl_xor(ss, m);
      const float inv = 1.f / sqrtf(fmaxf(ss, 1e-24f)); *(f4*)(p.Kraw + o + 256 * j) = k; const f4 kn = kq * inv; u2 w; w.x = pkbf(kn.x, kn.y); w.y = pkbf(kn.z, kn.w); *(u2*)(p.KK + o + 256 * j) = w; }
    const f4 x6 = ps[6];
    if (lane < 16) { u2 w; w.x = pkbf(tanhf(x6.x), tanhf(x6.y)); w.y = pkbf(tanhf(x6.z), tanhf(x6.w)); *(u2*)(p.AL1 + (size_t)row * 128 + 4 * lane) = w; }
    else if (lane < 32) { u2 w; w.x = pkbf(x6.x, x6.y); w.y = pkbf(x6.z, x6.w); *(u2*)(p.AL1 + (size_t)row * 128 + 4 * lane) = w; }
    else if (!ic) { u2 w; w.x = pkbf(sigmoidf_(x6.x), sigmoidf_(x6.y)); w.y = pkbf(sigmoidf_(x6.z), sigmoidf_(x6.w)); *(u2*)(p.AL2 + (size_t)row * 128 + 4 * (lane - 32)) = w; }
  }
}
__device__ __forceinline__ void f_lora_weights(const Pm& p, int gw, int ngw, int lane) {
  for (int it = gw; it < 48; it += ngw) { const int mat = it >> 3, nb = it & 7;
    const float* src = mat < 2 ? p.w2 + (size_t)mat * 64 * 512 : mat < 4 ? p.a2 + (size_t)(mat - 2) * 64 * 512 : p.g2 + (size_t)(mat - 4) * 64 * 512; src += nb * 64 + lane; float x[64];
#pragma unroll
    for (int j = 0; j < 64; ++j) x[j] = src[(size_t)j * 512];
    bf16_t* dst = mat < 2 ? p.WlT + (size_t)(mat * 512 + nb * 64 + lane) * 128 : mat < 4 ? p.WlT + (size_t)(1024 + (mat - 2) * 512 + nb * 64 + lane) * 128 + 64 : p.G2T + (size_t)(nb * 64 + lane) * 128 + (mat - 4) * 64;
#pragma unroll
    for (int c = 0; c < 8; ++c) { u4 o; o.x = pkbf(x[8 * c], x[8 * c + 1]); o.y = pkbf(x[8 * c + 2], x[8 * c + 3]); o.z = pkbf(x[8 * c + 4], x[8 * c + 5]); o.w = pkbf(x[8 * c + 6], x[8 * c + 7]); *(u4*)(dst + 8 * c) = o; }
    if (mat < 4) { bf16_t* z = mat < 2 ? dst + 64 : dst - 64; const u4 zz = {0u, 0u, 0u, 0u};
#pragma unroll
      for (int c = 0; c < 8; ++c) *(u4*)(z + 8 * c) = zz; } }
}
__device__ __forceinline__ float fma_s(float a, float b, float c) { float r; asm("v_fma_f32 %0, %1, %2, %3" : "=v"(r) : "v"(a), "v"(b), "v"(c)); return r; }
__device__ __forceinline__ void f_scan_a2(const Pm& p, LAS unsigned char* lds, int wave, int lane, int NSEG) {
  constexpr Dm d = DMC; constexpr int R = 6, PD = 4, SLOT = 18432; const int NB = 2 * d.B * d.RH * 8;
  for (int ub = blockIdx.x; ub < NB; ub += gridDim.x) { const int ch = ub >> 3, v0 = (ub & 7) * 8, v = v0 + wave; const float* base = p.Fend + (size_t)ch * NSEG * 128 * 64;
#define A2_ISSUE(gq) do { const float* fe_ = base + (size_t)(gq) * 128 * 64; LAS unsigned char* sl_ = lds + ((gq) % R) * SLOT; \
      __builtin_amdgcn_global_load_lds((const unsigned*)(fe_ + 64 * 64 + (wave * 2) * 256 + lane * 4), (LAS unsigned*)(sl_ + (wave * 2) * 1024), 16, 0, 0); \
      __builtin_amdgcn_global_load_lds((const unsigned*)(fe_ + 64 * 64 + (wave * 2 + 1) * 256 + lane * 4), (LAS unsigned*)(sl_ + (wave * 2 + 1) * 1024), 16, 0, 0); \
      __builtin_amdgcn_global_load_lds((const unsigned*)(fe_ + (v0 + (wave & 1) * 4) * 64 + lane * 4), (LAS unsigned*)(sl_ + 16384 + (wave & 1) * 1024), 16, 0, 0); } while (0)
    for (int g = 0; g < PD; ++g) A2_ISSUE(g);
    asm volatile("s_waitcnt vmcnt(0)" ::: "memory"); __builtin_amdgcn_s_barrier();
    float S = 0.f;
    for (int g = 0; g < NSEG; ++g) {
      if (g + PD < NSEG) A2_ISSUE(g + PD);
      p.Sst[(((size_t)ch * NSEG + g) * 64 + v) * 64 + lane] = S;
      if (g + PD < NSEG) asm volatile("s_waitcnt vmcnt(17)" ::: "memory"); else asm volatile("s_waitcnt vmcnt(0)" ::: "memory");
      __builtin_amdgcn_s_barrier();
      const LAS float* P = (const LAS float*)(lds + (g % R) * SLOT) + lane; float a0 = ((const LAS float*)(lds + (g % R) * SLOT + 16384))[wave * 64 + lane], a1 = 0.f, a2 = 0.f, a3 = 0.f;
      LAS float* srow = (LAS float*)(lds + R * SLOT) + wave * 64; srow[lane] = S;
      asm volatile("s_waitcnt lgkmcnt(0)" ::: "memory");
      float pv[64]; f4 sv[16];
#pragma unroll
      for (int i = 0; i < 64; ++i) pv[i] = P[i * 64];
#pragma unroll
      for (int i = 0; i < 16; ++i) sv[i] = *(const LAS f4*)(srow + 4 * i);
      asm volatile("s_waitcnt lgkmcnt(0)" ::: "memory");
#pragma unroll
      for (int i = 0; i < 16; ++i) { a0 = fma_s(sv[i].x, pv[4 * i], a0); a1 = fma_s(sv[i].y, pv[4 * i + 1], a1); a2 = fma_s(sv[i].z, pv[4 * i + 2], a2); a3 = fma_s(sv[i].w, pv[4 * i + 3], a3); }
      S = (a0 + a1) + (a2 + a3);
    }
#undef A2_ISSUE
    asm volatile("s_waitcnt vmcnt(0)" ::: "memory"); __builtin_amdgcn_s_barrier();
  }
}

#define SB_BF(x) __builtin_bit_cast(float, (unsigned)(x) << 16)
#ifdef HOST_EMU
#define SB_EXP2(x) exp2f(x)
#else
#define SB_EXP2(x) __builtin_amdgcn_exp2f(x)
#endif
#ifdef HOST_EMU
#define SB_BARRIER() __syncthreads()
#else
#define SB_BARRIER() do { asm volatile("s_waitcnt lgkmcnt(0)" ::: "memory"); __builtin_amdgcn_s_barrier(); } while (0)
#endif
#ifdef HOST_EMU
#define SB_OPAQUE_LANE() do {} while (0)
#define SB_WAITL() emu_wave_sync()
#else
#define SB_OPAQUE_LANE() do { int lo_ = lane; asm volatile("" : "+v"(lo_)); lane = lo_; hi = lane >> 5; l31 = lane & 31; } while (0)
#define SB_WAITL() asm volatile("s_waitcnt lgkmcnt(0)" ::: "memory")
#endif
namespace sb {
typedef short bf16x8 __attribute__((ext_vector_type(8)));
typedef float f32x16 __attribute__((ext_vector_type(16)));
constexpr int P144 = 144, P80 = 80;
constexpr int O_PM = 0, O_QM = 4608, O_KH = 9216, O_RH = 13824, O_QT = 18432, O_KT = 23552, O_VT = 28672, O_PM32 = 33792, O_WT = 33792, O_UT = 41984,
              O_AKP = 47104, O_BRQ = 49664, O_BRK = 52224, O_F = 54784, O_GL = 73216, O_CUM = 73472, O_ROW = 74496, UNIT_BYTES = 74752;
constexpr int O_MCT = O_PM, O_REFF = O_KH;
__device__ __forceinline__ int crow(int r, int hi) { return (r & 3) + 8 * (r >> 2) + 4 * hi; }
__device__ __forceinline__ bf16x8 frag(const LAS unsigned char* base, int pitch, int row0, int k0, int lane) {
  return *(const LAS bf16x8*)(base + (row0 + (lane & 31)) * pitch + (k0 + 8 * (lane >> 5)) * 2);
}
#define SB_MMA(acc, a, b) acc = __builtin_amdgcn_mfma_f32_32x32x16_bf16(a, b, acc, 0, 0, 0)
template <int KK> __device__ __forceinline__ void mma_nat(f32x16& acc, const LAS unsigned char* A, int pa, int m0, const LAS unsigned char* B, int pb, int n0, int lane) {
  bf16x8 a[KK / 16], b[KK / 16];
#pragma unroll
  for (int k = 0; k < KK / 16; ++k) { a[k] = frag(A, pa, m0, 16 * k, lane); b[k] = frag(B, pb, n0, 16 * k, lane); }
#pragma unroll
  for (int k = 0; k < KK / 16; ++k) SB_MMA(acc, a[k], b[k]);
}
#ifdef HOST_EMU
inline unsigned pkb(float lo, float hi) { return (unsigned)f2bf(lo) | ((unsigned)f2bf(hi) << 16); }
inline float fnma_sv(float s, float v, float c) { return fmaf(-s, v, c); }
inline float fnma_vv(float s, float v, float c) { return fmaf(-s, v, c); }
#else
__device__ __forceinline__ unsigned pkb(float lo, float hi) { unsigned r; asm("v_cvt_pk_bf16_f32 %0, %1, %2" : "=v"(r) : "v"(lo), "v"(hi)); return r; }
__device__ __forceinline__ float fnma_vv(float a, float v, float c) { float r; asm("v_fma_f32 %0, -%1, %2, %3" : "=v"(r) : "v"(a), "v"(v), "v"(c)); return r; }
__device__ __forceinline__ float fnma_sv(float s, float v, float c) { float r; asm("v_fma_f32 %0, -%1, %2, %3" : "=v"(r) : "s"(s), "v"(v), "v"(c)); return r; }
#endif
__device__ __forceinline__ void store_t(LAS unsigned char* T, int pitch, const f32x16& c, int cofs, int rofs, int lane) {
  LAS unsigned char* rowp = T + (cofs + (lane & 31)) * pitch + (rofs + 4 * (lane >> 5)) * 2;
#pragma unroll
  for (int g = 0; g < 4; ++g) { u2 w; w.x = pkb(c[4 * g], c[4 * g + 1]); w.y = pkb(c[4 * g + 2], c[4 * g + 3]); *(LAS u2*)(rowp + 16 * g) = w; }
}

#define SB_LOAD_CHUNK(cq) do { const int sg = sbeg + (cq) * 32 + 8 * wq + (lane >> 3); size_t row = 0; bool lat = false; const bool ok = sg < send; if (ok) chain_step(d, dd, b, sg, row, lat); \
        const size_t o = row * RW + h * 64 + (lane & 7) * 8; const u4 z4 = {0u, 0u, 0u, 0u}; \
        ld[0] = ok ? *(const u4*)(p.Wd + dd * NRW + o) : z4; ld[1] = ok ? *(const u4*)(p.KK + o) : z4; ld[2] = ok ? *(const u4*)(p.Bb + dd * NRW + o) : z4; \
        ld[3] = ok ? *(const u4*)(p.Kd + dd * NRW + o) : z4; ld[4] = ok ? *(const u4*)(p.Vv + o) : z4; ld[5] = ok ? *(const u4*)(p.Rr + o) : z4; } while (0)
#define XTR_SLOT_OK true
#ifndef HOST_EMU
__device__ __forceinline__ void xtr_item(const Pm& p, int it, int lane) {
  const int e = it / 768, r = it % 768; const bool first = r < 512; const int rr = first ? r : r - 512; const int N = first ? 2048 : 1024, nblk = N / 64, kb = rr / nblk, nb = rr % nblk;
  const float* src = (first ? p.exp_w1 + (size_t)e * 1024 * 2048 : p.exp_w2 + (size_t)e * 1024 * 1024) + (size_t)(kb * 64) * N + nb * 64 + lane; float x[64];
#pragma unroll
  for (int j = 0; j < 64; ++j) x[j] = __builtin_nontemporal_load(src + (size_t)j * N);
  bf16_t* dst = (first ? p.W1T + (size_t)e * 2048 * 1024 : p.W2T + (size_t)e * 1024 * 1024) + (size_t)(nb * 64 + lane) * 1024 + kb * 64;
#pragma unroll
  for (int c = 0; c < 8; ++c) { u4 o; o.x = pkb(x[8 * c], x[8 * c + 1]); o.y = pkb(x[8 * c + 2], x[8 * c + 3]); o.z = pkb(x[8 * c + 4], x[8 * c + 5]); o.w = pkb(x[8 * c + 6], x[8 * c + 7]); *(u4*)(dst + 8 * c) = o; }
}
#endif
__device__ __forceinline__ void f_scan_b1(const Pm& p, LAS unsigned char* lds, int wave, int lane_in, int NSEG, int xtr_first, int xtr_total) {
  int lane = lane_in;
  constexpr Dm d = DMC; constexpr int RW = 512; const int SL = (d.C + d.T) / NSEG, NCH = (SL + 31) / 32; const size_t NRW = (size_t)d.NR * RW, BTW = (size_t)d.BT * RW;
  const int NU = 2 * d.B * d.RH * NSEG; const int uq = wave >> 2, wq = wave & 3; int hi = lane >> 5, l31 = lane & 31;
  LAS unsigned char* U = lds + uq * UNIT_BYTES;
  LAS float* GL = (LAS float*)(U + O_GL); LAS float* CUM = (LAS float*)(U + O_CUM); LAS int* ROWT = (LAS int*)(U + O_ROW); LAS float* PM32 = (LAS float*)(U + O_PM32);
  int xslot = 0;
  for (int ub = blockIdx.x; ub * 2 < NU; ub += gridDim.x) { const int unit = ub * 2 + uq; const int g = unit % NSEG, ch = unit / NSEG; const int h = ch % d.RH, b = (ch / d.RH) % d.B, dd = ch / (d.RH * d.B);
    const int sbeg = g * SL, send = (g + 1) * SL;
    for (int i = wq * 64 + lane; i < 128 * 32; i += 256) { const int row = i >> 5, c2 = i & 31; unsigned v = 0u; if (row < 64 && (row >> 1) == c2) v = (row & 1) ? 0x3f800000u : 0x00003f80u; *(LAS unsigned*)(U + O_F + row * P144 + c2 * 4) = v; }
    u4 ld[6];
    SB_LOAD_CHUNK(0);
    for (int c = 0; c < NCH; ++c) { const int s0 = sbeg + c * 32;
      f32x16 R[4] = {};
#ifdef SB_PROBE_SUBST
      for (int rpe_ = 0; rpe_ < p.reps[19]; ++rpe_) {
#else
      {
#endif
      SB_OPAQUE_LANE();
      {
#pragma unroll
        for (int i = 0; i < 8; ++i) { const int sg = s0 + 8 * wq + i; size_t row = 0; bool lat = false; const bool ok = sg < send; if (ok) chain_step(d, dd, b, sg, row, lat); if (lane == i) ROWT[8 * wq + i] = (ok && lat) ? (int)row : -1; }
        float w8[8], kk8[8], bv8[8], kd8[8], v8[8], r8[8];
        { LAS unsigned char* stg = U + wq * 6144;
#pragma unroll
          for (int v = 0; v < 6; ++v) *(LAS u4*)(stg + v * 1024 + lane * 16) = ld[v];
          SB_WAITL();
#pragma unroll
          for (int i = 0; i < 8; ++i) { const LAS unsigned short* sp = (const LAS unsigned short*)(stg + i * 128) + lane;
            w8[i] = SB_EXP2(SB_BF(sp[0])); kk8[i] = SB_BF(sp[512]); bv8[i] = SB_BF(sp[1024]); kd8[i] = SB_BF(sp[1536]); v8[i] = SB_BF(sp[2048]); r8[i] = SB_BF(sp[2560]); } }
        float cp[8]; cp[0] = w8[0];
#pragma unroll
        for (int i = 1; i < 8; ++i) cp[i] = cp[i - 1] * w8[i];
        CUM[wq * 64 + lane] = cp[7];
        SB_BARRIER();
        float pre = 1.f;
#pragma unroll
        for (int q = 0; q < 3; ++q) if (q < wq) pre *= CUM[q * 64 + lane];
        unsigned qt[4], kt[4], vt[4];
#pragma unroll
        for (int i = 0; i < 8; ++i) { const int t = 8 * wq + i; const float G = pre * cp[i], Gp = i == 0 ? pre : pre * cp[i - 1], Gi = 1.f / G;
          const float pm = Gp * kk8[i], qm = bv8[i] * Gi, kh = kd8[i] * Gi, rh = G * r8[i];
          *(LAS unsigned short*)(U + O_PM + t * P144 + lane * 2) = f2bf(pm); *(LAS unsigned short*)(U + O_QM + t * P144 + lane * 2) = f2bf(qm);
          *(LAS unsigned short*)(U + O_KH + t * P144 + lane * 2) = f2bf(kh); *(LAS unsigned short*)(U + O_RH + t * P144 + lane * 2) = f2bf(rh);
          PM32[t * 64 + lane] = pm;
          if (i & 1) { qt[i >> 1] |= (unsigned)f2bf(qm) << 16; kt[i >> 1] |= (unsigned)f2bf(kh) << 16; vt[i >> 1] |= (unsigned)f2bf(v8[i]) << 16; }
          else { qt[i >> 1] = f2bf(qm); kt[i >> 1] = f2bf(kh); vt[i >> 1] = f2bf(v8[i]); }
          if (t == 31) GL[lane] = G; }
        *(LAS u4*)(U + O_QT + lane * P80 + 16 * wq) = (u4){qt[0], qt[1], qt[2], qt[3]};
        *(LAS u4*)(U + O_KT + lane * P80 + 16 * wq) = (u4){kt[0], kt[1], kt[2], kt[3]};
        *(LAS u4*)(U + O_VT + lane * P80 + 16 * wq) = (u4){vt[0], vt[1], vt[2], vt[3]}; }
      }
      if (c + 1 < NCH) SB_LOAD_CHUNK(c + 1);
      SB_BARRIER();
      SB_OPAQUE_LANE();
      if (wq < 2) { float xv[32];
        if (wq == 0) {
#pragma unroll
          for (int t = 0; t < 32; ++t) xv[t] = PM32[t * 64 + lane];
          SB_WAITL(); }
        else { f32x16 akp = {}; mma_nat<64>(akp, U + O_KH, P144, 0, U + O_PM, P144, 0, lane);
#pragma unroll
          for (int r = 0; r < 16; ++r) if (crow(r, hi) >= l31) akp[r] = 0.f;
          store_t(U + O_AKP, P80, akp, 0, 0, lane);
          SB_WAITL();
          f32x16 z0 = {}, z1 = {}; mma_nat<32>(z0, U + O_AKP, P80, 0, U + O_VT, P80, 0, lane); mma_nat<32>(z1, U + O_AKP, P80, 0, U + O_VT, P80, 32, lane);
#pragma unroll
          for (int r = 0; r < 16; ++r) { const float za_ = z0[r], zb_ = z1[r]; auto sw = __builtin_amdgcn_permlane32_swap(__builtin_bit_cast(unsigned, za_), __builtin_bit_cast(unsigned, zb_), false, false);
            const unsigned s0_ = sw[0], s1_ = sw[1]; xv[crow(r, 0)] = __builtin_bit_cast(float, s0_); xv[crow(r, 1)] = __builtin_bit_cast(float, s1_); } }
        f32x16 aqp = {}; mma_nat<64>(aqp, U + O_PM, P144, 0, U + O_QM, P144, 0, lane);
#pragma unroll
        for (int s = 0; s < 31; ++s) { const float xs = xv[s]; float as_[32];
#pragma unroll
          for (int t = s + 1; t < 32; ++t) { const int rt = (t & 3) + 4 * (t >> 3), ht = (t >> 2) & 1; const float af_ = aqp[rt]; const int av = __builtin_bit_cast(int, af_);
            as_[t] = __builtin_bit_cast(float, __builtin_amdgcn_readlane(av, s + 32 * ht)); }
#pragma unroll
          for (int t = s + 1; t < 32; ++t) xv[t] = fnma_sv(as_[t], xs, xv[t]); }
#ifdef SB_PROBE_SUBST
        for (int rep_ = 1; rep_ < p.reps[22]; ++rep_) { float xc[32];
#pragma unroll
          for (int t = 0; t < 32; ++t) xc[t] = xv[t] + (float)rep_;
#pragma unroll
          for (int s = 0; s < 31; ++s) { const float xs = xc[s]; float as_[32];
#pragma unroll
            for (int t = s + 1; t < 32; ++t) { const int rt = (t & 3) + 4 * (t >> 3), ht = (t >> 2) & 1; const float af_ = aqp[rt]; const int av = __builtin_bit_cast(int, af_); as_[t] = __builtin_bit_cast(float, __builtin_amdgcn_readlane(av, s + 32 * ht)); }
#pragma unroll
            for (int t = s + 1; t < 32; ++t) xc[t] = fnma_sv(as_[t], xs, xc[t]); }
          float sink = 0.f;
#pragma unroll
          for (int t = 0; t < 32; ++t) sink += xc[t];
          asm volatile("" :: "v"(sink)); }
#endif
        LAS unsigned char* dst = U + (wq == 0 ? O_WT : O_UT) + lane * P80;
#pragma unroll
        for (int q = 0; q < 4; ++q) *(LAS u4*)(dst + 16 * q) = (u4){pkb(xv[8 * q], xv[8 * q + 1]), pkb(xv[8 * q + 2], xv[8 * q + 3]), pkb(xv[8 * q + 4], xv[8 * q + 5]), pkb(xv[8 * q + 6], xv[8 * q + 7])};
      } else if (wq == 2) { f32x16 t0 = {}; mma_nat<64>(t0, U + O_QM, P144, 0, U + O_RH, P144, 0, lane);
#pragma unroll
        for (int r = 0; r < 16; ++r) if (crow(r, hi) > l31) t0[r] = 0.f;
        store_t(U + O_BRQ, P80, t0, 0, 0, lane);
#ifndef HOST_EMU
        { const int it = xtr_first + (xslot * 4 + uq * 2) * (int)gridDim.x + (int)blockIdx.x; if (it < xtr_total && XTR_SLOT_OK) xtr_item(p, it, lane); }
#endif
      } else { f32x16 t0 = {}; mma_nat<64>(t0, U + O_KH, P144, 0, U + O_RH, P144, 0, lane);
#pragma unroll
        for (int r = 0; r < 16; ++r) if (crow(r, hi) > l31) t0[r] = 0.f;
        store_t(U + O_BRK, P80, t0, 0, 0, lane);
        SB_WAITL();
        mma_nat<32>(R[0], U + O_BRK, P80, 0, U + O_VT, P80, 0, lane); mma_nat<32>(R[1], U + O_BRK, P80, 0, U + O_VT, P80, 32, lane);
#ifndef HOST_EMU
        { const int it = xtr_first + (xslot * 4 + uq * 2 + 1) * (int)gridDim.x + (int)blockIdx.x; if (it < xtr_total && XTR_SLOT_OK) xtr_item(p, it, lane); }
#endif
      }
      ++xslot;
      SB_BARRIER();
#ifdef SB_PROBE_SUBST
      f32x16 Rs3[4] = {R[0], R[1], R[2], R[3]};
      for (int rp3_ = 0; rp3_ < p.reps[20]; ++rp3_) { R[0] = Rs3[0]; R[1] = Rs3[1]; R[2] = Rs3[2]; R[3] = Rs3[3];
#else
      {
#endif
      SB_OPAQUE_LANE();
      if (wq == 0) {
#pragma unroll
        for (int kt2 = 0; kt2 < 2; ++kt2) { f32x16 cc = {}; mma_nat<32>(cc, U + O_WT, P80, 32 * kt2, U + O_BRQ, P80, 0, lane);
          const LAS unsigned char* rhp = U + O_RH + l31 * P144 + (32 * kt2 + 4 * hi) * 2; LAS unsigned char* rfp = U + O_REFF + l31 * P144 + (32 * kt2 + 4 * hi) * 2;
#pragma unroll
          for (int gq = 0; gq < 4; ++gq) { const u2 rh = *(const LAS u2*)(rhp + 16 * gq);
            const float a0 = __builtin_bit_cast(float, rh.x << 16) - cc[4 * gq], a1 = __builtin_bit_cast(float, rh.x & 0xffff0000u) - cc[4 * gq + 1], a2 = __builtin_bit_cast(float, rh.y << 16) - cc[4 * gq + 2], a3 = __builtin_bit_cast(float, rh.y & 0xffff0000u) - cc[4 * gq + 3];
            u2 w; w.x = pkb(a0, a1); w.y = pkb(a2, a3); *(LAS u2*)(rfp + 16 * gq) = w; } }
      } else if (wq == 1) {
#pragma unroll
        for (int jt = 0; jt < 2; ++jt)
#pragma unroll
          for (int it = 0; it < 2; ++it) { f32x16 cc = {}; mma_nat<32>(cc, U + O_WT, P80, 32 * jt, U + O_QT, P80, 32 * it, lane);
            const float gl = GL[l31 + 32 * it];
#pragma unroll
            for (int r = 0; r < 16; ++r) cc[r] = gl * (((crow(r, hi) + 32 * jt) == (l31 + 32 * it) ? 1.f : 0.f) - cc[r]);
            store_t(U + O_MCT, P144, cc, 32 * it, 32 * jt, lane); }
      } else if (wq == 2) {
#pragma unroll
        for (int it = 0; it < 2; ++it)
#pragma unroll
          for (int vt2 = 0; vt2 < 2; ++vt2) { f32x16 ca = {}, cb = {}; mma_nat<32>(ca, U + O_KT, P80, 32 * it, U + O_VT, P80, 32 * vt2, lane); mma_nat<32>(cb, U + O_QT, P80, 32 * it, U + O_UT, P80, 32 * vt2, lane);
#pragma unroll
            for (int r = 0; r < 16; ++r) ca[r] = GL[crow(r, hi) + 32 * it] * (ca[r] - cb[r]);
            R[it * 2 + vt2] = ca; }
      } else {
        f32x16 c0 = {}, c1 = {}; mma_nat<32>(c0, U + O_BRQ, P80, 0, U + O_UT, P80, 0, lane); mma_nat<32>(c1, U + O_BRQ, P80, 0, U + O_UT, P80, 32, lane); R[0] = R[0] - c0; R[1] = R[1] - c1; }
      }
      SB_BARRIER();
#ifdef SB_PROBE_SUBST
      f32x16 Rs4[4] = {R[0], R[1], R[2], R[3]};
      for (int rp4_ = 0; rp4_ < p.reps[18]; ++rp4_) { R[0] = Rs4[0]; R[1] = Rs4[1]; R[2] = Rs4[2]; R[3] = Rs4[3];
#else
      {
#endif
      SB_OPAQUE_LANE();
      if (wq == 0) {
        const int row = ROWT[l31];
#pragma unroll
        for (int jt = 0; jt < 2; ++jt) { f32x16 cc = {}; mma_nat<64>(cc, U + O_F, P144, 32 * jt, U + O_REFF, P144, 0, lane);
          if (row >= 0) { bf16_t* dst = p.Zt + dd * BTW + (size_t)row * RW + h * 64 + 32 * jt + 4 * hi;
#pragma unroll
            for (int gq = 0; gq < 4; ++gq) { u2 w; w.x = pkb(cc[4 * gq], cc[4 * gq + 1]); w.y = pkb(cc[4 * gq + 2], cc[4 * gq + 3]); *(u2*)(dst + 8 * gq) = w; } } }
      } else if (wq == 3) {
        mma_nat<64>(R[0], U + O_REFF, P144, 0, U + O_F + 64 * P144, P144, 0, lane); mma_nat<64>(R[1], U + O_REFF, P144, 0, U + O_F + 64 * P144, P144, 32, lane);
#pragma unroll
        for (int r = 0; r < 16; ++r) { const int row = ROWT[crow(r, hi)]; if (row >= 0) { float* dst = p.O2 + dd * BTW + (size_t)row * RW + h * 64 + l31; dst[0] = R[0][r]; dst[32] = R[1][r]; } }
      } else {
        const int cbase = wq == 1 ? 0 : 64;
#pragma unroll
        for (int it = 0; it < 2; ++it)
#pragma unroll
          for (int ct = 0; ct < 2; ++ct) mma_nat<64>(R[it * 2 + ct], U + O_MCT, P144, 32 * it, U + O_F + cbase * P144, P144, 32 * ct, lane); }
      }
      SB_BARRIER();
      if (wq == 1 || wq == 2) { const int cbase = wq == 1 ? 0 : 64;
#pragma unroll
        for (int it = 0; it < 2; ++it)
#pragma unroll
          for (int ct = 0; ct < 2; ++ct) store_t(U + O_F, P144, R[it * 2 + ct], cbase + 32 * ct, 32 * it, lane);
        if (c == NCH - 1) {
          float* fe = p.Fend + ((size_t)ch * NSEG + g) * 128 * 64 + (size_t)(wq == 1 ? 64 : 0) * 64;
#pragma unroll
          for (int it = 0; it < 2; ++it)
#pragma unroll
            for (int ct = 0; ct < 2; ++ct) { float* rp = fe + (size_t)(32 * ct + l31) * 64 + 32 * it + 4 * hi; const f32x16& cc = R[it * 2 + ct];
#pragma unroll
              for (int gq = 0; gq < 4; ++gq) *(f4*)(rp + 8 * gq) = (f4){cc[4 * gq], cc[4 * gq + 1], cc[4 * gq + 2], cc[4 * gq + 3]}; } } }
      SB_BARRIER();
    }
  }
}
}


template <class F> struct EpiFn {
  static constexpr bool PERM = true, AFTER_DRAIN = false; F f;
  __device__ __forceinline__ void operator()(const pg8::f32x4 (&acc)[2][2][4][2], const pg8::Unit& u, int wr, int wc, int fr, int fq) const {
#pragma unroll
    for (int ai = 0; ai < 2; ++ai)
#pragma unroll
      for (int m = 0; m < 4; ++m) { const int row = u.pm * 256 + ai * 128 + wr * 64 + m * 16 + fr;
#pragma unroll
        for (int bj = 0; bj < 2; ++bj) { const int col = u.pn * 256 + bj * 128 + wc * 32 + 8 * fq; f(u, row, col, acc[ai][bj][m][0], acc[ai][bj][m][1]); asm volatile("" ::: "memory"); } }
  }
};
template <class F> __device__ __forceinline__ void run_gemm(LAS unsigned char* lds, const bf16_t* A, const bf16_t* Bt, int M, int N, int K, F f, const int tid_in, const int* tile_e = nullptr, size_t bexp = 0) {
  asm volatile("" : "+s"(M), "+s"(N), "+s"(K));
  pg8::Gemm g{A, Bt, M, N, K, bexp}; pg8::StaticOrder S; S.init(M, N, (int)gridDim.x, (int)blockIdx.x, tile_e);
  EpiFn<F> E{f};
  pg8::gemm_phase<EpiFn<F>, pg8::StaticOrder, true, true>((PG8_LAS unsigned char*)lds, g, S, E, tid_in);
}

__device__ __forceinline__ unsigned pk2(float lo, float hi) { return (unsigned)f2bf(lo) | ((unsigned)f2bf(hi) << 16); }
__device__ __forceinline__ void transpose_all(const float* W, int K, int N, bf16_t* WT, int gw, int ngw, int lane) {
  const int nblk = N / 64, items = (K / 64) * nblk;
  for (int it = gw; it < items; it += ngw) { const int kb = it / nblk, nb = it % nblk; const float* src = W + (size_t)(kb * 64) * N + nb * 64 + lane; float x[64];
#pragma unroll
    for (int j = 0; j < 64; ++j) x[j] = src[(size_t)j * N];
    bf16_t* dst = WT + (size_t)(nb * 64 + lane) * K + kb * 64;
#pragma unroll
    for (int c = 0; c < 8; ++c) { v4u o; o.x = pk2(x[8 * c], x[8 * c + 1]); o.y = pk2(x[8 * c + 2], x[8 * c + 3]); o.z = pk2(x[8 * c + 4], x[8 * c + 5]); o.w = pk2(x[8 * c + 6], x[8 * c + 7]); *(v4u*)(dst + 8 * c) = o; } }
}

constexpr int INP = 2304;

__global__ void __launch_bounds__(NTHREADS, 2) fwd(Pm p, unsigned* bar) {
  extern __shared__ __attribute__((aligned(16))) unsigned char lds_raw[];
  LAS unsigned char* lds = (LAS unsigned char*)lds_raw;
#define IDS() int tidb; asm volatile("v_mbcnt_lo_u32_b32 %0, -1, 0\n\tv_mbcnt_hi_u32_b32 %0, -1, %0" : "=v"(tidb)); tidb += wave_s * 64; const int lane = tidb & 63, wave = __builtin_amdgcn_readfirstlane(tidb >> 6); \
    const long tid = (long)blockIdx.x * NTHREADS + tidb, nth = (long)gridDim.x * NTHREADS; const int gw = blockIdx.x * NWAVES + wave, ngw = gridDim.x * NWAVES; \
    (void)lane; (void)wave; (void)tid; (void)nth; (void)gw; (void)ngw
  for (int u = threadIdx.x; u < (LDS_BYTES - RING_BYTES) / 4; u += NTHREADS) ((LAS unsigned*)(lds + RING_BYTES))[u] = 0u;
  __syncthreads();
  const int wave_s = __builtin_amdgcn_readfirstlane((int)threadIdx.x >> 6);
  XcdBarrier xb = xcd_barrier_post(bar, (volatile LAS unsigned*)(lds + MISC_OFF + 32));
  constexpr Dm d = DMC;
#define GSYNC() xcd_barrier(xb)
  constexpr int NSEG = 16;
  const int XTR_P0 = (gridDim.x == 256) ? d.NE * 768 - 68 * 256 : d.NE * 768;
#define NPOS() __builtin_amdgcn_readfirstlane(__hip_atomic_load(p.npos, __ATOMIC_RELAXED, __HIP_MEMORY_SCOPE_AGENT))
  {
  IDS();
  for (int rep_ = 0; rep_ < 1; ++rep_) { f_mod_partial(p, tidb); f_rope_table(p, tid, nth); f_lora_weights(p, gw, ngw, lane); }
  for (int rep_ = 0; rep_ < 1; ++rep_) {
  transpose_all(p.w_in, d.D, d.IN, p.WinT, gw, ngw, lane);
  for (long i = tid; i < (long)(INP - d.IN) * d.D; i += nth) p.WinT[(size_t)d.IN * d.D + i] = 0;
  transpose_all(p.w_uq, d.QL, d.MH * d.QK, p.WuqT, gw, ngw, lane);
  transpose_all(p.w_ukv, d.KL, d.MH * (d.DN + d.DV), p.WukvT, gw, ngw, lane);
  transpose_all(p.w_out, d.MIX, d.D, p.WoutT, gw, ngw, lane); }
for (int rep_ = 0; rep_ < p.reps[17]; ++rep_) for (int it = gw; it < XTR_P0; it += ngw) { const int e = it / 768, r = it % 768; const bool first = r < 512; const int rr = first ? r : r - 512; const int N = first ? 2048 : 1024, nblk = N / 64, kb = rr / nblk, nb = rr % nblk;
    const float* src = (first ? p.exp_w1 + (size_t)e * 1024 * 2048 : p.exp_w2 + (size_t)e * 1024 * 1024) + (size_t)(kb * 64) * N + nb * 64 + lane; float x[64];
#pragma unroll
    for (int j = 0; j < 64; ++j) x[j] = __builtin_nontemporal_load(src + (size_t)j * N);
    bf16_t* dst = (first ? p.W1T + (size_t)e * 2048 * 1024 : p.W2T + (size_t)e * 1024 * 1024) + (size_t)(nb * 64 + lane) * 1024 + kb * 64;
#pragma unroll
    for (int c = 0; c < 8; ++c) { v4u o; o.x = pk2(x[8 * c], x[8 * c + 1]); o.y = pk2(x[8 * c + 2], x[8 * c + 3]); o.z = pk2(x[8 * c + 4], x[8 * c + 5]); o.w = pk2(x[8 * c + 6], x[8 * c + 7]); *(v4u*)(dst + 8 * c) = o; } }
    }
  GSYNC();
  {
  IDS();

  for (int rep_ = 0; rep_ < p.reps[16]; ++rep_) { f_mod_reduce(p, (LAS float*)lds, tidb); f_norm1(p, (const LAS float*)lds, gw, ngw, lane); }   }
  GSYNC();
  {
  IDS();

for (int rep_ = 0; rep_ < p.reps[6]; ++rep_) { bf16_t* P = p.P; const int IN = d.IN;
    run_gemm(lds, p.A1, p.WinT, d.NR, INP, d.D, [=](const pg8::Unit& u, int row, int col, pg8::f32x4 v0, pg8::f32x4 v1) {
      if (col < IN) { v4u w; w.x = pk2(v0[0], v0[1]); w.y = pk2(v0[2], v0[3]); w.z = pk2(v1[0], v1[1]); w.w = pk2(v1[2], v1[3]); *(v4u*)(P + (size_t)row * IN + col) = w; } }, tidb); }
  }
  GSYNC();
  {
  IDS();

  for (int rep_ = 0; rep_ < p.reps[11]; ++rep_) { f_mla_a(p, gw, ngw, lane); f_rwkv_s1(p, gw, ngw, lane); }   }
  GSYNC();
  {
  IDS();

for (int rep_ = 0; rep_ < p.reps[8]; ++rep_) { bf16_t* Q = p.Q; const float* ropet = p.ropet;
    run_gemm(lds, p.QN, p.WuqT, d.BT, 768, 256, [=](const pg8::Unit& u, int row, int col, pg8::f32x4 v0, pg8::f32x4 v1) {
      const int h = col / 192, i0 = col - h * 192, b = row >> 13, t = row & 8191;
      float x[8] = {v0[0], v0[1], v0[2], v0[3], v1[0], v1[1], v1[2], v1[3]}, pr[8];
#pragma unroll
      for (int e = 0; e < 8; ++e) pr[e] = __shfl_xor(x[e], 32);
      if (i0 >= 128) { const int i = i0 - 128, a = i >> 5, half = (i >> 4) & 1, f0 = i & 15; const float* ct = ropet + ROPE_IDX(t, a, f0);
#pragma unroll
        for (int e = 0; e < 8; ++e) { const float c = ct[2 * e], s = ct[2 * e + 1]; x[e] = half ? x[e] * c + pr[e] * s : x[e] * c - pr[e] * s; } }
      v4u w; w.x = pk2(x[0], x[1]); w.y = pk2(x[2], x[3]); w.z = pk2(x[4], x[5]); w.w = pk2(x[6], x[7]);
      *(v4u*)(Q + ((size_t)(b * 4 + h) * 8192 + t) * 192 + i0) = w; }, tidb); }
for (int rep_ = 0; rep_ < p.reps[9]; ++rep_) { bf16_t* K = p.K; bf16_t* V = p.V; const int BT = d.BT;
    run_gemm(lds, p.CN, p.WukvT, d.NR, 1024, 128, [=](const pg8::Unit& u, int row, int col, pg8::f32x4 v0, pg8::f32x4 v1) {
      const int h = col >> 8, i0 = col & 255; int b, key; if (row < BT) { b = row >> 13; key = 256 + (row & 8191); } else { b = (row - BT) >> 8; key = (row - BT) & 255; }
      v4u w; w.x = pk2(v0[0], v0[1]); w.y = pk2(v0[2], v0[3]); w.z = pk2(v1[0], v1[1]); w.w = pk2(v1[2], v1[3]);
      const size_t kr = (size_t)(b * 4 + h) * 8448 + key;
      if (i0 < 128) *(v4u*)(K + kr * 192 + i0) = w; else *(v4u*)(V + kr * 128 + (i0 - 128)) = w; }, tidb); }
for (int rep_ = 0; rep_ < p.reps[10]; ++rep_) { bf16_t* Wd = p.Wd; bf16_t* Bb = p.Bb; bf16_t* Kd = p.Kd; const bf16_t* KK = p.KK; const float* Kraw = p.Kraw; const float* w0 = p.w0; const float* a0 = p.a0; const float* k_a = p.k_a; const size_t NRW = (size_t)d.NR * 512;
    run_gemm(lds, p.AL1, p.WlT, d.NR, 2048, 128, [=](const pg8::Unit& u, int row, int col, pg8::f32x4 v0, pg8::f32x4 v1) {
      float x[8] = {v0[0], v0[1], v0[2], v0[3], v1[0], v1[1], v1[2], v1[3]};
      if (col < 1024) { const int dd = col >> 9, c = col & 511; const float* wb = w0 + dd * 512 + c; float o[8];
#pragma unroll
        for (int e = 0; e < 8; ++e) o[e] = -0.87503576f / (1.f + __expf(-(x[e] + wb[e])));
        v4u w; w.x = pk2(o[0], o[1]); w.y = pk2(o[2], o[3]); w.z = pk2(o[4], o[5]); w.w = pk2(o[6], o[7]); *(v4u*)(Wd + (size_t)dd * NRW + (size_t)row * 512 + c) = w; }
      else { const int q = col - 1024, dd = q >> 9, c = q & 511; const float* ab = a0 + dd * 512 + c; const v4u kk4 = *(const v4u*)(KK + (size_t)row * 512 + c); const float* kp = Kraw + (size_t)row * 512 + c; float ob[8], ok[8];
        const unsigned kw[4] = {kk4.x, kk4.y, kk4.z, kk4.w};
#pragma unroll
        for (int e = 0; e < 8; ++e) { const float a = 1.f / (1.f + __expf(-(x[e] + ab[e]))); const float kkv = __builtin_bit_cast(float, (e & 1) ? (kw[e >> 1] & 0xffff0000u) : (kw[e >> 1] << 16)); ob[e] = kkv * a; ok[e] = kp[e] * (1.f + (a - 1.f) * k_a[c + e]); }
        v4u w1; w1.x = pk2(ob[0], ob[1]); w1.y = pk2(ob[2], ob[3]); w1.z = pk2(ob[4], ob[5]); w1.w = pk2(ob[6], ob[7]); *(v4u*)(Bb + (size_t)dd * NRW + (size_t)row * 512 + c) = w1;
        v4u w2; w2.x = pk2(ok[0], ok[1]); w2.y = pk2(ok[2], ok[3]); w2.z = pk2(ok[4], ok[5]); w2.w = pk2(ok[6], ok[7]); *(v4u*)(Kd + (size_t)dd * NRW + (size_t)row * 512 + c) = w2; } }, tidb); }
  for (int rep_ = 0; rep_ < 1; ++rep_) { float* Gt = p.Gt;
    run_gemm(lds, p.AL2, p.G2T, d.BT, 512, 128, [=](const pg8::Unit& u, int row, int col, pg8::f32x4 v0, pg8::f32x4 v1) { float* o = Gt + (size_t)row * 512 + col; *(pg8::f32x4*)o = v0; *(pg8::f32x4*)(o + 4) = v1; }, tidb); }
    }
  GSYNC();
  {
  IDS();

for (int rep_ = 0; rep_ < p.reps[0]; ++rep_) sb::f_scan_b1(p, lds, wave, lane, NSEG, XTR_P0, d.NE * 768);   }
  GSYNC();
  {
  IDS();
for (int rep_ = 0; rep_ < p.reps[1]; ++rep_) f_scan_a2(p, lds, wave, lane, NSEG);   }
  GSYNC();
  {
  IDS();

for (int rep_ = 0; rep_ < p.reps[2]; ++rep_) ph_scan_a3(p, gw, ngw, lane, NSEG);
for (int rep_ = 0; rep_ < p.reps[3]; ++rep_) for (int u = blockIdx.x; u < d.B * d.MH * (d.T / 256); u += gridDim.x) { const int bh = u % (d.B * d.MH), qb = u / (d.B * d.MH), b = bh / d.MH, h = bh % d.MH; const int NK = d.C + d.T;
    attn::attn_dense_body(p.Q + ((size_t)bh * d.T + (size_t)qb * 256) * attn::DQK, p.K + (size_t)bh * NK * attn::DQK, p.V + (size_t)bh * NK * attn::DV,
                          p.MIXb + ((size_t)b * d.T + (size_t)qb * 256) * d.MIX + d.RW + h * attn::DV, NK, (char*)lds_raw, tidb); }
    }
  GSYNC();
  {
  IDS();

for (int rep_ = 0; rep_ < p.reps[15]; ++rep_) f_readout(p, gw, ngw, lane);   }
  GSYNC();
  {
  IDS();

for (int rep_ = 0; rep_ < p.reps[7]; ++rep_) { float* x1 = p.x1; const float* x = p.x; const float* modv = p.modv; const int D = d.D, T = d.T;
    run_gemm(lds, p.MIXb, p.WoutT, d.BT, D, d.MIX, [=](const pg8::Unit& u, int row, int col, pg8::f32x4 v0, pg8::f32x4 v1) {
      const float* g = modv + (size_t)(row / T) * 6 * D + 2 * D + col; const float* xr = x + (size_t)row * D + col; float* o = x1 + (size_t)row * D + col;
      const pg8::f32x4 g0 = *(const pg8::f32x4*)g, g1 = *(const pg8::f32x4*)(g + 4), x0 = *(const pg8::f32x4*)xr, x1v = *(const pg8::f32x4*)(xr + 4);
      *(pg8::f32x4*)o = x0 + g0 * v0; *(pg8::f32x4*)(o + 4) = x1v + g1 * v1; }, tidb); }
    }
  GSYNC();
  {
  IDS();

for (int rep_ = 0; rep_ < p.reps[12]; ++rep_) f_route(p, lds, wave, lane, tidb);
  }
  GSYNC();
  {
  IDS();
for (int rep_ = 0; rep_ < p.reps[13]; ++rep_) f_place(p, lds, wave, lane, tidb);
  }
  GSYNC();
  {
  IDS();
  const int npos = NPOS();
for (int rep_ = 0; rep_ < p.reps[4]; ++rep_) { bf16_t* ACT = p.ACTb; const float* b1 = p.exp_b1; const int DE = d.DE;
    run_gemm(lds, p.Xg, p.W1T, npos, 2 * d.DE, d.D, [=](const pg8::Unit& u, int row, int col, pg8::f32x4 v0, pg8::f32x4 v1) {
      const float* bb = b1 + (size_t)u.eb * 2 * DE + col; const pg8::f32x4 c0 = *(const pg8::f32x4*)bb, c1 = *(const pg8::f32x4*)(bb + 4);
      v0 = v0 + c0; v1 = v1 + c1; float o[4];
#pragma unroll
      for (int q = 0; q < 4; ++q) { const float gl = fminf(q < 2 ? v0[2 * q] : v1[2 * q - 4], 7.f), li = fminf(fmaxf(q < 2 ? v0[2 * q + 1] : v1[2 * q - 3], -7.f), 7.f);
        o[q] = gl * (li + 1.f) / (1.f + __expf(-1.702f * gl)); }
      uint2 w; w.x = pk2(o[0], o[1]); w.y = pk2(o[2], o[3]); *(uint2*)(ACT + (size_t)row * DE + (col >> 1)) = w; }, tidb, p.tile_e, (size_t)2 * d.DE * d.D * 2); }
    }
  GSYNC();
  {
  IDS();

  const int npos = NPOS();
for (int rep_ = 0; rep_ < p.reps[5]; ++rep_) { bf16_t* Y = p.Yb; const float* b2 = p.exp_b2; const int D = d.D;
    run_gemm(lds, p.ACTb, p.W2T, npos, d.D, d.DE, [=](const pg8::Unit& u, int row, int col, pg8::f32x4 v0, pg8::f32x4 v1) {
      const float* bb = b2 + (size_t)u.eb * D + col; const pg8::f32x4 c0 = *(const pg8::f32x4*)bb, c1 = *(const pg8::f32x4*)(bb + 4);
      v0 = v0 + c0; v1 = v1 + c1; v4u w; w.x = pk2(v0[0], v0[1]); w.y = pk2(v0[2], v0[3]); w.z = pk2(v1[0], v1[1]); w.w = pk2(v1[2], v1[3]);
      *(v4u*)(Y + (size_t)row * D + col) = w; }, tidb, p.tile_e, (size_t)d.D * d.DE * 2); }
    }
  GSYNC();
  {
  IDS();

for (int rep_ = 0; rep_ < p.reps[14]; ++rep_) f_final(p, gw, ngw, lane);
  for (int rep_ = 1; rep_ < p.reps[21]; ++rep_) GSYNC();
  }
}

static size_t carve(Pm& p, char* base) {
  const Dm& d = p.d; size_t off = 0;
#define CARVE(ptr, type, count) do { p.ptr = (type*)(base + off); off += (((size_t)(count) * sizeof(type)) + 255) / 256 * 256; } while (0)
  const size_t NRW = (size_t)d.NR * d.RW; const int NK = d.C + d.T;
  CARVE(modv, float, (size_t)(d.B + 1) * 6 * d.D); CARVE(modp, float, (size_t)16 * 3 * 6 * d.D); CARVE(ropet, float, (size_t)d.T * 64);
  CARVE(top_e, int, (size_t)d.BT * 4); CARVE(cnt, int, d.NE); CARVE(slot_pos, int, (size_t)d.BT * 4); CARVE(pos_tok, int, d.NPOSMAX); CARVE(tile_e, int, d.NPOSMAX / d.PADR + 1); CARVE(npos, int, 4);
  CARVE(gate, float, (size_t)d.BT * 4); CARVE(lrank, int, (size_t)d.BT * 4); CARVE(blkcnt, int, 1024 * 32);
  CARVE(WlT, bf16_t, (size_t)2048 * 128); CARVE(G2T, bf16_t, (size_t)512 * 128);
  CARVE(WinT, bf16_t, (size_t)INP * d.D); CARVE(WuqT, bf16_t, (size_t)d.MH * d.QK * d.QL); CARVE(WukvT, bf16_t, (size_t)d.MH * (d.DN + d.DV) * d.KL); CARVE(WoutT, bf16_t, (size_t)d.D * d.MIX);
  CARVE(W1T, bf16_t, (size_t)d.NE * 2 * d.DE * d.D); CARVE(W2T, bf16_t, (size_t)d.NE * d.D * d.DE);
  const size_t early0 = off;
  CARVE(P, bf16_t, (size_t)d.NR * d.IN); CARVE(A1, bf16_t, (size_t)d.NR * d.D);
  const size_t after_p = off;
  CARVE(Kraw, float, NRW); CARVE(AL1, bf16_t, (size_t)d.NR * 128); CARVE(AL2, bf16_t, (size_t)d.BT * 128); CARVE(Rr, bf16_t, NRW); CARVE(Vv, bf16_t, NRW); CARVE(KK, bf16_t, NRW); CARVE(Kd, bf16_t, 2 * NRW); CARVE(Wd, bf16_t, 2 * NRW); CARVE(Bb, bf16_t, 2 * NRW);
  CARVE(Gt, float, (size_t)d.BT * d.RW); CARVE(QN, bf16_t, (size_t)d.BT * d.QL); CARVE(CN, bf16_t, (size_t)d.NR * d.KL);
  CARVE(O2, float, (size_t)2 * d.BT * d.RW);
  CARVE(Q, bf16_t, (size_t)d.B * d.MH * d.T * d.QK); CARVE(K, bf16_t, (size_t)d.B * d.MH * NK * d.QK); CARVE(V, bf16_t, (size_t)d.B * d.MH * NK * d.DV);
  CARVE(MIXb, bf16_t, (size_t)d.BT * d.MIX);
  size_t end1 = off;
  off = early0; CARVE(x1, float, (size_t)d.BT * d.D); CARVE(H2b, bf16_t, (size_t)d.BT * d.D);
  if (off > after_p) return (size_t)-1;
  off = after_p; CARVE(Xg, bf16_t, (size_t)d.NPOSMAX * d.D); CARVE(ACTb, bf16_t, (size_t)d.NPOSMAX * d.DE); CARVE(Yb, bf16_t, (size_t)d.NPOSMAX * d.D);
  if (off > end1) end1 = off;
  off = end1; CARVE(Zt, bf16_t, (size_t)2 * d.BT * d.RW); CARVE(Fend, float, (size_t)2 * d.B * d.RH * 32 * 128 * 64); CARVE(Sst, float, (size_t)2 * d.B * d.RH * 32 * 64 * 64); end1 = off;
#undef CARVE
  return end1;
}

extern "C" void kernel_launch(void* const* d_in, const int* in_sizes, int n_in, void* d_out, int out_size, void* d_ws, size_t ws_size, hipStream_t stream) {
  static int grid = 0;
  if (!grid) {
    int dev = 0, cus = 0;
    hipGetDevice(&dev); hipDeviceGetAttribute(&cus, hipDeviceAttributeMultiprocessorCount, dev);
    if (hipFuncSetAttribute((const void*)fwd, hipFuncAttributeMaxDynamicSharedMemorySize, LDS_BYTES) != hipSuccess) { fprintf(stderr, "kernel_launch: hipFuncSetAttribute failed\n"); grid = -1; return; }
    grid = cus;
  }
  if (grid < 0) return;
  Pm p; memset(&p, 0, sizeof(p));
  Dm& d = p.d; d.D = 1024; d.B = 2; d.T = 8192; d.GW = 64; d.C = 256; d.RH = 8; d.LW = 64; d.LA = 64; d.LG = 128; d.MH = 4; d.DN = 128; d.DR = 64; d.DV = 128; d.QL = 256; d.KL = 128;
  d.NE = 32; d.DE = 1024; d.PADR = 256; dm_finish(d);
  const float** ip = &p.x; for (int i = 0; i < 32; ++i) ip[i] = (const float*)d_in[i];
  p.out = (float*)d_out;
  unsigned* bar = (unsigned*)d_ws;
  const size_t used = carve(p, (char*)d_ws + 16384);
  if (used == (size_t)-1 || used + 16384 > ws_size) { fprintf(stderr, "kernel_launch: workspace too small (%zu needed, %zu given)\n", used + 16384, ws_size); return; }
  static bool once = false; if (!once) { once = true; fprintf(stderr, "ws used %zu of %zu\n", used + 16384, ws_size); }
  for (int i = 0; i < 24; ++i) p.reps[i] = 1;
  p.reps[23] = 1;
  hipMemsetAsync(bar, 0, 16384, stream);
  hipLaunchKernelGGL(fwd, dim3(grid), dim3(NTHREADS), LDS_BYTES, stream, p, bar);
}
```
